# Optimizing an MI355X kernel written in HIP

```python
import math
import jax, jax.numpy as jnp
from jax import lax
import numpy as np

D_MODEL = 1024
BATCH = 32
SEQ = 256
DEPTH = 4
DEC_BATCH = 8
DEC_SEQ = 4096
PAST_LEN = 512

GRID_W = 64
POS_BASE = 10000.0
W_A = 256
H_A = 4
DK = 64
DV = 64
CONV_W = 4
DN_CHUNK = 64
W_B = 256
G_B = 4
SGU_CHUNK = 128
W_C = 256
POOL_WINDOWS = (2, 4, 8, 16)
C_C = 64
W_D = 256
G_D = 4
C_D = 64
MIX_W = W_A + W_B + W_C + W_D
SPLIT_SIZES = (3 * W_A, W_A, 2 * H_A, 2 * H_A, 2 * W_B, W_B, W_C, W_C, W_D, W_D)
P_IN = 3 * W_A + W_A + 4 * H_A + 3 * W_B + 2 * W_C + 2 * W_D
EPS = 1e-6

kernel_name = "hybrid_delta_sgu_pool_fourier_dit_step"


def _split_points():
    return [int(i) for i in np.cumsum(SPLIT_SIZES)[:-1]]


def rmsnorm(x, g):
    xf = x.astype(jnp.float32)
    y = xf * lax.rsqrt(jnp.mean(xf * xf, axis=-1, keepdims=True) + EPS)
    return y.astype(x.dtype) * g


def l2norm(x):
    xf = x.astype(jnp.float32)
    return xf * lax.rsqrt(jnp.sum(xf * xf, axis=-1, keepdims=True) + EPS)


def grid_pos_embed(T, dtype):
    rows = T // GRID_W
    r = jnp.repeat(jnp.arange(rows, dtype=jnp.float32), GRID_W)
    col = jnp.tile(jnp.arange(GRID_W, dtype=jnp.float32), rows)
    n_freq = D_MODEL // 4
    freqs = jnp.power(POS_BASE, -jnp.arange(n_freq, dtype=jnp.float32) / n_freq)
    ar = r[:, None] * freqs[None]
    ac = col[:, None] * freqs[None]
    return jnp.concatenate([jnp.sin(ar), jnp.cos(ar), jnp.sin(ac), jnp.cos(ac)], axis=-1).astype(dtype)


def short_conv(x, w):
    C = x.shape[-1]
    pad = (CONV_W // 2, CONV_W - 1 - CONV_W // 2)
    return lax.conv_general_dilated(x, w[:, None, :].astype(x.dtype), window_strides=(1,), padding=[pad],
                                    dimension_numbers=("NWC", "WIO", "NWC"), feature_group_count=C)


def chunk_delta_rule(q, k, v, beta, g, S0):
    B, T, H, _ = q.shape
    N = T // DN_CHUNK
    f32 = jnp.float32

    def chunks(a):
        a = a.astype(f32).reshape((B, N, DN_CHUNK) + a.shape[2:])
        return jnp.moveaxis(a, (1, 3), (0, 2))

    qc, kc, vc, bc, gc = chunks(q), chunks(k), chunks(v), chunks(beta), chunks(g)
    gcum = jnp.cumsum(gc, axis=-1)
    idx = jnp.arange(DN_CHUNK)
    incl = idx[:, None] >= idx[None, :]
    strict = idx[:, None] > idx[None, :]
    diff = gcum[..., :, None] - gcum[..., None, :]
    decay_mat = jnp.where(incl, jnp.exp(jnp.where(incl, diff, 0.0)), 0.0)
    kb = kc * bc[..., None]
    A = jnp.where(strict, jnp.einsum("nbhid,nbhjd->nbhij", kb, kc) * decay_mat, 0.0)
    eye = jnp.eye(DN_CHUNK, dtype=f32)
    Tinv = lax.linalg.triangular_solve(eye + A, jnp.broadcast_to(eye, A.shape), left_side=True, lower=True)
    u = jnp.einsum("nbhij,nbhje->nbhie", Tinv, vc * bc[..., None])
    w = jnp.einsum("nbhij,nbhjd->nbhid", Tinv, kb * jnp.exp(gcum)[..., None])
    qk = jnp.einsum("nbhid,nbhjd->nbhij", qc, kc) * decay_mat
    q_dec = qc * jnp.exp(gcum)[..., None]
    k_dec = kc * jnp.exp(gcum[..., -1:] - gcum)[..., None]
    g_last = jnp.exp(gcum[..., -1])

    def step(S, xs):
        q_i, k_i, u_i, w_i, qk_i, gl_i = xs
        v_new = u_i - jnp.einsum("bhcd,bhde->bhce", w_i, S)
        o_i = jnp.einsum("bhcd,bhde->bhce", q_i, S) + jnp.einsum("bhij,bhje->bhie", qk_i, v_new)
        S = S * gl_i[..., None, None] + jnp.einsum("bhcd,bhce->bhde", k_i, v_new)
        return S, o_i

    S_fin, o = lax.scan(step, S0.astype(f32), (q_dec, k_dec, u, w, qk, g_last))
    o = jnp.moveaxis(o, (0, 2), (1, 3)).reshape(B, T, H, o.shape[-1])
    return o.astype(q.dtype), S_fin.astype(q.dtype)


def deltanet_branch(qkv, g_gate, beta_logit, a_logit, S0, conv_qkv, a_log, dt_bias, dn_norm_g):
    B, T, _ = qkv.shape
    qkv = jax.nn.silu(short_conv(qkv, conv_qkv))
    q, k, v = jnp.split(qkv, 3, axis=-1)
    q = (l2norm(q.reshape(B, T, H_A, DK)) * (DK ** -0.5)).astype(qkv.dtype)
    k = l2norm(k.reshape(B, T, H_A, DK)).astype(qkv.dtype)
    v = v.reshape(B, T, H_A, DV)
    beta = jax.nn.sigmoid(beta_logit.reshape(B, T, 2, H_A))
    g = -jnp.exp(a_log.astype(jnp.float32)) * jax.nn.softplus(
        a_logit.reshape(B, T, 2, H_A).astype(jnp.float32) + dt_bias.astype(jnp.float32))
    o_f, S_f = chunk_delta_rule(q, k, v, beta[:, :, 0], g[:, :, 0], S0[:, 0])
    o_b, S_b = chunk_delta_rule(q[:, ::-1], k[:, ::-1], v[:, ::-1], beta[:, ::-1, 1], g[:, ::-1, 1], S0[:, 1])
    o = rmsnorm(o_f + o_b[:, ::-1], dn_norm_g)
    y = o.reshape(B, T, W_A) * jax.nn.silu(g_gate)
    return y, jnp.stack([S_f, S_b], axis=1)


def sgu_branch(uv, g_gate, sgu_norm_g, sgu_w, sgu_b):
    B, T, _ = uv.shape
    N = T // SGU_CHUNK
    u, v = jnp.split(jax.nn.gelu(uv), 2, axis=-1)
    v = rmsnorm(v, sgu_norm_g).reshape(B, N, SGU_CHUNK, G_B, W_B // G_B)
    sv = jnp.einsum("gpq,bnqgc->bnpgc", sgu_w, v) + sgu_b.T[None, None, :, :, None]
    return u * sv.reshape(B, T, W_B) * jax.nn.silu(g_gate)


def pool_branch(x_c, g_gate, pool_w, pool_scale):
    B, T, _ = x_c.shape
    xg = x_c.reshape(B, T, len(POOL_WINDOWS), C_C)
    cs = jnp.concatenate([jnp.zeros((B, 1, len(POOL_WINDOWS), C_C), jnp.float32),
                          jnp.cumsum(xg.astype(jnp.float32), axis=1)], axis=1)
    t = jnp.arange(T)
    means = []
    for gi, wsize in enumerate(POOL_WINDOWS):
        lo = jnp.clip(t - wsize // 2, 0, T)
        hi = jnp.clip(t + wsize - wsize // 2, 0, T)
        cs_g = cs[:, :, gi]
        means.append((cs_g[:, hi] - cs_g[:, lo]) / (hi - lo).astype(jnp.float32)[None, :, None])
    pooled = (jnp.stack(means, axis=2) - xg.astype(jnp.float32)).astype(x_c.dtype)
    y = jnp.einsum("btgc,gcd->btgd", pooled, pool_w).reshape(B, T, W_C)
    return y * pool_scale * jax.nn.silu(g_gate)


def fourier_branch(x_d, g_gate, fourier_w):
    B, T, _ = x_d.shape
    xg = x_d.reshape(B, T, G_D, C_D).astype(jnp.float32)
    f = jnp.fft.fftn(xg, axes=(1, 3), norm="ortho").real.astype(x_d.dtype)
    y = jnp.einsum("btgc,gcd->btgd", f, fourier_w).reshape(B, T, W_D)
    return y * jax.nn.silu(g_gate)


def trunk_layer(x, cond, S0, ada_w, ada_b, norm_g, w_in, conv_qkv, a_log, dt_bias, dn_norm_g,
                sgu_norm_g, sgu_w, sgu_b, pool_w, pool_scale, fourier_w, w_out):
    mod = jax.nn.silu(cond) @ ada_w + ada_b
    shift, scale, gate = jnp.split(mod, 3, axis=-1)
    h = rmsnorm(x, norm_g) * (1 + scale[:, None]) + shift[:, None]
    p = h @ w_in
    qkv, g_a, beta_logit, a_logit, uv, g_b, x_c, g_c, x_d, g_d = jnp.split(p, _split_points(), axis=-1)
    y_a, S_new = deltanet_branch(qkv, g_a, beta_logit, a_logit, S0, conv_qkv, a_log, dt_bias, dn_norm_g)
    y_b = sgu_branch(uv, g_b, sgu_norm_g, sgu_w, sgu_b)
    y_c = pool_branch(x_c, g_c, pool_w, pool_scale)
    y_d = fourier_branch(x_d, g_d, fourier_w)
    out = jnp.concatenate([y_a, y_b, y_c, y_d], axis=-1) @ w_out
    return x + gate[:, None] * out, S_new


def setup_inputs(seed: int = 0) -> dict:
    key = jax.random.key(seed)
    ks = jax.random.split(key, 24)
    f32 = jnp.float32

    def nrm(k, shape, s):
        return s * jax.random.normal(k, shape, f32)

    dt = jnp.exp(jax.random.uniform(ks[10], (DEPTH, 2, H_A), f32, minval=math.log(1e-3), maxval=math.log(1e-1)))
    return {
        "x_prompt": nrm(ks[0], (BATCH, SEQ, D_MODEL), 1.0),
        "x_sample": nrm(ks[1], (DEC_BATCH, DEC_SEQ, D_MODEL), 1.0),
        "state_delta": nrm(ks[2], (DEC_BATCH, DEPTH, 2, H_A, DK, DV), 1.0),
        "c": nrm(ks[3], (DEC_BATCH, D_MODEL), 1.0),
        "c_ctx": nrm(ks[4], (D_MODEL,), 1.0),
        "ada_w": nrm(ks[5], (DEPTH, D_MODEL, 3 * D_MODEL), 0.5 * D_MODEL ** -0.5),
        "ada_b": nrm(ks[6], (DEPTH, 3 * D_MODEL), 0.02),
        "norm_g": 1.0 + nrm(ks[7], (DEPTH, D_MODEL), 0.02),
        "w_in": nrm(ks[8], (DEPTH, D_MODEL, P_IN), D_MODEL ** -0.5),
        "conv_qkv": nrm(ks[9], (DEPTH, CONV_W, 3 * W_A), CONV_W ** -0.5),
        "a_log": jnp.log(jax.random.uniform(ks[11], (DEPTH, 2, H_A), f32, minval=1.0, maxval=16.0)),
        "dt_bias": dt + jnp.log(-jnp.expm1(-dt)),
        "dn_norm_g": 1.0 + nrm(ks[12], (DEPTH, DV), 0.02),
        "sgu_norm_g": 1.0 + nrm(ks[13], (DEPTH, W_B), 0.02),
        "sgu_w": nrm(ks[14], (DEPTH, G_B, SGU_CHUNK, SGU_CHUNK), SGU_CHUNK ** -0.5),
        "sgu_b": 1.0 + nrm(ks[15], (DEPTH, G_B, SGU_CHUNK), 0.02),
        "pool_w": nrm(ks[16], (DEPTH, len(POOL_WINDOWS), C_C, C_C), C_C ** -0.5),
        "pool_scale": 1.0 + nrm(ks[17], (DEPTH, W_C), 0.02),
        "fourier_w": nrm(ks[18], (DEPTH, G_D, C_D, C_D), C_D ** -0.5),
        "w_out": nrm(ks[19], (DEPTH, MIX_W, D_MODEL), MIX_W ** -0.5),
        "final_norm_g": 1.0 + nrm(ks[20], (D_MODEL,), 0.02),
    }


def reference(x_prompt, x_sample, state_delta, c, c_ctx, ada_w, ada_b, norm_g, w_in, conv_qkv, a_log, dt_bias,
              dn_norm_g, sgu_norm_g, sgu_w, sgu_b, pool_w, pool_scale, fourier_w, w_out, final_norm_g):
    per_layer = [dict(ada_w=ada_w[l], ada_b=ada_b[l], norm_g=norm_g[l], w_in=w_in[l], conv_qkv=conv_qkv[l],
                      a_log=a_log[l], dt_bias=dt_bias[l], dn_norm_g=dn_norm_g[l], sgu_norm_g=sgu_norm_g[l],
                      sgu_w=sgu_w[l], sgu_b=sgu_b[l], pool_w=pool_w[l], pool_scale=pool_scale[l],
                      fourier_w=fourier_w[l], w_out=w_out[l]) for l in range(DEPTH)]

    bp = x_prompt.shape[0]
    cond_ctx = jnp.broadcast_to(c_ctx, (bp, D_MODEL))
    xp = x_prompt
    ctx_states = []
    for l in range(DEPTH):
        S0 = jnp.zeros((bp, 2, H_A, DK, DV), x_prompt.dtype)
        xp, S_l = trunk_layer(xp, cond_ctx, S0, **per_layer[l])
        ctx_states.append(S_l)
    y_prompt = rmsnorm(xp, final_norm_g)
    new_state_delta = jnp.stack(ctx_states, axis=1)

    xs = x_sample + grid_pos_embed(x_sample.shape[1], x_sample.dtype)[None]
    for l in range(DEPTH):
        xs, _ = trunk_layer(xs, c, state_delta[:, l], **per_layer[l])
    y_sample = rmsnorm(xs, final_norm_g)
    return (y_prompt, y_sample, new_state_delta)
```

```cpp
#include <hip/hip_runtime.h>
#include <cstdio>
#include <cstdint>

#ifndef MK_MULTI
#define MK_MULTI 0
#endif
#ifndef NAIVE_MM
#define NAIVE_MM 0
#endif
#ifndef ONLY
#define ONLY -1
#endif
#define EN(k) (ONLY < 0 || ONLY == (k))

#define LAS __attribute__((address_space(3)))
#define GAS __attribute__((address_space(1)))
typedef unsigned short bf16;
typedef short bf16x8 __attribute__((ext_vector_type(8)));
typedef float f32x4 __attribute__((ext_vector_type(4)));
typedef float f32x2 __attribute__((ext_vector_type(2)));
typedef unsigned u32x4 __attribute__((ext_vector_type(4)));
typedef unsigned u32x2 __attribute__((ext_vector_type(2)));

constexpr int D = 1024, NL = 4, NCOND = 9;
constexpr int M_CTX = 8192, M = 40960;
constexpr int PIN = 2832;
constexpr int N1 = 3328, LDP = 3072;
constexpr float EPS = 1e-6f;
constexpr int C_GA = 0, C_U = 256, C_GC = 512, C_GD = 768, C_V = 1024, C_GB = 1280, C_XC = 1536, C_PF = 1792, C_QF = 2048, C_Q = 2304, C_K = 2560, C_VV = 2816;

constexpr size_t MiB = 1u << 20;
constexpr size_t WS_CTL = 0, CTL_ZERO_BYTES = 1 * MiB;
constexpr size_t WS_MOD = 1 * MiB;
constexpr size_t WS_SW = WS_MOD + 512 * 1024;
constexpr size_t WS_GMAT = 2 * MiB;
constexpr size_t WS_POS = WS_GMAT + 512 * 1024;
constexpr size_t WS_DFT = WS_POS + 256 * 1024;
constexpr size_t WS_M1 = 3 * MiB;
constexpr size_t WS_M2 = WS_M1 + 32 * 1024;
constexpr size_t WS_TW = WS_M1 + 64 * 1024;
constexpr size_t WS_W1T = 4 * MiB;
constexpr size_t WS_W2T = 30 * MiB;
constexpr size_t WS_BA = 38 * MiB;
constexpr size_t WS_RSS = 41 * MiB;
constexpr size_t WS_HB = 44 * MiB;
constexpr size_t WS_PB = 124 * MiB;
constexpr size_t WS_PQK = 364 * MiB;
constexpr size_t WS_PUW = 404 * MiB;
constexpr size_t WS_PGC = 484 * MiB;
constexpr size_t WS_END = 486 * MiB;
constexpr int CW_BAR = 4096;

constexpr int LDS_BYTES = 147456;
constexpr int MISC_OFF = 144 * 1024 - 256;
constexpr int NWAVES = 8, NTHR = 512;

__device__ __forceinline__ unsigned f2bf(float f) { unsigned u = __builtin_bit_cast(unsigned, f); return (u + 0x7fffu + ((u >> 16) & 1u)) >> 16; }
__device__ __forceinline__ float bf2f(unsigned b) { return __builtin_bit_cast(float, (b & 0xffffu) << 16); }
__device__ __forceinline__ unsigned pk2(float lo, float hi) { return f2bf(lo) | (f2bf(hi) << 16); }
__device__ __forceinline__ float bflo(unsigned w) { return __builtin_bit_cast(float, w << 16); }
__device__ __forceinline__ float bfhi(unsigned w) { return __builtin_bit_cast(float, w & 0xffff0000u); }
__device__ __forceinline__ float silu_f(float x) { return x / (1.f + __expf(-x)); }
__device__ __forceinline__ float gelu_tanh_f(float x) { const float z = 1.5957691216057308f * (x + 0.044715f * x * x * x); return x / (1.f + __expf(-z)); }
__device__ __forceinline__ float wave_sum(float v) {
#pragma unroll
    for (int o = 1; o < 64; o <<= 1) v += __shfl_xor(v, o);
    return v;
}
__device__ __forceinline__ int otid() { int t = threadIdx.x; asm volatile("" : "+v"(t)); return t; }
__device__ __forceinline__ int obid() { int b = blockIdx.x; asm volatile("" : "+s"(b)); return b; }
#define LDS_WAIT() asm volatile("s_waitcnt lgkmcnt(0)" ::: "memory")

namespace pg8 {
constexpr int BM = 256, BK = 64, HALF = 128, HTB = HALF * BK * 2, STAGE_BYTES = 8 * HTB, NXCD = 8, WGM = 8;
__host__ __device__ __forceinline__ int lds_byte(int r, int c) { const int st = (r >> 4) * 2 + (c >> 5), rr = r & 15, cc = c & 31, ob = rr * 64 + cc * 2; return st * 1024 + (ob ^ (((ob >> 9) & 1) << 5)); }
__host__ __device__ __forceinline__ void stage_rc(int b, int& R, int& C) { const int st = b / 1024, sb = b % 1024, swz = sb ^ (((sb >> 9) & 1) << 5); R = (st >> 1) * 16 + swz / 64; C = (st & 1) * 32 + (swz % 64) / 2; }
__host__ __device__ __forceinline__ int perm32(int rho) { const int n = rho >> 4, i = rho & 15; return 8 * (i >> 2) + 4 * n + (i & 3); }

struct Unit { int pm, pn; };
struct Gemm { const bf16* A; const bf16* Bt; int M, N, K, lda; };

struct StaticOrder {
    int nM, nN, nwg, G, c;
    __host__ __device__ void init(int M_, int N_, int G_, int c_) { nM = M_ / BM; nN = N_ / BM; nwg = nM * nN; G = G_; c = c_; }
    __host__ __device__ bool next(int i, Unit& u) const {
        const long L = (long)i * G + c; if (L >= nwg) return false;
        int wgid = (int)L; { const int q = nwg / NXCD, r = nwg % NXCD, xcd = wgid % NXCD, off = wgid / NXCD; wgid = (xcd < r ? xcd * (q + 1) : r * (q + 1) + (xcd - r) * q) + off; }
        const int nig = WGM * nN, gid = wgid / nig, fm = gid * WGM, gsz = (nM - fm) < WGM ? (nM - fm) : WGM;
        u.pm = fm + ((wgid % nig) % gsz); u.pn = (wgid % nig) / gsz; return true;
    }
};

template <class Epi>
__device__ __forceinline__ void gemm_phase(LAS unsigned char* lds, const Gemm g, const StaticOrder& S, const Epi& E) {
    const int tid = otid(), wid = __builtin_amdgcn_readfirstlane(tid >> 6), lane = tid & 63, wr = wid >> 2, wc = wid & 3, fr = lane & 15, fq = lane >> 4;
    const int K = g.K, nt = K / BK, lda = g.lda;
    unsigned voffA[2], voffB[2];
#pragma unroll
    for (int i = 0; i < 2; ++i) { int R, C; stage_rc(tid * 16 + i * 8192, R, C); const int Rb = Epi::PERM ? ((R & ~31) + perm32(R & 31)) : R;
        voffA[i] = (unsigned)(R * lda + C) * 2u; voffB[i] = (unsigned)(Rb * K + C) * 2u; }
    const size_t kstep = (size_t)(BK * 2);
    const size_t hstepA = (size_t)HALF * lda * 2, hstepB = (size_t)HALF * K * 2;
    const size_t tstepA = 2 * hstepA, tstepB = 2 * hstepB;
    const unsigned ldsw = (unsigned)wid * 1024u;
    const int aoff = lds_byte(wr * 64 + fr, fq * 8), boff = lds_byte(wc * 32 + fr, fq * 8);
#define PG8_SA(b, h) (((b) * 2 + (h)) * HTB)
#define PG8_SB(b, h) ((4 + (b) * 2 + (h)) * HTB)
#define PG8_STAGE(bufoff, gbase, voff) do { _Pragma("unroll") for (int _i = 0; _i < 2; ++_i) \
        __builtin_amdgcn_global_load_lds((const unsigned*)((const char*)(gbase) + (voff)[_i]), (LAS unsigned*)(lds + (bufoff) + ldsw + _i * 8192), 16, 0, 0); } while (0)
#define PG8_LDA(dst, b, h) do { _Pragma("unroll") for (int m = 0; m < 4; ++m) _Pragma("unroll") for (int k = 0; k < 2; ++k) dst[m][k] = *(const LAS bf16x8*)(lds + PG8_SA(b, h) + aoff + m * 2048 + k * 1024); } while (0)
#define PG8_LDB(dst, b, h) do { _Pragma("unroll") for (int n = 0; n < 2; ++n) _Pragma("unroll") for (int k = 0; k < 2; ++k) dst[n][k] = *(const LAS bf16x8*)(lds + PG8_SB(b, h) + boff + n * 2048 + k * 1024); } while (0)
#define PG8_MMA(ai, bj, At, Bt) do { __builtin_amdgcn_s_setprio(1); _Pragma("unroll") for (int m = 0; m < 4; ++m) _Pragma("unroll") for (int n = 0; n < 2; ++n) _Pragma("unroll") for (int k = 0; k < 2; ++k) \
        acc[ai][bj][m][n] = __builtin_amdgcn_mfma_f32_16x16x32_bf16(Bt[n][k], At[m][k], acc[ai][bj][m][n], 0, 0, 0); __builtin_amdgcn_s_setprio(0); } while (0)
#define PG8_WAIT_V(n) asm volatile("s_waitcnt vmcnt(" #n ")" ::: "memory")
#define PG8_WAIT_L(n) asm volatile("s_waitcnt lgkmcnt(" #n ")" ::: "memory")
#define PG8_BAR __builtin_amdgcn_s_barrier()
#define PG8_SCHED __builtin_amdgcn_sched_barrier(0)
    Unit cur, nxt; int ui = 0;
    if (!S.next(0, cur)) return;
    f32x4 acc[2][2][4][2];
#pragma unroll
    for (int a = 0; a < 2; ++a)
#pragma unroll
        for (int b = 0; b < 2; ++b)
#pragma unroll
            for (int m = 0; m < 4; ++m)
#pragma unroll
                for (int n = 0; n < 2; ++n) acc[a][b][m][n] = (f32x4){0.f, 0.f, 0.f, 0.f};
    bf16x8 At[4][2], B0[2][2], B1[2][2];
    const char* cA = (const char*)g.A + (size_t)cur.pm * tstepA; const char* cB = (const char*)g.Bt + (size_t)cur.pn * tstepB;
    PG8_STAGE(PG8_SB(0, 0), cB, voffB); PG8_STAGE(PG8_SA(0, 0), cA, voffA); PG8_STAGE(PG8_SB(0, 1), cB + hstepB, voffB); PG8_STAGE(PG8_SA(0, 1), cA + hstepA, voffA);
    if (wr == 1) PG8_BAR;
    PG8_WAIT_V(4); PG8_BAR;
    PG8_STAGE(PG8_SB(1, 0), cB + kstep, voffB); PG8_STAGE(PG8_SA(1, 0), cA + kstep, voffA); PG8_STAGE(PG8_SB(1, 1), cB + hstepB + kstep, voffB);
    PG8_WAIT_V(6); PG8_BAR;
    for (;;) {
        const bool has_next = S.next(ui + 1, nxt);
        const char* nA = has_next ? (const char*)g.A + (size_t)nxt.pm * tstepA : cA; const char* nB = has_next ? (const char*)g.Bt + (size_t)nxt.pn * tstepB : cB;
        for (int t = 0; t < nt; t += 2) {
            const bool last = (t == nt - 2);
            const char* a1 = cA + (size_t)(t + 1) * kstep;
            const char* a2 = last ? nA : cA + (size_t)(t + 2) * kstep; const char* b2 = last ? nB : cB + (size_t)(t + 2) * kstep;
            const char* a3 = a2 + kstep; const char* b3 = b2 + kstep;
            PG8_LDB(B0, 0, 0); PG8_SCHED; PG8_LDA(At, 0, 0); PG8_STAGE(PG8_SA(1, 1), a1 + hstepA, voffA);
            PG8_WAIT_L(8); PG8_BAR; PG8_WAIT_L(0); PG8_MMA(0, 0, At, B0); PG8_BAR; PG8_SCHED;
            PG8_LDB(B1, 0, 1); PG8_STAGE(PG8_SB(0, 0), b2, voffB);
            PG8_BAR; PG8_WAIT_L(0); PG8_MMA(0, 1, At, B1); PG8_BAR;
            PG8_LDA(At, 0, 1); PG8_STAGE(PG8_SA(0, 0), a2, voffA);
            PG8_BAR; PG8_WAIT_L(0); PG8_MMA(1, 0, At, B0); PG8_BAR; PG8_SCHED;
            PG8_STAGE(PG8_SB(0, 1), b2 + hstepB, voffB);
            PG8_WAIT_V(6); PG8_BAR; PG8_MMA(1, 1, At, B1); PG8_BAR;
            PG8_LDB(B0, 1, 0); PG8_SCHED; PG8_LDA(At, 1, 0); PG8_STAGE(PG8_SA(0, 1), a2 + hstepA, voffA);
            PG8_WAIT_L(8); PG8_BAR; PG8_WAIT_L(0); PG8_MMA(0, 0, At, B0); PG8_BAR; PG8_SCHED;
            PG8_LDB(B1, 1, 1); PG8_STAGE(PG8_SB(1, 0), b3, voffB);
            PG8_BAR; PG8_WAIT_L(0); PG8_MMA(0, 1, At, B1); PG8_BAR;
            PG8_LDA(At, 1, 1); PG8_STAGE(PG8_SA(1, 0), a3, voffA);
            PG8_BAR; PG8_WAIT_L(0); PG8_MMA(1, 0, At, B0); PG8_BAR; PG8_SCHED;
            PG8_STAGE(PG8_SB(1, 1), b3 + hstepB, voffB);
            PG8_WAIT_V(6); PG8_BAR; PG8_MMA(1, 1, At, B1); PG8_BAR;
        }
        E(acc, cur, wr, wc, fr, fq);
        if (!has_next) break;
#pragma unroll
        for (int a = 0; a < 2; ++a)
#pragma unroll
            for (int b = 0; b < 2; ++b)
#pragma unroll
                for (int m = 0; m < 4; ++m)
#pragma unroll
                    for (int n = 0; n < 2; ++n) acc[a][b][m][n] = (f32x4){0.f, 0.f, 0.f, 0.f};
        cur = nxt; cA = nA; cB = nB; ++ui;
    }
    PG8_WAIT_V(0);
    if (wr == 0) PG8_BAR;
    PG8_BAR;
#undef PG8_SA
#undef PG8_SB
#undef PG8_STAGE
#undef PG8_LDA
#undef PG8_LDB
#undef PG8_MMA
#undef PG8_WAIT_V
#undef PG8_WAIT_L
#undef PG8_BAR
#undef PG8_SCHED
}
}

#define XB_TMO      128
#define XB_XCNT(j)  (256  + 64 * (j))
#define XB_XSUB(j)  (1280 + 64 * (j))
#define XB_XGEN(j)  (2304 + 64 * (j))
#define XB_TOP      3328
#define XB_TOPGEN   3392
#define XCD_BAR_WORDS 3456
#define XB_SPIN_CAP (1u << 18)
__device__ __forceinline__ unsigned xb_ld(unsigned* p)              { return __hip_atomic_load(p, __ATOMIC_RELAXED, __HIP_MEMORY_SCOPE_AGENT); }
__device__ __forceinline__ unsigned xb_add(unsigned* p, unsigned v) { return __hip_atomic_fetch_add(p, v, __ATOMIC_RELAXED, __HIP_MEMORY_SCOPE_AGENT); }
__device__ __forceinline__ unsigned xb_xcc_id() { return (unsigned)__builtin_amdgcn_s_getreg((3 << 11) | 20) & 0xFu; }
#define XB_SPIN(cond, bar) do { unsigned _sp = 0; while (cond) { __builtin_amdgcn_s_sleep(1); \
    if ((++_sp & 255u) == 0u) { if (xb_ld(&(bar)[XB_TMO])) break; if (_sp > XB_SPIN_CAP) { atomicAdd(&(bar)[XB_TMO], 1u); break; } } } } while (0)
struct XcdBarrier { unsigned* bar; unsigned x; volatile LAS unsigned* st; };
__device__ __forceinline__ XcdBarrier xcd_barrier_post(unsigned* bar, volatile LAS unsigned* st) {
    XcdBarrier b; b.bar = bar; b.x = xb_xcc_id(); b.st = st;
    if (threadIdx.x == 0) (void)xb_add(&bar[XB_XCNT(b.x)], 1u);
    return b;
}
__device__ __forceinline__ void xcd_barrier_complete(unsigned* bar, unsigned x, unsigned& nloc, unsigned& nx) {
    const unsigned G = gridDim.x * gridDim.y * gridDim.z;
    unsigned sum, cnt, mine, sp = 0u;
    for (;;) {
        sum = 0u; cnt = 0u; mine = 0u;
#pragma unroll
        for (unsigned j = 0; j < 16; ++j) { const unsigned c = xb_ld(&bar[XB_XCNT(j)]); sum += c; cnt += (c > 0u) ? 1u : 0u; mine = (j == x) ? c : mine; }
        if (sum == G) break;
        __builtin_amdgcn_s_sleep(1);
        if ((++sp & 255u) == 0u) { if (xb_ld(&bar[XB_TMO])) break; if (sp > XB_SPIN_CAP) { atomicAdd(&bar[XB_TMO], 1u); break; } }
    }
    nloc = mine > 0u ? mine : 1u; nx = cnt > 0u ? cnt : 1u;
}
__device__ __forceinline__ void xcd_barrier(const XcdBarrier& b) {
    asm volatile("s_waitcnt vmcnt(0)" ::: "memory");
    __syncthreads();
    if (threadIdx.x == 0) {
        unsigned* bar = b.bar;
        __builtin_amdgcn_s_waitcnt(0);
        unsigned nloc = b.st[0], nx = b.st[1];
        if (nloc == 0u) { xcd_barrier_complete(bar, b.x, nloc, nx); b.st[0] = nloc; b.st[1] = nx; }
        const unsigned old = xb_add(&bar[XB_XSUB(b.x)], 1u);
        const unsigned gen = old / nloc;
        if (old + 1u == (gen + 1u) * nloc) {
            __builtin_amdgcn_fence(__ATOMIC_RELEASE, "agent");
            asm volatile("s_waitcnt vmcnt(0)" ::: "memory");
            const unsigned og = xb_add(&bar[XB_TOP], 1u);
            const unsigned tg = og / nx;
            if (og + 1u == (tg + 1u) * nx) xb_add(&bar[XB_TOPGEN], 1u);
            else XB_SPIN(xb_ld(&bar[XB_TOPGEN]) == tg, bar);
            __builtin_amdgcn_fence(__ATOMIC_ACQUIRE, "agent");
            xb_add(&bar[XB_XGEN(b.x)], 1u);
            asm volatile("s_waitcnt vmcnt(0)" ::: "memory");
        } else {
            XB_SPIN(xb_ld(&bar[XB_XGEN(b.x)]) == gen, bar);
            __builtin_amdgcn_fence(__ATOMIC_ACQUIRE, "agent");
            asm volatile("s_waitcnt vmcnt(0)" ::: "memory");
        }
    }
    __syncthreads();
}

template <int KS>
__device__ __forceinline__ f32x4 tile_mm(f32x4 acc, const LAS bf16* A, int lda, int m0, const LAS bf16* Bt, int ldb, int n0, int lane) {
    const int r = lane & 15, kg = lane >> 4;
#if NAIVE_MM
#pragma unroll 1
    for (int k = 0; k < KS * 32; ++k) {
        const float b = bf2f(Bt[(n0 + r) * ldb + k]);
#pragma unroll
        for (int q = 0; q < 4; ++q) acc[q] += bf2f(A[(m0 + 4 * kg + q) * lda + k]) * b;
    }
#else
#pragma unroll
    for (int ks = 0; ks < KS; ++ks) {
        const bf16x8 a = *(const LAS bf16x8*)(A + (m0 + r) * lda + ks * 32 + kg * 8);
        const bf16x8 b = *(const LAS bf16x8*)(Bt + (n0 + r) * ldb + ks * 32 + kg * 8);
        acc = __builtin_amdgcn_mfma_f32_16x16x32_bf16(a, b, acc, 0, 0, 0);
    }
#endif
    return acc;
}
template <int KS>
__device__ __forceinline__ f32x4 tile_mm_g(f32x4 acc, const bf16* A, int lda, int m0, const LAS bf16* Bt, int ldb, int n0, int lane) {
    const int r = lane & 15, kg = lane >> 4;
#if NAIVE_MM
#pragma unroll 1
    for (int k = 0; k < KS * 32; ++k) {
        const float b = bf2f(Bt[(n0 + r) * ldb + k]);
#pragma unroll
        for (int q = 0; q < 4; ++q) acc[q] += bf2f(A[(m0 + 4 * kg + q) * lda + k]) * b;
    }
#else
#pragma unroll
    for (int ks = 0; ks < KS; ++ks) {
        const bf16x8 a = *(const bf16x8*)(A + (size_t)(m0 + r) * lda + ks * 32 + kg * 8);
        const bf16x8 b = *(const LAS bf16x8*)(Bt + (n0 + r) * ldb + ks * 32 + kg * 8);
        acc = __builtin_amdgcn_mfma_f32_16x16x32_bf16(a, b, acc, 0, 0, 0);
    }
#endif
    return acc;
}

struct Args { const float* in[21]; float* out; unsigned char* ws; int ph_lo, ph_hi; };
enum { I_XP = 0, I_XS, I_STATE, I_C, I_CCTX, I_ADAW, I_ADAB, I_NORMG, I_WIN, I_CONV, I_ALOG, I_DTB, I_DNG, I_SGUNG, I_SGUW, I_SGUB, I_POOLW, I_POOLS, I_FW, I_WOUT, I_FNG };

struct SeqGeo { int T, tseq0, seq_row0; };
__device__ __forceinline__ SeqGeo seq_geo(int sc) {
    SeqGeo g;
    if (sc < 128) { g.T = 256; g.tseq0 = (sc & 3) * 64; g.seq_row0 = (sc >> 2) * 256; }
    else { const int s = sc - 128; g.T = 4096; g.tseq0 = (s & 63) * 64; g.seq_row0 = M_CTX + (s >> 6) * 4096; }
    return g;
}
__device__ __forceinline__ int cond_of_row(int row) { return row < M_CTX ? 0 : 1 + ((row - M_CTX) >> 12); }

__device__ __forceinline__ int srccol(int n) {
    if (n < 256) return 768 + n;
    if (n < 512) return 1040 + (n - 256);
    if (n < 768) return 2064 + (n - 512);
    if (n < 1024) return 2576 + (n - 768);
    if (n < 1280) return 1296 + (n - 1024);
    if (n < 1536) return 1552 + (n - 1280);
    if (n < 2304) return -2;
    if (n < 3072) return n - 2304;
    if (n < 3088) return 1024 + (n - 3072);
    return -1;
}

__device__ __forceinline__ void phase_0a(const Args& a, LAS unsigned char* lds) {
    const int tid = otid(), lane = tid & 63, wave = tid >> 6, G = gridDim.x, bid = obid();
    float* MOD = (float*)(a.ws + WS_MOD);
    if (bid < 192) {
        LAS float* sc = (LAS float*)lds;
        LAS float* red = (LAS float*)(lds + 9 * 1024 * 4);
        for (int i = tid; i < 9 * 1024; i += NTHR) { const int j = i >> 10, k = i & 1023; const float c = (j == 0) ? a.in[I_CCTX][k] : a.in[I_C][(j - 1) * 1024 + k]; sc[i] = silu_f(c); }
        __syncthreads();
        for (int it = bid; it < 192; it += G) {
            const int l = it / 48, cb = it % 48, col = cb * 64 + lane;
            float acc[9];
#pragma unroll
            for (int j = 0; j < 9; ++j) acc[j] = 0.f;
            const float* wp = a.in[I_ADAW] + ((size_t)l * 1024 + wave * 128) * 3072 + col;
#pragma unroll 8
            for (int k = 0; k < 128; ++k) { const float wv = wp[(size_t)k * 3072];
#pragma unroll
                for (int j = 0; j < 9; ++j) acc[j] += sc[j * 1024 + wave * 128 + k] * wv; }
#pragma unroll
            for (int j = 0; j < 9; ++j) red[(wave * 9 + j) * 64 + lane] = acc[j];
            __syncthreads();
            for (int i = tid; i < 576; i += NTHR) { const int j = i >> 6, ln = i & 63; float s = 0.f;
#pragma unroll
                for (int w = 0; w < 8; ++w) s += red[(w * 9 + j) * 64 + ln];
                MOD[(l * 9 + j) * 3072 + cb * 64 + ln] = s + a.in[I_ADAB][l * 3072 + cb * 64 + ln]; }
            __syncthreads();
        }
    }
    const int gtid = bid * NTHR + tid, GT = G * NTHR;
    float* GM = (float*)(a.ws + WS_GMAT);
    for (int t = gtid; t < 4 * 4 * 2 * 4096; t += GT) {
        const int d = t & 63, c = (t >> 6) & 63, cs = (t >> 12) & 1, g = (t >> 13) & 3, l = t >> 15;
        const float* fw = a.in[I_FW] + ((size_t)(l * 4 + g) * 64) * 64 + d;
        float s = 0.f;
        for (int m = 0; m < 64; ++m) { const float ph = (float)((m * c) & 63) * (1.f / 32.f); s += (cs ? sinpif(ph) : cospif(ph)) * fw[m * 64]; }
        GM[t] = s * 0.125f;
    }
    bf16* W1T = (bf16*)(a.ws + WS_W1T);
    for (int t = gtid; t < 4 * 128 * N1; t += GT) {
        const int n = t % N1, k8 = (t / N1) & 127, l = t / (N1 * 128);
        const int sc = srccol(n);
        if (sc == -2) continue;
        u32x4 o = (u32x4){0u, 0u, 0u, 0u};
        if (sc >= 0) { const float* wp = a.in[I_WIN] + ((size_t)l * 1024 + k8 * 8) * PIN + sc;
            o.x = pk2(wp[0], wp[PIN]); o.y = pk2(wp[2 * PIN], wp[3 * PIN]); o.z = pk2(wp[4 * PIN], wp[5 * PIN]); o.w = pk2(wp[6 * PIN], wp[7 * PIN]); }
        *(u32x4*)(W1T + ((size_t)l * N1 + n) * 1024 + k8 * 8) = o;
    }
    bf16* W2T = (bf16*)(a.ws + WS_W2T);
    for (int t = gtid; t < 4 * 128 * 1024; t += GT) {
        const int n = t & 1023, k8 = (t >> 10) & 127, l = t >> 17;
        const float* wp = a.in[I_WOUT] + ((size_t)l * 1024 + k8 * 8) * 1024 + n;
        u32x4 o; o.x = pk2(wp[0], wp[1024]); o.y = pk2(wp[2048], wp[3072]); o.z = pk2(wp[4096], wp[5120]); o.w = pk2(wp[6144], wp[7168]);
        *(u32x4*)(W2T + ((size_t)l * 1024 + n) * 1024 + k8 * 8) = o;
    }
    float* POS = (float*)(a.ws + WS_POS);
    for (int t = gtid; t < 64 * 256; t += GT) { const int f = t & 255, i = t >> 8; const float fr = powf(10000.f, -(float)f / 256.f); const float ang = (float)i * fr;
        POS[t] = sinf(ang); POS[64 * 256 + t] = cosf(ang); }
    bf16* DFT = (bf16*)(a.ws + WS_DFT);
    for (int t = gtid; t < 256 * 512; t += GT) { const int tp = t & 511, k = t >> 9, tt = tp & 255; const float ph = (float)((k * tt) & 255) * (1.f / 128.f);
        DFT[t] = (bf16)f2bf((tp < 256 ? cospif(ph) : -sinpif(ph)) * (1.f / 16.f)); }
    bf16* M1 = (bf16*)(a.ws + WS_M1);
    for (int t = gtid; t < 128 * 128; t += GT) { const int kk = t & 127, m = t >> 7, k1 = m & 63, t1 = kk & 63; const float ph = (float)((k1 * t1) & 63) * (1.f / 32.f);
        const float c = cospif(ph), s = sinpif(ph); float v;
        if (m < 64) v = (kk < 64) ? c : -s; else v = (kk < 64) ? s : c;
        M1[t] = (bf16)f2bf(v); }
    bf16* M2 = (bf16*)(a.ws + WS_M2);
    for (int t = gtid; t < 64 * 128; t += GT) { const int kk = t & 127, k2 = t >> 7, t2 = kk & 63; const float ph = (float)((k2 * t2) & 63) * (1.f / 32.f);
        M2[t] = (bf16)f2bf((kk < 64 ? cospif(ph) : -sinpif(ph)) * (1.f / 64.f)); }
    float* TW = (float*)(a.ws + WS_TW);
    for (int t = gtid; t < 64 * 64; t += GT) { const int t2 = t & 63, k1 = t >> 6; const float ph = (float)(k1 * t2) * (1.f / 2048.f); TW[2 * t] = cospif(ph); TW[2 * t + 1] = sinpif(ph); }
}

__device__ __forceinline__ void phase_0b(const Args& a) {
    const int tid = otid(), lane = tid & 63, wave = tid >> 6, G = gridDim.x, bid = obid();
    const int gtid = bid * NTHR + tid, GT = G * NTHR;
    const float* MOD = (const float*)(a.ws + WS_MOD);
    const float* GM = (const float*)(a.ws + WS_GMAT);
    bf16* W1T = (bf16*)(a.ws + WS_W1T);
    for (int t = gtid; t < 4 * 128 * 768; t += GT) {
        const int nf = t % 768, k8 = (t / 768) & 127, l = t / (768 * 128);
        const int kind = nf >> 8, g = (nf >> 6) & 3, d = nf & 63;
        const int base = (kind == 0 ? 1808 : 2320) + 64 * g;
        const float* Gm = (kind == 0) ? (a.in[I_POOLW] + ((size_t)(l * 4 + g) * 64) * 64 + d) : (GM + ((size_t)((l * 4 + g) * 2 + (kind - 1)) * 64) * 64 + d);
        const float* wp = a.in[I_WIN] + ((size_t)l * 1024 + k8 * 8) * PIN + base;
        float s[8];
#pragma unroll
        for (int j = 0; j < 8; ++j) s[j] = 0.f;
        for (int c = 0; c < 64; ++c) { const float gv = Gm[c * 64];
#pragma unroll
            for (int j = 0; j < 8; ++j) s[j] += wp[(size_t)j * PIN + c] * gv; }
        u32x4 o; o.x = pk2(s[0], s[1]); o.y = pk2(s[2], s[3]); o.z = pk2(s[4], s[5]); o.w = pk2(s[6], s[7]);
        *(u32x4*)(W1T + ((size_t)l * N1 + 1536 + nf) * 1024 + k8 * 8) = o;
    }
    const float* POS = (const float*)(a.ws + WS_POS);
    bf16* HB = (bf16*)(a.ws + WS_HB);
    float* RSS = (float*)(a.ws + WS_RSS);
    for (int row = bid * NWAVES + wave; row < M; row += G * NWAVES) {
        f32x4 v[4];
        const int j = cond_of_row(row);
        if (row < M_CTX) {
            const f32x4* xr = (const f32x4*)(a.in[I_XP] + (size_t)row * D) + lane;
#pragma unroll
            for (int q = 0; q < 4; ++q) v[q] = xr[64 * q];
        } else {
            const int rs = row - M_CTX, t = rs & 4095, gr = t >> 6, gc = t & 63;
            const f32x4* xr = (const f32x4*)(a.in[I_XS] + (size_t)rs * D) + lane;
            const f32x4 p0 = *((const f32x4*)(POS + gr * 256) + lane), p1 = *((const f32x4*)(POS + 64 * 256 + gr * 256) + lane);
            const f32x4 p2 = *((const f32x4*)(POS + gc * 256) + lane), p3 = *((const f32x4*)(POS + 64 * 256 + gc * 256) + lane);
            v[0] = xr[0] + p0; v[1] = xr[64] + p1; v[2] = xr[128] + p2; v[3] = xr[192] + p3;
        }
        float ss = 0.f;
#pragma unroll
        for (int q = 0; q < 4; ++q) ss += (v[q].x * v[q].x + v[q].y * v[q].y) + (v[q].z * v[q].z + v[q].w * v[q].w);
        ss = wave_sum(ss);
        f32x4* orow = (f32x4*)(a.out + (size_t)row * D) + lane;
        u32x2* hrow = (u32x2*)(HB + (size_t)row * D) + lane;
#pragma unroll
        for (int q = 0; q < 4; ++q) {
            orow[64 * q] = v[q];
            const f32x4 ng = *((const f32x4*)(a.in[I_NORMG] + 256 * q) + lane);
            const f32x4 sc = *((const f32x4*)(MOD + (0 * 9 + j) * 3072 + 1024 + 256 * q) + lane);
            u32x2 h; h.x = pk2(v[q].x * ng.x * (1.f + sc.x), v[q].y * ng.y * (1.f + sc.y)); h.y = pk2(v[q].z * ng.z * (1.f + sc.z), v[q].w * ng.w * (1.f + sc.w));
            hrow[64 * q] = h;
        }
        if (lane < 16) RSS[(size_t)row * 16 + lane] = (lane == 0) ? ss : 0.f;
    }
}

__device__ __forceinline__ void phase_0c(const Args& a) {
    const int tid = otid(), lane = tid & 63, wave = tid >> 6, G = gridDim.x, bid = obid();
    const float* MOD = (const float*)(a.ws + WS_MOD);
    const bf16* W1T = (const bf16*)(a.ws + WS_W1T);
    float* SW = (float*)(a.ws + WS_SW);
    for (int it = bid * NWAVES + wave; it < 4 * N1; it += G * NWAVES) {
        const int l = it / N1, n = it % N1;
        const u32x4* wr = (const u32x4*)(W1T + ((size_t)l * N1 + n) * 1024) + lane * 2;
        const u32x4 w0 = wr[0], w1 = wr[1];
        float w[16];
        w[0] = bflo(w0.x); w[1] = bfhi(w0.x); w[2] = bflo(w0.y); w[3] = bfhi(w0.y); w[4] = bflo(w0.z); w[5] = bfhi(w0.z); w[6] = bflo(w0.w); w[7] = bfhi(w0.w);
        w[8] = bflo(w1.x); w[9] = bfhi(w1.x); w[10] = bflo(w1.y); w[11] = bfhi(w1.y); w[12] = bflo(w1.z); w[13] = bfhi(w1.z); w[14] = bflo(w1.w); w[15] = bfhi(w1.w);
#pragma unroll
        for (int j = 0; j < 9; ++j) {
            const f32x4* sp = (const f32x4*)(MOD + (l * 9 + j) * 3072) + lane * 4;
            float s = 0.f;
#pragma unroll
            for (int q = 0; q < 4; ++q) { const f32x4 sv = sp[q]; s += sv.x * w[4 * q] + sv.y * w[4 * q + 1] + sv.z * w[4 * q + 2] + sv.w * w[4 * q + 3]; }
            s = wave_sum(s);
            if (lane == 0) SW[(l * 9 + j) * N1 + n] = s;
        }
    }
}

struct Epi1 {
    static constexpr bool PERM = true;
    bf16* PB; float* BA; const float* RSS; const float* SW;
    __device__ __forceinline__ void operator()(const f32x4 (&acc)[2][2][4][2], const pg8::Unit& u, int wr, int wc, int fr, int fq) const {
        const int pn = u.pn, j = u.pm < 32 ? 0 : 1 + ((u.pm - 32) >> 4);
        const int row0 = u.pm * 256 + wr * 64 + fr, cb = pn * 256 + wc * 32 + 8 * fq;
        const int act = (pn == 0 || pn == 2 || pn == 3 || pn == 5) ? 1 : ((pn == 1 || pn == 4) ? 2 : 0);
        f32x4 bv[2][2];
#pragma unroll
        for (int bj = 0; bj < 2; ++bj)
#pragma unroll
            for (int n = 0; n < 2; ++n) bv[bj][n] = *(const f32x4*)(SW + j * N1 + cb + bj * 128 + 4 * n);
#pragma unroll
        for (int ai = 0; ai < 2; ++ai)
#pragma unroll
            for (int m = 0; m < 4; ++m) {
                const int row = row0 + ai * 128 + m * 16;
                const f32x4* rp = (const f32x4*)(RSS + (size_t)row * 16);
                const f32x4 r0 = rp[0], r1 = rp[1], r2 = rp[2], r3 = rp[3];
                const float ss = ((r0.x + r0.y) + (r0.z + r0.w)) + ((r1.x + r1.y) + (r1.z + r1.w)) + ((r2.x + r2.y) + (r2.z + r2.w)) + ((r3.x + r3.y) + (r3.z + r3.w));
                const float rinv = rsqrtf(ss * (1.f / 1024.f) + EPS);
#pragma unroll
                for (int bj = 0; bj < 2; ++bj) {
                    f32x4 v0 = acc[ai][bj][m][0] * rinv + bv[bj][0], v1 = acc[ai][bj][m][1] * rinv + bv[bj][1];
                    if (pn < 12) {
                        if (act == 1) {
#pragma unroll
                            for (int q = 0; q < 4; ++q) { v0[q] = silu_f(v0[q]); v1[q] = silu_f(v1[q]); }
                        } else if (act == 2) {
#pragma unroll
                            for (int q = 0; q < 4; ++q) { v0[q] = gelu_tanh_f(v0[q]); v1[q] = gelu_tanh_f(v1[q]); }
                        }
                        u32x4 w; w.x = pk2(v0[0], v0[1]); w.y = pk2(v0[2], v0[3]); w.z = pk2(v1[0], v1[1]); w.w = pk2(v1[2], v1[3]);
                        *(u32x4*)(PB + (size_t)row * LDP + cb + bj * 128) = w;
                    } else if (bj == 0 && wc == 0 && fq < 2) {
                        f32x4* bp = (f32x4*)(BA + (size_t)row * 16 + 8 * fq); bp[0] = v0; bp[1] = v1;
                    }
                }
            }
    }
};
struct Epi2 {
    static constexpr bool PERM = true;
    float* X; bf16* HB; float* RSS; const float* gate;
    const float* ng_next; const float* sc_next;
    __device__ __forceinline__ void operator()(const f32x4 (&acc)[2][2][4][2], const pg8::Unit& u, int wr, int wc, int fr, int fq) const {
        const int pn = u.pn, j = u.pm < 32 ? 0 : 1 + ((u.pm - 32) >> 4);
        const int row0 = u.pm * 256 + wr * 64 + fr, cb = pn * 256 + wc * 32 + 8 * fq;
        f32x4 gv[2][2], gs[2][2];
#pragma unroll
        for (int bj = 0; bj < 2; ++bj)
#pragma unroll
            for (int n = 0; n < 2; ++n) {
                gv[bj][n] = *(const f32x4*)(gate + j * 3072 + cb + bj * 128 + 4 * n);
                if (ng_next) { const f32x4 ng = *(const f32x4*)(ng_next + cb + bj * 128 + 4 * n), sc = *(const f32x4*)(sc_next + j * 3072 + cb + bj * 128 + 4 * n); gs[bj][n] = ng * (sc + 1.f); }
                else gs[bj][n] = (f32x4){0.f, 0.f, 0.f, 0.f};
            }
#pragma unroll
        for (int ai = 0; ai < 2; ++ai)
#pragma unroll
            for (int m = 0; m < 4; ++m) {
                const int row = row0 + ai * 128 + m * 16;
                float ssq = 0.f;
#pragma unroll
                for (int bj = 0; bj < 2; ++bj) {
                    f32x4* xp = (f32x4*)(X + (size_t)row * D + cb + bj * 128);
                    const f32x4 n0 = xp[0] + gv[bj][0] * acc[ai][bj][m][0], n1 = xp[1] + gv[bj][1] * acc[ai][bj][m][1];
                    xp[0] = n0; xp[1] = n1;
                    ssq += (n0.x * n0.x + n0.y * n0.y) + (n0.z * n0.z + n0.w * n0.w) + (n1.x * n1.x + n1.y * n1.y) + (n1.z * n1.z + n1.w * n1.w);
                    if (ng_next) { const f32x4 h0 = n0 * gs[bj][0], h1 = n1 * gs[bj][1];
                        u32x4 w; w.x = pk2(h0[0], h0[1]); w.y = pk2(h0[2], h0[3]); w.z = pk2(h1[0], h1[1]); w.w = pk2(h1[2], h1[3]);
                        *(u32x4*)(HB + (size_t)row * D + cb + bj * 128) = w; }
                }
                ssq += __shfl_xor(ssq, 16); ssq += __shfl_xor(ssq, 32);
                if (fq == 0) RSS[(size_t)row * 16 + pn * 4 + wc] = ssq;
            }
    }
};

template <int DIR>
__device__ __forceinline__ void prep_solve(const LAS float* Am_, const LAS float* beta_, const LAS float* egs_, const LAS float* rsrc_, int isw, bf16* dst) {
    unsigned ab = (unsigned)(size_t)Am_, bb = (unsigned)(size_t)beta_, eb = (unsigned)(size_t)egs_, rb = (unsigned)(size_t)rsrc_;
    asm volatile("" : "+v"(ab), "+v"(bb), "+v"(eb), "+v"(rb));
    const LAS float* Am = (const LAS float*)(size_t)ab; const LAS float* beta = (const LAS float*)(size_t)bb; const LAS float* egs = (const LAS float*)(size_t)eb; const LAS float* rsrc = (const LAS float*)(size_t)rb;
    float x[64];
#pragma unroll
    for (int ib = 0; ib < 4; ++ib) {
        float acc[16];
#pragma unroll
        for (int ii = 0; ii < 16; ++ii) { const int i = 16 * ib + ii, ti = DIR ? 63 - i : i;
            const float b_ = beta[DIR * 64 + i];
            const float sc_ = isw ? b_ * egs[DIR * 64 + i] : b_;
            acc[ii] = sc_ * rsrc[ti * 65]; }
#pragma unroll
        for (int j = 0; j < 48; ++j) {
            if (j < 16 * ib) {
                const LAS f32x4* ap = (const LAS f32x4*)(Am + (DIR * 64 + j) * 68 + 16 * ib);
                const f32x4 a0 = ap[0], a1 = ap[1], a2 = ap[2], a3 = ap[3];
                const float xj = x[j];
                acc[0] -= a0.x * xj; acc[1] -= a0.y * xj; acc[2] -= a0.z * xj; acc[3] -= a0.w * xj;
                acc[4] -= a1.x * xj; acc[5] -= a1.y * xj; acc[6] -= a1.z * xj; acc[7] -= a1.w * xj;
                acc[8] -= a2.x * xj; acc[9] -= a2.y * xj; acc[10] -= a2.z * xj; acc[11] -= a2.w * xj;
                acc[12] -= a3.x * xj; acc[13] -= a3.y * xj; acc[14] -= a3.z * xj; acc[15] -= a3.w * xj;
                asm volatile("" : "+v"(acc[0]), "+v"(acc[1]), "+v"(acc[2]), "+v"(acc[3]), "+v"(acc[4]), "+v"(acc[5]), "+v"(acc[6]), "+v"(acc[7]), "+v"(acc[8]), "+v"(acc[9]), "+v"(acc[10]), "+v"(acc[11]), "+v"(acc[12]), "+v"(acc[13]), "+v"(acc[14]), "+v"(acc[15]) :: "memory");
            }
        }
#pragma unroll
        for (int jj = 0; jj < 15; ++jj) {
            const LAS f32x4* ap = (const LAS f32x4*)(Am + (DIR * 64 + 16 * ib + jj) * 68 + 16 * ib);
            const f32x4 a0 = ap[0], a1 = ap[1], a2 = ap[2], a3 = ap[3];
            const float av[16] = {a0.x, a0.y, a0.z, a0.w, a1.x, a1.y, a1.z, a1.w, a2.x, a2.y, a2.z, a2.w, a3.x, a3.y, a3.z, a3.w};
            const float xj = acc[jj];
#pragma unroll
            for (int ii = 0; ii < 16; ++ii) if (ii > jj) acc[ii] -= av[ii] * xj;
            asm volatile("" : "+v"(acc[0]), "+v"(acc[1]), "+v"(acc[2]), "+v"(acc[3]), "+v"(acc[4]), "+v"(acc[5]), "+v"(acc[6]), "+v"(acc[7]), "+v"(acc[8]), "+v"(acc[9]), "+v"(acc[10]), "+v"(acc[11]), "+v"(acc[12]), "+v"(acc[13]), "+v"(acc[14]), "+v"(acc[15]) :: "memory");
        }
#pragma unroll
        for (int ii = 0; ii < 16; ++ii) x[16 * ib + ii] = acc[ii];
    }
#pragma unroll
    for (int i = 0; i < 64; ++i) dst[i * 64] = (bf16)f2bf(x[i]);
}

__device__ __forceinline__ void prep_item(const Args& a, LAS unsigned char* lds, int l, int sc, int h) {
    const int tid = otid(), lane = tid & 63, wave = tid >> 6;
    LAS float* qs = (LAS float*)lds;
    LAS float* ks = qs + 64 * 65;
    LAS float* vs = ks + 64 * 65;
    LAS float* KK = vs + 64 * 65;
    LAS float* Am = KK + 64 * 65;
    LAS float* beta = Am + 2 * 64 * 68;
    LAS float* gcs = beta + 128;
    LAS float* egs = gcs + 128;
    const bf16* PB = (const bf16*)(a.ws + WS_PB);
    const float* BA = (const float*)(a.ws + WS_BA);
    bf16* PQK = (bf16*)(a.ws + WS_PQK) + (size_t)(sc * 4 + h) * 2 * 4096;
    bf16* PUW = (bf16*)(a.ws + WS_PUW) + (size_t)(sc * 4 + h) * 4 * 4096;
    float* PGC = (float*)(a.ws + WS_PGC) + (size_t)(sc * 4 + h) * 2 * 64;
    const SeqGeo sg = seq_geo(sc);
    const int row0 = sc * 64;
    if (wave < 2) {
        const int dir = wave, tok = dir ? 63 - lane : lane;
        const float bl = BA[(size_t)(row0 + tok) * 16 + dir * 4 + h], al = BA[(size_t)(row0 + tok) * 16 + 8 + dir * 4 + h];
        const float bt = 1.f / (1.f + expf(-bl));
        const float xx = al + a.in[I_DTB][(l * 2 + dir) * 4 + h];
        const float sp = xx > 20.f ? xx : log1pf(expf(xx));
        float g = -expf(a.in[I_ALOG][(l * 2 + dir) * 4 + h]) * sp;
#pragma unroll
        for (int o = 1; o < 64; o <<= 1) { const float t = __shfl_up(g, o); if (lane >= o) g += t; }
        beta[dir * 64 + lane] = bt; gcs[dir * 64 + lane] = g; egs[dir * 64 + lane] = expf(g);
        PGC[dir * 64 + lane] = g;
    }
    for (int t = tid; t < 64 * 24; t += NTHR) {
        const int tok = t / 24, cg = t % 24, part = cg >> 3, d0 = (cg & 7) * 8;
        const int col = C_Q + part * 256 + h * 64 + d0, chan = part * 256 + h * 64 + d0;
        float o[8];
#pragma unroll
        for (int c = 0; c < 8; ++c) o[c] = 0.f;
#pragma unroll
        for (int jj = 0; jj < 4; ++jj) {
            const int ts = sg.tseq0 + tok + jj - 2;
            if (ts >= 0 && ts < sg.T) {
                const u32x4 xv = *(const u32x4*)(PB + (size_t)(sg.seq_row0 + ts) * LDP + col);
                const f32x4 w0 = *(const f32x4*)(a.in[I_CONV] + (size_t)(l * 4 + jj) * 768 + chan), w1 = *(const f32x4*)(a.in[I_CONV] + (size_t)(l * 4 + jj) * 768 + chan + 4);
                o[0] += w0.x * bflo(xv.x); o[1] += w0.y * bfhi(xv.x); o[2] += w0.z * bflo(xv.y); o[3] += w0.w * bfhi(xv.y);
                o[4] += w1.x * bflo(xv.z); o[5] += w1.y * bfhi(xv.z); o[6] += w1.z * bflo(xv.w); o[7] += w1.w * bfhi(xv.w);
            }
        }
        LAS float* dst = (part == 0 ? qs : (part == 1 ? ks : vs)) + tok * 65 + d0;
#pragma unroll
        for (int c = 0; c < 8; ++c) dst[c] = silu_f(o[c]);
    }
    __syncthreads();
    if (tid < 128) {
        LAS float* arr = (tid < 64 ? qs : ks) + (tid & 63) * 65;
        float ss = 0.f;
        for (int d = 0; d < 64; ++d) ss += arr[d] * arr[d];
        const float s = rsqrtf(ss + EPS) * (tid < 64 ? 0.125f : 1.f);
        for (int d = 0; d < 64; ++d) arr[d] *= s;
    }
    __syncthreads();
    for (int t = tid; t < 1024; t += NTHR) {
        const int which = t >> 9, tok = (t >> 3) & 63, d0 = (t & 7) * 8;
        const LAS float* src = (which ? ks : qs) + tok * 65 + d0;
        u32x4 o; o.x = pk2(src[0], src[1]); o.y = pk2(src[2], src[3]); o.z = pk2(src[4], src[5]); o.w = pk2(src[6], src[7]);
        *(u32x4*)(PQK + (size_t)which * 4096 + tok * 64 + d0) = o;
    }
    {
        const int ar = tid >> 3, b0 = (tid & 7) * 8;
        float acc[8];
#pragma unroll
        for (int c = 0; c < 8; ++c) acc[c] = 0.f;
        for (int d = 0; d < 64; ++d) { const float ka = ks[ar * 65 + d];
#pragma unroll
            for (int c = 0; c < 8; ++c) acc[c] += ka * ks[(b0 + c) * 65 + d]; }
#pragma unroll
        for (int c = 0; c < 8; ++c) KK[ar * 65 + b0 + c] = acc[c];
    }
    __syncthreads();
    for (int t = tid; t < 2 * 64 * 64; t += NTHR) {
        const int dir = t >> 12, jx = (t >> 6) & 63, i = t & 63;
        const int ti = dir ? 63 - i : i, tj = dir ? 63 - jx : jx;
        float v = 0.f;
        if (i > jx) v = beta[dir * 64 + i] * KK[ti * 65 + tj] * expf(gcs[dir * 64 + i] - gcs[dir * 64 + jx]);
        Am[(dir * 64 + jx) * 68 + i] = v;
    }
    __syncthreads();
#ifndef SKIP6
    if (tid < 256) {
        const int col = tid & 127, isw = col >> 6, cc = col & 63;
        if (tid < 128) prep_solve<0>(Am, beta, egs, (isw ? ks : vs) + cc, isw, PUW + (size_t)(0 * 2 + isw) * 4096 + cc);
        else           prep_solve<1>(Am, beta, egs, (isw ? ks : vs) + cc, isw, PUW + (size_t)(1 * 2 + isw) * 4096 + cc);
    }
#endif
    __syncthreads();
}

__device__ __forceinline__ void sgu_item(const Args& a, LAS unsigned char* lds, int l, int ch, int g) {
    const int tid = otid(), lane = tid & 63, wave = tid >> 6;
    LAS bf16* Wl = (LAS bf16*)lds;
    LAS bf16* VT = Wl + 128 * 136;
    LAS float* rstd = (LAS float*)(VT + 64 * 136);
    bf16* PB = (bf16*)(a.ws + WS_PB);
    const int row0 = ch * 128;
    {
        const int q = tid >> 2, part = tid & 3;
        const u32x4* vp = (const u32x4*)(PB + (size_t)(row0 + q) * LDP + C_V + part * 64);
        float ss = 0.f;
#pragma unroll
        for (int i = 0; i < 8; ++i) { const u32x4 v = vp[i];
            const float f0 = bflo(v.x), f1 = bfhi(v.x), f2 = bflo(v.y), f3 = bfhi(v.y), f4 = bflo(v.z), f5 = bfhi(v.z), f6 = bflo(v.w), f7 = bfhi(v.w);
            ss += (f0 * f0 + f1 * f1) + (f2 * f2 + f3 * f3) + (f4 * f4 + f5 * f5) + (f6 * f6 + f7 * f7); }
        ss += __shfl_xor(ss, 1); ss += __shfl_xor(ss, 2);
        if (part == 0) rstd[q] = rsqrtf(ss * (1.f / 256.f) + EPS);
    }
    for (int t = tid; t < 128 * 16; t += NTHR) {
        const int p = t >> 4, q8 = t & 15;
        const f32x4* wp = (const f32x4*)(a.in[I_SGUW] + ((size_t)(l * 4 + g) * 128 + p) * 128 + q8 * 8);
        const f32x4 w0 = wp[0], w1 = wp[1];
        u32x4 o; o.x = pk2(w0.x, w0.y); o.y = pk2(w0.z, w0.w); o.z = pk2(w1.x, w1.y); o.w = pk2(w1.z, w1.w);
        *(LAS u32x4*)(Wl + p * 136 + q8 * 8) = o;
    }
    __syncthreads();
    for (int t = tid; t < 128 * 8; t += NTHR) {
        const int q = t >> 3, c0 = (t & 7) * 8;
        const u32x4 v = *(const u32x4*)(PB + (size_t)(row0 + q) * LDP + C_V + g * 64 + c0);
        const f32x4 g0 = *(const f32x4*)(a.in[I_SGUNG] + l * 256 + g * 64 + c0), g1 = *(const f32x4*)(a.in[I_SGUNG] + l * 256 + g * 64 + c0 + 4);
        const float r = rstd[q];
        VT[(c0 + 0) * 136 + q] = (bf16)f2bf(bflo(v.x) * r * g0.x); VT[(c0 + 1) * 136 + q] = (bf16)f2bf(bfhi(v.x) * r * g0.y);
        VT[(c0 + 2) * 136 + q] = (bf16)f2bf(bflo(v.y) * r * g0.z); VT[(c0 + 3) * 136 + q] = (bf16)f2bf(bfhi(v.y) * r * g0.w);
        VT[(c0 + 4) * 136 + q] = (bf16)f2bf(bflo(v.z) * r * g1.x); VT[(c0 + 5) * 136 + q] = (bf16)f2bf(bfhi(v.z) * r * g1.y);
        VT[(c0 + 6) * 136 + q] = (bf16)f2bf(bflo(v.w) * r * g1.z); VT[(c0 + 7) * 136 + q] = (bf16)f2bf(bfhi(v.w) * r * g1.w);
    }
    __syncthreads();
    {
        const int m0 = wave * 16, r = lane & 15, kg = lane >> 4;
#pragma unroll
        for (int nt = 0; nt < 4; ++nt) {
            f32x4 acc = (f32x4){0.f, 0.f, 0.f, 0.f};
            acc = tile_mm<4>(acc, Wl, 136, m0, VT, 136, nt * 16, lane);
#pragma unroll
            for (int q = 0; q < 4; ++q) {
                const int p = m0 + 4 * kg + q, c = nt * 16 + r;
                const float sv = acc[q] + a.in[I_SGUB][(l * 4 + g) * 128 + p];
                bf16* up = PB + (size_t)(row0 + p) * LDP + C_U + g * 64 + c;
                const float uu = bf2f(*up), gb = bf2f(PB[(size_t)(row0 + p) * LDP + C_GB + g * 64 + c]);
                *up = (bf16)f2bf(uu * sv * gb);
            }
        }
    }
    __syncthreads();
}

__device__ __forceinline__ void pool_item(const Args& a, LAS unsigned char* lds, int l, int sc) {
    const int tid = otid();
    LAS bf16* xt = (LAS bf16*)lds;
    bf16* PB = (bf16*)(a.ws + WS_PB);
    const SeqGeo sg = seq_geo(sc);
    for (int t = tid; t < 80 * 32; t += NTHR) {
        const int r = t >> 5, c8 = t & 31, ts = sg.tseq0 - 8 + r;
        u32x4 v = (u32x4){0u, 0u, 0u, 0u};
        if (ts >= 0 && ts < sg.T) v = *(const u32x4*)(PB + (size_t)(sg.seq_row0 + ts) * LDP + C_XC + c8 * 8);
        *(LAS u32x4*)(xt + r * 264 + c8 * 8) = v;
    }
    __syncthreads();
    for (int t = tid; t < 64 * 32; t += NTHR) {
        const int tok = t >> 5, c8 = t & 31, gi = c8 >> 3, half = 1 << gi;
        const int ts = sg.tseq0 + tok;
        const int lo = (ts - half) < 0 ? 0 : ts - half, hi = (ts + half) > sg.T ? sg.T : ts + half;
        float s[8];
#pragma unroll
        for (int c = 0; c < 8; ++c) s[c] = 0.f;
        for (int tt = lo; tt < hi; ++tt) {
            const u32x4 v = *(const LAS u32x4*)(xt + (tt - sg.tseq0 + 8) * 264 + c8 * 8);
            s[0] += bflo(v.x); s[1] += bfhi(v.x); s[2] += bflo(v.y); s[3] += bfhi(v.y); s[4] += bflo(v.z); s[5] += bfhi(v.z); s[6] += bflo(v.w); s[7] += bfhi(v.w);
        }
        const float inv = 1.f / (float)(hi - lo);
        const u32x4 xv = *(const LAS u32x4*)(xt + (tok + 8) * 264 + c8 * 8);
        const float x0[8] = {bflo(xv.x), bfhi(xv.x), bflo(xv.y), bfhi(xv.y), bflo(xv.z), bfhi(xv.z), bflo(xv.w), bfhi(xv.w)};
        bf16* yp = PB + (size_t)(sg.seq_row0 + ts) * LDP + C_GC + c8 * 8;
        const u32x4 gv = *(const u32x4*)yp;
        const float gg[8] = {bflo(gv.x), bfhi(gv.x), bflo(gv.y), bfhi(gv.y), bflo(gv.z), bfhi(gv.z), bflo(gv.w), bfhi(gv.w)};
        const f32x4 p0 = *(const f32x4*)(a.in[I_POOLS] + l * 256 + c8 * 8), p1 = *(const f32x4*)(a.in[I_POOLS] + l * 256 + c8 * 8 + 4);
        const float ps[8] = {p0.x, p0.y, p0.z, p0.w, p1.x, p1.y, p1.z, p1.w};
        float y[8];
#pragma unroll
        for (int c = 0; c < 8; ++c) y[c] = (s[c] * inv - x0[c]) * ps[c] * gg[c];
        u32x4 o; o.x = pk2(y[0], y[1]); o.y = pk2(y[2], y[3]); o.z = pk2(y[4], y[5]); o.w = pk2(y[6], y[7]);
        *(u32x4*)yp = o;
    }
    __syncthreads();
}

__device__ __forceinline__ void fctx_item(const Args& a, LAS unsigned char* lds, int b, int dblk) {
    const int tid = otid(), lane = tid & 63, wave = tid >> 6;
    LAS bf16* ZT = (LAS bf16*)lds;
    bf16* PB = (bf16*)(a.ws + WS_PB);
    const bf16* DFT = (const bf16*)(a.ws + WS_DFT);
    for (int t = tid; t < 256 * 2 * 8; t += NTHR) {
        const int d8 = t & 7, ri = (t >> 3) & 1, tt = t >> 4;
        const u32x4 v = *(const u32x4*)(PB + (size_t)(b * 256 + tt) * LDP + (ri ? C_QF : C_PF) + dblk * 64 + d8 * 8);
        LAS bf16* dst = ZT + (d8 * 8) * 520 + ri * 256 + tt;
        dst[0 * 520] = (bf16)(v.x & 0xffffu); dst[1 * 520] = (bf16)(v.x >> 16); dst[2 * 520] = (bf16)(v.y & 0xffffu); dst[3 * 520] = (bf16)(v.y >> 16);
        dst[4 * 520] = (bf16)(v.z & 0xffffu); dst[5 * 520] = (bf16)(v.z >> 16); dst[6 * 520] = (bf16)(v.w & 0xffffu); dst[7 * 520] = (bf16)(v.w >> 16);
    }
    __syncthreads();
    const int r = lane & 15, kg = lane >> 4;
#pragma unroll 1
    for (int mi = 0; mi < 2; ++mi) {
        const int m0 = wave * 32 + mi * 16;
#pragma unroll 1
        for (int nt = 0; nt < 4; ++nt) {
            f32x4 acc = (f32x4){0.f, 0.f, 0.f, 0.f};
            acc = tile_mm_g<16>(acc, DFT, 512, m0, ZT, 520, nt * 16, lane);
#pragma unroll
            for (int q = 0; q < 4; ++q) {
                const int k = m0 + 4 * kg + q, d = nt * 16 + r;
                bf16* yp = PB + (size_t)(b * 256 + k) * LDP + C_GD + dblk * 64 + d;
                *yp = (bf16)f2bf(acc[q] * bf2f(*yp));
            }
        }
    }
    __syncthreads();
}

__device__ __forceinline__ void fsmp_item(const Args& a, LAS unsigned char* lds, int b, int ds) {
    const int tid = otid(), lane = tid & 63, wave = tid >> 6;
    LAS bf16* ZT = (LAS bf16*)lds;
    LAS bf16* B2 = ZT + 256 * 136;
    bf16* PB = (bf16*)(a.ws + WS_PB);
    const bf16* M1 = (const bf16*)(a.ws + WS_M1);
    const bf16* M2 = (const bf16*)(a.ws + WS_M2);
    const float* TW = (const float*)(a.ws + WS_TW);
    const int d0 = ds * 4;
    const size_t rowb = (size_t)M_CTX + (size_t)b * 4096;
    for (int t = tid; t < 4096 * 2; t += NTHR) {
        const int ri = t & 1, tt = t >> 1, t1 = tt >> 6, t2 = tt & 63;
        const u32x2 v = *(const u32x2*)(PB + (rowb + tt) * LDP + (ri ? C_QF : C_PF) + d0);
        LAS bf16* dst = ZT + (t2 * 4) * 136 + ri * 64 + t1;
        dst[0] = (bf16)(v.x & 0xffffu); dst[136] = (bf16)(v.x >> 16); dst[272] = (bf16)(v.y & 0xffffu); dst[408] = (bf16)(v.y >> 16);
    }
    __syncthreads();
    const int r = lane & 15, kg = lane >> 4;
#pragma unroll 1
    for (int jb = 0; jb < 8; ++jb) {
        const int job = wave + 8 * jb, mp = job & 3, nt = job >> 2;
        f32x4 ar = (f32x4){0.f, 0.f, 0.f, 0.f}, ai = (f32x4){0.f, 0.f, 0.f, 0.f};
        ar = tile_mm_g<4>(ar, M1, 128, 16 * mp, ZT, 136, 16 * nt, lane);
        ai = tile_mm_g<4>(ai, M1, 128, 64 + 16 * mp, ZT, 136, 16 * nt, lane);
        const int n = 16 * nt + r, t2 = n >> 2, dd = n & 3;
#pragma unroll
        for (int q = 0; q < 4; ++q) {
            const int k1 = 16 * mp + 4 * kg + q;
            const f32x2 tw = *(const f32x2*)(TW + (k1 * 64 + t2) * 2);
            const float xr = ar[q] * tw.x - ai[q] * tw.y, xi = ar[q] * tw.y + ai[q] * tw.x;
            B2[(k1 * 4 + dd) * 136 + t2] = (bf16)f2bf(xr);
            B2[(k1 * 4 + dd) * 136 + 64 + t2] = (bf16)f2bf(xi);
        }
    }
    __syncthreads();
#pragma unroll 1
    for (int jb = 0; jb < 8; ++jb) {
        const int job = wave + 8 * jb, mt = job & 3, nt = job >> 2;
        f32x4 acc = (f32x4){0.f, 0.f, 0.f, 0.f};
        acc = tile_mm_g<4>(acc, M2, 128, 16 * mt, B2, 136, 16 * nt, lane);
        const int n = 16 * nt + r, k1 = n >> 2, dd = n & 3;
#pragma unroll
        for (int q = 0; q < 4; ++q) {
            const int k2 = 16 * mt + 4 * kg + q, kk = k1 + 64 * k2;
            bf16* yp = PB + (rowb + kk) * LDP + C_GD + d0 + dd;
            *yp = (bf16)f2bf(acc[q] * bf2f(*yp));
        }
    }
    __syncthreads();
}

__device__ __forceinline__ void scan_item(const Args& a, LAS unsigned char* lds, int l, int seq, int h, int dir) {
    const int tid = otid(), lane = tid & 63, wave = tid >> 6;
    constexpr int LD = 72;
    LAS bf16* Wm = (LAS bf16*)lds;
    LAS bf16* Qd = Wm + 64 * LD;
    LAS bf16* KdT = Qd + 64 * LD;
    LAS bf16* Qm = KdT + 64 * LD;
    LAS bf16* Km = Qm + 64 * LD;
    LAS bf16* QKm = Km + 64 * LD;
    LAS bf16* St = QKm + 64 * LD;
    LAS bf16* VnT = St + 64 * LD;
    LAS bf16* Ub = VnT + 64 * LD;
    LAS float* gcl = (LAS float*)(Ub + 64 * LD);
    bf16* PB = (bf16*)(a.ws + WS_PB);
    const int nch = seq < 32 ? 4 : 64;
    const int sc0 = seq < 32 ? seq * 4 : 128 + (seq - 32) * 64;
    const int mt = wave >> 1, nh = wave & 1, m0 = mt * 16, r = lane & 15, kg = lane >> 4;
    f32x4 Sreg[2];
#pragma unroll
    for (int t = 0; t < 2; ++t) {
        const int e = nh * 32 + 16 * t + r;
#pragma unroll
        for (int q = 0; q < 4; ++q) {
            const int d = m0 + 4 * kg + q;
            Sreg[t][q] = (seq < 32) ? 0.f : a.in[I_STATE][((size_t)(((seq - 32) * 4 + l) * 2 + dir) * 4 + h) * 4096 + d * 64 + e];
        }
        u32x2 w; w.x = pk2(Sreg[t][0], Sreg[t][1]); w.y = pk2(Sreg[t][2], Sreg[t][3]);
        *(LAS u32x2*)(St + e * LD + m0 + 4 * kg) = w;
    }
#pragma unroll 1
    for (int s = 0; s < nch; ++s) {
        const int c = dir ? nch - 1 - s : s, sc = sc0 + c;
        const bf16* PQK = (const bf16*)(a.ws + WS_PQK) + (size_t)(sc * 4 + h) * 2 * 4096;
        const bf16* PUW = (const bf16*)(a.ws + WS_PUW) + (size_t)((sc * 4 + h) * 2 + dir) * 2 * 4096;
        const float* PGC = (const float*)(a.ws + WS_PGC) + (size_t)((sc * 4 + h) * 2 + dir) * 64;
        {
            const int i = tid >> 3, d0 = (tid & 7) * 8, tok = dir ? 63 - i : i;
            const u32x4 qv = *(const u32x4*)(PQK + tok * 64 + d0), kv = *(const u32x4*)(PQK + 4096 + tok * 64 + d0);
            const u32x4 uv = *(const u32x4*)(PUW + i * 64 + d0), wv = *(const u32x4*)(PUW + 4096 + i * 64 + d0);
            const float gci = PGC[i], gl = PGC[63];
            const float eq = expf(gci), ek = expf(gl - gci);
            *(LAS u32x4*)(Qm + i * LD + d0) = qv; *(LAS u32x4*)(Km + i * LD + d0) = kv; *(LAS u32x4*)(Wm + i * LD + d0) = wv; *(LAS u32x4*)(Ub + i * LD + d0) = uv;
            u32x4 qd; qd.x = pk2(bflo(qv.x) * eq, bfhi(qv.x) * eq); qd.y = pk2(bflo(qv.y) * eq, bfhi(qv.y) * eq); qd.z = pk2(bflo(qv.z) * eq, bfhi(qv.z) * eq); qd.w = pk2(bflo(qv.w) * eq, bfhi(qv.w) * eq);
            *(LAS u32x4*)(Qd + i * LD + d0) = qd;
            KdT[(d0 + 0) * LD + i] = (bf16)f2bf(bflo(kv.x) * ek); KdT[(d0 + 1) * LD + i] = (bf16)f2bf(bfhi(kv.x) * ek);
            KdT[(d0 + 2) * LD + i] = (bf16)f2bf(bflo(kv.y) * ek); KdT[(d0 + 3) * LD + i] = (bf16)f2bf(bfhi(kv.y) * ek);
            KdT[(d0 + 4) * LD + i] = (bf16)f2bf(bflo(kv.z) * ek); KdT[(d0 + 5) * LD + i] = (bf16)f2bf(bfhi(kv.z) * ek);
            KdT[(d0 + 6) * LD + i] = (bf16)f2bf(bflo(kv.w) * ek); KdT[(d0 + 7) * LD + i] = (bf16)f2bf(bfhi(kv.w) * ek);
            if (tid < 64) gcl[tid] = PGC[tid];
        }
        __syncthreads();
#pragma unroll
        for (int t = 0; t < 2; ++t) {
            const int n0 = nh * 32 + 16 * t;
            f32x4 a1 = (f32x4){0.f, 0.f, 0.f, 0.f}, aq = (f32x4){0.f, 0.f, 0.f, 0.f};
            a1 = tile_mm<2>(a1, Wm, LD, m0, St, LD, n0, lane);
            aq = tile_mm<2>(aq, Qm, LD, m0, Km, LD, n0, lane);
            const int e = n0 + r;
            float vn[4];
#pragma unroll
            for (int q = 0; q < 4; ++q) { const int ci = m0 + 4 * kg + q;
                vn[q] = bf2f(Ub[ci * LD + e]) - a1[q];
                const float dec = (ci >= e) ? expf(gcl[ci] - gcl[e]) : 0.f;
                QKm[ci * LD + e] = (bf16)f2bf(aq[q] * dec); }
            u32x2 w; w.x = pk2(vn[0], vn[1]); w.y = pk2(vn[2], vn[3]);
            *(LAS u32x2*)(VnT + e * LD + m0 + 4 * kg) = w;
        }
        __syncthreads();
        const float egl = expf(gcl[63]);
#pragma unroll
        for (int t = 0; t < 2; ++t) {
            const int n0 = nh * 32 + 16 * t, e = n0 + r;
            f32x4 ao = (f32x4){0.f, 0.f, 0.f, 0.f}, as = (f32x4){0.f, 0.f, 0.f, 0.f};
            ao = tile_mm<2>(ao, Qd, LD, m0, St, LD, n0, lane);
            ao = tile_mm<2>(ao, QKm, LD, m0, VnT, LD, n0, lane);
            as = tile_mm<2>(as, KdT, LD, m0, VnT, LD, n0, lane);
#pragma unroll
            for (int q = 0; q < 4; ++q) { const int ci = m0 + 4 * kg + q, tok = dir ? 63 - ci : ci;
                PB[(size_t)(sc * 64 + tok) * LDP + (dir ? C_K : C_Q) + h * 64 + e] = (bf16)f2bf(ao[q]);
                Sreg[t][q] = Sreg[t][q] * egl + as[q]; }
        }
        __syncthreads();
#pragma unroll
        for (int t = 0; t < 2; ++t) {
            const int e = nh * 32 + 16 * t + r;
            u32x2 w; w.x = pk2(Sreg[t][0], Sreg[t][1]); w.y = pk2(Sreg[t][2], Sreg[t][3]);
            *(LAS u32x2*)(St + e * LD + m0 + 4 * kg) = w;
        }
    }
    if (seq < 32) {
        float* ns = a.out + (size_t)M * D + ((size_t)((seq * 4 + l) * 2 + dir) * 4 + h) * 4096;
#pragma unroll
        for (int t = 0; t < 2; ++t) { const int e = nh * 32 + 16 * t + r;
#pragma unroll
            for (int q = 0; q < 4; ++q) ns[(m0 + 4 * kg + q) * 64 + e] = Sreg[t][q]; }
    }
    __syncthreads();
}

__device__ __forceinline__ void phase_combine(const Args& a, int l) {
    const int tid = otid(), lane = tid & 63, wave = tid >> 6, G = gridDim.x, bid = obid();
    bf16* PB = (bf16*)(a.ws + WS_PB);
    const f32x4 ng = *(const f32x4*)(a.in[I_DNG] + l * 64 + (lane & 15) * 4);
    for (int row = bid * NWAVES + wave; row < M; row += G * NWAVES) {
        bf16* rp = PB + (size_t)row * LDP;
        const u32x2 of = *((const u32x2*)(rp + C_Q) + lane), ob = *((const u32x2*)(rp + C_K) + lane), ga = *((const u32x2*)(rp + C_GA) + lane);
        const float o0 = bflo(of.x) + bflo(ob.x), o1 = bfhi(of.x) + bfhi(ob.x), o2 = bflo(of.y) + bflo(ob.y), o3 = bfhi(of.y) + bfhi(ob.y);
        float ss = (o0 * o0 + o1 * o1) + (o2 * o2 + o3 * o3);
        ss += __shfl_xor(ss, 1); ss += __shfl_xor(ss, 2); ss += __shfl_xor(ss, 4); ss += __shfl_xor(ss, 8);
        const float rinv = rsqrtf(ss * (1.f / 64.f) + EPS);
        u32x2 y; y.x = pk2(o0 * rinv * ng.x * bflo(ga.x), o1 * rinv * ng.y * bfhi(ga.x)); y.y = pk2(o2 * rinv * ng.z * bflo(ga.y), o3 * rinv * ng.w * bfhi(ga.y));
        *((u32x2*)(rp + C_GA) + lane) = y;
    }
}

__device__ __forceinline__ void phase_final(const Args& a) {
    const int tid = otid(), lane = tid & 63, wave = tid >> 6, G = gridDim.x, bid = obid();
    const float* RSS = (const float*)(a.ws + WS_RSS);
    f32x4 fg[4];
#pragma unroll
    for (int q = 0; q < 4; ++q) fg[q] = *((const f32x4*)(a.in[I_FNG] + 256 * q) + lane);
    for (int row = bid * NWAVES + wave; row < M; row += G * NWAVES) {
        float p = (lane < 16) ? RSS[(size_t)row * 16 + lane] : 0.f;
        p += __shfl_xor(p, 1); p += __shfl_xor(p, 2); p += __shfl_xor(p, 4); p += __shfl_xor(p, 8);
        const float ss = __shfl(p, 0);
        const float rinv = rsqrtf(ss * (1.f / 1024.f) + EPS);
        f32x4* orow = (f32x4*)(a.out + (size_t)row * D) + lane;
#pragma unroll
        for (int q = 0; q < 4; ++q) { const f32x4 v = orow[64 * q]; orow[64 * q] = v * rinv * fg[q]; }
    }
}

constexpr int NPHASE = 24;
__global__ void __launch_bounds__(NTHR, 2) fwd_kernel(Args args) {
    extern __shared__ __attribute__((aligned(16))) unsigned char lds_raw[];
    LAS unsigned char* lds = (LAS unsigned char*)lds_raw;
    const int tid = threadIdx.x;
#if !MK_MULTI
    volatile LAS unsigned* MISC = (volatile LAS unsigned*)(lds + MISC_OFF);
    if (tid < 64) MISC[tid] = 0u;
    __syncthreads();
    XcdBarrier bar = xcd_barrier_post((unsigned*)(args.ws + WS_CTL) + CW_BAR, MISC + 8);
#define GRID_BAR() xcd_barrier(bar)
#else
#define GRID_BAR() do { } while (0)
#endif
    const int G = gridDim.x, bid = blockIdx.x;
    for (int ph = args.ph_lo; ph < args.ph_hi; ++ph) {
        if (ph == 0) { if (EN(0)) phase_0a(args, lds); }
        else if (ph == 1) { if (EN(1)) phase_0b(args); }
        else if (ph == 2) { if (EN(2)) phase_0c(args); }
        else if (ph == 23) { if (EN(3)) phase_final(args); }
        else {
            const int l = (ph - 3) / 5, sub = (ph - 3) % 5;
            if (sub == 0) { if (EN(4)) {
                pg8::Gemm g{(const bf16*)(args.ws + WS_HB), (const bf16*)(args.ws + WS_W1T) + (size_t)l * N1 * 1024, M, N1, 1024, 1024};
                pg8::StaticOrder S; S.init(M, N1, G, bid);
                Epi1 E{(bf16*)(args.ws + WS_PB), (float*)(args.ws + WS_BA), (const float*)(args.ws + WS_RSS), (const float*)(args.ws + WS_SW) + (size_t)l * 9 * N1};
                pg8::gemm_phase<Epi1>(lds, g, S, E); }
            } else if (sub == 1) {
                for (int it = bid; it < 5120; it += G) {
                    if (it < 2560) { if (EN(5)) prep_item(args, lds, l, it >> 2, it & 3); }
                    else if (it < 3840) { const int i2 = it - 2560; if (EN(6)) sgu_item(args, lds, l, i2 >> 2, i2 & 3); }
                    else if (it < 4480) { if (EN(7)) pool_item(args, lds, l, it - 3840); }
                    else if (it < 4608) { const int i2 = it - 4480; if (EN(8)) fctx_item(args, lds, i2 >> 2, i2 & 3); }
                    else { const int i2 = it - 4608; if (EN(9)) fsmp_item(args, lds, i2 >> 6, i2 & 63); }
                }
            } else if (sub == 2) {
                for (int it = bid; it < 320; it += G) {
                    int seq, h, dir;
                    if (it < 64) { seq = 32 + (it >> 3); h = (it >> 1) & 3; dir = it & 1; }
                    else { const int i2 = it - 64; seq = i2 >> 3; h = (i2 >> 1) & 3; dir = i2 & 1; }
                    if (EN(10)) scan_item(args, lds, l, seq, h, dir);
                }
            } else if (sub == 3) {
                if (EN(11)) phase_combine(args, l);
            } else if (EN(12)) {
                pg8::Gemm g{(const bf16*)(args.ws + WS_PB), (const bf16*)(args.ws + WS_W2T) + (size_t)l * 1024 * 1024, M, 1024, 1024, LDP};
                pg8::StaticOrder S; S.init(M, 1024, G, bid);
                const float* MOD = (const float*)(args.ws + WS_MOD);
                Epi2 E{args.out, (bf16*)(args.ws + WS_HB), (float*)(args.ws + WS_RSS), MOD + (size_t)l * 9 * 3072 + 2048,
                       l < 3 ? args.in[I_NORMG] + (l + 1) * 1024 : nullptr, l < 3 ? MOD + (size_t)(l + 1) * 9 * 3072 + 1024 : nullptr};
                pg8::gemm_phase<Epi2>(lds, g, S, E);
            }
        }
        if (ph + 1 < args.ph_hi) GRID_BAR();
    }
}

extern "C" void kernel_launch(void* const* d_in, const int* in_sizes, int n_in, void* d_out, int out_size, void* d_ws, size_t ws_size, hipStream_t stream) {
    static int grid = 0;
    if (grid == 0) {
        if (n_in != 21 || ws_size < WS_END) { fprintf(stderr, "kernel_launch: unexpected n_in %d or ws_size %zu (< %zu)\n", n_in, ws_size, (size_t)WS_END); grid = -1; return; }
        int dev = 0, cus = 0, per_cu = 0;
        if (hipGetDevice(&dev) != hipSuccess || hipDeviceGetAttribute(&cus, hipDeviceAttributeMultiprocessorCount, dev) != hipSuccess) { grid = -1; return; }
        if (hipFuncSetAttribute((const void*)fwd_kernel, hipFuncAttributeMaxDynamicSharedMemorySize, LDS_BYTES) != hipSuccess) { fprintf(stderr, "kernel_launch: hipFuncSetAttribute failed\n"); grid = -1; return; }
        if (hipOccupancyMaxActiveBlocksPerMultiprocessor(&per_cu, (const void*)fwd_kernel, NTHR, LDS_BYTES) != hipSuccess || per_cu < 1) { fprintf(stderr, "kernel_launch: occupancy query failed (%d)\n", per_cu); (void)hipGetLastError(); per_cu = 1; }
        grid = cus * 1;
    }
    if (grid < 0) return;
    Args a{};
    for (int i = 0; i < 21; ++i) a.in[i] = (const float*)d_in[i];
    a.out = (float*)d_out; a.ws = (unsigned char*)d_ws;
#if MK_MULTI
    for (int ph = 0; ph < NPHASE; ++ph) {
        a.ph_lo = ph; a.ph_hi = ph + 1;
        hipLaunchKernelGGL(fwd_kernel, dim3(grid), dim3(NTHR), LDS_BYTES, stream, a);
    }
#else
    (void)hipMemsetAsync((char*)d_ws + WS_CTL, 0, CTL_ZERO_BYTES, stream);
    a.ph_lo = 0; a.ph_hi = NPHASE;
    void* kargs[] = {&a};
    hipError_t e = hipLaunchCooperativeKernel((const void*)fwd_kernel, dim3(grid), dim3(NTHR), kargs, LDS_BYTES, stream);
    if (e != hipSuccess) fprintf(stderr, "kernel_launch: cooperative launch failed: %s (grid %d)\n", hipGetErrorString(e), grid);
#endif
}
```

```cpp
#include <hip/hip_runtime.h>
#include <cstdio>
#include <cstdint>

#ifndef MK_MULTI
#define MK_MULTI 0
#endif
#ifndef NAIVE_MM
#define NAIVE_MM 0
#endif
#ifndef ONLY
#define ONLY -1
#endif
#define EN(k) (ONLY < 0 || ONLY == (k))
#ifndef REP_G1
#define REP_G1 1
#endif
#ifndef REP_PREP
#define REP_PREP 1
#endif
#ifndef REP_SCAN
#define REP_SCAN 1
#endif
#ifndef REP_P0
#define REP_P0 1
#endif
#ifndef REP_MIX
#define REP_MIX 1
#endif
#ifndef REP_COMB
#define REP_COMB 1
#endif
#ifndef REP_G2
#define REP_G2 1
#endif
#ifndef MIXSEL
#define MIXSEL 15
#endif

#define LAS __attribute__((address_space(3)))
#define GAS __attribute__((address_space(1)))
typedef unsigned short bf16;
typedef short bf16x8 __attribute__((ext_vector_type(8)));
typedef float f32x4 __attribute__((ext_vector_type(4)));
typedef float f32x2 __attribute__((ext_vector_type(2)));
typedef unsigned u32x4 __attribute__((ext_vector_type(4)));
typedef unsigned u32x2 __attribute__((ext_vector_type(2)));

constexpr int D = 1024, NL = 4, NCOND = 9;
constexpr int M_CTX = 8192, M = 40960;
constexpr int PIN = 2832;
constexpr int N1 = 3328, LDP = 3072;
constexpr float EPS = 1e-6f;
constexpr int C_GA = 0, C_U = 256, C_GC = 512, C_GD = 768, C_V = 1024, C_GB = 1280, C_XC = 1536, C_PF = 1792, C_QF = 2048, C_Q = 2304, C_K = 2560, C_VV = 2816;

constexpr size_t MiB = 1u << 20;
constexpr size_t WS_CTL = 0, CTL_ZERO_BYTES = 1 * MiB;
constexpr size_t WS_MOD = 1 * MiB;
constexpr size_t WS_SW = WS_MOD + 512 * 1024;
constexpr size_t WS_GMAT = 2 * MiB;
constexpr size_t WS_POS = WS_GMAT + 512 * 1024;
constexpr size_t WS_DFT = WS_POS + 256 * 1024;
constexpr size_t WS_M1 = 3 * MiB;
constexpr size_t WS_M2 = WS_M1 + 32 * 1024;
constexpr size_t WS_TW = WS_M1 + 64 * 1024;
constexpr size_t WS_W1T = 4 * MiB;
constexpr size_t WS_W2T = 30 * MiB;
constexpr size_t WS_BA = 38 * MiB;
constexpr size_t WS_RSS = 41 * MiB;
constexpr size_t WS_PB = 44 * MiB;
constexpr size_t WS_HB = 284 * MiB;
constexpr size_t WS_PREP = 284 * MiB;
constexpr size_t WS_PGL = 484 * MiB;
constexpr size_t WS_END = 485 * MiB;
constexpr size_t WS_DUM = 486 * MiB;
constexpr int CW_BAR = 4096, CW_Q = 8192;

constexpr int LDS_BYTES = 147456;
constexpr int MISC_OFF = 144 * 1024 - 256;
constexpr int NWAVES = 8, NTHR = 512;

__device__ __forceinline__ unsigned f2bf(float f) { unsigned u = __builtin_bit_cast(unsigned, f); return (u + 0x7fffu + ((u >> 16) & 1u)) >> 16; }
__device__ __forceinline__ float bf2f(unsigned b) { return __builtin_bit_cast(float, (b & 0xffffu) << 16); }
__device__ __forceinline__ unsigned pk2(float lo, float hi) { return f2bf(lo) | (f2bf(hi) << 16); }
__device__ __forceinline__ float bflo(unsigned w) { return __builtin_bit_cast(float, w << 16); }
__device__ __forceinline__ float bfhi(unsigned w) { return __builtin_bit_cast(float, w & 0xffff0000u); }
__device__ __forceinline__ float silu_f(float x) { return x / (1.f + __expf(-x)); }
__device__ __forceinline__ float gelu_tanh_f(float x) { const float z = 1.5957691216057308f * (x + 0.044715f * x * x * x); return x / (1.f + __expf(-z)); }
__device__ __forceinline__ float wave_sum(float v) {
#pragma unroll
    for (int o = 1; o < 64; o <<= 1) v += __shfl_xor(v, o);
    return v;
}
__device__ __forceinline__ int otid() { int t = threadIdx.x; asm volatile("" : "+v"(t)); return t; }
__device__ __forceinline__ int obid() { int b = blockIdx.x; asm volatile("" : "+s"(b)); return b; }
#define LDS_WAIT() asm volatile("s_waitcnt lgkmcnt(0)" ::: "memory")

namespace pg8 {
constexpr int BM = 256, BK = 64, HALF = 128, HTB = HALF * BK * 2, STAGE_BYTES = 8 * HTB, NXCD = 8, WGM = 8;
__host__ __device__ __forceinline__ int lds_byte(int r, int c) { const int st = (r >> 4) * 2 + (c >> 5), rr = r & 15, cc = c & 31, ob = rr * 64 + cc * 2; return st * 1024 + (ob ^ (((ob >> 9) & 1) << 5)); }
__host__ __device__ __forceinline__ void stage_rc(int b, int& R, int& C) { const int st = b / 1024, sb = b % 1024, swz = sb ^ (((sb >> 9) & 1) << 5); R = (st >> 1) * 16 + swz / 64; C = (st & 1) * 32 + (swz % 64) / 2; }
__host__ __device__ __forceinline__ int perm32(int rho) { const int n = rho >> 4, i = rho & 15; return 8 * (i >> 2) + 4 * n + (i & 3); }

struct Unit { int pm, pn; };
struct Gemm { const bf16* A; const bf16* Bt; int M, N, K, lda; };

struct StaticOrder {
    int nM, nN, nwg, G, c;
    __host__ __device__ void init(int M_, int N_, int G_, int c_) { nM = M_ / BM; nN = N_ / BM; nwg = nM * nN; G = G_; c = c_; }
    __host__ __device__ bool next(int i, Unit& u) const {
        const long L = (long)i * G + c; if (L >= nwg) return false;
        int wgid = (int)L; { const int q = nwg / NXCD, r = nwg % NXCD, xcd = wgid % NXCD, off = wgid / NXCD; wgid = (xcd < r ? xcd * (q + 1) : r * (q + 1) + (xcd - r) * q) + off; }
        const int nig = WGM * nN, gid = wgid / nig, fm = gid * WGM, gsz = (nM - fm) < WGM ? (nM - fm) : WGM;
        u.pm = fm + ((wgid % nig) % gsz); u.pn = (wgid % nig) / gsz; return true;
    }
};

template <class Epi>
__device__ __forceinline__ void gemm_phase(LAS unsigned char* lds, const Gemm g, const StaticOrder& S, const Epi& E) {
    const int tid = otid(), wid = __builtin_amdgcn_readfirstlane(tid >> 6), lane = tid & 63, wr = wid >> 2, wc = wid & 3, fr = lane & 15, fq = lane >> 4;
    const int K = g.K, nt = K / BK, lda = g.lda;
    unsigned voffA[2], voffB[2];
#pragma unroll
    for (int i = 0; i < 2; ++i) { int R, C; stage_rc(tid * 16 + i * 8192, R, C); const int Rb = Epi::PERM ? ((R & ~31) + perm32(R & 31)) : R;
        voffA[i] = (unsigned)(R * lda + C) * 2u; voffB[i] = (unsigned)(Rb * K + C) * 2u; }
    const size_t kstep = (size_t)(BK * 2);
    const size_t hstepA = (size_t)HALF * lda * 2, hstepB = (size_t)HALF * K * 2;
    const size_t tstepA = 2 * hstepA, tstepB = 2 * hstepB;
    const unsigned ldsw = (unsigned)wid * 1024u;
    const int aoff = lds_byte(wr * 64 + fr, fq * 8), boff = lds_byte(wc * 32 + fr, fq * 8);
#define PG8_SA(b, h) (((b) * 2 + (h)) * HTB)
#define PG8_SB(b, h) ((4 + (b) * 2 + (h)) * HTB)
#define PG8_STAGE(bufoff, gbase, voff) do { _Pragma("unroll") for (int _i = 0; _i < 2; ++_i) \
        __builtin_amdgcn_global_load_lds((const unsigned*)((const char*)(gbase) + (voff)[_i]), (LAS unsigned*)(lds + (bufoff) + ldsw + _i * 8192), 16, 0, 0); } while (0)
#define PG8_LDA(dst, b, h) do { _Pragma("unroll") for (int m = 0; m < 4; ++m) _Pragma("unroll") for (int k = 0; k < 2; ++k) dst[m][k] = *(const LAS bf16x8*)(lds + PG8_SA(b, h) + aoff + m * 2048 + k * 1024); } while (0)
#define PG8_LDB(dst, b, h) do { _Pragma("unroll") for (int n = 0; n < 2; ++n) _Pragma("unroll") for (int k = 0; k < 2; ++k) dst[n][k] = *(const LAS bf16x8*)(lds + PG8_SB(b, h) + boff + n * 2048 + k * 1024); } while (0)
#define PG8_MMA(ai, bj, At, Bt) do { __builtin_amdgcn_s_setprio(1); _Pragma("unroll") for (int m = 0; m < 4; ++m) _Pragma("unroll") for (int n = 0; n < 2; ++n) _Pragma("unroll") for (int k = 0; k < 2; ++k) \
        acc[ai][bj][m][n] = __builtin_amdgcn_mfma_f32_16x16x32_bf16(Bt[n][k], At[m][k], acc[ai][bj][m][n], 0, 0, 0); __builtin_amdgcn_s_setprio(0); } while (0)
#define PG8_WAIT_V(n) asm volatile("s_waitcnt vmcnt(" #n ")" ::: "memory")
#define PG8_WAIT_L(n) asm volatile("s_waitcnt lgkmcnt(" #n ")" ::: "memory")
#define PG8_BAR __builtin_amdgcn_s_barrier()
#define PG8_SCHED __builtin_amdgcn_sched_barrier(0)
    Unit cur, nxt; int ui = 0;
    if (!S.next(0, cur)) return;
    f32x4 acc[2][2][4][2];
#pragma unroll
    for (int a = 0; a < 2; ++a)
#pragma unroll
        for (int b = 0; b < 2; ++b)
#pragma unroll
            for (int m = 0; m < 4; ++m)
#pragma unroll
                for (int n = 0; n < 2; ++n) acc[a][b][m][n] = (f32x4){0.f, 0.f, 0.f, 0.f};
    bf16x8 At[4][2], B0[2][2], B1[2][2];
    const char* cA = (const char*)g.A + (size_t)cur.pm * tstepA; const char* cB = (const char*)g.Bt + (size_t)cur.pn * tstepB;
    PG8_STAGE(PG8_SB(0, 0), cB, voffB); PG8_STAGE(PG8_SA(0, 0), cA, voffA); PG8_STAGE(PG8_SB(0, 1), cB + hstepB, voffB); PG8_STAGE(PG8_SA(0, 1), cA + hstepA, voffA);
    if (wr == 1) PG8_BAR;
    PG8_WAIT_V(4); PG8_BAR;
    PG8_STAGE(PG8_SB(1, 0), cB + kstep, voffB); PG8_STAGE(PG8_SA(1, 0), cA + kstep, voffA); PG8_STAGE(PG8_SB(1, 1), cB + hstepB + kstep, voffB);
    PG8_WAIT_V(6); PG8_BAR;
    for (;;) {
        const bool has_next = S.next(ui + 1, nxt);
        const char* nA = has_next ? (const char*)g.A + (size_t)nxt.pm * tstepA : cA; const char* nB = has_next ? (const char*)g.Bt + (size_t)nxt.pn * tstepB : cB;
        for (int t = 0; t < nt; t += 2) {
            const bool last = (t == nt - 2);
            const char* a1 = cA + (size_t)(t + 1) * kstep;
            const char* a2 = last ? nA : cA + (size_t)(t + 2) * kstep; const char* b2 = last ? nB : cB + (size_t)(t + 2) * kstep;
            const char* a3 = a2 + kstep; const char* b3 = b2 + kstep;
            PG8_LDB(B0, 0, 0); PG8_SCHED; PG8_LDA(At, 0, 0); PG8_STAGE(PG8_SA(1, 1), a1 + hstepA, voffA);
            PG8_WAIT_L(8); PG8_BAR; PG8_WAIT_L(0); PG8_MMA(0, 0, At, B0); PG8_BAR; PG8_SCHED;
            PG8_LDB(B1, 0, 1); PG8_STAGE(PG8_SB(0, 0), b2, voffB);
            PG8_BAR; PG8_WAIT_L(0); PG8_MMA(0, 1, At, B1); PG8_BAR;
            PG8_LDA(At, 0, 1); PG8_STAGE(PG8_SA(0, 0), a2, voffA);
            PG8_BAR; PG8_WAIT_L(0); PG8_MMA(1, 0, At, B0); PG8_BAR; PG8_SCHED;
            PG8_STAGE(PG8_SB(0, 1), b2 + hstepB, voffB);
            PG8_WAIT_V(6); PG8_BAR; PG8_MMA(1, 1, At, B1); PG8_BAR;
            PG8_LDB(B0, 1, 0); PG8_SCHED; PG8_LDA(At, 1, 0); PG8_STAGE(PG8_SA(0, 1), a2 + hstepA, voffA);
            PG8_WAIT_L(8); PG8_BAR; PG8_WAIT_L(0); PG8_MMA(0, 0, At, B0); PG8_BAR; PG8_SCHED;
            PG8_LDB(B1, 1, 1); PG8_STAGE(PG8_SB(1, 0), b3, voffB);
            PG8_BAR; PG8_WAIT_L(0); PG8_MMA(0, 1, At, B1); PG8_BAR;
            PG8_LDA(At, 1, 1); PG8_STAGE(PG8_SA(1, 0), a3, voffA);
            PG8_BAR; PG8_WAIT_L(0); PG8_MMA(1, 0, At, B0); PG8_BAR; PG8_SCHED;
            PG8_STAGE(PG8_SB(1, 1), b3 + hstepB, voffB);
            PG8_WAIT_V(6); PG8_BAR; PG8_MMA(1, 1, At, B1); PG8_BAR;
        }
        E(acc, cur, wr, wc, fr, fq);
        if (!has_next) break;
#pragma unroll
        for (int a = 0; a < 2; ++a)
#pragma unroll
            for (int b = 0; b < 2; ++b)
#pragma unroll
                for (int m = 0; m < 4; ++m)
#pragma unroll
                    for (int n = 0; n < 2; ++n) acc[a][b][m][n] = (f32x4){0.f, 0.f, 0.f, 0.f};
        cur = nxt; cA = nA; cB = nB; ++ui;
    }
    PG8_WAIT_V(0);
    if (wr == 0) PG8_BAR;
    PG8_BAR;
#undef PG8_SA
#undef PG8_SB
#undef PG8_STAGE
#undef PG8_LDA
#undef PG8_LDB
#undef PG8_MMA
#undef PG8_WAIT_V
#undef PG8_WAIT_L
#undef PG8_BAR
#undef PG8_SCHED
}
}

#define XB_TMO      128
#define XB_XCNT(j)  (256  + 64 * (j))
#define XB_XSUB(j)  (1280 + 64 * (j))
#define XB_XGEN(j)  (2304 + 64 * (j))
#define XB_TOP      3328
#define XB_TOPGEN   3392
#define XCD_BAR_WORDS 3456
#define XB_SPIN_CAP (1u << 18)
__device__ __forceinline__ unsigned xb_ld(unsigned* p)              { return __hip_atomic_load(p, __ATOMIC_RELAXED, __HIP_MEMORY_SCOPE_AGENT); }
__device__ __forceinline__ unsigned xb_add(unsigned* p, unsigned v) { return __hip_atomic_fetch_add(p, v, __ATOMIC_RELAXED, __HIP_MEMORY_SCOPE_AGENT); }
__device__ __forceinline__ unsigned xb_xcc_id() { return (unsigned)__builtin_amdgcn_s_getreg((3 << 11) | 20) & 0xFu; }
#define XB_SPIN(cond, bar) do { unsigned _sp = 0; while (cond) { __builtin_amdgcn_s_sleep(1); \
    if ((++_sp & 255u) == 0u) { if (xb_ld(&(bar)[XB_TMO])) break; if (_sp > XB_SPIN_CAP) { atomicAdd(&(bar)[XB_TMO], 1u); break; } } } } while (0)
struct XcdBarrier { unsigned* bar; unsigned x; volatile LAS unsigned* st; };
__device__ __forceinline__ XcdBarrier xcd_barrier_post(unsigned* bar, volatile LAS unsigned* st) {
    XcdBarrier b; b.bar = bar; b.x = xb_xcc_id(); b.st = st;
    if (threadIdx.x == 0) (void)xb_add(&bar[XB_XCNT(b.x)], 1u);
    return b;
}
__device__ __forceinline__ void xcd_barrier_complete(unsigned* bar, unsigned x, unsigned& nloc, unsigned& nx) {
    const unsigned G = gridDim.x * gridDim.y * gridDim.z;
    unsigned sum, cnt, mine, sp = 0u;
    for (;;) {
        sum = 0u; cnt = 0u; mine = 0u;
#pragma unroll
        for (unsigned j = 0; j < 16; ++j) { const unsigned c = xb_ld(&bar[XB_XCNT(j)]); sum += c; cnt += (c > 0u) ? 1u : 0u; mine = (j == x) ? c : mine; }
        if (sum == G) break;
        __builtin_amdgcn_s_sleep(1);
        if ((++sp & 255u) == 0u) { if (xb_ld(&bar[XB_TMO])) break; if (sp > XB_SPIN_CAP) { atomicAdd(&bar[XB_TMO], 1u); break; } }
    }
    nloc = mine > 0u ? mine : 1u; nx = cnt > 0u ? cnt : 1u;
}
__device__ __forceinline__ void xcd_barrier(const XcdBarrier& b) {
    asm volatile("s_waitcnt vmcnt(0)" ::: "memory");
    __syncthreads();
    if (threadIdx.x == 0) {
        unsigned* bar = b.bar;
        __builtin_amdgcn_s_waitcnt(0);
        unsigned nloc = b.st[0], nx = b.st[1];
        if (nloc == 0u) { xcd_barrier_complete(bar, b.x, nloc, nx); b.st[0] = nloc; b.st[1] = nx; }
        const unsigned old = xb_add(&bar[XB_XSUB(b.x)], 1u);
        const unsigned gen = old / nloc;
        if (old + 1u == (gen + 1u) * nloc) {
            __builtin_amdgcn_fence(__ATOMIC_RELEASE, "agent");
            asm volatile("s_waitcnt vmcnt(0)" ::: "memory");
            const unsigned og = xb_add(&bar[XB_TOP], 1u);
            const unsigned tg = og / nx;
            if (og + 1u == (tg + 1u) * nx) xb_add(&bar[XB_TOPGEN], 1u);
            else XB_SPIN(xb_ld(&bar[XB_TOPGEN]) == tg, bar);
            __builtin_amdgcn_fence(__ATOMIC_ACQUIRE, "agent");
            xb_add(&bar[XB_XGEN(b.x)], 1u);
            asm volatile("s_waitcnt vmcnt(0)" ::: "memory");
        } else {
            XB_SPIN(xb_ld(&bar[XB_XGEN(b.x)]) == gen, bar);
            __builtin_amdgcn_fence(__ATOMIC_ACQUIRE, "agent");
            asm volatile("s_waitcnt vmcnt(0)" ::: "memory");
        }
    }
    __syncthreads();
}

template <int KS>
__device__ __forceinline__ f32x4 tile_mm(f32x4 acc, const LAS bf16* A, int lda, int m0, const LAS bf16* Bt, int ldb, int n0, int lane) {
    const int r = lane & 15, kg = lane >> 4;
#if NAIVE_MM
#pragma unroll 1
    for (int k = 0; k < KS * 32; ++k) {
        const float b = bf2f(Bt[(n0 + r) * ldb + k]);
#pragma unroll
        for (int q = 0; q < 4; ++q) acc[q] += bf2f(A[(m0 + 4 * kg + q) * lda + k]) * b;
    }
#else
#pragma unroll
    for (int ks = 0; ks < KS; ++ks) {
        const bf16x8 a = *(const LAS bf16x8*)(A + (m0 + r) * lda + ks * 32 + kg * 8);
        const bf16x8 b = *(const LAS bf16x8*)(Bt + (n0 + r) * ldb + ks * 32 + kg * 8);
        acc = __builtin_amdgcn_mfma_f32_16x16x32_bf16(a, b, acc, 0, 0, 0);
    }
#endif
    return acc;
}
template <int KS>
__device__ __forceinline__ f32x4 tile_mm_g(f32x4 acc, const bf16* A, int lda, int m0, const LAS bf16* Bt, int ldb, int n0, int lane) {
    const int r = lane & 15, kg = lane >> 4;
#if NAIVE_MM
#pragma unroll 1
    for (int k = 0; k < KS * 32; ++k) {
        const float b = bf2f(Bt[(n0 + r) * ldb + k]);
#pragma unroll
        for (int q = 0; q < 4; ++q) acc[q] += bf2f(A[(m0 + 4 * kg + q) * lda + k]) * b;
    }
#else
#pragma unroll
    for (int ks = 0; ks < KS; ++ks) {
        const bf16x8 a = *(const bf16x8*)(A + (size_t)(m0 + r) * lda + ks * 32 + kg * 8);
        const bf16x8 b = *(const LAS bf16x8*)(Bt + (n0 + r) * ldb + ks * 32 + kg * 8);
        acc = __builtin_amdgcn_mfma_f32_16x16x32_bf16(a, b, acc, 0, 0, 0);
    }
#endif
    return acc;
}

struct Args { const float* in[21]; float* out; unsigned char* ws; int ph_lo, ph_hi, one, pad; };
enum { I_XP = 0, I_XS, I_STATE, I_C, I_CCTX, I_ADAW, I_ADAB, I_NORMG, I_WIN, I_CONV, I_ALOG, I_DTB, I_DNG, I_SGUNG, I_SGUW, I_SGUB, I_POOLW, I_POOLS, I_FW, I_WOUT, I_FNG };

struct SeqGeo { int T, tseq0, seq_row0; };
__device__ __forceinline__ SeqGeo seq_geo(int sc) {
    SeqGeo g;
    if (sc < 128) { g.T = 256; g.tseq0 = (sc & 3) * 64; g.seq_row0 = (sc >> 2) * 256; }
    else { const int s = sc - 128; g.T = 4096; g.tseq0 = (s & 63) * 64; g.seq_row0 = M_CTX + (s >> 6) * 4096; }
    return g;
}
__device__ __forceinline__ int cond_of_row(int row) { return row < M_CTX ? 0 : 1 + ((row - M_CTX) >> 12); }

__device__ __forceinline__ int srccol(int n) {
    if (n < 256) return 768 + n;
    if (n < 512) return 1040 + (n - 256);
    if (n < 768) return 2064 + (n - 512);
    if (n < 1024) return 2576 + (n - 768);
    if (n < 1280) return 1296 + (n - 1024);
    if (n < 1536) return 1552 + (n - 1280);
    if (n < 2304) return -2;
    if (n < 3072) return n - 2304;
    if (n < 3088) return 1024 + (n - 3072);
    return -1;
}

__device__ __forceinline__ void phase_0a(const Args& a, LAS unsigned char* lds) {
    const int tid = otid(), lane = tid & 63, wave = tid >> 6, G = gridDim.x, bid = obid();
    float* MOD = (float*)(a.ws + WS_MOD);
    if (bid < 192) {
        LAS float* sc = (LAS float*)lds;
        LAS float* red = (LAS float*)(lds + 9 * 1024 * 4);
        for (int i = tid; i < 9 * 1024; i += NTHR) { const int j = i >> 10, k = i & 1023; const float c = (j == 0) ? a.in[I_CCTX][k] : a.in[I_C][(j - 1) * 1024 + k]; sc[i] = silu_f(c); }
        __syncthreads();
        for (int it = bid; it < 192; it += G) {
            const int l = it / 48, cb = it % 48, col = cb * 64 + lane;
            float acc[9];
#pragma unroll
            for (int j = 0; j < 9; ++j) acc[j] = 0.f;
            const float* wp = a.in[I_ADAW] + ((size_t)l * 1024 + wave * 128) * 3072 + col;
#pragma unroll 8
            for (int k = 0; k < 128; ++k) { const float wv = wp[(size_t)k * 3072];
#pragma unroll
                for (int j = 0; j < 9; ++j) acc[j] += sc[j * 1024 + wave * 128 + k] * wv; }
#pragma unroll
            for (int j = 0; j < 9; ++j) red[(wave * 9 + j) * 64 + lane] = acc[j];
            __syncthreads();
            for (int i = tid; i < 576; i += NTHR) { const int j = i >> 6, ln = i & 63; float s = 0.f;
#pragma unroll
                for (int w = 0; w < 8; ++w) s += red[(w * 9 + j) * 64 + ln];
                MOD[(l * 9 + j) * 3072 + cb * 64 + ln] = s + a.in[I_ADAB][l * 3072 + cb * 64 + ln]; }
            __syncthreads();
        }
    }
    const int gtid = bid * NTHR + tid, GT = G * NTHR;
    float* GM = (float*)(a.ws + WS_GMAT);
    for (int t = gtid; t < 4 * 4 * 2 * 4096; t += GT) {
        const int d = t & 63, c = (t >> 6) & 63, cs = (t >> 12) & 1, g = (t >> 13) & 3, l = t >> 15;
        const float* fw = a.in[I_FW] + ((size_t)(l * 4 + g) * 64) * 64 + d;
        float s = 0.f;
        for (int m = 0; m < 64; ++m) { const float ph = (float)((m * c) & 63) * (1.f / 32.f); s += (cs ? sinpif(ph) : cospif(ph)) * fw[m * 64]; }
        GM[t] = s * 0.125f;
    }
    bf16* W1T = (bf16*)(a.ws + WS_W1T);
    for (int t = gtid; t < 4 * 128 * N1; t += GT) {
        const int n = t % N1, k8 = (t / N1) & 127, l = t / (N1 * 128);
        const int sc = srccol(n);
        if (sc == -2) continue;
        u32x4 o = (u32x4){0u, 0u, 0u, 0u};
        if (sc >= 0) { const float* wp = a.in[I_WIN] + ((size_t)l * 1024 + k8 * 8) * PIN + sc;
            o.x = pk2(wp[0], wp[PIN]); o.y = pk2(wp[2 * PIN], wp[3 * PIN]); o.z = pk2(wp[4 * PIN], wp[5 * PIN]); o.w = pk2(wp[6 * PIN], wp[7 * PIN]); }
        *(u32x4*)(W1T + ((size_t)l * N1 + n) * 1024 + k8 * 8) = o;
    }
    bf16* W2T = (bf16*)(a.ws + WS_W2T);
    for (int t = gtid; t < 4 * 128 * 1024; t += GT) {
        const int n = t & 1023, k8 = (t >> 10) & 127, l = t >> 17;
        const float* wp = a.in[I_WOUT] + ((size_t)l * 1024 + k8 * 8) * 1024 + n;
        u32x4 o; o.x = pk2(wp[0], wp[1024]); o.y = pk2(wp[2048], wp[3072]); o.z = pk2(wp[4096], wp[5120]); o.w = pk2(wp[6144], wp[7168]);
        *(u32x4*)(W2T + ((size_t)l * 1024 + n) * 1024 + k8 * 8) = o;
    }
    float* POS = (float*)(a.ws + WS_POS);
    for (int t = gtid; t < 64 * 256; t += GT) { const int f = t & 255, i = t >> 8; const float fr = powf(10000.f, -(float)f / 256.f); const float ang = (float)i * fr;
        POS[t] = sinf(ang); POS[64 * 256 + t] = cosf(ang); }
    bf16* DFT = (bf16*)(a.ws + WS_DFT);
    for (int t = gtid; t < 256 * 512; t += GT) { const int tp = t & 511, k = t >> 9, tt = tp & 255; const float ph = (float)((k * tt) & 255) * (1.f / 128.f);
        DFT[t] = (bf16)f2bf((tp < 256 ? cospif(ph) : -sinpif(ph)) * (1.f / 16.f)); }
    bf16* M1 = (bf16*)(a.ws + WS_M1);
    for (int t = gtid; t < 128 * 128; t += GT) { const int kk = t & 127, m = t >> 7, k1 = m & 63, t1 = kk & 63; const float ph = (float)((k1 * t1) & 63) * (1.f / 32.f);
        const float c = cospif(ph), s = sinpif(ph); float v;
        if (m < 64) v = (kk < 64) ? c : -s; else v = (kk < 64) ? s : c;
        M1[t] = (bf16)f2bf(v); }
    bf16* M2 = (bf16*)(a.ws + WS_M2);
    for (int t = gtid; t < 64 * 128; t += GT) { const int kk = t & 127, k2 = t >> 7, t2 = kk & 63; const float ph = (float)((k2 * t2) & 63) * (1.f / 32.f);
        M2[t] = (bf16)f2bf((kk < 64 ? cospif(ph) : -sinpif(ph)) * (1.f / 64.f)); }
    float* TW = (float*)(a.ws + WS_TW);
    for (int t = gtid; t < 64 * 64; t += GT) { const int t2 = t & 63, k1 = t >> 6; const float ph = (float)(k1 * t2) * (1.f / 2048.f); TW[2 * t] = cospif(ph); TW[2 * t + 1] = sinpif(ph); }
}

__device__ __forceinline__ void phase_0b(const Args& a) {
    const int tid = otid(), lane = tid & 63, wave = tid >> 6, G = gridDim.x, bid = obid();
    const int gtid = bid * NTHR + tid, GT = G * NTHR;
    const float* MOD = (const float*)(a.ws + WS_MOD);
    const float* GM = (const float*)(a.ws + WS_GMAT);
    bf16* W1T = (bf16*)(a.ws + WS_W1T);
    for (int t = gtid; t < 4 * 128 * 768; t += GT) {
        const int nf = t % 768, k8 = (t / 768) & 127, l = t / (768 * 128);
        const int kind = nf >> 8, g = (nf >> 6) & 3, d = nf & 63;
        const int base = (kind == 0 ? 1808 : 2320) + 64 * g;
        const float* Gm = (kind == 0) ? (a.in[I_POOLW] + ((size_t)(l * 4 + g) * 64) * 64 + d) : (GM + ((size_t)((l * 4 + g) * 2 + (kind - 1)) * 64) * 64 + d);
        const float* wp = a.in[I_WIN] + ((size_t)l * 1024 + k8 * 8) * PIN + base;
        float s[8];
#pragma unroll
        for (int j = 0; j < 8; ++j) s[j] = 0.f;
        for (int c = 0; c < 64; ++c) { const float gv = Gm[c * 64];
#pragma unroll
            for (int j = 0; j < 8; ++j) s[j] += wp[(size_t)j * PIN + c] * gv; }
        u32x4 o; o.x = pk2(s[0], s[1]); o.y = pk2(s[2], s[3]); o.z = pk2(s[4], s[5]); o.w = pk2(s[6], s[7]);
        *(u32x4*)(W1T + ((size_t)l * N1 + 1536 + nf) * 1024 + k8 * 8) = o;
    }
    const float* POS = (const float*)(a.ws + WS_POS);
    bf16* HB = (bf16*)(a.ws + WS_HB);
    float* RSS = (float*)(a.ws + WS_RSS);
    for (int row = bid * NWAVES + wave; row < M; row += G * NWAVES) {
        f32x4 v[4];
        const int j = cond_of_row(row);
        if (row < M_CTX) {
            const f32x4* xr = (const f32x4*)(a.in[I_XP] + (size_t)row * D) + lane;
#pragma unroll
            for (int q = 0; q < 4; ++q) v[q] = xr[64 * q];
        } else {
            const int rs = row - M_CTX, t = rs & 4095, gr = t >> 6, gc = t & 63;
            const f32x4* xr = (const f32x4*)(a.in[I_XS] + (size_t)rs * D) + lane;
            const f32x4 p0 = *((const f32x4*)(POS + gr * 256) + lane), p1 = *((const f32x4*)(POS + 64 * 256 + gr * 256) + lane);
            const f32x4 p2 = *((const f32x4*)(POS + gc * 256) + lane), p3 = *((const f32x4*)(POS + 64 * 256 + gc * 256) + lane);
            v[0] = xr[0] + p0; v[1] = xr[64] + p1; v[2] = xr[128] + p2; v[3] = xr[192] + p3;
        }
        float ss = 0.f;
#pragma unroll
        for (int q = 0; q < 4; ++q) ss += (v[q].x * v[q].x + v[q].y * v[q].y) + (v[q].z * v[q].z + v[q].w * v[q].w);
        ss = wave_sum(ss);
        f32x4* orow = (f32x4*)(a.out + (size_t)row * D) + lane;
        u32x2* hrow = (u32x2*)(HB + (size_t)row * D) + lane;
#pragma unroll
        for (int q = 0; q < 4; ++q) {
            orow[64 * q] = v[q];
            const f32x4 ng = *((const f32x4*)(a.in[I_NORMG] + 256 * q) + lane);
            const f32x4 sc = *((const f32x4*)(MOD + (0 * 9 + j) * 3072 + 1024 + 256 * q) + lane);
            u32x2 h; h.x = pk2(v[q].x * ng.x * (1.f + sc.x), v[q].y * ng.y * (1.f + sc.y)); h.y = pk2(v[q].z * ng.z * (1.f + sc.z), v[q].w * ng.w * (1.f + sc.w));
            hrow[64 * q] = h;
        }
        if (lane < 16) RSS[(size_t)row * 16 + lane] = (lane == 0) ? ss : 0.f;
    }
}

__device__ __forceinline__ void phase_0c(const Args& a) {
    const int tid = otid(), lane = tid & 63, wave = tid >> 6, G = gridDim.x, bid = obid();
    const float* MOD = (const float*)(a.ws + WS_MOD);
    const bf16* W1T = (const bf16*)(a.ws + WS_W1T);
    float* SW = (float*)(a.ws + WS_SW);
    for (int it = bid * NWAVES + wave; it < 4 * N1; it += G * NWAVES) {
        const int l = it / N1, n = it % N1;
        const u32x4* wr = (const u32x4*)(W1T + ((size_t)l * N1 + n) * 1024) + lane * 2;
        const u32x4 w0 = wr[0], w1 = wr[1];
        float w[16];
        w[0] = bflo(w0.x); w[1] = bfhi(w0.x); w[2] = bflo(w0.y); w[3] = bfhi(w0.y); w[4] = bflo(w0.z); w[5] = bfhi(w0.z); w[6] = bflo(w0.w); w[7] = bfhi(w0.w);
        w[8] = bflo(w1.x); w[9] = bfhi(w1.x); w[10] = bflo(w1.y); w[11] = bfhi(w1.y); w[12] = bflo(w1.z); w[13] = bfhi(w1.z); w[14] = bflo(w1.w); w[15] = bfhi(w1.w);
#pragma unroll
        for (int j = 0; j < 9; ++j) {
            const f32x4* sp = (const f32x4*)(MOD + (l * 9 + j) * 3072) + lane * 4;
            float s = 0.f;
#pragma unroll
            for (int q = 0; q < 4; ++q) { const f32x4 sv = sp[q]; s += sv.x * w[4 * q] + sv.y * w[4 * q + 1] + sv.z * w[4 * q + 2] + sv.w * w[4 * q + 3]; }
            s = wave_sum(s);
            if (lane == 0) SW[(l * 9 + j) * N1 + n] = s;
        }
    }
}

struct Epi1 {
    static constexpr bool PERM = true;
    bf16* PB; float* BA; const float* RSS; const float* SW;
    __device__ __forceinline__ void operator()(const f32x4 (&acc)[2][2][4][2], const pg8::Unit& u, int wr, int wc, int fr, int fq) const {
        const int pn = u.pn, j = u.pm < 32 ? 0 : 1 + ((u.pm - 32) >> 4);
        const int row0 = u.pm * 256 + wr * 64 + fr, cb = pn * 256 + wc * 32 + 8 * fq;
        const int act = (pn == 0 || pn == 2 || pn == 3 || pn == 5) ? 1 : ((pn == 1 || pn == 4) ? 2 : 0);
        f32x4 bv[2][2];
#pragma unroll
        for (int bj = 0; bj < 2; ++bj)
#pragma unroll
            for (int n = 0; n < 2; ++n) bv[bj][n] = *(const f32x4*)(SW + j * N1 + cb + bj * 128 + 4 * n);
#pragma unroll
        for (int ai = 0; ai < 2; ++ai)
#pragma unroll
            for (int m = 0; m < 4; ++m) {
                const int row = row0 + ai * 128 + m * 16;
                const f32x4* rp = (const f32x4*)(RSS + (size_t)row * 16);
                const f32x4 r0 = rp[0], r1 = rp[1], r2 = rp[2], r3 = rp[3];
                const float ss = ((r0.x + r0.y) + (r0.z + r0.w)) + ((r1.x + r1.y) + (r1.z + r1.w)) + ((r2.x + r2.y) + (r2.z + r2.w)) + ((r3.x + r3.y) + (r3.z + r3.w));
                const float rinv = rsqrtf(ss * (1.f / 1024.f) + EPS);
#pragma unroll
                for (int bj = 0; bj < 2; ++bj) {
                    f32x4 v0 = acc[ai][bj][m][0] * rinv + bv[bj][0], v1 = acc[ai][bj][m][1] * rinv + bv[bj][1];
                    if (pn < 12) {
                        if (act == 1) {
#pragma unroll
                            for (int q = 0; q < 4; ++q) { v0[q] = silu_f(v0[q]); v1[q] = silu_f(v1[q]); }
                        } else if (act == 2) {
#pragma unroll
                            for (int q = 0; q < 4; ++q) { v0[q] = gelu_tanh_f(v0[q]); v1[q] = gelu_tanh_f(v1[q]); }
                        }
                        u32x4 w; w.x = pk2(v0[0], v0[1]); w.y = pk2(v0[2], v0[3]); w.z = pk2(v1[0], v1[1]); w.w = pk2(v1[2], v1[3]);
                        *(u32x4*)(PB + (size_t)row * LDP + cb + bj * 128) = w;
                    } else if (bj == 0 && wc == 0 && fq < 2) {
                        f32x4* bp = (f32x4*)(BA + (size_t)row * 16 + 8 * fq); bp[0] = v0; bp[1] = v1;
                    }
                }
            }
    }
};
struct Epi2 {
    static constexpr bool PERM = true;
    float* X; bf16* HB; float* RSS; const float* gate;
    const float* ng_next; const float* sc_next;
    unsigned char* dum; int dry;
    __device__ __forceinline__ void operator()(const f32x4 (&acc)[2][2][4][2], const pg8::Unit& u, int wr, int wc, int fr, int fq) const {
        const int pn = u.pn, j = u.pm < 32 ? 0 : 1 + ((u.pm - 32) >> 4);
        const int row0 = u.pm * 256 + wr * 64 + fr, cb = pn * 256 + wc * 32 + 8 * fq;
        f32x4 gv[2][2], gs[2][2];
#pragma unroll
        for (int bj = 0; bj < 2; ++bj)
#pragma unroll
            for (int n = 0; n < 2; ++n) {
                gv[bj][n] = *(const f32x4*)(gate + j * 3072 + cb + bj * 128 + 4 * n);
                if (ng_next) { const f32x4 ng = *(const f32x4*)(ng_next + cb + bj * 128 + 4 * n), sc = *(const f32x4*)(sc_next + j * 3072 + cb + bj * 128 + 4 * n); gs[bj][n] = ng * (sc + 1.f); }
                else gs[bj][n] = (f32x4){0.f, 0.f, 0.f, 0.f};
            }
#pragma unroll
        for (int ai = 0; ai < 2; ++ai)
#pragma unroll
            for (int m = 0; m < 4; ++m) {
                const int row = row0 + ai * 128 + m * 16;
                float ssq = 0.f;
#pragma unroll
                for (int bj = 0; bj < 2; ++bj) {
                    f32x4* xp = (f32x4*)(X + (size_t)row * D + cb + bj * 128);
                    const f32x4 n0 = xp[0] + gv[bj][0] * acc[ai][bj][m][0], n1 = xp[1] + gv[bj][1] * acc[ai][bj][m][1];
                    if (dry) xp = (f32x4*)((float*)dum + (size_t)(row & 1023) * D + cb + bj * 128);
                    xp[0] = n0; xp[1] = n1;
                    ssq += (n0.x * n0.x + n0.y * n0.y) + (n0.z * n0.z + n0.w * n0.w) + (n1.x * n1.x + n1.y * n1.y) + (n1.z * n1.z + n1.w * n1.w);
                    if (ng_next) { const f32x4 h0 = n0 * gs[bj][0], h1 = n1 * gs[bj][1];
                        u32x4 w; w.x = pk2(h0[0], h0[1]); w.y = pk2(h0[2], h0[3]); w.z = pk2(h1[0], h1[1]); w.w = pk2(h1[2], h1[3]);
                        *(u32x4*)((dry ? (bf16*)(dum + 4 * MiB) + (size_t)(row & 1023) * D : HB + (size_t)row * D) + cb + bj * 128) = w; }
                }
                ssq += __shfl_xor(ssq, 16); ssq += __shfl_xor(ssq, 32);
                if (fq == 0) (dry ? (float*)(dum + 8 * MiB) + (size_t)(row & 1023) * 16 : RSS + (size_t)row * 16)[pn * 4 + wc] = ssq;
            }
    }
};

typedef short bf16x4 __attribute__((ext_vector_type(4)));
__device__ __forceinline__ f32x4 mfma16(bf16x4 a, bf16x4 b, f32x4 c) { return __builtin_amdgcn_mfma_f32_16x16x16bf16_1k(a, b, c, 0, 0, 0); }
__device__ __forceinline__ bf16x4 pack4(f32x4 v) { u32x2 w; w.x = pk2(v[0], v[1]); w.y = pk2(v[2], v[3]); return __builtin_bit_cast(bf16x4, w); }
__device__ __forceinline__ bf16x8 pack8(f32x4 lo, f32x4 hi) { u32x4 w; w.x = pk2(lo[0], lo[1]); w.y = pk2(lo[2], lo[3]); w.z = pk2(hi[0], hi[1]); w.w = pk2(hi[2], hi[3]); return __builtin_bit_cast(bf16x8, w); }
constexpr int PREP_ITEM = 5 * 4096;

__device__ __forceinline__ void prep_dinv(const LAS float* Af_, LAS bf16* Dl, int lane) {
    const int blk = lane >> 4, c = lane & 15;
    unsigned ab = (unsigned)(size_t)(Af_ + (16 * blk) * 68 + 16 * blk);
    asm volatile("" : "+v"(ab));
    const LAS float* Ab = (const LAS float*)(size_t)ab;
    float x[16];
#pragma unroll
    for (int ii = 0; ii < 16; ++ii) {
        float acc = (ii == c) ? 1.f : 0.f;
        const LAS f32x4* ar = (const LAS f32x4*)(Ab + ii * 68);
#pragma unroll
        for (int jq = 0; jq < 4; ++jq) {
            if (4 * jq < ii) {
                const f32x4 av = ar[jq];
                if (4 * jq + 0 < ii) acc -= av.x * x[4 * jq + 0];
                if (4 * jq + 1 < ii) acc -= av.y * x[4 * jq + 1];
                if (4 * jq + 2 < ii) acc -= av.z * x[4 * jq + 2];
                if (4 * jq + 3 < ii) acc -= av.w * x[4 * jq + 3];
            }
        }
        asm volatile("" : "+v"(acc) :: "memory");
        x[ii] = acc;
    }
#pragma unroll
    for (int ii = 0; ii < 16; ++ii) Dl[(blk * 16 + ii) * 24 + c] = (bf16)f2bf(x[ii]);
}

__device__ __forceinline__ void prep_item(const Args& a, LAS unsigned char* lds, int l, int sc, int h) {
    const int tid = otid(), lane = tid & 63, wave = __builtin_amdgcn_readfirstlane(tid >> 6);
    LAS float* qs = (LAS float*)lds;
    LAS float* ks = qs + 64 * 65;
    LAS float* vs = ks + 64 * 65;
    LAS bf16* Qb = (LAS bf16*)(lds + 49920);
    LAS bf16* Kb = (LAS bf16*)(lds + 59136);
    LAS float* Af = (LAS float*)(lds + 68352);
    LAS bf16* Ab = (LAS bf16*)(lds + 85760);
    LAS bf16* QKl = (LAS bf16*)(lds + 94976);
    LAS bf16* Wl = (LAS bf16*)(lds + 104192);
    LAS bf16* Dl = (LAS bf16*)(lds + 113408);
    LAS float* beta = (LAS float*)(lds + 116480);
    LAS float* gcs = beta + 128;
    const bf16* PB = (const bf16*)(a.ws + WS_PB);
    const float* BA = (const float*)(a.ws + WS_BA);
    const SeqGeo sg = seq_geo(sc);
    const int row0 = sc * 64;
    if (wave < 2) {
        const int dir = wave, tok = dir ? 63 - lane : lane;
        const float bl = BA[(size_t)(row0 + tok) * 16 + dir * 4 + h], al = BA[(size_t)(row0 + tok) * 16 + 8 + dir * 4 + h];
        const float bt = 1.f / (1.f + expf(-bl));
        const float xx = al + a.in[I_DTB][(l * 2 + dir) * 4 + h];
        const float sp = xx > 20.f ? xx : log1pf(expf(xx));
        float g = -expf(a.in[I_ALOG][(l * 2 + dir) * 4 + h]) * sp;
#pragma unroll
        for (int o = 1; o < 64; o <<= 1) { const float t = __shfl_up(g, o); if (lane >= o) g += t; }
        beta[dir * 64 + lane] = bt; gcs[dir * 64 + lane] = g;
        if (lane == 63) ((float*)(a.ws + WS_PGL))[(sc * 4 + h) * 2 + dir] = expf(g);
    }
    for (int t = tid; t < 64 * 24; t += NTHR) {
        const int tok = t / 24, cg = t % 24, part = cg >> 3, d0 = (cg & 7) * 8;
        const int col = C_Q + part * 256 + h * 64 + d0, chan = part * 256 + h * 64 + d0;
        float o[8];
#pragma unroll
        for (int c = 0; c < 8; ++c) o[c] = 0.f;
#pragma unroll
        for (int jj = 0; jj < 4; ++jj) {
            const int ts = sg.tseq0 + tok + jj - 2;
            if (ts >= 0 && ts < sg.T) {
                const u32x4 xv = *(const u32x4*)(PB + (size_t)(sg.seq_row0 + ts) * LDP + col);
                const f32x4 w0 = *(const f32x4*)(a.in[I_CONV] + (size_t)(l * 4 + jj) * 768 + chan), w1 = *(const f32x4*)(a.in[I_CONV] + (size_t)(l * 4 + jj) * 768 + chan + 4);
                o[0] += w0.x * bflo(xv.x); o[1] += w0.y * bfhi(xv.x); o[2] += w0.z * bflo(xv.y); o[3] += w0.w * bfhi(xv.y);
                o[4] += w1.x * bflo(xv.z); o[5] += w1.y * bfhi(xv.z); o[6] += w1.z * bflo(xv.w); o[7] += w1.w * bfhi(xv.w);
            }
        }
        LAS float* dst = (part == 0 ? qs : (part == 1 ? ks : vs)) + tok * 65 + d0;
#pragma unroll
        for (int c = 0; c < 8; ++c) dst[c] = silu_f(o[c]);
    }
    __syncthreads();
    {
        const int rowid = tid >> 2, seg = tid & 3, ar = rowid & 63;
        LAS float* p = (rowid < 64 ? qs : ks) + ar * 65 + seg * 16;
        float v[16]; float ss = 0.f;
#pragma unroll
        for (int c = 0; c < 16; ++c) { v[c] = p[c]; ss += v[c] * v[c]; }
        ss += __shfl_xor(ss, 1); ss += __shfl_xor(ss, 2);
        const float s = rsqrtf(ss + EPS) * (rowid < 64 ? 0.125f : 1.f);
#pragma unroll
        for (int c = 0; c < 16; ++c) { v[c] *= s; p[c] = v[c]; }
        LAS bf16* bp = (rowid < 64 ? Qb : Kb) + ar * 72 + seg * 16;
        u32x4 o0, o1; o0.x = pk2(v[0], v[1]); o0.y = pk2(v[2], v[3]); o0.z = pk2(v[4], v[5]); o0.w = pk2(v[6], v[7]);
        o1.x = pk2(v[8], v[9]); o1.y = pk2(v[10], v[11]); o1.z = pk2(v[12], v[13]); o1.w = pk2(v[14], v[15]);
        *(LAS u32x4*)bp = o0; *(LAS u32x4*)(bp + 8) = o1;
    }
    __syncthreads();
    const int mt = wave >> 1, nh = wave & 1, m0 = mt * 16, r = lane & 15, kg = lane >> 4;
    f32x4 KKa[2], QKa[2];
#pragma unroll
    for (int t = 0; t < 2; ++t) {
        KKa[t] = tile_mm<2>((f32x4){0.f, 0.f, 0.f, 0.f}, Kb, 72, m0, Kb, 72, nh * 32 + 16 * t, lane);
        QKa[t] = tile_mm<2>((f32x4){0.f, 0.f, 0.f, 0.f}, Qb, 72, m0, Kb, 72, nh * 32 + 16 * t, lane);
    }
#pragma unroll 1
    for (int dir = 0; dir < 2; ++dir) {
        bf16* PI = (bf16*)(a.ws + WS_PREP) + (size_t)((sc * 4 + h) * 2 + dir) * PREP_ITEM;
        const LAS float* bt_ = beta + dir * 64; const LAS float* gc_ = gcs + dir * 64;
#pragma unroll
        for (int t = 0; t < 2; ++t) {
            const int bcol = nh * 32 + 16 * t + r, j = dir ? 63 - bcol : bcol;
            const float gj = gc_[j];
#pragma unroll
            for (int q = 0; q < 4; ++q) {
                const int arow = m0 + 4 * kg + q, i = dir ? 63 - arow : arow;
                const float dec = (i >= j) ? expf(gc_[i] - gj) : 0.f;
                const float av = (i > j) ? bt_[i] * KKa[t][q] * dec : 0.f;
                Af[i * 68 + j] = av; Ab[i * 72 + j] = (bf16)f2bf(-av); QKl[i * 72 + j] = (bf16)f2bf(QKa[t][q] * dec);
            }
        }
        __syncthreads();
        if (wave == 0) prep_dinv(Af, Dl, lane);
        const float gl = gc_[63];
        for (int t = tid; t < 1024; t += NTHR) {
            const int which = t >> 9, rw = (t >> 3) & 63, sgp = t & 7, n0a = 32 * (sgp >> 2) + 4 * (sgp & 3), n0b = n0a + 16;
            float v[8];
            if (which == 0) {
                const int tok = dir ? 63 - rw : rw; const float e = expf(gc_[rw]);
#pragma unroll
                for (int c = 0; c < 4; ++c) { v[c] = qs[tok * 65 + n0a + c] * e; v[4 + c] = qs[tok * 65 + n0b + c] * e; }
            } else {
#pragma unroll
                for (int c = 0; c < 4; ++c) { const int ia = n0a + c, ib = n0b + c;
                    v[c] = ks[(dir ? 63 - ia : ia) * 65 + rw] * expf(gl - gc_[ia]); v[4 + c] = ks[(dir ? 63 - ib : ib) * 65 + rw] * expf(gl - gc_[ib]); }
            }
            u32x4 o; o.x = pk2(v[0], v[1]); o.y = pk2(v[2], v[3]); o.z = pk2(v[4], v[5]); o.w = pk2(v[6], v[7]);
            *(u32x4*)(PI + (1 + which) * 4096 + rw * 64 + sgp * 8) = o;
        }
        __syncthreads();
        {
            const int n = 16 * wave + r, isw = wave >> 2, cc = n & 63;
            const LAS float* rsrc = (isw ? ks : vs) + cc;
            f32x4 X[4];
#pragma unroll
            for (int b = 0; b < 4; ++b) {
                f32x4 T;
#pragma unroll
                for (int q = 0; q < 4; ++q) { const int i = 16 * b + 4 * kg + q, tok = dir ? 63 - i : i;
                    const float sc_ = isw ? bt_[i] * expf(gc_[i]) : bt_[i];
                    T[q] = sc_ * rsrc[tok * 65]; }
#pragma unroll
                for (int m = 0; m < 4; ++m) if (m < b) {
                    const bf16x4 af = *(const LAS bf16x4*)(Ab + (16 * b + r) * 72 + 16 * m + 4 * kg);
                    T = mfma16(af, pack4(X[m]), T);
                }
                const bf16x4 df = *(const LAS bf16x4*)(Dl + (b * 16 + r) * 24 + 4 * kg);
                X[b] = mfma16(df, pack4(T), (f32x4){0.f, 0.f, 0.f, 0.f});
                if (!isw) { *(u32x2*)(PI + 4 * 4096 + cc * 64 + 16 * b + 4 * kg) = __builtin_bit_cast(u32x2, pack4(X[b])); }
                else {
#pragma unroll
                    for (int q = 0; q < 4; ++q) Wl[(16 * b + 4 * kg + q) * 72 + cc] = (bf16)f2bf(X[b][q]);
                }
            }
        }
        __syncthreads();
        for (int t = tid; t < 1024; t += NTHR) {
            const int which = t >> 9, rw = (t >> 3) & 63, sgp = t & 7, n0a = 32 * (sgp >> 2) + 4 * (sgp & 3);
            const LAS bf16* src = (which ? QKl : Wl) + rw * 72 + n0a;
            const u32x2 lo = *(const LAS u32x2*)src, hi = *(const LAS u32x2*)(src + 16);
            u32x4 o; o.x = lo.x; o.y = lo.y; o.z = hi.x; o.w = hi.y;
            *(u32x4*)(PI + (which ? 3 : 0) * 4096 + rw * 64 + sgp * 8) = o;
        }
        __syncthreads();
    }
}

__device__ __forceinline__ void sgu_item(const Args& a, LAS unsigned char* lds, int l, int ch, int g, int dry) {
    const int tid = otid(), lane = tid & 63, wave = tid >> 6;
    LAS bf16* Wl = (LAS bf16*)lds;
    LAS bf16* VT = Wl + 128 * 136;
    LAS float* rstd = (LAS float*)(VT + 64 * 136);
    bf16* PB = (bf16*)(a.ws + WS_PB);
    const int row0 = ch * 128;
    {
        const int q = tid >> 2, part = tid & 3;
        const u32x4* vp = (const u32x4*)(PB + (size_t)(row0 + q) * LDP + C_V + part * 64);
        float ss = 0.f;
#pragma unroll
        for (int i = 0; i < 8; ++i) { const u32x4 v = vp[i];
            const float f0 = bflo(v.x), f1 = bfhi(v.x), f2 = bflo(v.y), f3 = bfhi(v.y), f4 = bflo(v.z), f5 = bfhi(v.z), f6 = bflo(v.w), f7 = bfhi(v.w);
            ss += (f0 * f0 + f1 * f1) + (f2 * f2 + f3 * f3) + (f4 * f4 + f5 * f5) + (f6 * f6 + f7 * f7); }
        ss += __shfl_xor(ss, 1); ss += __shfl_xor(ss, 2);
        if (part == 0) rstd[q] = rsqrtf(ss * (1.f / 256.f) + EPS);
    }
    for (int t = tid; t < 128 * 16; t += NTHR) {
        const int p = t >> 4, q8 = t & 15;
        const f32x4* wp = (const f32x4*)(a.in[I_SGUW] + ((size_t)(l * 4 + g) * 128 + p) * 128 + q8 * 8);
        const f32x4 w0 = wp[0], w1 = wp[1];
        u32x4 o; o.x = pk2(w0.x, w0.y); o.y = pk2(w0.z, w0.w); o.z = pk2(w1.x, w1.y); o.w = pk2(w1.z, w1.w);
        *(LAS u32x4*)(Wl + p * 136 + q8 * 8) = o;
    }
    __syncthreads();
    for (int t = tid; t < 128 * 8; t += NTHR) {
        const int q = t >> 3, c0 = (t & 7) * 8;
        const u32x4 v = *(const u32x4*)(PB + (size_t)(row0 + q) * LDP + C_V + g * 64 + c0);
        const f32x4 g0 = *(const f32x4*)(a.in[I_SGUNG] + l * 256 + g * 64 + c0), g1 = *(const f32x4*)(a.in[I_SGUNG] + l * 256 + g * 64 + c0 + 4);
        const float r = rstd[q];
        VT[(c0 + 0) * 136 + q] = (bf16)f2bf(bflo(v.x) * r * g0.x); VT[(c0 + 1) * 136 + q] = (bf16)f2bf(bfhi(v.x) * r * g0.y);
        VT[(c0 + 2) * 136 + q] = (bf16)f2bf(bflo(v.y) * r * g0.z); VT[(c0 + 3) * 136 + q] = (bf16)f2bf(bfhi(v.y) * r * g0.w);
        VT[(c0 + 4) * 136 + q] = (bf16)f2bf(bflo(v.z) * r * g1.x); VT[(c0 + 5) * 136 + q] = (bf16)f2bf(bfhi(v.z) * r * g1.y);
        VT[(c0 + 6) * 136 + q] = (bf16)f2bf(bflo(v.w) * r * g1.z); VT[(c0 + 7) * 136 + q] = (bf16)f2bf(bfhi(v.w) * r * g1.w);
    }
    __syncthreads();
    {
        const int m0 = wave * 16, r = lane & 15, kg = lane >> 4;
#pragma unroll
        for (int nt = 0; nt < 4; ++nt) {
            f32x4 acc = (f32x4){0.f, 0.f, 0.f, 0.f};
            acc = tile_mm<4>(acc, Wl, 136, m0, VT, 136, nt * 16, lane);
#pragma unroll
            for (int q = 0; q < 4; ++q) {
                const int p = m0 + 4 * kg + q, c = nt * 16 + r;
                const float sv = acc[q] + a.in[I_SGUB][(l * 4 + g) * 128 + p];
                bf16* up = PB + (size_t)(row0 + p) * LDP + C_U + g * 64 + c;
                const float uu = bf2f(*up), gb = bf2f(PB[(size_t)(row0 + p) * LDP + C_GB + g * 64 + c]);
                if (dry) up = (bf16*)(a.ws + WS_DUM) + (size_t)((row0 + p) & 1023) * LDP + C_U + g * 64 + c;
                *up = (bf16)f2bf(uu * sv * gb);
            }
        }
    }
    __syncthreads();
}

__device__ __forceinline__ void pool_item(const Args& a, LAS unsigned char* lds, int l, int sc, int dry) {
    const int tid = otid();
    LAS bf16* xt = (LAS bf16*)lds;
    bf16* PB = (bf16*)(a.ws + WS_PB);
    const SeqGeo sg = seq_geo(sc);
    for (int t = tid; t < 80 * 32; t += NTHR) {
        const int r = t >> 5, c8 = t & 31, ts = sg.tseq0 - 8 + r;
        u32x4 v = (u32x4){0u, 0u, 0u, 0u};
        if (ts >= 0 && ts < sg.T) v = *(const u32x4*)(PB + (size_t)(sg.seq_row0 + ts) * LDP + C_XC + c8 * 8);
        *(LAS u32x4*)(xt + r * 264 + c8 * 8) = v;
    }
    __syncthreads();
    for (int t = tid; t < 64 * 32; t += NTHR) {
        const int tok = t >> 5, c8 = t & 31, gi = c8 >> 3, half = 1 << gi;
        const int ts = sg.tseq0 + tok;
        const int lo = (ts - half) < 0 ? 0 : ts - half, hi = (ts + half) > sg.T ? sg.T : ts + half;
        float s[8];
#pragma unroll
        for (int c = 0; c < 8; ++c) s[c] = 0.f;
        for (int tt = lo; tt < hi; ++tt) {
            const u32x4 v = *(const LAS u32x4*)(xt + (tt - sg.tseq0 + 8) * 264 + c8 * 8);
            s[0] += bflo(v.x); s[1] += bfhi(v.x); s[2] += bflo(v.y); s[3] += bfhi(v.y); s[4] += bflo(v.z); s[5] += bfhi(v.z); s[6] += bflo(v.w); s[7] += bfhi(v.w);
        }
        const float inv = 1.f / (float)(hi - lo);
        const u32x4 xv = *(const LAS u32x4*)(xt + (tok + 8) * 264 + c8 * 8);
        const float x0[8] = {bflo(xv.x), bfhi(xv.x), bflo(xv.y), bfhi(xv.y), bflo(xv.z), bfhi(xv.z), bflo(xv.w), bfhi(xv.w)};
        bf16* yp = PB + (size_t)(sg.seq_row0 + ts) * LDP + C_GC + c8 * 8;
        const u32x4 gv = *(const u32x4*)yp;
        const float gg[8] = {bflo(gv.x), bfhi(gv.x), bflo(gv.y), bfhi(gv.y), bflo(gv.z), bfhi(gv.z), bflo(gv.w), bfhi(gv.w)};
        const f32x4 p0 = *(const f32x4*)(a.in[I_POOLS] + l * 256 + c8 * 8), p1 = *(const f32x4*)(a.in[I_POOLS] + l * 256 + c8 * 8 + 4);
        const float ps[8] = {p0.x, p0.y, p0.z, p0.w, p1.x, p1.y, p1.z, p1.w};
        float y[8];
#pragma unroll
        for (int c = 0; c < 8; ++c) y[c] = (s[c] * inv - x0[c]) * ps[c] * gg[c];
        u32x4 o; o.x = pk2(y[0], y[1]); o.y = pk2(y[2], y[3]); o.z = pk2(y[4], y[5]); o.w = pk2(y[6], y[7]);
        if (dry) yp = (bf16*)(a.ws + WS_DUM) + (size_t)((sg.seq_row0 + ts) & 1023) * LDP + C_GC + c8 * 8;
        *(u32x4*)yp = o;
    }
    __syncthreads();
}

__device__ __forceinline__ void fctx_item(const Args& a, LAS unsigned char* lds, int b, int dblk, int dry) {
    const int tid = otid(), lane = tid & 63, wave = __builtin_amdgcn_readfirstlane(tid >> 6);
    LAS bf16* ZT = (LAS bf16*)lds;
    bf16* PB = (bf16*)(a.ws + WS_PB);
    const bf16* DFT = (const bf16*)(a.ws + WS_DFT);
    {
        u32x4 v[8];
#pragma unroll
        for (int i = 0; i < 8; ++i) { const int t = tid + NTHR * i, d8 = t & 7, ri = (t >> 3) & 1, tt = t >> 4;
            v[i] = *(const u32x4*)(PB + (size_t)(b * 256 + tt) * LDP + (ri ? C_QF : C_PF) + dblk * 64 + d8 * 8); }
#pragma unroll
        for (int i = 0; i < 8; ++i) { const int t = tid + NTHR * i, d8 = t & 7, ri = (t >> 3) & 1, tt = t >> 4;
            LAS bf16* dst = ZT + (d8 * 8) * 520 + ri * 256 + tt;
            dst[0 * 520] = (bf16)(v[i].x & 0xffffu); dst[1 * 520] = (bf16)(v[i].x >> 16); dst[2 * 520] = (bf16)(v[i].y & 0xffffu); dst[3 * 520] = (bf16)(v[i].y >> 16);
            dst[4 * 520] = (bf16)(v[i].z & 0xffffu); dst[5 * 520] = (bf16)(v[i].z >> 16); dst[6 * 520] = (bf16)(v[i].w & 0xffffu); dst[7 * 520] = (bf16)(v[i].w >> 16); }
    }
    __syncthreads();
    const int r = lane & 15, kg = lane >> 4;
#pragma unroll 1
    for (int mi = 0; mi < 2; ++mi) {
        const int m0 = wave * 32 + mi * 16;
        bf16 gdv[4][4];
#pragma unroll
        for (int nt = 0; nt < 4; ++nt)
#pragma unroll
            for (int q = 0; q < 4; ++q) gdv[nt][q] = PB[(size_t)(b * 256 + m0 + 4 * kg + q) * LDP + C_GD + dblk * 64 + nt * 16 + r];
        f32x4 acc[4];
#pragma unroll
        for (int nt = 0; nt < 4; ++nt) acc[nt] = (f32x4){0.f, 0.f, 0.f, 0.f};
#pragma unroll
        for (int kh = 0; kh < 2; ++kh) {
            bf16x8 af[8];
#pragma unroll
            for (int ksx = 0; ksx < 8; ++ksx) af[ksx] = *(const bf16x8*)(DFT + (size_t)(m0 + r) * 512 + (kh * 8 + ksx) * 32 + kg * 8);
#pragma unroll
            for (int nt = 0; nt < 4; ++nt) {
#pragma unroll
                for (int ksx = 0; ksx < 8; ++ksx) {
                    const bf16x8 bfr = *(const LAS bf16x8*)(ZT + (nt * 16 + r) * 520 + (kh * 8 + ksx) * 32 + kg * 8);
                    acc[nt] = __builtin_amdgcn_mfma_f32_16x16x32_bf16(af[ksx], bfr, acc[nt], 0, 0, 0);
                }
                __builtin_amdgcn_sched_barrier(0);
            }
        }
#pragma unroll
        for (int nt = 0; nt < 4; ++nt)
#pragma unroll
            for (int q = 0; q < 4; ++q) {
                const int k = m0 + 4 * kg + q, d = nt * 16 + r;
                bf16* yp = (dry ? (bf16*)(a.ws + WS_DUM) + (size_t)((b * 256 + k) & 1023) * LDP : PB + (size_t)(b * 256 + k) * LDP) + C_GD + dblk * 64 + d;
                *yp = (bf16)f2bf(acc[nt][q] * bf2f(gdv[nt][q]));
            }
    }
    __syncthreads();
}

__device__ __forceinline__ void fsmp_item(const Args& a, LAS unsigned char* lds, int b, int ds, int dry) {
    const int tid = otid(), lane = tid & 63, wave = __builtin_amdgcn_readfirstlane(tid >> 6);
    LAS bf16* ZT = (LAS bf16*)lds;
    LAS bf16* B2 = ZT + 256 * 136;
    bf16* PB = (bf16*)(a.ws + WS_PB);
    const bf16* M1 = (const bf16*)(a.ws + WS_M1);
    const bf16* M2 = (const bf16*)(a.ws + WS_M2);
    const int d0 = ds * 4;
    const size_t rowb = (size_t)M_CTX + (size_t)b * 4096;
    const int r = lane & 15, kg = lane >> 4, mp = wave & 3, nb = wave >> 2;
    {
        u32x2 v[16];
#pragma unroll
        for (int i = 0; i < 16; ++i) { const int t = tid + NTHR * i, ri = t & 1, tt = t >> 1;
            v[i] = *(const u32x2*)(PB + (rowb + tt) * LDP + (ri ? C_QF : C_PF) + d0); }
#pragma unroll
        for (int i = 0; i < 16; ++i) { const int t = tid + NTHR * i, ri = t & 1, tt = t >> 1, t1 = tt >> 6, t2 = tt & 63;
            LAS bf16* dst = ZT + (t2 * 4) * 136 + ri * 64 + t1;
            dst[0] = (bf16)(v[i].x & 0xffffu); dst[136] = (bf16)(v[i].x >> 16); dst[272] = (bf16)(v[i].y & 0xffffu); dst[408] = (bf16)(v[i].y >> 16); }
    }
    bf16x8 aRe[4], aIm[4], a2[4];
#pragma unroll
    for (int ksx = 0; ksx < 4; ++ksx) {
        aRe[ksx] = *(const bf16x8*)(M1 + (16 * mp + r) * 128 + ksx * 32 + kg * 8);
        aIm[ksx] = *(const bf16x8*)(M1 + (64 + 16 * mp + r) * 128 + ksx * 32 + kg * 8);
        a2[ksx] = *(const bf16x8*)(M2 + (16 * mp + r) * 128 + ksx * 32 + kg * 8);
    }
    bf16 gdv[8][4];
#pragma unroll
    for (int jb = 0; jb < 8; ++jb) { const int n = 16 * (nb + 2 * jb) + r, k1 = n >> 2, dd = n & 3;
#pragma unroll
        for (int q = 0; q < 4; ++q) gdv[jb][q] = PB[(rowb + k1 + 64 * (16 * mp + 4 * kg + q)) * LDP + C_GD + d0 + dd]; }
    __syncthreads();
#pragma unroll 2
    for (int jb = 0; jb < 8; ++jb) {
        const int nt = nb + 2 * jb;
        f32x4 ar = (f32x4){0.f, 0.f, 0.f, 0.f}, ai = (f32x4){0.f, 0.f, 0.f, 0.f};
#pragma unroll
        for (int ksx = 0; ksx < 4; ++ksx) {
            const bf16x8 z = *(const LAS bf16x8*)(ZT + (16 * nt + r) * 136 + ksx * 32 + kg * 8);
            ar = __builtin_amdgcn_mfma_f32_16x16x32_bf16(aRe[ksx], z, ar, 0, 0, 0);
            ai = __builtin_amdgcn_mfma_f32_16x16x32_bf16(aIm[ksx], z, ai, 0, 0, 0);
        }
        const int n = 16 * nt + r, t2 = n >> 2, dd = n & 3;
#pragma unroll
        for (int q = 0; q < 4; ++q) {
            const int k1 = 16 * mp + 4 * kg + q;
            const float rev = (float)((k1 * t2) & 4095) * (1.f / 4096.f);
            const float cw = __builtin_amdgcn_cosf(rev), sw = __builtin_amdgcn_sinf(rev);
            const float xr = ar[q] * cw - ai[q] * sw, xi = ar[q] * sw + ai[q] * cw;
            B2[(k1 * 4 + dd) * 136 + t2] = (bf16)f2bf(xr);
            B2[(k1 * 4 + dd) * 136 + 64 + t2] = (bf16)f2bf(xi);
        }
    }
    __syncthreads();
#pragma unroll 2
    for (int jb = 0; jb < 8; ++jb) {
        const int nt = nb + 2 * jb;
        f32x4 acc = (f32x4){0.f, 0.f, 0.f, 0.f};
#pragma unroll
        for (int ksx = 0; ksx < 4; ++ksx) {
            const bf16x8 z = *(const LAS bf16x8*)(B2 + (16 * nt + r) * 136 + ksx * 32 + kg * 8);
            acc = __builtin_amdgcn_mfma_f32_16x16x32_bf16(a2[ksx], z, acc, 0, 0, 0);
        }
        const int n = 16 * nt + r, k1 = n >> 2, dd = n & 3;
#pragma unroll
        for (int q = 0; q < 4; ++q) {
            const int k2 = 16 * mp + 4 * kg + q, kk = k1 + 64 * k2;
            bf16* yp = (dry ? (bf16*)(a.ws + WS_DUM) + (size_t)(kk & 1023) * LDP : PB + (rowb + kk) * LDP) + C_GD + d0 + dd;
            *yp = (bf16)f2bf(acc[q] * bf2f(gdv[jb][q]));
        }
    }
    __syncthreads();
}

constexpr int SC_MAT = 64 * 72 * 2;
constexpr int SC_BUF = 5 * SC_MAT + 16;
constexpr int SC_OT = 2 * SC_BUF;
__device__ __forceinline__ void scan_item(const Args& a, LAS unsigned char* lds, int l, int seq, int h, int dir) {
    const int tid = otid(), lane = tid & 63, wave = __builtin_amdgcn_readfirstlane(tid >> 6);
    bf16* PB = (bf16*)(a.ws + WS_PB);
    const int nch = seq < 32 ? 4 : 64;
    const int sc0 = seq < 32 ? seq * 4 : 128 + (seq - 32) * 64;
    const int r = lane & 15, kg = lane >> 4;
    if (wave >= 4) {
        const int ht = tid - 256;
        u32x4 pre[10]; float pgl = 0.f;
#define SC_ISSUE(ss) do { const int c_ = dir ? nch - 1 - (ss) : (ss); const size_t pid_ = (size_t)((sc0 + c_) * 4 + h) * 2 + dir; \
            const u32x4* src_ = (const u32x4*)((const bf16*)(a.ws + WS_PREP) + pid_ * PREP_ITEM) + ht; \
            _Pragma("unroll") for (int i_ = 0; i_ < 10; ++i_) pre[i_] = src_[256 * i_]; \
            pgl = ((const float*)(a.ws + WS_PGL))[pid_]; } while (0)
#define SC_WRITE(bb) do { LAS unsigned char* B_ = lds + (bb) * SC_BUF; \
            _Pragma("unroll") for (int i_ = 0; i_ < 10; ++i_) { const int ch_ = ht + 256 * i_; \
                *(LAS u32x4*)(B_ + (ch_ >> 9) * SC_MAT + ((ch_ >> 3) & 63) * 144 + (ch_ & 7) * 16) = pre[i_]; } \
            if (ht == 0) *(LAS float*)(B_ + 5 * SC_MAT) = pgl; } while (0)
#define SC_OSTORE(ss) do { const int c_ = dir ? nch - 1 - (ss) : (ss); const LAS unsigned char* O_ = lds + SC_OT + ((ss) & 1) * SC_MAT; \
            _Pragma("unroll") for (int i_ = 0; i_ < 2; ++i_) { const int ch_ = ht + 256 * i_, rw_ = ch_ >> 3, c8_ = ch_ & 7; \
                const u32x4 v_ = *(const LAS u32x4*)(O_ + rw_ * 144 + c8_ * 16); \
                *(u32x4*)(PB + (size_t)((sc0 + c_) * 64 + (dir ? 63 - rw_ : rw_)) * LDP + (dir ? C_K : C_Q) + h * 64 + c8_ * 8) = v_; } } while (0)
        SC_ISSUE(0);
        SC_WRITE(0);
        { const int sn = nch > 1 ? 1 : 0; SC_ISSUE(sn); }
        __syncthreads();
#pragma unroll 1
        for (int s = 0; s < nch; ++s) {
            SC_WRITE((s + 1) & 1);
            if (s > 0) SC_OSTORE(s - 1);
            { const int sn = (s + 2 < nch) ? s + 2 : nch - 1; SC_ISSUE(sn); }
            __syncthreads();
        }
        SC_OSTORE(nch - 1);
#undef SC_ISSUE
#undef SC_WRITE
#undef SC_OSTORE
    } else {
        const int e = 16 * wave + r;
        f32x4 S[4];
#pragma unroll
        for (int t = 0; t < 4; ++t)
#pragma unroll
            for (int q = 0; q < 4; ++q) {
                const int d = 16 * t + 4 * kg + q;
                S[t][q] = (seq < 32) ? 0.f : a.in[I_STATE][((size_t)(((seq - 32) * 4 + l) * 2 + dir) * 4 + h) * 4096 + d * 64 + e];
            }
        __syncthreads();
#pragma unroll 1
        for (int s = 0; s < nch; ++s) {
            const LAS unsigned char* B = lds + (s & 1) * SC_BUF;
            const LAS bf16* Wm = (const LAS bf16*)B; const LAS bf16* Qd = Wm + 64 * 72; const LAS bf16* KdT = Qd + 64 * 72; const LAS bf16* QKm = KdT + 64 * 72; const LAS bf16* UT = QKm + 64 * 72;
            const float egl = *(const LAS float*)(B + 5 * SC_MAT);
            LAS bf16* OT = (LAS bf16*)(lds + SC_OT + (s & 1) * SC_MAT);
            bf16x8 bS[2];
            bS[0] = pack8(S[0], S[1]); bS[1] = pack8(S[2], S[3]);
            f32x4 a1[4], oo[4];
#pragma unroll
            for (int t = 0; t < 4; ++t) {
                a1[t] = (f32x4){0.f, 0.f, 0.f, 0.f}; oo[t] = (f32x4){0.f, 0.f, 0.f, 0.f};
#pragma unroll
                for (int ksx = 0; ksx < 2; ++ksx) {
                    const bf16x8 wf = *(const LAS bf16x8*)(Wm + (16 * t + r) * 72 + ksx * 32 + kg * 8);
                    const bf16x8 qf = *(const LAS bf16x8*)(Qd + (16 * t + r) * 72 + ksx * 32 + kg * 8);
                    a1[t] = __builtin_amdgcn_mfma_f32_16x16x32_bf16(wf, bS[ksx], a1[t], 0, 0, 0);
                    oo[t] = __builtin_amdgcn_mfma_f32_16x16x32_bf16(qf, bS[ksx], oo[t], 0, 0, 0);
                }
            }
            f32x4 vn[4];
#pragma unroll
            for (int t = 0; t < 4; ++t) {
                const u32x2 uu = *(const LAS u32x2*)(UT + e * 72 + 16 * t + 4 * kg);
                vn[t][0] = bflo(uu.x) - a1[t][0]; vn[t][1] = bfhi(uu.x) - a1[t][1]; vn[t][2] = bflo(uu.y) - a1[t][2]; vn[t][3] = bfhi(uu.y) - a1[t][3];
            }
            bf16x8 bV[2];
            bV[0] = pack8(vn[0], vn[1]); bV[1] = pack8(vn[2], vn[3]);
#pragma unroll
            for (int t = 0; t < 4; ++t) {
                f32x4 as = (f32x4){0.f, 0.f, 0.f, 0.f};
#pragma unroll
                for (int ksx = 0; ksx < 2; ++ksx) {
                    const bf16x8 kf = *(const LAS bf16x8*)(QKm + (16 * t + r) * 72 + ksx * 32 + kg * 8);
                    const bf16x8 df = *(const LAS bf16x8*)(KdT + (16 * t + r) * 72 + ksx * 32 + kg * 8);
                    oo[t] = __builtin_amdgcn_mfma_f32_16x16x32_bf16(kf, bV[ksx], oo[t], 0, 0, 0);
                    as = __builtin_amdgcn_mfma_f32_16x16x32_bf16(df, bV[ksx], as, 0, 0, 0);
                }
                S[t] = S[t] * egl + as;
            }
#pragma unroll
            for (int t = 0; t < 4; ++t)
#pragma unroll
                for (int q = 0; q < 4; ++q) OT[(16 * t + 4 * kg + q) * 72 + e] = (bf16)f2bf(oo[t][q]);
            __syncthreads();
        }
        if (seq < 32) {
            float* ns = a.out + (size_t)M * D + ((size_t)((seq * 4 + l) * 2 + dir) * 4 + h) * 4096;
#pragma unroll
            for (int t = 0; t < 4; ++t)
#pragma unroll
                for (int q = 0; q < 4; ++q) ns[(16 * t + 4 * kg + q) * 64 + e] = S[t][q];
        }
    }
    __syncthreads();
}

__device__ __forceinline__ void phase_combine(const Args& a, int l, int dry) {
    const int tid = otid(), lane = tid & 63, wave = tid >> 6, G = gridDim.x, bid = obid();
    bf16* PB = (bf16*)(a.ws + WS_PB);
    const f32x4 ng = *(const f32x4*)(a.in[I_DNG] + l * 64 + (lane & 15) * 4);
    for (int row = bid * NWAVES + wave; row < M; row += G * NWAVES) {
        bf16* rp = PB + (size_t)row * LDP;
        const u32x2 of = *((const u32x2*)(rp + C_Q) + lane), ob = *((const u32x2*)(rp + C_K) + lane), ga = *((const u32x2*)(rp + C_GA) + lane);
        const float o0 = bflo(of.x) + bflo(ob.x), o1 = bfhi(of.x) + bfhi(ob.x), o2 = bflo(of.y) + bflo(ob.y), o3 = bfhi(of.y) + bfhi(ob.y);
        float ss = (o0 * o0 + o1 * o1) + (o2 * o2 + o3 * o3);
        ss += __shfl_xor(ss, 1); ss += __shfl_xor(ss, 2); ss += __shfl_xor(ss, 4); ss += __shfl_xor(ss, 8);
        const float rinv = rsqrtf(ss * (1.f / 64.f) + EPS);
        u32x2 y; y.x = pk2(o0 * rinv * ng.x * bflo(ga.x), o1 * rinv * ng.y * bfhi(ga.x)); y.y = pk2(o2 * rinv * ng.z * bflo(ga.y), o3 * rinv * ng.w * bfhi(ga.y));
        if (dry) rp = (bf16*)(a.ws + WS_DUM) + (size_t)(row & 1023) * LDP;
        *((u32x2*)(rp + C_GA) + lane) = y;
    }
}

__device__ __forceinline__ void phase_final(const Args& a) {
    const int tid = otid(), lane = tid & 63, wave = tid >> 6, G = gridDim.x, bid = obid();
    const float* RSS = (const float*)(a.ws + WS_RSS);
    f32x4 fg[4];
#pragma unroll
    for (int q = 0; q < 4; ++q) fg[q] = *((const f32x4*)(a.in[I_FNG] + 256 * q) + lane);
    for (int row = bid * NWAVES + wave; row < M; row += G * NWAVES) {
        float p = (lane < 16) ? RSS[(size_t)row * 16 + lane] : 0.f;
        p += __shfl_xor(p, 1); p += __shfl_xor(p, 2); p += __shfl_xor(p, 4); p += __shfl_xor(p, 8);
        const float ss = __shfl(p, 0);
        const float rinv = rsqrtf(ss * (1.f / 1024.f) + EPS);
        f32x4* orow = (f32x4*)(a.out + (size_t)row * D) + lane;
#pragma unroll
        for (int q = 0; q < 4; ++q) { const f32x4 v = orow[64 * q]; orow[64 * q] = v * rinv * fg[q]; }
    }
}

constexpr int NPHASE = 24;
__global__ void __launch_bounds__(NTHR, 2) fwd_kernel(Args args) {
    extern __shared__ __attribute__((aligned(16))) unsigned char lds_raw[];
    LAS unsigned char* lds = (LAS unsigned char*)lds_raw;
    const int tid = threadIdx.x;
#if !MK_MULTI
    volatile LAS unsigned* MISC = (volatile LAS unsigned*)(lds + MISC_OFF);
    if (tid < 64) MISC[tid] = 0u;
    __syncthreads();
    XcdBarrier bar = xcd_barrier_post((unsigned*)(args.ws + WS_CTL) + CW_BAR, MISC + 8);
#define GRID_BAR() xcd_barrier(bar)
#else
#define GRID_BAR() do { } while (0)
#endif
    const int G = gridDim.x, bid = blockIdx.x;
    for (int ph = args.ph_lo; ph < args.ph_hi; ++ph) {
        if (ph == 0) { if (EN(0)) for (int rep = 0; rep < REP_P0; ++rep) phase_0a(args, lds); }
        else if (ph == 1) { if (EN(1)) for (int rep = 0; rep < REP_P0; ++rep) phase_0b(args); }
        else if (ph == 2) { if (EN(2)) phase_0c(args); }
        else if (ph == 23) { if (EN(3)) phase_final(args); }
        else {
            const int l = (ph - 3) / 5, sub = (ph - 3) % 5;
            if (sub == 0) { if (EN(4)) {
                pg8::Gemm g{(const bf16*)(args.ws + WS_HB), (const bf16*)(args.ws + WS_W1T) + (size_t)l * N1 * 1024, M, N1, 1024, 1024};
                pg8::StaticOrder S; S.init(M, N1, G, bid);
                Epi1 E{(bf16*)(args.ws + WS_PB), (float*)(args.ws + WS_BA), (const float*)(args.ws + WS_RSS), (const float*)(args.ws + WS_SW) + (size_t)l * 9 * N1};
                for (int rep = 0; rep < REP_G1; ++rep) pg8::gemm_phase<Epi1>(lds, g, S, E); }
            } else if (sub == 1) {
                for (int rmix = 0; rmix < REP_MIX; ++rmix)
                for (int it = bid; it < 4480; it += G) {
                    const int dry = rmix ? args.one : 0;
                    if (it < 2560) { if (rmix) continue; if (EN(5)) for (int rep = 0; rep < REP_PREP; ++rep) prep_item(args, lds, l, it >> 2, it & 3); }
                    else if (it < 3840) { const int i2 = it - 2560; if (EN(6) && (!rmix || (MIXSEL & 1))) sgu_item(args, lds, l, i2 >> 2, i2 & 3, dry); }
                    else { if (EN(7) && (!rmix || (MIXSEL & 2))) pool_item(args, lds, l, it - 3840, dry); }
                }
            } else if (sub == 2) {
                if (bid < 64) { if (EN(10)) for (int rep = 0; rep < REP_SCAN; ++rep) scan_item(args, lds, l, 32 + (bid >> 3), (bid >> 1) & 3, bid & 1); }
                unsigned* qc = (unsigned*)(args.ws + WS_CTL) + CW_Q + 64 * l;
                volatile LAS unsigned* qslot = (volatile LAS unsigned*)(lds + MISC_OFF) + 16;
                for (;;) {
                    if (tid == 0) qslot[0] = atomicAdd(qc, 1u);
                    __syncthreads();
                    const int it = (int)qslot[0];
                    __syncthreads();
                    if (it >= 896) break;
                    if (it < 512) { if (EN(9)) fsmp_item(args, lds, it >> 6, it & 63, 0); }
                    else if (it < 640) { const int i2 = it - 512; if (EN(8)) fctx_item(args, lds, i2 >> 2, i2 & 3, 0); }
                    else { const int i2 = it - 640; if (EN(10)) for (int rep = 0; rep < REP_SCAN; ++rep) scan_item(args, lds, l, i2 >> 3, (i2 >> 1) & 3, i2 & 1); }
                }
                for (int rmix = 1; rmix < REP_MIX; ++rmix)
                for (int it = bid; it < 640; it += G) {
                    if (it < 512) { if (MIXSEL & 8) fsmp_item(args, lds, it >> 6, it & 63, args.one); }
                    else { const int i2 = it - 512; if (MIXSEL & 4) fctx_item(args, lds, i2 >> 2, i2 & 3, args.one); }
                }
            } else if (sub == 3) {
                if (EN(11)) for (int rep = 0; rep < REP_COMB; ++rep) phase_combine(args, l, rep ? args.one : 0);
            } else if (EN(12)) {
                pg8::Gemm g{(const bf16*)(args.ws + WS_PB), (const bf16*)(args.ws + WS_W2T) + (size_t)l * 1024 * 1024, M, 1024, 1024, LDP};
                pg8::StaticOrder S; S.init(M, 1024, G, bid);
                const float* MOD = (const float*)(args.ws + WS_MOD);
                Epi2 E{args.out, (bf16*)(args.ws + WS_HB), (float*)(args.ws + WS_RSS), MOD + (size_t)l * 9 * 3072 + 2048,
                       l < 3 ? args.in[I_NORMG] + (l + 1) * 1024 : nullptr, l < 3 ? MOD + (size_t)(l + 1) * 9 * 3072 + 1024 : nullptr, args.ws + WS_DUM, 0};
                pg8::gemm_phase<Epi2>(lds, g, S, E);
                for (int rep = 1; rep < REP_G2; ++rep) { Epi2 E2 = E; E2.dry = args.one; pg8::gemm_phase<Epi2>(lds, g, S, E2); }
            }
        }
        if (ph + 1 < args.ph_hi) GRID_BAR();
    }
}

extern "C" void kernel_launch(void* const* d_in, const int* in_sizes, int n_in, void* d_out, int out_size, void* d_ws, size_t ws_size, hipStream_t stream) {
    static int grid = 0;
    if (grid == 0) {
        if (n_in != 21 || ws_size < WS_DUM + 16 * MiB) { fprintf(stderr, "kernel_launch: unexpected n_in %d or ws_size %zu (< %zu)\n", n_in, ws_size, (size_t)WS_END); grid = -1; return; }
        int dev = 0, cus = 0, per_cu = 0;
        if (hipGetDevice(&dev) != hipSuccess || hipDeviceGetAttribute(&cus, hipDeviceAttributeMultiprocessorCount, dev) != hipSuccess) { grid = -1; return; }
        if (hipFuncSetAttribute((const void*)fwd_kernel, hipFuncAttributeMaxDynamicSharedMemorySize, LDS_BYTES) != hipSuccess) { fprintf(stderr, "kernel_launch: hipFuncSetAttribute failed\n"); grid = -1; return; }
        if (hipOccupancyMaxActiveBlocksPerMultiprocessor(&per_cu, (const void*)fwd_kernel, NTHR, LDS_BYTES) != hipSuccess || per_cu < 1) { fprintf(stderr, "kernel_launch: occupancy query failed (%d)\n", per_cu); (void)hipGetLastError(); per_cu = 1; }
        grid = cus * 1;
    }
    if (grid < 0) return;
    Args a{};
    for (int i = 0; i < 21; ++i) a.in[i] = (const float*)d_in[i];
    a.out = (float*)d_out; a.ws = (unsigned char*)d_ws; a.one = 1;
    (void)hipMemsetAsync((char*)d_ws + WS_CTL, 0, CTL_ZERO_BYTES, stream);
#if MK_MULTI
    for (int ph = 0; ph < NPHASE; ++ph) {
        a.ph_lo = ph; a.ph_hi = ph + 1;
        hipLaunchKernelGGL(fwd_kernel, dim3(grid), dim3(NTHR), LDS_BYTES, stream, a);
    }
#else
    a.ph_lo = 0; a.ph_hi = NPHASE;
    void* kargs[] = {&a};
    hipError_t e = hipLaunchCooperativeKernel((const void*)fwd_kernel, dim3(grid), dim3(NTHR), kargs, LDS_BYTES, stream);
    if (e != hipSuccess) fprintf(stderr, "kernel_launch: cooperative launch failed: %s (grid %d)\n", hipGetErrorString(e), grid);
#endif
}
```

```cpp
#include <hip/hip_runtime.h>
#include <cstdio>
#include <cstdint>

#ifndef MK_MULTI
#define MK_MULTI 0
#endif
#ifndef NAIVE_MM
#define NAIVE_MM 0
#endif
#ifndef ONLY
#define ONLY -1
#endif
#define EN(k) (ONLY < 0 || ONLY == (k))
#ifndef REP_G1
#define REP_G1 1
#endif
#ifndef REP_PREP
#define REP_PREP 1
#endif
#ifndef REP_SCAN
#define REP_SCAN 1
#endif
#ifndef REP_P0
#define REP_P0 1
#endif
#ifndef REP_MIX
#define REP_MIX 1
#endif
#ifndef REP_COMB
#define REP_COMB 1
#endif
#ifndef REP_G2
#define REP_G2 1
#endif
#ifndef MIXSEL
#define MIXSEL 15
#endif
#ifndef G1CHEAP
#define G1CHEAP 0
#endif

#define LAS __attribute__((address_space(3)))
#define GAS __attribute__((address_space(1)))
typedef unsigned short bf16;
typedef short bf16x8 __attribute__((ext_vector_type(8)));
typedef float f32x4 __attribute__((ext_vector_type(4)));
typedef float f32x2 __attribute__((ext_vector_type(2)));
typedef unsigned u32x4 __attribute__((ext_vector_type(4)));
typedef unsigned u32x2 __attribute__((ext_vector_type(2)));

constexpr int D = 1024, NL = 4, NCOND = 9;
constexpr int M_CTX = 8192, M = 40960;
constexpr int PIN = 2832;
constexpr int N1 = 3328, LDP = 3072;
constexpr float EPS = 1e-6f;
constexpr int C_GA = 0, C_U = 256, C_GC = 512, C_GD = 768, C_V = 1024, C_GB = 1280, C_XC = 1536, C_PF = 1792, C_QF = 2048, C_Q = 2304, C_K = 2560, C_VV = 2816;

constexpr size_t MiB = 1u << 20;
constexpr size_t WS_CTL = 0, CTL_ZERO_BYTES = 1 * MiB;
constexpr size_t WS_MOD = 1 * MiB;
constexpr size_t WS_SW = WS_MOD + 512 * 1024;
constexpr size_t WS_GMAT = 2 * MiB;
constexpr size_t WS_POS = WS_GMAT + 512 * 1024;
constexpr size_t WS_DFT = WS_POS + 256 * 1024;
constexpr size_t WS_M1 = 3 * MiB;
constexpr size_t WS_M2 = WS_M1 + 32 * 1024;
constexpr size_t WS_TW = WS_M1 + 64 * 1024;
constexpr size_t WS_W1T = 4 * MiB;
constexpr size_t WS_W2T = 30 * MiB;
constexpr size_t WS_BA = 38 * MiB;
constexpr size_t WS_RSS = 41 * MiB;
constexpr size_t WS_PB = 44 * MiB;
constexpr size_t WS_HB = 284 * MiB;
constexpr size_t WS_PREP = 284 * MiB;
constexpr size_t WS_PGL = 484 * MiB;
constexpr size_t WS_END = 485 * MiB;
constexpr size_t WS_DUM = 486 * MiB;
constexpr int CW_BAR = 4096, CW_Q = 8192;

constexpr int LDS_BYTES = 147456;
constexpr int MISC_OFF = 144 * 1024 - 256;
constexpr int NWAVES = 8, NTHR = 512;

__device__ __forceinline__ unsigned f2bf(float f) { unsigned u = __builtin_bit_cast(unsigned, f); return (u + 0x7fffu + ((u >> 16) & 1u)) >> 16; }
__device__ __forceinline__ float bf2f(unsigned b) { return __builtin_bit_cast(float, (b & 0xffffu) << 16); }
__device__ __forceinline__ unsigned pk2(float lo, float hi) { return f2bf(lo) | (f2bf(hi) << 16); }
__device__ __forceinline__ float bflo(unsigned w) { return __builtin_bit_cast(float, w << 16); }
__device__ __forceinline__ float bfhi(unsigned w) { return __builtin_bit_cast(float, w & 0xffff0000u); }
__device__ __forceinline__ float silu_f(float x) { return x * __builtin_amdgcn_rcpf(1.f + __builtin_amdgcn_exp2f(-1.4426950408889634f * x)); }
__device__ __forceinline__ float gelu_tanh_f(float x) { const float z = (-1.5957691216057308f * 1.4426950408889634f) * (x + 0.044715f * x * x * x); return x * __builtin_amdgcn_rcpf(1.f + __builtin_amdgcn_exp2f(z)); }
__device__ __forceinline__ float wave_sum(float v) {
#pragma unroll
    for (int o = 1; o < 64; o <<= 1) v += __shfl_xor(v, o);
    return v;
}
__device__ __forceinline__ int otid() { int t = threadIdx.x; asm volatile("" : "+v"(t)); return t; }
__device__ __forceinline__ int obid() { int b = blockIdx.x; asm volatile("" : "+s"(b)); return b; }
#define LDS_WAIT() asm volatile("s_waitcnt lgkmcnt(0)" ::: "memory")

namespace pg8 {
constexpr int BM = 256, BK = 64, HALF = 128, HTB = HALF * BK * 2, STAGE_BYTES = 8 * HTB, NXCD = 8, WGM = 8;
__host__ __device__ __forceinline__ int lds_byte(int r, int c) { const int st = (r >> 4) * 2 + (c >> 5), rr = r & 15, cc = c & 31, ob = rr * 64 + cc * 2; return st * 1024 + (ob ^ (((ob >> 9) & 1) << 5)); }
__host__ __device__ __forceinline__ void stage_rc(int b, int& R, int& C) { const int st = b / 1024, sb = b % 1024, swz = sb ^ (((sb >> 9) & 1) << 5); R = (st >> 1) * 16 + swz / 64; C = (st & 1) * 32 + (swz % 64) / 2; }
__host__ __device__ __forceinline__ int perm32(int rho) { const int n = rho >> 4, i = rho & 15; return 8 * (i >> 2) + 4 * n + (i & 3); }

struct Unit { int pm, pn; };
struct Gemm { const bf16* A; const bf16* Bt; int M, N, K, lda; };

struct StaticOrder {
    int nM, nN, nwg, G, c;
    __host__ __device__ void init(int M_, int N_, int G_, int c_) { nM = M_ / BM; nN = N_ / BM; nwg = nM * nN; G = G_; c = c_; }
    __host__ __device__ bool next(int i, Unit& u) const {
        const long L = (long)i * G + c; if (L >= nwg) return false;
        int wgid = (int)L; { const int q = nwg / NXCD, r = nwg % NXCD, xcd = wgid % NXCD, off = wgid / NXCD; wgid = (xcd < r ? xcd * (q + 1) : r * (q + 1) + (xcd - r) * q) + off; }
        const int nig = WGM * nN, gid = wgid / nig, fm = gid * WGM, gsz = (nM - fm) < WGM ? (nM - fm) : WGM;
        u.pm = fm + ((wgid % nig) % gsz); u.pn = (wgid % nig) / gsz; return true;
    }
};

template <class Epi>
__device__ __forceinline__ void gemm_phase(LAS unsigned char* lds, const Gemm g, const StaticOrder& S, const Epi& E) {
    const int tid = otid(), wid = __builtin_amdgcn_readfirstlane(tid >> 6), lane = tid & 63, wr = wid >> 2, wc = wid & 3, fr = lane & 15, fq = lane >> 4;
    const int K = g.K, nt = K / BK, lda = g.lda;
    unsigned voffA[2], voffB[2];
#pragma unroll
    for (int i = 0; i < 2; ++i) { int R, C; stage_rc(tid * 16 + i * 8192, R, C); const int Rb = Epi::PERM ? ((R & ~31) + perm32(R & 31)) : R;
        voffA[i] = (unsigned)(R * lda + C) * 2u; voffB[i] = (unsigned)(Rb * K + C) * 2u; }
    const size_t kstep = (size_t)(BK * 2);
    const size_t hstepA = (size_t)HALF * lda * 2, hstepB = (size_t)HALF * K * 2;
    const size_t tstepA = 2 * hstepA, tstepB = 2 * hstepB;
    const unsigned ldsw = (unsigned)wid * 1024u;
    const int aoff = lds_byte(wr * 64 + fr, fq * 8), boff = lds_byte(wc * 32 + fr, fq * 8);
#define PG8_SA(b, h) (((b) * 2 + (h)) * HTB)
#define PG8_SB(b, h) ((4 + (b) * 2 + (h)) * HTB)
#define PG8_STAGE(bufoff, gbase, voff) do { _Pragma("unroll") for (int _i = 0; _i < 2; ++_i) \
        __builtin_amdgcn_global_load_lds((const unsigned*)((const char*)(gbase) + (voff)[_i]), (LAS unsigned*)(lds + (bufoff) + ldsw + _i * 8192), 16, 0, 0); } while (0)
#define PG8_LDA(dst, b, h) do { _Pragma("unroll") for (int m = 0; m < 4; ++m) _Pragma("unroll") for (int k = 0; k < 2; ++k) dst[m][k] = *(const LAS bf16x8*)(lds + PG8_SA(b, h) + aoff + m * 2048 + k * 1024); } while (0)
#define PG8_LDB(dst, b, h) do { _Pragma("unroll") for (int n = 0; n < 2; ++n) _Pragma("unroll") for (int k = 0; k < 2; ++k) dst[n][k] = *(const LAS bf16x8*)(lds + PG8_SB(b, h) + boff + n * 2048 + k * 1024); } while (0)
#define PG8_MMA(ai, bj, At, Bt) do { __builtin_amdgcn_s_setprio(1); _Pragma("unroll") for (int m = 0; m < 4; ++m) _Pragma("unroll") for (int n = 0; n < 2; ++n) _Pragma("unroll") for (int k = 0; k < 2; ++k) \
        acc[ai][bj][m][n] = __builtin_amdgcn_mfma_f32_16x16x32_bf16(Bt[n][k], At[m][k], acc[ai][bj][m][n], 0, 0, 0); __builtin_amdgcn_s_setprio(0); } while (0)
#define PG8_WAIT_V(n) asm volatile("s_waitcnt vmcnt(" #n ")" ::: "memory")
#define PG8_WAIT_L(n) asm volatile("s_waitcnt lgkmcnt(" #n ")" ::: "memory")
#define PG8_BAR __builtin_amdgcn_s_barrier()
#define PG8_SCHED __builtin_amdgcn_sched_barrier(0)
    Unit cur, nxt; int ui = 0;
    if (!S.next(0, cur)) return;
    f32x4 acc[2][2][4][2];
#pragma unroll
    for (int a = 0; a < 2; ++a)
#pragma unroll
        for (int b = 0; b < 2; ++b)
#pragma unroll
            for (int m = 0; m < 4; ++m)
#pragma unroll
                for (int n = 0; n < 2; ++n) acc[a][b][m][n] = (f32x4){0.f, 0.f, 0.f, 0.f};
    bf16x8 At[4][2], B0[2][2], B1[2][2];
    const char* cA = (const char*)g.A + (size_t)cur.pm * tstepA; const char* cB = (const char*)g.Bt + (size_t)cur.pn * tstepB;
    PG8_STAGE(PG8_SB(0, 0), cB, voffB); PG8_STAGE(PG8_SA(0, 0), cA, voffA); PG8_STAGE(PG8_SB(0, 1), cB + hstepB, voffB); PG8_STAGE(PG8_SA(0, 1), cA + hstepA, voffA);
    if (wr == 1) PG8_BAR;
    PG8_WAIT_V(4); PG8_BAR;
    PG8_STAGE(PG8_SB(1, 0), cB + kstep, voffB); PG8_STAGE(PG8_SA(1, 0), cA + kstep, voffA); PG8_STAGE(PG8_SB(1, 1), cB + hstepB + kstep, voffB);
    PG8_WAIT_V(6); PG8_BAR;
    for (;;) {
        const bool has_next = S.next(ui + 1, nxt);
        const char* nA = has_next ? (const char*)g.A + (size_t)nxt.pm * tstepA : cA; const char* nB = has_next ? (const char*)g.Bt + (size_t)nxt.pn * tstepB : cB;
        for (int t = 0; t < nt; t += 2) {
            const bool last = (t == nt - 2);
            const char* a1 = cA + (size_t)(t + 1) * kstep;
            const char* a2 = last ? nA : cA + (size_t)(t + 2) * kstep; const char* b2 = last ? nB : cB + (size_t)(t + 2) * kstep;
            const char* a3 = a2 + kstep; const char* b3 = b2 + kstep;
            PG8_LDB(B0, 0, 0); PG8_SCHED; PG8_LDA(At, 0, 0); PG8_STAGE(PG8_SA(1, 1), a1 + hstepA, voffA);
            PG8_WAIT_L(8); PG8_BAR; PG8_WAIT_L(0); PG8_MMA(0, 0, At, B0); PG8_BAR; PG8_SCHED;
            PG8_LDB(B1, 0, 1); PG8_STAGE(PG8_SB(0, 0), b2, voffB);
            PG8_BAR; PG8_WAIT_L(0); PG8_MMA(0, 1, At, B1); PG8_BAR;
            PG8_LDA(At, 0, 1); PG8_STAGE(PG8_SA(0, 0), a2, voffA);
            PG8_BAR; PG8_WAIT_L(0); PG8_MMA(1, 0, At, B0); PG8_BAR; PG8_SCHED;
            PG8_STAGE(PG8_SB(0, 1), b2 + hstepB, voffB);
            PG8_WAIT_V(6); PG8_BAR; PG8_MMA(1, 1, At, B1); PG8_BAR;
            PG8_LDB(B0, 1, 0); PG8_SCHED; PG8_LDA(At, 1, 0); PG8_STAGE(PG8_SA(0, 1), a2 + hstepA, voffA);
            PG8_WAIT_L(8); PG8_BAR; PG8_WAIT_L(0); PG8_MMA(0, 0, At, B0); PG8_BAR; PG8_SCHED;
            PG8_LDB(B1, 1, 1); PG8_STAGE(PG8_SB(1, 0), b3, voffB);
            PG8_BAR; PG8_WAIT_L(0); PG8_MMA(0, 1, At, B1); PG8_BAR;
            PG8_LDA(At, 1, 1); PG8_STAGE(PG8_SA(1, 0), a3, voffA);
            PG8_BAR; PG8_WAIT_L(0); PG8_MMA(1, 0, At, B0); PG8_BAR; PG8_SCHED;
            PG8_STAGE(PG8_SB(1, 1), b3 + hstepB, voffB);
            PG8_WAIT_V(6); PG8_BAR; PG8_MMA(1, 1, At, B1); PG8_BAR;
        }
        E(acc, cur, wr, wc, fr, fq, ui);
        if (!has_next) break;
#pragma unroll
        for (int a = 0; a < 2; ++a)
#pragma unroll
            for (int b = 0; b < 2; ++b)
#pragma unroll
                for (int m = 0; m < 4; ++m)
#pragma unroll
                    for (int n = 0; n < 2; ++n) acc[a][b][m][n] = (f32x4){0.f, 0.f, 0.f, 0.f};
        cur = nxt; cA = nA; cB = nB; ++ui;
    }
    PG8_WAIT_V(0);
    if (wr == 0) PG8_BAR;
    PG8_BAR;
#undef PG8_SA
#undef PG8_SB
#undef PG8_STAGE
#undef PG8_LDA
#undef PG8_LDB
#undef PG8_MMA
#undef PG8_WAIT_V
#undef PG8_WAIT_L
#undef PG8_BAR
#undef PG8_SCHED
}
}

#define XB_TMO      128
#define XB_XCNT(j)  (256  + 64 * (j))
#define XB_XSUB(j)  (1280 + 64 * (j))
#define XB_XGEN(j)  (2304 + 64 * (j))
#define XB_TOP      3328
#define XB_TOPGEN   3392
#define XCD_BAR_WORDS 3456
#define XB_SPIN_CAP (1u << 18)
__device__ __forceinline__ unsigned xb_ld(unsigned* p)              { return __hip_atomic_load(p, __ATOMIC_RELAXED, __HIP_MEMORY_SCOPE_AGENT); }
__device__ __forceinline__ unsigned xb_add(unsigned* p, unsigned v) { return __hip_atomic_fetch_add(p, v, __ATOMIC_RELAXED, __HIP_MEMORY_SCOPE_AGENT); }
__device__ __forceinline__ unsigned xb_xcc_id() { return (unsigned)__builtin_amdgcn_s_getreg((3 << 11) | 20) & 0xFu; }
#define XB_SPIN(cond, bar) do { unsigned _sp = 0; while (cond) { __builtin_amdgcn_s_sleep(1); \
    if ((++_sp & 255u) == 0u) { if (xb_ld(&(bar)[XB_TMO])) break; if (_sp > XB_SPIN_CAP) { atomicAdd(&(bar)[XB_TMO], 1u); break; } } } } while (0)
struct XcdBarrier { unsigned* bar; unsigned x; volatile LAS unsigned* st; };
__device__ __forceinline__ XcdBarrier xcd_barrier_post(unsigned* bar, volatile LAS unsigned* st) {
    XcdBarrier b; b.bar = bar; b.x = xb_xcc_id(); b.st = st;
    if (threadIdx.x == 0) (void)xb_add(&bar[XB_XCNT(b.x)], 1u);
    return b;
}
__device__ __forceinline__ void xcd_barrier_complete(unsigned* bar, unsigned x, unsigned& nloc, unsigned& nx) {
    const unsigned G = gridDim.x * gridDim.y * gridDim.z;
    unsigned sum, cnt, mine, sp = 0u;
    for (;;) {
        sum = 0u; cnt = 0u; mine = 0u;
#pragma unroll
        for (unsigned j = 0; j < 16; ++j) { const unsigned c = xb_ld(&bar[XB_XCNT(j)]); sum += c; cnt += (c > 0u) ? 1u : 0u; mine = (j == x) ? c : mine; }
        if (sum == G) break;
        __builtin_amdgcn_s_sleep(1);
        if ((++sp & 255u) == 0u) { if (xb_ld(&bar[XB_TMO])) break; if (sp > XB_SPIN_CAP) { atomicAdd(&bar[XB_TMO], 1u); break; } }
    }
    nloc = mine > 0u ? mine : 1u; nx = cnt > 0u ? cnt : 1u;
}
__device__ __forceinline__ void xcd_barrier(const XcdBarrier& b) {
    asm volatile("s_waitcnt vmcnt(0)" ::: "memory");
    __syncthreads();
    if (threadIdx.x == 0) {
        unsigned* bar = b.bar;
        __builtin_amdgcn_s_waitcnt(0);
        unsigned nloc = b.st[0], nx = b.st[1];
        if (nloc == 0u) { xcd_barrier_complete(bar, b.x, nloc, nx); b.st[0] = nloc; b.st[1] = nx; }
        const unsigned old = xb_add(&bar[XB_XSUB(b.x)], 1u);
        const unsigned gen = old / nloc;
        if (old + 1u == (gen + 1u) * nloc) {
            __builtin_amdgcn_fence(__ATOMIC_RELEASE, "agent");
            asm volatile("s_waitcnt vmcnt(0)" ::: "memory");
            const unsigned og = xb_add(&bar[XB_TOP], 1u);
            const unsigned tg = og / nx;
            if (og + 1u == (tg + 1u) * nx) xb_add(&bar[XB_TOPGEN], 1u);
            else XB_SPIN(xb_ld(&bar[XB_TOPGEN]) == tg, bar);
            __builtin_amdgcn_fence(__ATOMIC_ACQUIRE, "agent");
            xb_add(&bar[XB_XGEN(b.x)], 1u);
            asm volatile("s_waitcnt vmcnt(0)" ::: "memory");
        } else {
            XB_SPIN(xb_ld(&bar[XB_XGEN(b.x)]) == gen, bar);
            __builtin_amdgcn_fence(__ATOMIC_ACQUIRE, "agent");
            asm volatile("s_waitcnt vmcnt(0)" ::: "memory");
        }
    }
    __syncthreads();
}

template <int KS>
__device__ __forceinline__ f32x4 tile_mm(f32x4 acc, const LAS bf16* A, int lda, int m0, const LAS bf16* Bt, int ldb, int n0, int lane) {
    const int r = lane & 15, kg = lane >> 4;
#if NAIVE_MM
#pragma unroll 1
    for (int k = 0; k < KS * 32; ++k) {
        const float b = bf2f(Bt[(n0 + r) * ldb + k]);
#pragma unroll
        for (int q = 0; q < 4; ++q) acc[q] += bf2f(A[(m0 + 4 * kg + q) * lda + k]) * b;
    }
#else
#pragma unroll
    for (int ks = 0; ks < KS; ++ks) {
        const bf16x8 a = *(const LAS bf16x8*)(A + (m0 + r) * lda + ks * 32 + kg * 8);
        const bf16x8 b = *(const LAS bf16x8*)(Bt + (n0 + r) * ldb + ks * 32 + kg * 8);
        acc = __builtin_amdgcn_mfma_f32_16x16x32_bf16(a, b, acc, 0, 0, 0);
    }
#endif
    return acc;
}
template <int KS>
__device__ __forceinline__ f32x4 tile_mm_g(f32x4 acc, const bf16* A, int lda, int m0, const LAS bf16* Bt, int ldb, int n0, int lane) {
    const int r = lane & 15, kg = lane >> 4;
#if NAIVE_MM
#pragma unroll 1
    for (int k = 0; k < KS * 32; ++k) {
        const float b = bf2f(Bt[(n0 + r) * ldb + k]);
#pragma unroll
        for (int q = 0; q < 4; ++q) acc[q] += bf2f(A[(m0 + 4 * kg + q) * lda + k]) * b;
    }
#else
#pragma unroll
    for (int ks = 0; ks < KS; ++ks) {
        const bf16x8 a = *(const bf16x8*)(A + (size_t)(m0 + r) * lda + ks * 32 + kg * 8);
        const bf16x8 b = *(const LAS bf16x8*)(Bt + (n0 + r) * ldb + ks * 32 + kg * 8);
        acc = __builtin_amdgcn_mfma_f32_16x16x32_bf16(a, b, acc, 0, 0, 0);
    }
#endif
    return acc;
}

struct Args { const float* in[21]; float* out; unsigned char* ws; int ph_lo, ph_hi, one, pad; };
enum { I_XP = 0, I_XS, I_STATE, I_C, I_CCTX, I_ADAW, I_ADAB, I_NORMG, I_WIN, I_CONV, I_ALOG, I_DTB, I_DNG, I_SGUNG, I_SGUW, I_SGUB, I_POOLW, I_POOLS, I_FW, I_WOUT, I_FNG };

struct SeqGeo { int T, tseq0, seq_row0; };
__device__ __forceinline__ SeqGeo seq_geo(int sc) {
    SeqGeo g;
    if (sc < 128) { g.T = 256; g.tseq0 = (sc & 3) * 64; g.seq_row0 = (sc >> 2) * 256; }
    else { const int s = sc - 128; g.T = 4096; g.tseq0 = (s & 63) * 64; g.seq_row0 = M_CTX + (s >> 6) * 4096; }
    return g;
}
__device__ __forceinline__ int cond_of_row(int row) { return row < M_CTX ? 0 : 1 + ((row - M_CTX) >> 12); }

__device__ __forceinline__ int srccol(int n) {
    if (n < 256) return 768 + n;
    if (n < 512) return 1040 + (n - 256);
    if (n < 768) return 2064 + (n - 512);
    if (n < 1024) return 2576 + (n - 768);
    if (n < 1280) return 1296 + (n - 1024);
    if (n < 1536) return 1552 + (n - 1280);
    if (n < 2304) return -2;
    if (n < 3072) return n - 2304;
    if (n < 3088) return 1024 + (n - 3072);
    return -1;
}

__device__ __forceinline__ void phase_0a(const Args& a, LAS unsigned char* lds) {
    const int tid = otid(), lane = tid & 63, wave = tid >> 6, G = gridDim.x, bid = obid();
    float* MOD = (float*)(a.ws + WS_MOD);
    if (bid < 192) {
        LAS float* sc = (LAS float*)lds;
        LAS float* red = (LAS float*)(lds + 9 * 1024 * 4);
        for (int i = tid; i < 9 * 1024; i += NTHR) { const int j = i >> 10, k = i & 1023; const float c = (j == 0) ? a.in[I_CCTX][k] : a.in[I_C][(j - 1) * 1024 + k]; sc[i] = silu_f(c); }
        __syncthreads();
        for (int it = bid; it < 192; it += G) {
            const int l = it / 48, cb = it % 48, col = cb * 64 + lane;
            float acc[9];
#pragma unroll
            for (int j = 0; j < 9; ++j) acc[j] = 0.f;
            const float* wp = a.in[I_ADAW] + ((size_t)l * 1024 + wave * 128) * 3072 + col;
#pragma unroll 8
            for (int k = 0; k < 128; ++k) { const float wv = wp[(size_t)k * 3072];
#pragma unroll
                for (int j = 0; j < 9; ++j) acc[j] += sc[j * 1024 + wave * 128 + k] * wv; }
#pragma unroll
            for (int j = 0; j < 9; ++j) red[(wave * 9 + j) * 64 + lane] = acc[j];
            __syncthreads();
            for (int i = tid; i < 576; i += NTHR) { const int j = i >> 6, ln = i & 63; float s = 0.f;
#pragma unroll
                for (int w = 0; w < 8; ++w) s += red[(w * 9 + j) * 64 + ln];
                MOD[(l * 9 + j) * 3072 + cb * 64 + ln] = s + a.in[I_ADAB][l * 3072 + cb * 64 + ln]; }
            __syncthreads();
        }
    }
    const int gtid = bid * NTHR + tid, GT = G * NTHR;
    float* GM = (float*)(a.ws + WS_GMAT);
    for (int t = gtid; t < 4 * 4 * 2 * 4096; t += GT) {
        const int d = t & 63, c = (t >> 6) & 63, cs = (t >> 12) & 1, g = (t >> 13) & 3, l = t >> 15;
        const float* fw = a.in[I_FW] + ((size_t)(l * 4 + g) * 64) * 64 + d;
        float s = 0.f;
        for (int m = 0; m < 64; ++m) { const float ph = (float)((m * c) & 63) * (1.f / 32.f); s += (cs ? sinpif(ph) : cospif(ph)) * fw[m * 64]; }
        GM[t] = s * 0.125f;
    }
    bf16* W1T = (bf16*)(a.ws + WS_W1T);
    for (int t = gtid; t < 4 * 128 * N1; t += GT) {
        const int n = t % N1, k8 = (t / N1) & 127, l = t / (N1 * 128);
        const int sc = srccol(n);
        if (sc == -2) continue;
        u32x4 o = (u32x4){0u, 0u, 0u, 0u};
        if (sc >= 0) { const float* wp = a.in[I_WIN] + ((size_t)l * 1024 + k8 * 8) * PIN + sc;
            o.x = pk2(wp[0], wp[PIN]); o.y = pk2(wp[2 * PIN], wp[3 * PIN]); o.z = pk2(wp[4 * PIN], wp[5 * PIN]); o.w = pk2(wp[6 * PIN], wp[7 * PIN]); }
        *(u32x4*)(W1T + ((size_t)l * N1 + n) * 1024 + k8 * 8) = o;
    }
    bf16* W2T = (bf16*)(a.ws + WS_W2T);
    for (int t = gtid; t < 4 * 128 * 1024; t += GT) {
        const int n = t & 1023, k8 = (t >> 10) & 127, l = t >> 17;
        const float* wp = a.in[I_WOUT] + ((size_t)l * 1024 + k8 * 8) * 1024 + n;
        u32x4 o; o.x = pk2(wp[0], wp[1024]); o.y = pk2(wp[2048], wp[3072]); o.z = pk2(wp[4096], wp[5120]); o.w = pk2(wp[6144], wp[7168]);
        *(u32x4*)(W2T + ((size_t)l * 1024 + n) * 1024 + k8 * 8) = o;
    }
    float* POS = (float*)(a.ws + WS_POS);
    for (int t = gtid; t < 64 * 256; t += GT) { const int f = t & 255, i = t >> 8; const float fr = powf(10000.f, -(float)f / 256.f); const float ang = (float)i * fr;
        POS[t] = sinf(ang); POS[64 * 256 + t] = cosf(ang); }
    bf16* DFT = (bf16*)(a.ws + WS_DFT);
    for (int t = gtid; t < 256 * 512; t += GT) { const int tp = t & 511, k = t >> 9, tt = tp & 255; const float ph = (float)((k * tt) & 255) * (1.f / 128.f);
        DFT[t] = (bf16)f2bf((tp < 256 ? cospif(ph) : -sinpif(ph)) * (1.f / 16.f)); }
    bf16* M1 = (bf16*)(a.ws + WS_M1);
    for (int t = gtid; t < 128 * 128; t += GT) { const int kk = t & 127, m = t >> 7, k1 = m & 63, t1 = kk & 63; const float ph = (float)((k1 * t1) & 63) * (1.f / 32.f);
        const float c = cospif(ph), s = sinpif(ph); float v;
        if (m < 64) v = (kk < 64) ? c : -s; else v = (kk < 64) ? s : c;
        M1[t] = (bf16)f2bf(v); }
    bf16* M2 = (bf16*)(a.ws + WS_M2);
    for (int t = gtid; t < 64 * 128; t += GT) { const int kk = t & 127, k2 = t >> 7, t2 = kk & 63; const float ph = (float)((k2 * t2) & 63) * (1.f / 32.f);
        M2[t] = (bf16)f2bf((kk < 64 ? cospif(ph) : -sinpif(ph)) * (1.f / 64.f)); }
    float* TW = (float*)(a.ws + WS_TW);
    for (int t = gtid; t < 64 * 64; t += GT) { const int t2 = t & 63, k1 = t >> 6; const float ph = (float)(k1 * t2) * (1.f / 2048.f); TW[2 * t] = cospif(ph); TW[2 * t + 1] = sinpif(ph); }
}

__device__ __forceinline__ void phase_0b(const Args& a) {
    const int tid = otid(), lane = tid & 63, wave = tid >> 6, G = gridDim.x, bid = obid();
    const int gtid = bid * NTHR + tid, GT = G * NTHR;
    const float* MOD = (const float*)(a.ws + WS_MOD);
    const float* GM = (const float*)(a.ws + WS_GMAT);
    bf16* W1T = (bf16*)(a.ws + WS_W1T);
    for (int t = gtid; t < 4 * 128 * 768; t += GT) {
        const int nf = t % 768, k8 = (t / 768) & 127, l = t / (768 * 128);
        const int kind = nf >> 8, g = (nf >> 6) & 3, d = nf & 63;
        const int base = (kind == 0 ? 1808 : 2320) + 64 * g;
        const float* Gm = (kind == 0) ? (a.in[I_POOLW] + ((size_t)(l * 4 + g) * 64) * 64 + d) : (GM + ((size_t)((l * 4 + g) * 2 + (kind - 1)) * 64) * 64 + d);
        const float* wp = a.in[I_WIN] + ((size_t)l * 1024 + k8 * 8) * PIN + base;
        float s[8];
#pragma unroll
        for (int j = 0; j < 8; ++j) s[j] = 0.f;
        for (int c = 0; c < 64; ++c) { const float gv = Gm[c * 64];
#pragma unroll
            for (int j = 0; j < 8; ++j) s[j] += wp[(size_t)j * PIN + c] * gv; }
        u32x4 o; o.x = pk2(s[0], s[1]); o.y = pk2(s[2], s[3]); o.z = pk2(s[4], s[5]); o.w = pk2(s[6], s[7]);
        *(u32x4*)(W1T + ((size_t)l * N1 + 1536 + nf) * 1024 + k8 * 8) = o;
    }
    const float* POS = (const float*)(a.ws + WS_POS);
    bf16* HB = (bf16*)(a.ws + WS_HB);
    float* RSS = (float*)(a.ws + WS_RSS);
    for (int row = bid * NWAVES + wave; row < M; row += G * NWAVES) {
        f32x4 v[4];
        const int j = cond_of_row(row);
        if (row < M_CTX) {
            const f32x4* xr = (const f32x4*)(a.in[I_XP] + (size_t)row * D) + lane;
#pragma unroll
            for (int q = 0; q < 4; ++q) v[q] = xr[64 * q];
        } else {
            const int rs = row - M_CTX, t = rs & 4095, gr = t >> 6, gc = t & 63;
            const f32x4* xr = (const f32x4*)(a.in[I_XS] + (size_t)rs * D) + lane;
            const f32x4 p0 = *((const f32x4*)(POS + gr * 256) + lane), p1 = *((const f32x4*)(POS + 64 * 256 + gr * 256) + lane);
            const f32x4 p2 = *((const f32x4*)(POS + gc * 256) + lane), p3 = *((const f32x4*)(POS + 64 * 256 + gc * 256) + lane);
            v[0] = xr[0] + p0; v[1] = xr[64] + p1; v[2] = xr[128] + p2; v[3] = xr[192] + p3;
        }
        float ss = 0.f;
#pragma unroll
        for (int q = 0; q < 4; ++q) ss += (v[q].x * v[q].x + v[q].y * v[q].y) + (v[q].z * v[q].z + v[q].w * v[q].w);
        ss = wave_sum(ss);
        f32x4* orow = (f32x4*)(a.out + (size_t)row * D) + lane;
        u32x2* hrow = (u32x2*)(HB + (size_t)row * D) + lane;
#pragma unroll
        for (int q = 0; q < 4; ++q) {
            orow[64 * q] = v[q];
            const f32x4 ng = *((const f32x4*)(a.in[I_NORMG] + 256 * q) + lane);
            const f32x4 sc = *((const f32x4*)(MOD + (0 * 9 + j) * 3072 + 1024 + 256 * q) + lane);
            u32x2 h; h.x = pk2(v[q].x * ng.x * (1.f + sc.x), v[q].y * ng.y * (1.f + sc.y)); h.y = pk2(v[q].z * ng.z * (1.f + sc.z), v[q].w * ng.w * (1.f + sc.w));
            hrow[64 * q] = h;
        }
        if (lane < 16) RSS[(size_t)row * 16 + lane] = (lane == 0) ? ss : 0.f;
    }
}

__device__ __forceinline__ void phase_0c(const Args& a) {
    const int tid = otid(), lane = tid & 63, wave = tid >> 6, G = gridDim.x, bid = obid();
    const float* MOD = (const float*)(a.ws + WS_MOD);
    const bf16* W1T = (const bf16*)(a.ws + WS_W1T);
    float* SW = (float*)(a.ws + WS_SW);
    for (int it = bid * NWAVES + wave; it < 4 * N1; it += G * NWAVES) {
        const int l = it / N1, n = it % N1;
        const u32x4* wr = (const u32x4*)(W1T + ((size_t)l * N1 + n) * 1024) + lane * 2;
        const u32x4 w0 = wr[0], w1 = wr[1];
        float w[16];
        w[0] = bflo(w0.x); w[1] = bfhi(w0.x); w[2] = bflo(w0.y); w[3] = bfhi(w0.y); w[4] = bflo(w0.z); w[5] = bfhi(w0.z); w[6] = bflo(w0.w); w[7] = bfhi(w0.w);
        w[8] = bflo(w1.x); w[9] = bfhi(w1.x); w[10] = bflo(w1.y); w[11] = bfhi(w1.y); w[12] = bflo(w1.z); w[13] = bfhi(w1.z); w[14] = bflo(w1.w); w[15] = bfhi(w1.w);
#pragma unroll
        for (int j = 0; j < 9; ++j) {
            const f32x4* sp = (const f32x4*)(MOD + (l * 9 + j) * 3072) + lane * 4;
            float s = 0.f;
#pragma unroll
            for (int q = 0; q < 4; ++q) { const f32x4 sv = sp[q]; s += sv.x * w[4 * q] + sv.y * w[4 * q + 1] + sv.z * w[4 * q + 2] + sv.w * w[4 * q + 3]; }
            s = wave_sum(s);
            if (lane == 0) SW[(l * 9 + j) * N1 + n] = s;
        }
    }
}

struct Epi1 {
    static constexpr bool PERM = true;
    bf16* PB; float* BA; const float* RSS; const float* SW;
    int cheap; bf16* dumb;
    const LAS float* rtab;
    __device__ __forceinline__ void operator()(const f32x4 (&acc)[2][2][4][2], const pg8::Unit& u, int wr, int wc, int fr, int fq, int ui) const {
        const int pn = u.pn, j = u.pm < 32 ? 0 : 1 + ((u.pm - 32) >> 4);
        const int row0 = u.pm * 256 + wr * 64 + fr, cb = pn * 256 + wc * 32 + 8 * fq;
        if (cheap) {
#pragma unroll
            for (int ai = 0; ai < 2; ++ai)
#pragma unroll
                for (int m = 0; m < 4; ++m)
#pragma unroll
                    for (int bj = 0; bj < 2; ++bj) { const f32x4 v0 = acc[ai][bj][m][0], v1 = acc[ai][bj][m][1];
                        u32x4 w; w.x = pk2(v0[0], v0[1]); w.y = pk2(v0[2], v0[3]); w.z = pk2(v1[0], v1[1]); w.w = pk2(v1[2], v1[3]);
                        *(u32x4*)(dumb + (size_t)((row0 + ai * 128 + m * 16) & 1023) * LDP + cb + bj * 128) = w; }
            return;
        }
        const int act = (pn == 0 || pn == 2 || pn == 3 || pn == 5) ? 1 : ((pn == 1 || pn == 4) ? 2 : 0);
        f32x4 bv[2][2];
#pragma unroll
        for (int bj = 0; bj < 2; ++bj)
#pragma unroll
            for (int n = 0; n < 2; ++n) bv[bj][n] = *(const f32x4*)(SW + j * N1 + cb + bj * 128 + 4 * n);
#pragma unroll
        for (int ai = 0; ai < 2; ++ai)
#pragma unroll
            for (int m = 0; m < 4; ++m) {
                const int row = row0 + ai * 128 + m * 16;
                const float rinv = rtab[ui * 256 + wr * 64 + fr + ai * 128 + m * 16];
#pragma unroll
                for (int bj = 0; bj < 2; ++bj) {
                    f32x4 v0 = acc[ai][bj][m][0] * rinv + bv[bj][0], v1 = acc[ai][bj][m][1] * rinv + bv[bj][1];
                    if (pn < 12) {
                        if (act == 1) {
#pragma unroll
                            for (int q = 0; q < 4; ++q) { v0[q] = silu_f(v0[q]); v1[q] = silu_f(v1[q]); }
                        } else if (act == 2) {
#pragma unroll
                            for (int q = 0; q < 4; ++q) { v0[q] = gelu_tanh_f(v0[q]); v1[q] = gelu_tanh_f(v1[q]); }
                        }
                        u32x4 w; w.x = pk2(v0[0], v0[1]); w.y = pk2(v0[2], v0[3]); w.z = pk2(v1[0], v1[1]); w.w = pk2(v1[2], v1[3]);
                        *(u32x4*)(PB + (size_t)row * LDP + cb + bj * 128) = w;
                    } else if (bj == 0 && wc == 0 && fq < 2) {
                        f32x4* bp = (f32x4*)(BA + (size_t)row * 16 + 8 * fq); bp[0] = v0; bp[1] = v1;
                    }
                }
            }
    }
};
struct Epi2 {
    static constexpr bool PERM = true;
    float* X; bf16* HB; float* RSS; const float* gate;
    const float* ng_next; const float* sc_next;
    unsigned char* dum; int dry;
    __device__ __forceinline__ void operator()(const f32x4 (&acc)[2][2][4][2], const pg8::Unit& u, int wr, int wc, int fr, int fq, int) const {
        const int pn = u.pn, j = u.pm < 32 ? 0 : 1 + ((u.pm - 32) >> 4);
        const int row0 = u.pm * 256 + wr * 64 + fr, cb = pn * 256 + wc * 32 + 8 * fq;
        f32x4 gv[2][2];
#pragma unroll
        for (int bj = 0; bj < 2; ++bj)
#pragma unroll
            for (int n = 0; n < 2; ++n) gv[bj][n] = *(const f32x4*)(gate + j * 3072 + cb + bj * 128 + 4 * n);
#pragma unroll
        for (int am = 0; am < 4; ++am) {
            const int ai = am >> 1;
            f32x4 gs[2][2];
#pragma unroll
            for (int bj = 0; bj < 2; ++bj)
#pragma unroll
                for (int n = 0; n < 2; ++n) {
                    if (ng_next) { const f32x4 ng = *(const f32x4*)(ng_next + cb + bj * 128 + 4 * n), sc = *(const f32x4*)(sc_next + j * 3072 + cb + bj * 128 + 4 * n); gs[bj][n] = ng * (sc + 1.f); }
                    else gs[bj][n] = (f32x4){0.f, 0.f, 0.f, 0.f};
                }
            f32x4 xv[4][2][2];
#pragma unroll
            for (int m = 2 * (am & 1); m < 2 * (am & 1) + 2; ++m)
#pragma unroll
                for (int bj = 0; bj < 2; ++bj) { const f32x4* xq = (const f32x4*)(X + (size_t)(row0 + ai * 128 + m * 16) * D + cb + bj * 128); xv[m][bj][0] = xq[0]; xv[m][bj][1] = xq[1]; }
#pragma unroll
            for (int m = 2 * (am & 1); m < 2 * (am & 1) + 2; ++m) {
                const int row = row0 + ai * 128 + m * 16;
                float ssq = 0.f;
#pragma unroll
                for (int bj = 0; bj < 2; ++bj) {
                    f32x4* xp = (f32x4*)(X + (size_t)row * D + cb + bj * 128);
                    const f32x4 n0 = xv[m][bj][0] + gv[bj][0] * acc[ai][bj][m][0], n1 = xv[m][bj][1] + gv[bj][1] * acc[ai][bj][m][1];
                    if (dry) xp = (f32x4*)((float*)dum + (size_t)(row & 1023) * D + cb + bj * 128);
                    xp[0] = n0; xp[1] = n1;
                    ssq += (n0.x * n0.x + n0.y * n0.y) + (n0.z * n0.z + n0.w * n0.w) + (n1.x * n1.x + n1.y * n1.y) + (n1.z * n1.z + n1.w * n1.w);
                    if (ng_next) { const f32x4 h0 = n0 * gs[bj][0], h1 = n1 * gs[bj][1];
                        u32x4 w; w.x = pk2(h0[0], h0[1]); w.y = pk2(h0[2], h0[3]); w.z = pk2(h1[0], h1[1]); w.w = pk2(h1[2], h1[3]);
                        *(u32x4*)((dry ? (bf16*)(dum + 4 * MiB) + (size_t)(row & 1023) * D : HB + (size_t)row * D) + cb + bj * 128) = w; }
                }
                ssq += __shfl_xor(ssq, 16); ssq += __shfl_xor(ssq, 32);
                if (fq == 0) (dry ? (float*)(dum + 8 * MiB) + (size_t)(row & 1023) * 16 : RSS + (size_t)row * 16)[pn * 4 + wc] = ssq;
            }
        }
    }
};

typedef short bf16x4 __attribute__((ext_vector_type(4)));
__device__ __forceinline__ f32x4 mfma16(bf16x4 a, bf16x4 b, f32x4 c) { return __builtin_amdgcn_mfma_f32_16x16x16bf16_1k(a, b, c, 0, 0, 0); }
__device__ __forceinline__ bf16x4 pack4(f32x4 v) { u32x2 w; w.x = pk2(v[0], v[1]); w.y = pk2(v[2], v[3]); return __builtin_bit_cast(bf16x4, w); }
__device__ __forceinline__ bf16x8 pack8(f32x4 lo, f32x4 hi) { u32x4 w; w.x = pk2(lo[0], lo[1]); w.y = pk2(lo[2], lo[3]); w.z = pk2(hi[0], hi[1]); w.w = pk2(hi[2], hi[3]); return __builtin_bit_cast(bf16x8, w); }
constexpr int PREP_ITEM = 5 * 4096;

__device__ __forceinline__ void prep_dinv(const LAS bf16* Ab_, LAS bf16* Dl, int lane) {
    const int blk = lane >> 4, c = lane & 15;
    unsigned ab = (unsigned)(size_t)(Ab_ + (16 * blk) * 72 + 16 * blk);
    asm volatile("" : "+v"(ab));
    const LAS bf16* Ab = (const LAS bf16*)(size_t)ab;
    float x[16];
#pragma unroll
    for (int ii = 0; ii < 16; ++ii) {
        float acc = (ii == c) ? 1.f : 0.f;
        const LAS u32x4* ar = (const LAS u32x4*)(Ab + ii * 72);
#pragma unroll
        for (int jq = 0; jq < 2; ++jq) {
            if (8 * jq < ii) {
                const u32x4 av = ar[jq];
                if (8 * jq + 0 < ii) acc += bflo(av.x) * x[8 * jq + 0];
                if (8 * jq + 1 < ii) acc += bfhi(av.x) * x[8 * jq + 1];
                if (8 * jq + 2 < ii) acc += bflo(av.y) * x[8 * jq + 2];
                if (8 * jq + 3 < ii) acc += bfhi(av.y) * x[8 * jq + 3];
                if (8 * jq + 4 < ii) acc += bflo(av.z) * x[8 * jq + 4];
                if (8 * jq + 5 < ii) acc += bfhi(av.z) * x[8 * jq + 5];
                if (8 * jq + 6 < ii) acc += bflo(av.w) * x[8 * jq + 6];
                if (8 * jq + 7 < ii) acc += bfhi(av.w) * x[8 * jq + 7];
            }
        }
        asm volatile("" : "+v"(acc) :: "memory");
        x[ii] = acc;
    }
#pragma unroll
    for (int ii = 0; ii < 16; ++ii) Dl[(blk * 16 + ii) * 24 + c] = (bf16)f2bf(x[ii]);
}

__device__ __forceinline__ void prep_item(const Args& a, LAS unsigned char* lds, int l, int sc, int h) {
    const int tid = otid(), lane = tid & 63, wave = __builtin_amdgcn_readfirstlane(tid >> 6);
    LAS float* qs = (LAS float*)lds;
    LAS float* ks = qs + 64 * 65;
    LAS float* vs = ks + 64 * 65;
    LAS bf16* Qb = (LAS bf16*)(lds + 49920);
    LAS bf16* Kb = (LAS bf16*)(lds + 59136);
    constexpr int PD = 30720;
    LAS unsigned char* dbase = lds + 68352;
    LAS float* beta = (LAS float*)(lds + 129792);
    LAS float* gcs = beta + 128;
    LAS float* egs = gcs + 128;
    LAS float* eks = egs + 128;
    const bf16* PB = (const bf16*)(a.ws + WS_PB);
    const float* BA = (const float*)(a.ws + WS_BA);
    const SeqGeo sg = seq_geo(sc);
    const int row0 = sc * 64;
    if (wave < 2) {
        const int dir = wave, tok = dir ? 63 - lane : lane;
        const float bl = BA[(size_t)(row0 + tok) * 16 + dir * 4 + h], al = BA[(size_t)(row0 + tok) * 16 + 8 + dir * 4 + h];
        const float bt = 1.f / (1.f + __expf(-bl));
        const float xx = al + a.in[I_DTB][(l * 2 + dir) * 4 + h];
        const float sp = xx > 20.f ? xx : log1pf(expf(xx));
        float g = -expf(a.in[I_ALOG][(l * 2 + dir) * 4 + h]) * sp;
#pragma unroll
        for (int o = 1; o < 64; o <<= 1) { const float t = __shfl_up(g, o); if (lane >= o) g += t; }
        const float gl = __shfl(g, 63);
        beta[dir * 64 + lane] = bt; gcs[dir * 64 + lane] = g; egs[dir * 64 + lane] = __expf(g); eks[dir * 64 + lane] = __expf(gl - g);
        if (lane == 63) ((float*)(a.ws + WS_PGL))[(sc * 4 + h) * 2 + dir] = __expf(g);
    }
    for (int t = tid; t < 64 * 24; t += NTHR) {
        const int tok = t / 24, cg = t % 24, part = cg >> 3, d0 = (cg & 7) * 8;
        const int col = C_Q + part * 256 + h * 64 + d0, chan = part * 256 + h * 64 + d0;
        float o[8];
#pragma unroll
        for (int c = 0; c < 8; ++c) o[c] = 0.f;
#pragma unroll
        for (int jj = 0; jj < 4; ++jj) {
            const int ts = sg.tseq0 + tok + jj - 2;
            if (ts >= 0 && ts < sg.T) {
                const u32x4 xv = *(const u32x4*)(PB + (size_t)(sg.seq_row0 + ts) * LDP + col);
                const f32x4 w0 = *(const f32x4*)(a.in[I_CONV] + (size_t)(l * 4 + jj) * 768 + chan), w1 = *(const f32x4*)(a.in[I_CONV] + (size_t)(l * 4 + jj) * 768 + chan + 4);
                o[0] += w0.x * bflo(xv.x); o[1] += w0.y * bfhi(xv.x); o[2] += w0.z * bflo(xv.y); o[3] += w0.w * bfhi(xv.y);
                o[4] += w1.x * bflo(xv.z); o[5] += w1.y * bfhi(xv.z); o[6] += w1.z * bflo(xv.w); o[7] += w1.w * bfhi(xv.w);
            }
        }
        LAS float* dst = (part == 0 ? qs : (part == 1 ? ks : vs)) + tok * 65 + d0;
#pragma unroll
        for (int c = 0; c < 8; ++c) dst[c] = silu_f(o[c]);
    }
    __syncthreads();
    {
        const int rowid = tid >> 2, seg = tid & 3, ar = rowid & 63;
        LAS float* p = (rowid < 64 ? qs : ks) + ar * 65 + seg * 16;
        float v[16]; float ss = 0.f;
#pragma unroll
        for (int c = 0; c < 16; ++c) { v[c] = p[c]; ss += v[c] * v[c]; }
        ss += __shfl_xor(ss, 1); ss += __shfl_xor(ss, 2);
        const float s = rsqrtf(ss + EPS) * (rowid < 64 ? 0.125f : 1.f);
#pragma unroll
        for (int c = 0; c < 16; ++c) { v[c] *= s; p[c] = v[c]; }
        LAS bf16* bp = (rowid < 64 ? Qb : Kb) + ar * 72 + seg * 16;
        u32x4 o0, o1; o0.x = pk2(v[0], v[1]); o0.y = pk2(v[2], v[3]); o0.z = pk2(v[4], v[5]); o0.w = pk2(v[6], v[7]);
        o1.x = pk2(v[8], v[9]); o1.y = pk2(v[10], v[11]); o1.z = pk2(v[12], v[13]); o1.w = pk2(v[14], v[15]);
        *(LAS u32x4*)bp = o0; *(LAS u32x4*)(bp + 8) = o1;
    }
    __syncthreads();
    {
        const int mt = wave >> 1, nh = wave & 1, m0 = mt * 16, r = lane & 15, kg = lane >> 4;
#pragma unroll
        for (int t = 0; t < 2; ++t) {
            const f32x4 KKa = tile_mm<2>((f32x4){0.f, 0.f, 0.f, 0.f}, Kb, 72, m0, Kb, 72, nh * 32 + 16 * t, lane);
            const f32x4 QKa = tile_mm<2>((f32x4){0.f, 0.f, 0.f, 0.f}, Qb, 72, m0, Kb, 72, nh * 32 + 16 * t, lane);
            const int bcol = nh * 32 + 16 * t + r;
#pragma unroll
            for (int dir = 0; dir < 2; ++dir) {
                LAS bf16* Ab = (LAS bf16*)(dbase + dir * PD); LAS bf16* QKl = Ab + 64 * 72;
                const int j = dir ? 63 - bcol : bcol; const float gj = gcs[dir * 64 + j];
#pragma unroll
                for (int q = 0; q < 4; ++q) {
                    const int arow = m0 + 4 * kg + q, i = dir ? 63 - arow : arow;
                    const float dec = (i >= j) ? __expf(gcs[dir * 64 + i] - gj) : 0.f;
                    const float av = (i > j) ? beta[dir * 64 + i] * KKa[q] * dec : 0.f;
                    Ab[i * 72 + j] = (bf16)f2bf(-av); QKl[i * 72 + j] = (bf16)f2bf(QKa[q] * dec);
                }
            }
        }
    }
    __syncthreads();
    bf16* PI0 = (bf16*)(a.ws + WS_PREP) + (size_t)((sc * 4 + h) * 2) * PREP_ITEM;
    if (wave < 2) prep_dinv((const LAS bf16*)(dbase + wave * PD), (LAS bf16*)(dbase + wave * PD + 3 * 9216), lane);
    for (int t = tid; t < 2048; t += NTHR) {
        const int dir = t >> 10, which = (t >> 9) & 1, rw = (t >> 3) & 63, sgp = t & 7, n0a = 32 * (sgp >> 2) + 4 * (sgp & 3), n0b = n0a + 16;
        float v[8];
        if (which == 0) {
            const int tok = dir ? 63 - rw : rw; const float e = egs[dir * 64 + rw];
#pragma unroll
            for (int c = 0; c < 4; ++c) { v[c] = qs[tok * 65 + n0a + c] * e; v[4 + c] = qs[tok * 65 + n0b + c] * e; }
        } else {
#pragma unroll
            for (int c = 0; c < 4; ++c) { const int ia = n0a + c, ib = n0b + c;
                v[c] = ks[(dir ? 63 - ia : ia) * 65 + rw] * eks[dir * 64 + ia]; v[4 + c] = ks[(dir ? 63 - ib : ib) * 65 + rw] * eks[dir * 64 + ib]; }
        }
        u32x4 o; o.x = pk2(v[0], v[1]); o.y = pk2(v[2], v[3]); o.z = pk2(v[4], v[5]); o.w = pk2(v[6], v[7]);
        *(u32x4*)(PI0 + (size_t)dir * PREP_ITEM + (1 + which) * 4096 + rw * 64 + sgp * 8) = o;
    }
    __syncthreads();
    {
        const int dir = wave >> 2, r = lane & 15, kg = lane >> 4, cc = 16 * (wave & 3) + r;
        const LAS bf16* Ab = (const LAS bf16*)(dbase + dir * PD); LAS bf16* Wl = (LAS bf16*)(dbase + dir * PD + 2 * 9216); const LAS bf16* Dl = (const LAS bf16*)(dbase + dir * PD + 3 * 9216);
        bf16* PI = PI0 + (size_t)dir * PREP_ITEM;
        f32x4 XU[4], XW[4];
#pragma unroll
        for (int b = 0; b < 4; ++b) {
            f32x4 TU, TW_;
#pragma unroll
            for (int q = 0; q < 4; ++q) { const int i = 16 * b + 4 * kg + q, tok = dir ? 63 - i : i;
                const float bt = beta[dir * 64 + i];
                TU[q] = bt * vs[tok * 65 + cc]; TW_[q] = bt * egs[dir * 64 + i] * ks[tok * 65 + cc]; }
#pragma unroll
            for (int m = 0; m < 4; ++m) if (m < b) {
                const bf16x4 af = *(const LAS bf16x4*)(Ab + (16 * b + r) * 72 + 16 * m + 4 * kg);
                TU = mfma16(af, pack4(XU[m]), TU); TW_ = mfma16(af, pack4(XW[m]), TW_);
            }
            const bf16x4 df = *(const LAS bf16x4*)(Dl + (b * 16 + r) * 24 + 4 * kg);
            XU[b] = mfma16(df, pack4(TU), (f32x4){0.f, 0.f, 0.f, 0.f});
            XW[b] = mfma16(df, pack4(TW_), (f32x4){0.f, 0.f, 0.f, 0.f});
            *(u32x2*)(PI + 4 * 4096 + cc * 64 + 16 * b + 4 * kg) = __builtin_bit_cast(u32x2, pack4(XU[b]));
#pragma unroll
            for (int q = 0; q < 4; ++q) Wl[(16 * b + 4 * kg + q) * 72 + cc] = (bf16)f2bf(XW[b][q]);
        }
    }
    __syncthreads();
    for (int t = tid; t < 2048; t += NTHR) {
        const int dir = t >> 10, which = (t >> 9) & 1, rw = (t >> 3) & 63, sgp = t & 7, n0a = 32 * (sgp >> 2) + 4 * (sgp & 3);
        const LAS bf16* src = (const LAS bf16*)(dbase + dir * PD + (which ? 1 : 2) * 9216) + rw * 72 + n0a;
        const u32x2 lo = *(const LAS u32x2*)src, hi = *(const LAS u32x2*)(src + 16);
        u32x4 o; o.x = lo.x; o.y = lo.y; o.z = hi.x; o.w = hi.y;
        *(u32x4*)(PI0 + (size_t)dir * PREP_ITEM + (which ? 3 : 0) * 4096 + rw * 64 + sgp * 8) = o;
    }
    __syncthreads();
}

__device__ __forceinline__ void sgu_item(const Args& a, LAS unsigned char* lds, int l, int ch, int g, int dry) {
    const int tid = otid(), lane = tid & 63, wave = tid >> 6;
    LAS bf16* Wl = (LAS bf16*)lds;
    LAS bf16* VT = Wl + 128 * 136;
    LAS float* rstd = (LAS float*)(VT + 64 * 136);
    bf16* PB = (bf16*)(a.ws + WS_PB);
    const int row0 = ch * 128;
    {
        const int q = tid >> 2, part = tid & 3;
        const u32x4* vp = (const u32x4*)(PB + (size_t)(row0 + q) * LDP + C_V + part * 64);
        float ss = 0.f;
#pragma unroll
        for (int i = 0; i < 8; ++i) { const u32x4 v = vp[i];
            const float f0 = bflo(v.x), f1 = bfhi(v.x), f2 = bflo(v.y), f3 = bfhi(v.y), f4 = bflo(v.z), f5 = bfhi(v.z), f6 = bflo(v.w), f7 = bfhi(v.w);
            ss += (f0 * f0 + f1 * f1) + (f2 * f2 + f3 * f3) + (f4 * f4 + f5 * f5) + (f6 * f6 + f7 * f7); }
        ss += __shfl_xor(ss, 1); ss += __shfl_xor(ss, 2);
        if (part == 0) rstd[q] = rsqrtf(ss * (1.f / 256.f) + EPS);
    }
    for (int t = tid; t < 128 * 16; t += NTHR) {
        const int p = t >> 4, q8 = t & 15;
        const f32x4* wp = (const f32x4*)(a.in[I_SGUW] + ((size_t)(l * 4 + g) * 128 + p) * 128 + q8 * 8);
        const f32x4 w0 = wp[0], w1 = wp[1];
        u32x4 o; o.x = pk2(w0.x, w0.y); o.y = pk2(w0.z, w0.w); o.z = pk2(w1.x, w1.y); o.w = pk2(w1.z, w1.w);
        *(LAS u32x4*)(Wl + p * 136 + q8 * 8) = o;
    }
    __syncthreads();
    for (int t = tid; t < 128 * 8; t += NTHR) {
        const int q = t >> 3, c0 = (t & 7) * 8;
        const u32x4 v = *(const u32x4*)(PB + (size_t)(row0 + q) * LDP + C_V + g * 64 + c0);
        const f32x4 g0 = *(const f32x4*)(a.in[I_SGUNG] + l * 256 + g * 64 + c0), g1 = *(const f32x4*)(a.in[I_SGUNG] + l * 256 + g * 64 + c0 + 4);
        const float r = rstd[q];
        VT[(c0 + 0) * 136 + q] = (bf16)f2bf(bflo(v.x) * r * g0.x); VT[(c0 + 1) * 136 + q] = (bf16)f2bf(bfhi(v.x) * r * g0.y);
        VT[(c0 + 2) * 136 + q] = (bf16)f2bf(bflo(v.y) * r * g0.z); VT[(c0 + 3) * 136 + q] = (bf16)f2bf(bfhi(v.y) * r * g0.w);
        VT[(c0 + 4) * 136 + q] = (bf16)f2bf(bflo(v.z) * r * g1.x); VT[(c0 + 5) * 136 + q] = (bf16)f2bf(bfhi(v.z) * r * g1.y);
        VT[(c0 + 6) * 136 + q] = (bf16)f2bf(bflo(v.w) * r * g1.z); VT[(c0 + 7) * 136 + q] = (bf16)f2bf(bfhi(v.w) * r * g1.w);
    }
    __syncthreads();
    {
        const int m0 = wave * 16, r = lane & 15, kg = lane >> 4;
#pragma unroll
        for (int nt = 0; nt < 4; ++nt) {
            f32x4 acc = (f32x4){0.f, 0.f, 0.f, 0.f};
            acc = tile_mm<4>(acc, Wl, 136, m0, VT, 136, nt * 16, lane);
#pragma unroll
            for (int q = 0; q < 4; ++q) {
                const int p = m0 + 4 * kg + q, c = nt * 16 + r;
                const float sv = acc[q] + a.in[I_SGUB][(l * 4 + g) * 128 + p];
                bf16* up = PB + (size_t)(row0 + p) * LDP + C_U + g * 64 + c;
                const float uu = bf2f(*up), gb = bf2f(PB[(size_t)(row0 + p) * LDP + C_GB + g * 64 + c]);
                if (dry) up = (bf16*)(a.ws + WS_DUM) + (size_t)((row0 + p) & 1023) * LDP + C_U + g * 64 + c;
                *up = (bf16)f2bf(uu * sv * gb);
            }
        }
    }
    __syncthreads();
}

__device__ __forceinline__ void pool_item(const Args& a, LAS unsigned char* lds, int l, int sc, int dry) {
    const int tid = otid();
    LAS bf16* xt = (LAS bf16*)lds;
    bf16* PB = (bf16*)(a.ws + WS_PB);
    const SeqGeo sg = seq_geo(sc);
    for (int t = tid; t < 80 * 32; t += NTHR) {
        const int r = t >> 5, c8 = t & 31, ts = sg.tseq0 - 8 + r;
        u32x4 v = (u32x4){0u, 0u, 0u, 0u};
        if (ts >= 0 && ts < sg.T) v = *(const u32x4*)(PB + (size_t)(sg.seq_row0 + ts) * LDP + C_XC + c8 * 8);
        *(LAS u32x4*)(xt + r * 264 + c8 * 8) = v;
    }
    __syncthreads();
    for (int t = tid; t < 64 * 32; t += NTHR) {
        const int tok = t >> 5, c8 = t & 31, gi = c8 >> 3, half = 1 << gi;
        const int ts = sg.tseq0 + tok;
        const int lo = (ts - half) < 0 ? 0 : ts - half, hi = (ts + half) > sg.T ? sg.T : ts + half;
        float s[8];
#pragma unroll
        for (int c = 0; c < 8; ++c) s[c] = 0.f;
        for (int tt = lo; tt < hi; ++tt) {
            const u32x4 v = *(const LAS u32x4*)(xt + (tt - sg.tseq0 + 8) * 264 + c8 * 8);
            s[0] += bflo(v.x); s[1] += bfhi(v.x); s[2] += bflo(v.y); s[3] += bfhi(v.y); s[4] += bflo(v.z); s[5] += bfhi(v.z); s[6] += bflo(v.w); s[7] += bfhi(v.w);
        }
        const float inv = 1.f / (float)(hi - lo);
        const u32x4 xv = *(const LAS u32x4*)(xt + (tok + 8) * 264 + c8 * 8);
        const float x0[8] = {bflo(xv.x), bfhi(xv.x), bflo(xv.y), bfhi(xv.y), bflo(xv.z), bfhi(xv.z), bflo(xv.w), bfhi(xv.w)};
        bf16* yp = PB + (size_t)(sg.seq_row0 + ts) * LDP + C_GC + c8 * 8;
        const u32x4 gv = *(const u32x4*)yp;
        const float gg[8] = {bflo(gv.x), bfhi(gv.x), bflo(gv.y), bfhi(gv.y), bflo(gv.z), bfhi(gv.z), bflo(gv.w), bfhi(gv.w)};
        const f32x4 p0 = *(const f32x4*)(a.in[I_POOLS] + l * 256 + c8 * 8), p1 = *(const f32x4*)(a.in[I_POOLS] + l * 256 + c8 * 8 + 4);
        const float ps[8] = {p0.x, p0.y, p0.z, p0.w, p1.x, p1.y, p1.z, p1.w};
        float y[8];
#pragma unroll
        for (int c = 0; c < 8; ++c) y[c] = (s[c] * inv - x0[c]) * ps[c] * gg[c];
        u32x4 o; o.x = pk2(y[0], y[1]); o.y = pk2(y[2], y[3]); o.z = pk2(y[4], y[5]); o.w = pk2(y[6], y[7]);
        if (dry) yp = (bf16*)(a.ws + WS_DUM) + (size_t)((sg.seq_row0 + ts) & 1023) * LDP + C_GC + c8 * 8;
        *(u32x4*)yp = o;
    }
    __syncthreads();
}

__device__ __forceinline__ void fctx_item(const Args& a, LAS unsigned char* lds, int b, int dblk, int dry) {
    const int tid = otid(), lane = tid & 63, wave = __builtin_amdgcn_readfirstlane(tid >> 6);
    LAS bf16* ZT = (LAS bf16*)lds;
    bf16* PB = (bf16*)(a.ws + WS_PB);
    const bf16* DFT = (const bf16*)(a.ws + WS_DFT);
    {
        u32x4 v[8];
#pragma unroll
        for (int i = 0; i < 8; ++i) { const int t = tid + NTHR * i, d8 = t & 7, ri = (t >> 3) & 1, tt = t >> 4;
            v[i] = *(const u32x4*)(PB + (size_t)(b * 256 + tt) * LDP + (ri ? C_QF : C_PF) + dblk * 64 + d8 * 8); }
#pragma unroll
        for (int i = 0; i < 8; ++i) { const int t = tid + NTHR * i, d8 = t & 7, ri = (t >> 3) & 1, tt = t >> 4;
            LAS bf16* dst = ZT + (d8 * 8) * 520 + ri * 256 + tt;
            dst[0 * 520] = (bf16)(v[i].x & 0xffffu); dst[1 * 520] = (bf16)(v[i].x >> 16); dst[2 * 520] = (bf16)(v[i].y & 0xffffu); dst[3 * 520] = (bf16)(v[i].y >> 16);
            dst[4 * 520] = (bf16)(v[i].z & 0xffffu); dst[5 * 520] = (bf16)(v[i].z >> 16); dst[6 * 520] = (bf16)(v[i].w & 0xffffu); dst[7 * 520] = (bf16)(v[i].w >> 16); }
    }
    __syncthreads();
    const int r = lane & 15, kg = lane >> 4;
#pragma unroll 1
    for (int mi = 0; mi < 2; ++mi) {
        const int m0 = wave * 32 + mi * 16;
        bf16 gdv[4][4];
#pragma unroll
        for (int nt = 0; nt < 4; ++nt)
#pragma unroll
            for (int q = 0; q < 4; ++q) gdv[nt][q] = PB[(size_t)(b * 256 + m0 + 4 * kg + q) * LDP + C_GD + dblk * 64 + nt * 16 + r];
        f32x4 acc[4];
#pragma unroll
        for (int nt = 0; nt < 4; ++nt) acc[nt] = (f32x4){0.f, 0.f, 0.f, 0.f};
#pragma unroll
        for (int kh = 0; kh < 2; ++kh) {
            bf16x8 af[8];
#pragma unroll
            for (int ksx = 0; ksx < 8; ++ksx) af[ksx] = *(const bf16x8*)(DFT + (size_t)(m0 + r) * 512 + (kh * 8 + ksx) * 32 + kg * 8);
#pragma unroll
            for (int nt = 0; nt < 4; ++nt) {
#pragma unroll
                for (int ksx = 0; ksx < 8; ++ksx) {
                    const bf16x8 bfr = *(const LAS bf16x8*)(ZT + (nt * 16 + r) * 520 + (kh * 8 + ksx) * 32 + kg * 8);
                    acc[nt] = __builtin_amdgcn_mfma_f32_16x16x32_bf16(af[ksx], bfr, acc[nt], 0, 0, 0);
                }
                __builtin_amdgcn_sched_barrier(0);
            }
        }
#pragma unroll
        for (int nt = 0; nt < 4; ++nt)
#pragma unroll
            for (int q = 0; q < 4; ++q) {
                const int k = m0 + 4 * kg + q, d = nt * 16 + r;
                bf16* yp = (dry ? (bf16*)(a.ws + WS_DUM) + (size_t)((b * 256 + k) & 1023) * LDP : PB + (size_t)(b * 256 + k) * LDP) + C_GD + dblk * 64 + d;
                *yp = (bf16)f2bf(acc[nt][q] * bf2f(gdv[nt][q]));
            }
    }
    __syncthreads();
}

__device__ __forceinline__ void fsmp_item(const Args& a, LAS unsigned char* lds, int b, int ds, int dry) {
    const int tid = otid(), lane = tid & 63, wave = __builtin_amdgcn_readfirstlane(tid >> 6);
    LAS bf16* ZT = (LAS bf16*)lds;
    LAS bf16* B2 = ZT + 256 * 136;
    bf16* PB = (bf16*)(a.ws + WS_PB);
    const bf16* M1 = (const bf16*)(a.ws + WS_M1);
    const bf16* M2 = (const bf16*)(a.ws + WS_M2);
    const int d0 = ds * 4;
    const size_t rowb = (size_t)M_CTX + (size_t)b * 4096;
    const int r = lane & 15, kg = lane >> 4, mp = wave & 3, nb = wave >> 2;
    {
        u32x2 v[16];
#pragma unroll
        for (int i = 0; i < 16; ++i) { const int t = tid + NTHR * i, ri = t & 1, tt = t >> 1;
            v[i] = *(const u32x2*)(PB + (rowb + tt) * LDP + (ri ? C_QF : C_PF) + d0); }
#pragma unroll
        for (int i = 0; i < 16; ++i) { const int t = tid + NTHR * i, ri = t & 1, tt = t >> 1, t1 = tt >> 6, t2 = tt & 63;
            LAS bf16* dst = ZT + (t2 * 4) * 136 + ri * 64 + t1;
            dst[0] = (bf16)(v[i].x & 0xffffu); dst[136] = (bf16)(v[i].x >> 16); dst[272] = (bf16)(v[i].y & 0xffffu); dst[408] = (bf16)(v[i].y >> 16); }
    }
    bf16x8 aRe[4], aIm[4], a2[4];
#pragma unroll
    for (int ksx = 0; ksx < 4; ++ksx) {
        aRe[ksx] = *(const bf16x8*)(M1 + (16 * mp + r) * 128 + ksx * 32 + kg * 8);
        aIm[ksx] = *(const bf16x8*)(M1 + (64 + 16 * mp + r) * 128 + ksx * 32 + kg * 8);
        a2[ksx] = *(const bf16x8*)(M2 + (16 * mp + r) * 128 + ksx * 32 + kg * 8);
    }
    bf16 gdv[8][4];
#pragma unroll
    for (int jb = 0; jb < 8; ++jb) { const int n = 16 * (nb + 2 * jb) + r, k1 = n >> 2, dd = n & 3;
#pragma unroll
        for (int q = 0; q < 4; ++q) gdv[jb][q] = PB[(rowb + k1 + 64 * (16 * mp + 4 * kg + q)) * LDP + C_GD + d0 + dd]; }
    __syncthreads();
#pragma unroll 2
    for (int jb = 0; jb < 8; ++jb) {
        const int nt = nb + 2 * jb;
        f32x4 ar = (f32x4){0.f, 0.f, 0.f, 0.f}, ai = (f32x4){0.f, 0.f, 0.f, 0.f};
#pragma unroll
        for (int ksx = 0; ksx < 4; ++ksx) {
            const bf16x8 z = *(const LAS bf16x8*)(ZT + (16 * nt + r) * 136 + ksx * 32 + kg * 8);
            ar = __builtin_amdgcn_mfma_f32_16x16x32_bf16(aRe[ksx], z, ar, 0, 0, 0);
            ai = __builtin_amdgcn_mfma_f32_16x16x32_bf16(aIm[ksx], z, ai, 0, 0, 0);
        }
        const int n = 16 * nt + r, t2 = n >> 2, dd = n & 3;
#pragma unroll
        for (int q = 0; q < 4; ++q) {
            const int k1 = 16 * mp + 4 * kg + q;
            const float rev = (float)((k1 * t2) & 4095) * (1.f / 4096.f);
            const float cw = __builtin_amdgcn_cosf(rev), sw = __builtin_amdgcn_sinf(rev);
            const float xr = ar[q] * cw - ai[q] * sw, xi = ar[q] * sw + ai[q] * cw;
            B2[(k1 * 4 + dd) * 136 + t2] = (bf16)f2bf(xr);
            B2[(k1 * 4 + dd) * 136 + 64 + t2] = (bf16)f2bf(xi);
        }
    }
    __syncthreads();
#pragma unroll 2
    for (int jb = 0; jb < 8; ++jb) {
        const int nt = nb + 2 * jb;
        f32x4 acc = (f32x4){0.f, 0.f, 0.f, 0.f};
#pragma unroll
        for (int ksx = 0; ksx < 4; ++ksx) {
            const bf16x8 z = *(const LAS bf16x8*)(B2 + (16 * nt + r) * 136 + ksx * 32 + kg * 8);
            acc = __builtin_amdgcn_mfma_f32_16x16x32_bf16(a2[ksx], z, acc, 0, 0, 0);
        }
        const int n = 16 * nt + r, k1 = n >> 2, dd = n & 3;
#pragma unroll
        for (int q = 0; q < 4; ++q) {
            const int k2 = 16 * mp + 4 * kg + q, kk = k1 + 64 * k2;
            bf16* yp = (dry ? (bf16*)(a.ws + WS_DUM) + (size_t)(kk & 1023) * LDP : PB + (rowb + kk) * LDP) + C_GD + d0 + dd;
            *yp = (bf16)f2bf(acc[q] * bf2f(gdv[jb][q]));
        }
    }
    __syncthreads();
}

constexpr int SC_MAT = 64 * 72 * 2;
constexpr int SC_BUF = 5 * SC_MAT + 16;
constexpr int SC_OT = 2 * SC_BUF;
__device__ __forceinline__ void scan_item(const Args& a, LAS unsigned char* lds, int l, int seq, int h, int dir) {
    const int tid = otid(), lane = tid & 63, wave = __builtin_amdgcn_readfirstlane(tid >> 6);
    bf16* PB = (bf16*)(a.ws + WS_PB);
    const int nch = seq < 32 ? 4 : 64;
    const int sc0 = seq < 32 ? seq * 4 : 128 + (seq - 32) * 64;
    const int r = lane & 15, kg = lane >> 4;
    if (wave >= 4) {
        const int ht = tid - 256;
        u32x4 pre[10]; float pgl = 0.f;
#define SC_ISSUE(ss) do { const int c_ = dir ? nch - 1 - (ss) : (ss); const size_t pid_ = (size_t)((sc0 + c_) * 4 + h) * 2 + dir; \
            const u32x4* src_ = (const u32x4*)((const bf16*)(a.ws + WS_PREP) + pid_ * PREP_ITEM) + ht; \
            _Pragma("unroll") for (int i_ = 0; i_ < 10; ++i_) pre[i_] = src_[256 * i_]; \
            pgl = ((const float*)(a.ws + WS_PGL))[pid_]; } while (0)
#define SC_WRITE(bb) do { LAS unsigned char* B_ = lds + (bb) * SC_BUF; \
            _Pragma("unroll") for (int i_ = 0; i_ < 10; ++i_) { const int ch_ = ht + 256 * i_; \
                *(LAS u32x4*)(B_ + (ch_ >> 9) * SC_MAT + ((ch_ >> 3) & 63) * 144 + (ch_ & 7) * 16) = pre[i_]; } \
            if (ht == 0) *(LAS float*)(B_ + 5 * SC_MAT) = pgl; } while (0)
#define SC_OSTORE(ss) do { const int c_ = dir ? nch - 1 - (ss) : (ss); const LAS unsigned char* O_ = lds + SC_OT + ((ss) & 1) * SC_MAT; \
            _Pragma("unroll") for (int i_ = 0; i_ < 2; ++i_) { const int ch_ = ht + 256 * i_, rw_ = ch_ >> 3, c8_ = ch_ & 7; \
                const u32x4 v_ = *(const LAS u32x4*)(O_ + rw_ * 144 + c8_ * 16); \
                *(u32x4*)(PB + (size_t)((sc0 + c_) * 64 + (dir ? 63 - rw_ : rw_)) * LDP + (dir ? C_K : C_Q) + h * 64 + c8_ * 8) = v_; } } while (0)
        SC_ISSUE(0);
        SC_WRITE(0);
        { const int sn = nch > 1 ? 1 : 0; SC_ISSUE(sn); }
        __syncthreads();
#pragma unroll 1
        for (int s = 0; s < nch; ++s) {
            SC_WRITE((s + 1) & 1);
            if (s > 0) SC_OSTORE(s - 1);
            { const int sn = (s + 2 < nch) ? s + 2 : nch - 1; SC_ISSUE(sn); }
            __syncthreads();
        }
        SC_OSTORE(nch - 1);
#undef SC_ISSUE
#undef SC_WRITE
#undef SC_OSTORE
    } else {
        const int e = 16 * wave + r;
        f32x4 S[4];
#pragma unroll
        for (int t = 0; t < 4; ++t)
#pragma unroll
            for (int q = 0; q < 4; ++q) {
                const int d = 16 * t + 4 * kg + q;
                S[t][q] = (seq < 32) ? 0.f : a.in[I_STATE][((size_t)(((seq - 32) * 4 + l) * 2 + dir) * 4 + h) * 4096 + d * 64 + e];
            }
        __syncthreads();
#pragma unroll 1
        for (int s = 0; s < nch; ++s) {
            const LAS unsigned char* B = lds + (s & 1) * SC_BUF;
            const LAS bf16* Wm = (const LAS bf16*)B; const LAS bf16* Qd = Wm + 64 * 72; const LAS bf16* KdT = Qd + 64 * 72; const LAS bf16* QKm = KdT + 64 * 72; const LAS bf16* UT = QKm + 64 * 72;
            const float egl = *(const LAS float*)(B + 5 * SC_MAT);
            LAS bf16* OT = (LAS bf16*)(lds + SC_OT + (s & 1) * SC_MAT);
            bf16x8 bS[2];
            bS[0] = pack8(S[0], S[1]); bS[1] = pack8(S[2], S[3]);
            f32x4 a1[4], oo[4];
#pragma unroll
            for (int t = 0; t < 4; ++t) {
                a1[t] = (f32x4){0.f, 0.f, 0.f, 0.f}; oo[t] = (f32x4){0.f, 0.f, 0.f, 0.f};
#pragma unroll
                for (int ksx = 0; ksx < 2; ++ksx) {
                    const bf16x8 wf = *(const LAS bf16x8*)(Wm + (16 * t + r) * 72 + ksx * 32 + kg * 8);
                    const bf16x8 qf = *(const LAS bf16x8*)(Qd + (16 * t + r) * 72 + ksx * 32 + kg * 8);
                    a1[t] = __builtin_amdgcn_mfma_f32_16x16x32_bf16(wf, bS[ksx], a1[t], 0, 0, 0);
                    oo[t] = __builtin_amdgcn_mfma_f32_16x16x32_bf16(qf, bS[ksx], oo[t], 0, 0, 0);
                }
            }
            f32x4 vn[4];
#pragma unroll
            for (int t = 0; t < 4; ++t) {
                const u32x2 uu = *(const LAS u32x2*)(UT + e * 72 + 16 * t + 4 * kg);
                vn[t][0] = bflo(uu.x) - a1[t][0]; vn[t][1] = bfhi(uu.x) - a1[t][1]; vn[t][2] = bflo(uu.y) - a1[t][2]; vn[t][3] = bfhi(uu.y) - a1[t][3];
            }
            bf16x8 bV[2];
            bV[0] = pack8(vn[0], vn[1]); bV[1] = pack8(vn[2], vn[3]);
#pragma unroll
            for (int t = 0; t < 4; ++t) {
                f32x4 as = (f32x4){0.f, 0.f, 0.f, 0.f};
#pragma unroll
                for (int ksx = 0; ksx < 2; ++ksx) {
                    const bf16x8 kf = *(const LAS bf16x8*)(QKm + (16 * t + r) * 72 + ksx * 32 + kg * 8);
                    const bf16x8 df = *(const LAS bf16x8*)(KdT + (16 * t + r) * 72 + ksx * 32 + kg * 8);
                    oo[t] = __builtin_amdgcn_mfma_f32_16x16x32_bf16(kf, bV[ksx], oo[t], 0, 0, 0);
                    as = __builtin_amdgcn_mfma_f32_16x16x32_bf16(df, bV[ksx], as, 0, 0, 0);
                }
                S[t] = S[t] * egl + as;
            }
#pragma unroll
            for (int t = 0; t < 4; ++t)
#pragma unroll
                for (int q = 0; q < 4; ++q) OT[(16 * t + 4 * kg + q) * 72 + e] = (bf16)f2bf(oo[t][q]);
            __syncthreads();
        }
        if (seq < 32) {
            float* ns = a.out + (size_t)M * D + ((size_t)((seq * 4 + l) * 2 + dir) * 4 + h) * 4096;
#pragma unroll
            for (int t = 0; t < 4; ++t)
#pragma unroll
                for (int q = 0; q < 4; ++q) ns[(16 * t + 4 * kg + q) * 64 + e] = S[t][q];
        }
    }
    __syncthreads();
}

__device__ __forceinline__ void phase_combine(const Args& a, int l, int dry) {
    const int tid = otid(), lane = tid & 63, wave = tid >> 6, G = gridDim.x, bid = obid();
    bf16* PB = (bf16*)(a.ws + WS_PB);
    const f32x4 ng = *(const f32x4*)(a.in[I_DNG] + l * 64 + (lane & 15) * 4);
    for (int row = bid * NWAVES + wave; row < M; row += G * NWAVES) {
        bf16* rp = PB + (size_t)row * LDP;
        const u32x2 of = *((const u32x2*)(rp + C_Q) + lane), ob = *((const u32x2*)(rp + C_K) + lane), ga = *((const u32x2*)(rp + C_GA) + lane);
        const float o0 = bflo(of.x) + bflo(ob.x), o1 = bfhi(of.x) + bfhi(ob.x), o2 = bflo(of.y) + bflo(ob.y), o3 = bfhi(of.y) + bfhi(ob.y);
        float ss = (o0 * o0 + o1 * o1) + (o2 * o2 + o3 * o3);
        ss += __shfl_xor(ss, 1); ss += __shfl_xor(ss, 2); ss += __shfl_xor(ss, 4); ss += __shfl_xor(ss, 8);
        const float rinv = rsqrtf(ss * (1.f / 64.f) + EPS);
        u32x2 y; y.x = pk2(o0 * rinv * ng.x * bflo(ga.x), o1 * rinv * ng.y * bfhi(ga.x)); y.y = pk2(o2 * rinv * ng.z * bflo(ga.y), o3 * rinv * ng.w * bfhi(ga.y));
        if (dry) rp = (bf16*)(a.ws + WS_DUM) + (size_t)(row & 1023) * LDP;
        *((u32x2*)(rp + C_GA) + lane) = y;
    }
}

__device__ __forceinline__ void phase_final(const Args& a) {
    const int tid = otid(), lane = tid & 63, wave = tid >> 6, G = gridDim.x, bid = obid();
    const float* RSS = (const float*)(a.ws + WS_RSS);
    f32x4 fg[4];
#pragma unroll
    for (int q = 0; q < 4; ++q) fg[q] = *((const f32x4*)(a.in[I_FNG] + 256 * q) + lane);
    for (int row = bid * NWAVES + wave; row < M; row += G * NWAVES) {
        float p = (lane < 16) ? RSS[(size_t)row * 16 + lane] : 0.f;
        p += __shfl_xor(p, 1); p += __shfl_xor(p, 2); p += __shfl_xor(p, 4); p += __shfl_xor(p, 8);
        const float ss = __shfl(p, 0);
        const float rinv = rsqrtf(ss * (1.f / 1024.f) + EPS);
        f32x4* orow = (f32x4*)(a.out + (size_t)row * D) + lane;
#pragma unroll
        for (int q = 0; q < 4; ++q) { const f32x4 v = orow[64 * q]; orow[64 * q] = v * rinv * fg[q]; }
    }
}

__device__ __forceinline__ void skinny_ba(const Args& a, int l, int pm) {
    const int tid = otid(), lane = tid & 63, wave = __builtin_amdgcn_readfirstlane(tid >> 6), r = lane & 15, kg = lane >> 4;
    const bf16* A = (const bf16*)(a.ws + WS_HB) + (size_t)(pm * 256 + wave * 32 + r) * 1024 + kg * 8;
    const bf16* Bw = (const bf16*)(a.ws + WS_W1T) + ((size_t)l * N1 + 3072 + r) * 1024 + kg * 8;
    f32x4 acc0 = (f32x4){0.f, 0.f, 0.f, 0.f}, acc1 = acc0;
    bf16x8 a0[2][4], a1[2][4], bw[2][4];
#define SK_LOAD(buf, kc_) do { _Pragma("unroll") for (int ksx = 0; ksx < 4; ++ksx) { const int k = ((kc_) * 4 + ksx) * 32; \
        a0[buf][ksx] = *(const bf16x8*)(A + k); a1[buf][ksx] = *(const bf16x8*)(A + 16 * 1024 + k); bw[buf][ksx] = *(const bf16x8*)(Bw + k); } } while (0)
#define SK_MMA(buf) do { _Pragma("unroll") for (int ksx = 0; ksx < 4; ++ksx) { \
        acc0 = __builtin_amdgcn_mfma_f32_16x16x32_bf16(a0[buf][ksx], bw[buf][ksx], acc0, 0, 0, 0); \
        acc1 = __builtin_amdgcn_mfma_f32_16x16x32_bf16(a1[buf][ksx], bw[buf][ksx], acc1, 0, 0, 0); } } while (0)
    SK_LOAD(0, 0); SK_LOAD(1, 1);
    SK_MMA(0); SK_LOAD(0, 2); SK_MMA(1); SK_LOAD(1, 3); SK_MMA(0); SK_LOAD(0, 4); SK_MMA(1); SK_LOAD(1, 5);
    SK_MMA(0); SK_LOAD(0, 6); SK_MMA(1); SK_LOAD(1, 7); SK_MMA(0); SK_MMA(1);
#undef SK_LOAD
#undef SK_MMA
    const int j = pm < 32 ? 0 : 1 + ((pm - 32) >> 4);
    const float sw = ((const float*)(a.ws + WS_SW))[((size_t)l * 9 + j) * N1 + 3072 + r];
    const float* RSS = (const float*)(a.ws + WS_RSS);
    float* BA = (float*)(a.ws + WS_BA);
#pragma unroll
    for (int mi = 0; mi < 2; ++mi)
#pragma unroll
        for (int q = 0; q < 4; ++q) {
            const int row = pm * 256 + wave * 32 + mi * 16 + 4 * kg + q;
            const f32x4* rp = (const f32x4*)(RSS + (size_t)row * 16);
            const f32x4 r0 = rp[0], r1 = rp[1], r2 = rp[2], r3 = rp[3];
            const float ss = ((r0.x + r0.y) + (r0.z + r0.w)) + ((r1.x + r1.y) + (r1.z + r1.w)) + ((r2.x + r2.y) + (r2.z + r2.w)) + ((r3.x + r3.y) + (r3.z + r3.w));
            const float rinv = rsqrtf(ss * (1.f / 1024.f) + EPS);
            BA[(size_t)row * 16 + r] = (mi ? acc1[q] : acc0[q]) * rinv + sw;
        }
}

constexpr int NPHASE = 24;
__global__ void __launch_bounds__(NTHR, 2) fwd_kernel(Args args) {
    extern __shared__ __attribute__((aligned(16))) unsigned char lds_raw[];
    LAS unsigned char* lds = (LAS unsigned char*)lds_raw;
#if !MK_MULTI
    volatile LAS unsigned* MISC = (volatile LAS unsigned*)(lds + MISC_OFF);
    if (threadIdx.x < 64) MISC[threadIdx.x] = 0u;
    __syncthreads();
    XcdBarrier bar = xcd_barrier_post((unsigned*)(args.ws + WS_CTL) + CW_BAR, MISC + 8);
#define GRID_BAR() xcd_barrier(bar)
#else
#define GRID_BAR() do { } while (0)
#endif
    const int G = gridDim.x, bid = blockIdx.x;
    for (int ph = args.ph_lo; ph < args.ph_hi; ++ph) {
        if (ph == 0) { if (EN(0)) for (int rep = 0; rep < REP_P0; ++rep) phase_0a(args, lds); }
        else if (ph == 1) { if (EN(1)) for (int rep = 0; rep < REP_P0; ++rep) phase_0b(args); }
        else if (ph == 2) { if (EN(2)) phase_0c(args); }
        else if (ph == 23) { if (EN(3)) phase_final(args); }
        else {
            const int l = (ph - 3) / 5, sub = (ph - 3) % 5;
            if (sub == 0) { if (EN(4)) {
                pg8::Gemm g{(const bf16*)(args.ws + WS_HB), (const bf16*)(args.ws + WS_W1T) + (size_t)l * N1 * 1024, M, LDP, 1024, 1024};
                pg8::StaticOrder S; S.init(M, LDP, G, bid);
                Epi1 E{(bf16*)(args.ws + WS_PB), (float*)(args.ws + WS_BA), (const float*)(args.ws + WS_RSS), (const float*)(args.ws + WS_SW) + (size_t)l * 9 * N1, 0, (bf16*)(args.ws + WS_DUM), (const LAS float*)(lds + 131072)};
                {
                    LAS float* rtab = (LAS float*)(lds + 131072); const float* RSSp = (const float*)(args.ws + WS_RSS);
                    for (int idx = otid(); idx < 8 * 256; idx += NTHR) { pg8::Unit u;
                        if (S.next(idx >> 8, u)) { const f32x4* rp = (const f32x4*)(RSSp + (size_t)(u.pm * 256 + (idx & 255)) * 16);
                            const f32x4 r0 = rp[0], r1 = rp[1], r2 = rp[2], r3 = rp[3];
                            const float ss = ((r0.x + r0.y) + (r0.z + r0.w)) + ((r1.x + r1.y) + (r1.z + r1.w)) + ((r2.x + r2.y) + (r2.z + r2.w)) + ((r3.x + r3.y) + (r3.z + r3.w));
                            rtab[idx] = rsqrtf(ss * (1.f / 1024.f) + EPS); } }
                    __syncthreads();
                }
                for (int rep = 0; rep < REP_G1; ++rep) { if (rep && G1CHEAP) E.cheap = args.one; pg8::gemm_phase<Epi1>(lds, g, S, E); if (rep && G1CHEAP) continue;
                    if (bid >= 128) for (int pm = bid - 128; pm < 160; pm += 128) skinny_ba(args, l, pm); } }
            } else if (sub == 1) {
                for (int rmix = 0; rmix < REP_MIX; ++rmix)
                for (int it = bid; it < 4480; it += G) {
                    const int dry = rmix ? args.one : 0;
                    if (it < 2560) { if (rmix) continue; if (EN(5)) for (int rep = 0; rep < REP_PREP; ++rep) prep_item(args, lds, l, it >> 2, it & 3); }
                    else if (it < 3840) { const int i2 = it - 2560; if (EN(6) && (!rmix || (MIXSEL & 1))) sgu_item(args, lds, l, i2 >> 2, i2 & 3, dry); }
                    else { if (EN(7) && (!rmix || (MIXSEL & 2))) pool_item(args, lds, l, it - 3840, dry); }
                }
            } else if (sub == 2) {
                if (bid < 64) { if (EN(10)) for (int rep = 0; rep < REP_SCAN; ++rep) scan_item(args, lds, l, 32 + (bid >> 3), (bid >> 1) & 3, bid & 1); }
                unsigned* qc = (unsigned*)(args.ws + WS_CTL) + CW_Q + 64 * l;
                volatile LAS unsigned* qslot = (volatile LAS unsigned*)(lds + MISC_OFF) + 16;
                for (;;) {
                    if (otid() == 0) qslot[0] = atomicAdd(qc, 1u);
                    __syncthreads();
                    const int it = (int)qslot[0];
                    __syncthreads();
                    if (it >= 896) break;
                    if (it < 512) { if (EN(9)) fsmp_item(args, lds, it >> 6, it & 63, 0); }
                    else if (it < 640) { const int i2 = it - 512; if (EN(8)) fctx_item(args, lds, i2 >> 2, i2 & 3, 0); }
                    else { const int i2 = it - 640; if (EN(10)) for (int rep = 0; rep < REP_SCAN; ++rep) scan_item(args, lds, l, i2 >> 3, (i2 >> 1) & 3, i2 & 1); }
                }
                for (int rmix = 1; rmix < REP_MIX; ++rmix)
                for (int it = bid; it < 640; it += G) {
                    if (it < 512) { if (MIXSEL & 8) fsmp_item(args, lds, it >> 6, it & 63, args.one); }
                    else { const int i2 = it - 512; if (MIXSEL & 4) fctx_item(args, lds, i2 >> 2, i2 & 3, args.one); }
                }
            } else if (sub == 3) {
                if (EN(11)) for (int rep = 0; rep < REP_COMB; ++rep) phase_combine(args, l, rep ? args.one : 0);
            } else if (EN(12)) {
                pg8::Gemm g{(const bf16*)(args.ws + WS_PB), (const bf16*)(args.ws + WS_W2T) + (size_t)l * 1024 * 1024, M, 1024, 1024, LDP};
                pg8::StaticOrder S; S.init(M, 1024, G, bid);
                const float* MOD = (const float*)(args.ws + WS_MOD);
                Epi2 E{args.out, (bf16*)(args.ws + WS_HB), (float*)(args.ws + WS_RSS), MOD + (size_t)l * 9 * 3072 + 2048,
                       l < 3 ? args.in[I_NORMG] + (l + 1) * 1024 : nullptr, l < 3 ? MOD + (size_t)(l + 1) * 9 * 3072 + 1024 : nullptr, args.ws + WS_DUM, 0};
                pg8::gemm_phase<Epi2>(lds, g, S, E);
                for (int rep = 1; rep < REP_G2; ++rep) { Epi2 E2 = E; E2.dry = args.one; pg8::gemm_phase<Epi2>(lds, g, S, E2); }
            }
        }
        if (ph + 1 < args.ph_hi) GRID_BAR();
    }
}

extern "C" void kernel_launch(void* const* d_in, const int* in_sizes, int n_in, void* d_out, int out_size, void* d_ws, size_t ws_size, hipStream_t stream) {
    static int grid = 0;
    if (grid == 0) {
        if (n_in != 21 || ws_size < WS_DUM + 16 * MiB) { fprintf(stderr, "kernel_launch: unexpected n_in %d or ws_size %zu (< %zu)\n", n_in, ws_size, (size_t)WS_END); grid = -1; return; }
        int dev = 0, cus = 0, per_cu = 0;
        if (hipGetDevice(&dev) != hipSuccess || hipDeviceGetAttribute(&cus, hipDeviceAttributeMultiprocessorCount, dev) != hipSuccess) { grid = -1; return; }
        if (hipFuncSetAttribute((const void*)fwd_kernel, hipFuncAttributeMaxDynamicSharedMemorySize, LDS_BYTES) != hipSuccess) { fprintf(stderr, "kernel_launch: hipFuncSetAttribute failed\n"); grid = -1; return; }
        if (hipOccupancyMaxActiveBlocksPerMultiprocessor(&per_cu, (const void*)fwd_kernel, NTHR, LDS_BYTES) != hipSuccess || per_cu < 1) { fprintf(stderr, "kernel_launch: occupancy query failed (%d)\n", per_cu); (void)hipGetLastError(); per_cu = 1; }
        grid = cus * 1;
    }
    if (grid < 0) return;
    Args a{};
    for (int i = 0; i < 21; ++i) a.in[i] = (const float*)d_in[i];
    a.out = (float*)d_out; a.ws = (unsigned char*)d_ws; a.one = 1;
    (void)hipMemsetAsync((char*)d_ws + WS_CTL, 0, CTL_ZERO_BYTES, stream);
#if MK_MULTI
    for (int ph = 0; ph < NPHASE; ++ph) {
        a.ph_lo = ph; a.ph_hi = ph + 1;
        hipLaunchKernelGGL(fwd_kernel, dim3(grid), dim3(NTHR), LDS_BYTES, stream, a);
    }
#else
    a.ph_lo = 0; a.ph_hi = NPHASE;
    void* kargs[] = {&a};
    hipError_t e = hipLaunchCooperativeKernel((const void*)fwd_kernel, dim3(grid), dim3(NTHR), kargs, LDS_BYTES, stream);
    if (e != hipSuccess) fprintf(stderr, "kernel_launch: cooperative launch failed: %s (grid %d)\n", hipGetErrorString(e), grid);
#endif
}
```

```cpp
#include <hip/hip_runtime.h>
#include <cstdio>
#include <cstdint>

#ifndef MK_MULTI
#define MK_MULTI 0
#endif
#ifndef NAIVE_MM
#define NAIVE_MM 0
#endif
#ifndef ONLY
#define ONLY -1
#endif
#define EN(k) (ONLY < 0 || ONLY == (k))
#ifndef REP_G1
#define REP_G1 1
#endif
#ifndef REP_PREP
#define REP_PREP 1
#endif
#ifndef REP_SCAN
#define REP_SCAN 1
#endif
#ifndef REP_P0
#define REP_P0 1
#endif
#ifndef REP_MIX
#define REP_MIX 1
#endif
#ifndef REP_COMB
#define REP_COMB 1
#endif
#ifndef REP_G2
#define REP_G2 1
#endif
#ifndef MIXSEL
#define MIXSEL 15
#endif
#ifndef G1CHEAP
#define G1CHEAP 0
#endif
#ifndef REP_BAR
#define REP_BAR 1
#endif
#ifndef PRE_HI
#define PRE_HI 0
#endif

#define LAS __attribute__((address_space(3)))
#define GAS __attribute__((address_space(1)))
typedef unsigned short bf16;
typedef short bf16x8 __attribute__((ext_vector_type(8)));
typedef float f32x4 __attribute__((ext_vector_type(4)));
typedef float f32x2 __attribute__((ext_vector_type(2)));
typedef unsigned u32x4 __attribute__((ext_vector_type(4)));
typedef unsigned u32x2 __attribute__((ext_vector_type(2)));

constexpr int D = 1024, NL = 4, NCOND = 9;
constexpr int M_CTX = 8192, M = 40960;
constexpr int PIN = 2832;
constexpr int N1 = 3328, LDP = 3072;
constexpr float EPS = 1e-6f;
constexpr int C_GA = 0, C_U = 256, C_GC = 512, C_GD = 768, C_V = 1024, C_GB = 1280, C_XC = 1536, C_PF = 1792, C_QF = 2048, C_Q = 2304, C_K = 2560, C_VV = 2816;

constexpr size_t MiB = 1u << 20;
constexpr size_t WS_CTL = 0, CTL_ZERO_BYTES = 1 * MiB;
constexpr size_t WS_MOD = 1 * MiB;
constexpr size_t WS_SW = WS_MOD + 512 * 1024;
constexpr size_t WS_GMAT = 2 * MiB;
constexpr size_t WS_POS = WS_GMAT + 512 * 1024;
constexpr size_t WS_DFT = WS_POS + 256 * 1024;
constexpr size_t WS_M1 = 3 * MiB;
constexpr size_t WS_M2 = WS_M1 + 32 * 1024;
constexpr size_t WS_TW = WS_M1 + 64 * 1024;
constexpr size_t WS_W1T = 4 * MiB;
constexpr size_t WS_W2T = 30 * MiB;
constexpr size_t WS_BA = 38 * MiB;
constexpr size_t WS_RSS = 41 * MiB;
constexpr size_t WS_PB = 44 * MiB;
constexpr size_t WS_HB = 284 * MiB;
constexpr size_t WS_PREP = 284 * MiB;
constexpr size_t WS_PGL = 484 * MiB;
constexpr size_t WS_END = 485 * MiB;
constexpr size_t WS_DUM = 486 * MiB;
constexpr int CW_BAR = 4096, CW_Q = 8192;

constexpr int LDS_BYTES = 147456;
constexpr int MISC_OFF = 144 * 1024 - 256;
constexpr int NWAVES = 8, NTHR = 512;

typedef __bf16 hwbf16x2 __attribute__((ext_vector_type(2)));
__device__ __forceinline__ unsigned f2bf(float f) { return (unsigned)__builtin_bit_cast(unsigned short, (__bf16)f); }
__device__ __forceinline__ float bf2f(unsigned b) { return __builtin_bit_cast(float, (b & 0xffffu) << 16); }
__device__ __forceinline__ unsigned pk2(float lo, float hi) { const f32x2 v = {lo, hi}; return __builtin_bit_cast(unsigned, __builtin_convertvector(v, hwbf16x2)); }
__device__ __forceinline__ float bflo(unsigned w) { return __builtin_bit_cast(float, w << 16); }
__device__ __forceinline__ float bfhi(unsigned w) { return __builtin_bit_cast(float, w & 0xffff0000u); }
__device__ __forceinline__ float silu_f(float x) { return x * __builtin_amdgcn_rcpf(1.f + __builtin_amdgcn_exp2f(-1.4426950408889634f * x)); }
__device__ __forceinline__ float gelu_tanh_f(float x) { const float z = (-1.5957691216057308f * 1.4426950408889634f) * (x + 0.044715f * x * x * x); return x * __builtin_amdgcn_rcpf(1.f + __builtin_amdgcn_exp2f(z)); }
__device__ __forceinline__ float wave_sum(float v) {
#pragma unroll
    for (int o = 1; o < 64; o <<= 1) v += __shfl_xor(v, o);
    return v;
}
__device__ __forceinline__ int otid() { int t = threadIdx.x; asm volatile("" : "+v"(t)); return t; }
__device__ __forceinline__ int obid() { int b = blockIdx.x; asm volatile("" : "+s"(b)); return b; }
#define LDS_WAIT() asm volatile("s_waitcnt lgkmcnt(0)" ::: "memory")

namespace pg8 {
constexpr int BM = 256, BK = 64, HALF = 128, HTB = HALF * BK * 2, STAGE_BYTES = 8 * HTB, NXCD = 8, WGM = 8;
__host__ __device__ __forceinline__ int lds_byte(int r, int c) { const int st = (r >> 4) * 2 + (c >> 5), rr = r & 15, cc = c & 31, ob = rr * 64 + cc * 2; return st * 1024 + (ob ^ (((ob >> 9) & 1) << 5)); }
__host__ __device__ __forceinline__ void stage_rc(int b, int& R, int& C) { const int st = b / 1024, sb = b % 1024, swz = sb ^ (((sb >> 9) & 1) << 5); R = (st >> 1) * 16 + swz / 64; C = (st & 1) * 32 + (swz % 64) / 2; }
__host__ __device__ __forceinline__ int perm32(int rho) { const int n = rho >> 4, i = rho & 15; return 8 * (i >> 2) + 4 * n + (i & 3); }

struct Unit { int pm, pn; };
struct Gemm { const bf16* A; const bf16* Bt; int M, N, K, lda; };

struct StaticOrder {
    int nM, nN, nwg, G, c;
    __host__ __device__ void init(int M_, int N_, int G_, int c_) { nM = M_ / BM; nN = N_ / BM; nwg = nM * nN; G = G_; c = c_; }
    __host__ __device__ bool next(int i, Unit& u) const {
        const long L = (long)i * G + c; if (L >= nwg) return false;
        int wgid = (int)L; { const int q = nwg / NXCD, r = nwg % NXCD, xcd = wgid % NXCD, off = wgid / NXCD; wgid = (xcd < r ? xcd * (q + 1) : r * (q + 1) + (xcd - r) * q) + off; }
        const int nig = WGM * nN, gid = wgid / nig, fm = gid * WGM, gsz = (nM - fm) < WGM ? (nM - fm) : WGM;
        u.pm = fm + ((wgid % nig) % gsz); u.pn = (wgid % nig) / gsz; return true;
    }
};

template <class Epi>
__device__ __forceinline__ void gemm_phase(LAS unsigned char* lds, const Gemm g, const StaticOrder& S, const Epi& E) {
    const int tid = otid(), wid = __builtin_amdgcn_readfirstlane(tid >> 6), lane = tid & 63, wr = wid >> 2, wc = wid & 3, fr = lane & 15, fq = lane >> 4;
    const int K = g.K, nt = K / BK, lda = g.lda;
    unsigned voffA[2], voffB[2];
#pragma unroll
    for (int i = 0; i < 2; ++i) { int R, C; stage_rc(tid * 16 + i * 8192, R, C); const int Rb = Epi::PERM ? ((R & ~31) + perm32(R & 31)) : R;
        voffA[i] = (unsigned)(R * lda + C) * 2u; voffB[i] = (unsigned)(Rb * K + C) * 2u; }
    const size_t kstep = (size_t)(BK * 2);
    const size_t hstepA = (size_t)HALF * lda * 2, hstepB = (size_t)HALF * K * 2;
    const size_t tstepA = 2 * hstepA, tstepB = 2 * hstepB;
    const unsigned ldsw = (unsigned)wid * 1024u;
    const int aoff = lds_byte(wr * 64 + fr, fq * 8), boff = lds_byte(wc * 32 + fr, fq * 8);
#define PG8_SA(b, h) (((b) * 2 + (h)) * HTB)
#define PG8_SB(b, h) ((4 + (b) * 2 + (h)) * HTB)
#define PG8_STAGE(bufoff, gbase, voff) do { _Pragma("unroll") for (int _i = 0; _i < 2; ++_i) \
        __builtin_amdgcn_global_load_lds((const unsigned*)((const char*)(gbase) + (voff)[_i]), (LAS unsigned*)(lds + (bufoff) + ldsw + _i * 8192), 16, 0, 0); } while (0)
#define PG8_LDA(dst, b, h) do { _Pragma("unroll") for (int m = 0; m < 4; ++m) _Pragma("unroll") for (int k = 0; k < 2; ++k) dst[m][k] = *(const LAS bf16x8*)(lds + PG8_SA(b, h) + aoff + m * 2048 + k * 1024); } while (0)
#define PG8_LDB(dst, b, h) do { _Pragma("unroll") for (int n = 0; n < 2; ++n) _Pragma("unroll") for (int k = 0; k < 2; ++k) dst[n][k] = *(const LAS bf16x8*)(lds + PG8_SB(b, h) + boff + n * 2048 + k * 1024); } while (0)
#define PG8_MMA(ai, bj, At, Bt) do { __builtin_amdgcn_s_setprio(1); _Pragma("unroll") for (int m = 0; m < 4; ++m) _Pragma("unroll") for (int n = 0; n < 2; ++n) _Pragma("unroll") for (int k = 0; k < 2; ++k) \
        acc[ai][bj][m][n] = __builtin_amdgcn_mfma_f32_16x16x32_bf16(Bt[n][k], At[m][k], acc[ai][bj][m][n], 0, 0, 0); __builtin_amdgcn_s_setprio(0); } while (0)
#define PG8_WAIT_V(n) asm volatile("s_waitcnt vmcnt(" #n ")" ::: "memory")
#define PG8_WAIT_L(n) asm volatile("s_waitcnt lgkmcnt(" #n ")" ::: "memory")
#define PG8_BAR __builtin_amdgcn_s_barrier()
#define PG8_SCHED __builtin_amdgcn_sched_barrier(0)
    Unit cur, nxt; int ui = 0;
    if (!S.next(0, cur)) return;
    f32x4 acc[2][2][4][2];
#pragma unroll
    for (int a = 0; a < 2; ++a)
#pragma unroll
        for (int b = 0; b < 2; ++b)
#pragma unroll
            for (int m = 0; m < 4; ++m)
#pragma unroll
                for (int n = 0; n < 2; ++n) acc[a][b][m][n] = (f32x4){0.f, 0.f, 0.f, 0.f};
    bf16x8 At[4][2], B0[2][2], B1[2][2];
    const char* cA = (const char*)g.A + (size_t)cur.pm * tstepA; const char* cB = (const char*)g.Bt + (size_t)cur.pn * tstepB;
    PG8_STAGE(PG8_SB(0, 0), cB, voffB); PG8_STAGE(PG8_SA(0, 0), cA, voffA); PG8_STAGE(PG8_SB(0, 1), cB + hstepB, voffB); PG8_STAGE(PG8_SA(0, 1), cA + hstepA, voffA);
    if (wr == 1) PG8_BAR;
    PG8_WAIT_V(4); PG8_BAR;
    PG8_STAGE(PG8_SB(1, 0), cB + kstep, voffB); PG8_STAGE(PG8_SA(1, 0), cA + kstep, voffA); PG8_STAGE(PG8_SB(1, 1), cB + hstepB + kstep, voffB);
    PG8_WAIT_V(6); PG8_BAR;
    for (;;) {
        const bool has_next = S.next(ui + 1, nxt);
        const char* nA = has_next ? (const char*)g.A + (size_t)nxt.pm * tstepA : cA; const char* nB = has_next ? (const char*)g.Bt + (size_t)nxt.pn * tstepB : cB;
        for (int t = 0; t < nt; t += 2) {
            const bool last = (t == nt - 2);
            const char* a1 = cA + (size_t)(t + 1) * kstep;
            const char* a2 = last ? nA : cA + (size_t)(t + 2) * kstep; const char* b2 = last ? nB : cB + (size_t)(t + 2) * kstep;
            const char* a3 = a2 + kstep; const char* b3 = b2 + kstep;
            PG8_LDB(B0, 0, 0); PG8_SCHED; PG8_LDA(At, 0, 0); PG8_STAGE(PG8_SA(1, 1), a1 + hstepA, voffA);
            PG8_WAIT_L(8); PG8_BAR; PG8_WAIT_L(0); PG8_MMA(0, 0, At, B0); PG8_BAR; PG8_SCHED;
            PG8_LDB(B1, 0, 1); PG8_STAGE(PG8_SB(0, 0), b2, voffB);
            PG8_BAR; PG8_WAIT_L(0); PG8_MMA(0, 1, At, B1); PG8_BAR;
            PG8_LDA(At, 0, 1); PG8_STAGE(PG8_SA(0, 0), a2, voffA);
            PG8_BAR; PG8_WAIT_L(0); PG8_MMA(1, 0, At, B0); PG8_BAR; PG8_SCHED;
            PG8_STAGE(PG8_SB(0, 1), b2 + hstepB, voffB);
            PG8_WAIT_V(6); PG8_BAR; PG8_MMA(1, 1, At, B1); PG8_BAR;
            PG8_LDB(B0, 1, 0); PG8_SCHED; PG8_LDA(At, 1, 0); PG8_STAGE(PG8_SA(0, 1), a2 + hstepA, voffA);
            PG8_WAIT_L(8); PG8_BAR; PG8_WAIT_L(0); PG8_MMA(0, 0, At, B0); PG8_BAR; PG8_SCHED;
            PG8_LDB(B1, 1, 1); PG8_STAGE(PG8_SB(1, 0), b3, voffB);
            PG8_BAR; PG8_WAIT_L(0); PG8_MMA(0, 1, At, B1); PG8_BAR;
            PG8_LDA(At, 1, 1); PG8_STAGE(PG8_SA(1, 0), a3, voffA);
            PG8_BAR; PG8_WAIT_L(0); PG8_MMA(1, 0, At, B0); PG8_BAR; PG8_SCHED;
            PG8_STAGE(PG8_SB(1, 1), b3 + hstepB, voffB);
            PG8_WAIT_V(6); PG8_BAR; PG8_MMA(1, 1, At, B1); PG8_BAR;
        }
        E(acc, cur, wr, wc, fr, fq, ui);
        if (!has_next) break;
#pragma unroll
        for (int a = 0; a < 2; ++a)
#pragma unroll
            for (int b = 0; b < 2; ++b)
#pragma unroll
                for (int m = 0; m < 4; ++m)
#pragma unroll
                    for (int n = 0; n < 2; ++n) acc[a][b][m][n] = (f32x4){0.f, 0.f, 0.f, 0.f};
        cur = nxt; cA = nA; cB = nB; ++ui;
    }
    PG8_WAIT_V(0);
    if (wr == 0) PG8_BAR;
    PG8_BAR;
#undef PG8_SA
#undef PG8_SB
#undef PG8_STAGE
#undef PG8_LDA
#undef PG8_LDB
#undef PG8_MMA
#undef PG8_WAIT_V
#undef PG8_WAIT_L
#undef PG8_BAR
#undef PG8_SCHED
}
}

#define XB_TMO      128
#define XB_XCNT(j)  (256  + 64 * (j))
#define XB_XSUB(j)  (1280 + 64 * (j))
#define XB_XGEN(j)  (2304 + 64 * (j))
#define XB_TOP      3328
#define XB_TOPGEN   3392
#define XCD_BAR_WORDS 3456
#define XB_SPIN_CAP (1u << 18)
__device__ __forceinline__ unsigned xb_ld(unsigned* p)              { return __hip_atomic_load(p, __ATOMIC_RELAXED, __HIP_MEMORY_SCOPE_AGENT); }
__device__ __forceinline__ unsigned xb_add(unsigned* p, unsigned v) { return __hip_atomic_fetch_add(p, v, __ATOMIC_RELAXED, __HIP_MEMORY_SCOPE_AGENT); }
__device__ __forceinline__ unsigned xb_xcc_id() { return (unsigned)__builtin_amdgcn_s_getreg((3 << 11) | 20) & 0xFu; }
#define XB_SPIN(cond, bar) do { unsigned _sp = 0; while (cond) { __builtin_amdgcn_s_sleep(1); \
    if ((++_sp & 255u) == 0u) { if (xb_ld(&(bar)[XB_TMO])) break; if (_sp > XB_SPIN_CAP) { atomicAdd(&(bar)[XB_TMO], 1u); break; } } } } while (0)
struct XcdBarrier { unsigned* bar; unsigned x; volatile LAS unsigned* st; };
__device__ __forceinline__ XcdBarrier xcd_barrier_post(unsigned* bar, volatile LAS unsigned* st) {
    XcdBarrier b; b.bar = bar; b.x = xb_xcc_id(); b.st = st;
    if (threadIdx.x == 0) (void)xb_add(&bar[XB_XCNT(b.x)], 1u);
    return b;
}
__device__ __forceinline__ void xcd_barrier_complete(unsigned* bar, unsigned x, unsigned& nloc, unsigned& nx) {
    const unsigned G = gridDim.x * gridDim.y * gridDim.z;
    unsigned sum, cnt, mine, sp = 0u;
    for (;;) {
        sum = 0u; cnt = 0u; mine = 0u;
#pragma unroll
        for (unsigned j = 0; j < 16; ++j) { const unsigned c = xb_ld(&bar[XB_XCNT(j)]); sum += c; cnt += (c > 0u) ? 1u : 0u; mine = (j == x) ? c : mine; }
        if (sum == G) break;
        __builtin_amdgcn_s_sleep(1);
        if ((++sp & 255u) == 0u) { if (xb_ld(&bar[XB_TMO])) break; if (sp > XB_SPIN_CAP) { atomicAdd(&bar[XB_TMO], 1u); break; } }
    }
    nloc = mine > 0u ? mine : 1u; nx = cnt > 0u ? cnt : 1u;
}
__device__ __forceinline__ void xcd_barrier(const XcdBarrier& b) {
    asm volatile("s_waitcnt vmcnt(0)" ::: "memory");
    __syncthreads();
    if (threadIdx.x == 0) {
        unsigned* bar = b.bar;
        __builtin_amdgcn_s_waitcnt(0);
        unsigned nloc = b.st[0], nx = b.st[1];
        if (nloc == 0u) { xcd_barrier_complete(bar, b.x, nloc, nx); b.st[0] = nloc; b.st[1] = nx; }
        const unsigned old = xb_add(&bar[XB_XSUB(b.x)], 1u);
        const unsigned gen = old / nloc;
        if (old + 1u == (gen + 1u) * nloc) {
            __builtin_amdgcn_fence(__ATOMIC_RELEASE, "agent");
            asm volatile("s_waitcnt vmcnt(0)" ::: "memory");
            const unsigned og = xb_add(&bar[XB_TOP], 1u);
            const unsigned tg = og / nx;
            if (og + 1u == (tg + 1u) * nx) xb_add(&bar[XB_TOPGEN], 1u);
            else XB_SPIN(xb_ld(&bar[XB_TOPGEN]) == tg, bar);
            __builtin_amdgcn_fence(__ATOMIC_ACQUIRE, "agent");
            xb_add(&bar[XB_XGEN(b.x)], 1u);
            asm volatile("s_waitcnt vmcnt(0)" ::: "memory");
        } else {
            XB_SPIN(xb_ld(&bar[XB_XGEN(b.x)]) == gen, bar);
            __builtin_amdgcn_fence(__ATOMIC_ACQUIRE, "agent");
            asm volatile("s_waitcnt vmcnt(0)" ::: "memory");
        }
    }
    __syncthreads();
}

template <int KS>
__device__ __forceinline__ f32x4 tile_mm(f32x4 acc, const LAS bf16* A, int lda, int m0, const LAS bf16* Bt, int ldb, int n0, int lane) {
    const int r = lane & 15, kg = lane >> 4;
#if NAIVE_MM
#pragma unroll 1
    for (int k = 0; k < KS * 32; ++k) {
        const float b = bf2f(Bt[(n0 + r) * ldb + k]);
#pragma unroll
        for (int q = 0; q < 4; ++q) acc[q] += bf2f(A[(m0 + 4 * kg + q) * lda + k]) * b;
    }
#else
#pragma unroll
    for (int ks = 0; ks < KS; ++ks) {
        const bf16x8 a = *(const LAS bf16x8*)(A + (m0 + r) * lda + ks * 32 + kg * 8);
        const bf16x8 b = *(const LAS bf16x8*)(Bt + (n0 + r) * ldb + ks * 32 + kg * 8);
        acc = __builtin_amdgcn_mfma_f32_16x16x32_bf16(a, b, acc, 0, 0, 0);
    }
#endif
    return acc;
}
template <int KS>
__device__ __forceinline__ f32x4 tile_mm_g(f32x4 acc, const bf16* A, int lda, int m0, const LAS bf16* Bt, int ldb, int n0, int lane) {
    const int r = lane & 15, kg = lane >> 4;
#if NAIVE_MM
#pragma unroll 1
    for (int k = 0; k < KS * 32; ++k) {
        const float b = bf2f(Bt[(n0 + r) * ldb + k]);
#pragma unroll
        for (int q = 0; q < 4; ++q) acc[q] += bf2f(A[(m0 + 4 * kg + q) * lda + k]) * b;
    }
#else
#pragma unroll
    for (int ks = 0; ks < KS; ++ks) {
        const bf16x8 a = *(const bf16x8*)(A + (size_t)(m0 + r) * lda + ks * 32 + kg * 8);
        const bf16x8 b = *(const LAS bf16x8*)(Bt + (n0 + r) * ldb + ks * 32 + kg * 8);
        acc = __builtin_amdgcn_mfma_f32_16x16x32_bf16(a, b, acc, 0, 0, 0);
    }
#endif
    return acc;
}

struct Args { const float* in[21]; float* out; unsigned char* ws; int ph_lo, ph_hi, one, pad; };
enum { I_XP = 0, I_XS, I_STATE, I_C, I_CCTX, I_ADAW, I_ADAB, I_NORMG, I_WIN, I_CONV, I_ALOG, I_DTB, I_DNG, I_SGUNG, I_SGUW, I_SGUB, I_POOLW, I_POOLS, I_FW, I_WOUT, I_FNG };

struct SeqGeo { int T, tseq0, seq_row0; };
__device__ __forceinline__ SeqGeo seq_geo(int sc) {
    SeqGeo g;
    if (sc < 128) { g.T = 256; g.tseq0 = (sc & 3) * 64; g.seq_row0 = (sc >> 2) * 256; }
    else { const int s = sc - 128; g.T = 4096; g.tseq0 = (s & 63) * 64; g.seq_row0 = M_CTX + (s >> 6) * 4096; }
    return g;
}
__device__ __forceinline__ int cond_of_row(int row) { return row < M_CTX ? 0 : 1 + ((row - M_CTX) >> 12); }

__device__ __forceinline__ int srccol(int n) {
    if (n < 256) return 768 + n;
    if (n < 512) return 1040 + (n - 256);
    if (n < 768) return 2064 + (n - 512);
    if (n < 1024) return 2576 + (n - 768);
    if (n < 1280) return 1296 + (n - 1024);
    if (n < 1536) return 1552 + (n - 1280);
    if (n < 2304) return -2;
    if (n < 3072) return n - 2304;
    if (n < 3088) return 1024 + (n - 3072);
    return -1;
}

__device__ __forceinline__ void phase_0a(const Args& a, LAS unsigned char* lds) {
    const int tid = otid(), lane = tid & 63, wave = tid >> 6, G = gridDim.x, bid = obid();
    float* MOD = (float*)(a.ws + WS_MOD);
    if (bid < 192) {
        LAS float* sc = (LAS float*)lds;
        LAS float* red = (LAS float*)(lds + 9 * 1024 * 4);
        for (int i = tid; i < 9 * 1024; i += NTHR) { const int j = i >> 10, k = i & 1023; const float c = (j == 0) ? a.in[I_CCTX][k] : a.in[I_C][(j - 1) * 1024 + k]; sc[i] = silu_f(c); }
        __syncthreads();
        for (int it = bid; it < 192; it += G) {
            const int l = it / 48, cb = it % 48, col = cb * 64 + lane;
            float acc[9];
#pragma unroll
            for (int j = 0; j < 9; ++j) acc[j] = 0.f;
            const float* wp = a.in[I_ADAW] + ((size_t)l * 1024 + wave * 128) * 3072 + col;
#pragma unroll 8
            for (int k = 0; k < 128; ++k) { const float wv = wp[(size_t)k * 3072];
#pragma unroll
                for (int j = 0; j < 9; ++j) acc[j] += sc[j * 1024 + wave * 128 + k] * wv; }
#pragma unroll
            for (int j = 0; j < 9; ++j) red[(wave * 9 + j) * 64 + lane] = acc[j];
            __syncthreads();
            for (int i = tid; i < 576; i += NTHR) { const int j = i >> 6, ln = i & 63; float s = 0.f;
#pragma unroll
                for (int w = 0; w < 8; ++w) s += red[(w * 9 + j) * 64 + ln];
                MOD[(l * 9 + j) * 3072 + cb * 64 + ln] = s + a.in[I_ADAB][l * 3072 + cb * 64 + ln]; }
            __syncthreads();
        }
    }
    const int gtid = bid * NTHR + tid, GT = G * NTHR;
    float* GM = (float*)(a.ws + WS_GMAT);
    for (int t = gtid; t < 4 * 4 * 2 * 4096; t += GT) {
        const int d = t & 63, c = (t >> 6) & 63, cs = (t >> 12) & 1, g = (t >> 13) & 3, l = t >> 15;
        const float* fw = a.in[I_FW] + ((size_t)(l * 4 + g) * 64) * 64 + d;
        float s = 0.f;
        for (int m = 0; m < 64; ++m) { const float ph = (float)((m * c) & 63) * (1.f / 32.f); s += (cs ? sinpif(ph) : cospif(ph)) * fw[m * 64]; }
        GM[t] = s * 0.125f;
    }
    bf16* W1T = (bf16*)(a.ws + WS_W1T);
    for (int t = gtid; t < 4 * 128 * N1; t += GT) {
        const int n = t % N1, k8 = (t / N1) & 127, l = t / (N1 * 128);
        const int sc = srccol(n);
        if (sc == -2) continue;
        u32x4 o = (u32x4){0u, 0u, 0u, 0u};
        if (sc >= 0) { const float* wp = a.in[I_WIN] + ((size_t)l * 1024 + k8 * 8) * PIN + sc;
            o.x = pk2(wp[0], wp[PIN]); o.y = pk2(wp[2 * PIN], wp[3 * PIN]); o.z = pk2(wp[4 * PIN], wp[5 * PIN]); o.w = pk2(wp[6 * PIN], wp[7 * PIN]); }
        *(u32x4*)(W1T + ((size_t)l * N1 + n) * 1024 + k8 * 8) = o;
    }
    bf16* W2T = (bf16*)(a.ws + WS_W2T);
    for (int t = gtid; t < 4 * 128 * 1024; t += GT) {
        const int n = t & 1023, k8 = (t >> 10) & 127, l = t >> 17;
        const float* wp = a.in[I_WOUT] + ((size_t)l * 1024 + k8 * 8) * 1024 + n;
        u32x4 o; o.x = pk2(wp[0], wp[1024]); o.y = pk2(wp[2048], wp[3072]); o.z = pk2(wp[4096], wp[5120]); o.w = pk2(wp[6144], wp[7168]);
        *(u32x4*)(W2T + ((size_t)l * 1024 + n) * 1024 + k8 * 8) = o;
    }
    float* POS = (float*)(a.ws + WS_POS);
    for (int t = gtid; t < 64 * 256; t += GT) { const int f = t & 255, i = t >> 8; const float fr = powf(10000.f, -(float)f / 256.f); const float ang = (float)i * fr;
        POS[t] = sinf(ang); POS[64 * 256 + t] = cosf(ang); }
    bf16* DFT = (bf16*)(a.ws + WS_DFT);
    for (int t = gtid; t < 256 * 512; t += GT) { const int tp = t & 511, k = t >> 9, tt = tp & 255; const float ph = (float)((k * tt) & 255) * (1.f / 128.f);
        DFT[t] = (bf16)f2bf((tp < 256 ? cospif(ph) : -sinpif(ph)) * (1.f / 16.f)); }
    bf16* M1 = (bf16*)(a.ws + WS_M1);
    for (int t = gtid; t < 128 * 128; t += GT) { const int kk = t & 127, m = t >> 7, k1 = m & 63, t1 = kk & 63; const float ph = (float)((k1 * t1) & 63) * (1.f / 32.f);
        const float c = cospif(ph), s = sinpif(ph); float v;
        if (m < 64) v = (kk < 64) ? c : -s; else v = (kk < 64) ? s : c;
        M1[t] = (bf16)f2bf(v); }
    bf16* M2 = (bf16*)(a.ws + WS_M2);
    for (int t = gtid; t < 64 * 128; t += GT) { const int kk = t & 127, k2 = t >> 7, t2 = kk & 63; const float ph = (float)((k2 * t2) & 63) * (1.f / 32.f);
        M2[t] = (bf16)f2bf((kk < 64 ? cospif(ph) : -sinpif(ph)) * (1.f / 64.f)); }
    float* TW = (float*)(a.ws + WS_TW);
    for (int t = gtid; t < 64 * 64; t += GT) { const int t2 = t & 63, k1 = t >> 6; const float ph = (float)(k1 * t2) * (1.f / 2048.f); TW[2 * t] = cospif(ph); TW[2 * t + 1] = sinpif(ph); }
}

__device__ __forceinline__ void phase_0b(const Args& a) {
    const int tid = otid(), lane = tid & 63, wave = tid >> 6, G = gridDim.x, bid = obid();
    const int gtid = bid * NTHR + tid, GT = G * NTHR;
    const float* MOD = (const float*)(a.ws + WS_MOD);
    const float* GM = (const float*)(a.ws + WS_GMAT);
    bf16* W1T = (bf16*)(a.ws + WS_W1T);
    for (int t = gtid; t < 4 * 128 * 768; t += GT) {
        const int nf = t % 768, k8 = (t / 768) & 127, l = t / (768 * 128);
        const int kind = nf >> 8, g = (nf >> 6) & 3, d = nf & 63;
        const int base = (kind == 0 ? 1808 : 2320) + 64 * g;
        const float* Gm = (kind == 0) ? (a.in[I_POOLW] + ((size_t)(l * 4 + g) * 64) * 64 + d) : (GM + ((size_t)((l * 4 + g) * 2 + (kind - 1)) * 64) * 64 + d);
        const float* wp = a.in[I_WIN] + ((size_t)l * 1024 + k8 * 8) * PIN + base;
        float s[8];
#pragma unroll
        for (int j = 0; j < 8; ++j) s[j] = 0.f;
        for (int c = 0; c < 64; ++c) { const float gv = Gm[c * 64];
#pragma unroll
            for (int j = 0; j < 8; ++j) s[j] += wp[(size_t)j * PIN + c] * gv; }
        u32x4 o; o.x = pk2(s[0], s[1]); o.y = pk2(s[2], s[3]); o.z = pk2(s[4], s[5]); o.w = pk2(s[6], s[7]);
        *(u32x4*)(W1T + ((size_t)l * N1 + 1536 + nf) * 1024 + k8 * 8) = o;
    }
    const float* POS = (const float*)(a.ws + WS_POS);
    bf16* HB = (bf16*)(a.ws + WS_HB);
    float* RSS = (float*)(a.ws + WS_RSS);
    for (int row = bid * NWAVES + wave; row < M; row += G * NWAVES) {
        f32x4 v[4];
        const int j = cond_of_row(row);
        if (row < M_CTX) {
            const f32x4* xr = (const f32x4*)(a.in[I_XP] + (size_t)row * D) + lane;
#pragma unroll
            for (int q = 0; q < 4; ++q) v[q] = xr[64 * q];
        } else {
            const int rs = row - M_CTX, t = rs & 4095, gr = t >> 6, gc = t & 63;
            const f32x4* xr = (const f32x4*)(a.in[I_XS] + (size_t)rs * D) + lane;
            const f32x4 p0 = *((const f32x4*)(POS + gr * 256) + lane), p1 = *((const f32x4*)(POS + 64 * 256 + gr * 256) + lane);
            const f32x4 p2 = *((const f32x4*)(POS + gc * 256) + lane), p3 = *((const f32x4*)(POS + 64 * 256 + gc * 256) + lane);
            v[0] = xr[0] + p0; v[1] = xr[64] + p1; v[2] = xr[128] + p2; v[3] = xr[192] + p3;
        }
        float ss = 0.f;
#pragma unroll
        for (int q = 0; q < 4; ++q) ss += (v[q].x * v[q].x + v[q].y * v[q].y) + (v[q].z * v[q].z + v[q].w * v[q].w);
        ss = wave_sum(ss);
        f32x4* orow = (f32x4*)(a.out + (size_t)row * D) + lane;
        u32x2* hrow = (u32x2*)(HB + (size_t)row * D) + lane;
#pragma unroll
        for (int q = 0; q < 4; ++q) {
            orow[64 * q] = v[q];
            const f32x4 ng = *((const f32x4*)(a.in[I_NORMG] + 256 * q) + lane);
            const f32x4 sc = *((const f32x4*)(MOD + (0 * 9 + j) * 3072 + 1024 + 256 * q) + lane);
            u32x2 h; h.x = pk2(v[q].x * ng.x * (1.f + sc.x), v[q].y * ng.y * (1.f + sc.y)); h.y = pk2(v[q].z * ng.z * (1.f + sc.z), v[q].w * ng.w * (1.f + sc.w));
            hrow[64 * q] = h;
        }
        if (lane < 16) RSS[(size_t)row * 16 + lane] = (lane == 0) ? ss : 0.f;
    }
}

__device__ __forceinline__ void phase_0c(const Args& a) {
    const int tid = otid(), lane = tid & 63, wave = tid >> 6, G = gridDim.x, bid = obid();
    const float* MOD = (const float*)(a.ws + WS_MOD);
    const bf16* W1T = (const bf16*)(a.ws + WS_W1T);
    float* SW = (float*)(a.ws + WS_SW);
    for (int it = bid * NWAVES + wave; it < 4 * N1; it += G * NWAVES) {
        const int l = it / N1, n = it % N1;
        const u32x4* wr = (const u32x4*)(W1T + ((size_t)l * N1 + n) * 1024) + lane * 2;
        const u32x4 w0 = wr[0], w1 = wr[1];
        float w[16];
        w[0] = bflo(w0.x); w[1] = bfhi(w0.x); w[2] = bflo(w0.y); w[3] = bfhi(w0.y); w[4] = bflo(w0.z); w[5] = bfhi(w0.z); w[6] = bflo(w0.w); w[7] = bfhi(w0.w);
        w[8] = bflo(w1.x); w[9] = bfhi(w1.x); w[10] = bflo(w1.y); w[11] = bfhi(w1.y); w[12] = bflo(w1.z); w[13] = bfhi(w1.z); w[14] = bflo(w1.w); w[15] = bfhi(w1.w);
#pragma unroll
        for (int j = 0; j < 9; ++j) {
            const f32x4* sp = (const f32x4*)(MOD + (l * 9 + j) * 3072) + lane * 4;
            float s = 0.f;
#pragma unroll
            for (int q = 0; q < 4; ++q) { const f32x4 sv = sp[q]; s += sv.x * w[4 * q] + sv.y * w[4 * q + 1] + sv.z * w[4 * q + 2] + sv.w * w[4 * q + 3]; }
            s = wave_sum(s);
            if (lane == 0) SW[(l * 9 + j) * N1 + n] = s;
        }
    }
}

struct Epi1 {
    static constexpr bool PERM = true;
    bf16* PB; float* BA; const float* RSS; const float* SW;
    int cheap; bf16* dumb;
    const LAS float* rtab;
    __device__ __forceinline__ void operator()(const f32x4 (&acc)[2][2][4][2], const pg8::Unit& u, int wr, int wc, int fr, int fq, int ui) const {
        const int pn = u.pn, j = u.pm < 32 ? 0 : 1 + ((u.pm - 32) >> 4);
        const int row0 = u.pm * 256 + wr * 64 + fr, cb = pn * 256 + wc * 32 + 8 * fq;
        if (cheap == 1) {
#pragma unroll
            for (int ai = 0; ai < 2; ++ai)
#pragma unroll
                for (int m = 0; m < 4; ++m)
#pragma unroll
                    for (int bj = 0; bj < 2; ++bj) { const f32x4 v0 = acc[ai][bj][m][0], v1 = acc[ai][bj][m][1];
                        u32x4 w; w.x = pk2(v0[0], v0[1]); w.y = pk2(v0[2], v0[3]); w.z = pk2(v1[0], v1[1]); w.w = pk2(v1[2], v1[3]);
                        *(u32x4*)(dumb + (size_t)((row0 + ai * 128 + m * 16) & 1023) * LDP + cb + bj * 128) = w; }
            return;
        }
        const int act = (pn == 0 || pn == 2 || pn == 3 || pn == 5) ? 1 : ((pn == 1 || pn == 4) ? 2 : 0);
        f32x4 bv[2][2];
#pragma unroll
        for (int bj = 0; bj < 2; ++bj)
#pragma unroll
            for (int n = 0; n < 2; ++n) bv[bj][n] = *(const f32x4*)(SW + j * N1 + cb + bj * 128 + 4 * n);
#pragma unroll
        for (int ai = 0; ai < 2; ++ai)
#pragma unroll
            for (int m = 0; m < 4; ++m) {
                const int row = row0 + ai * 128 + m * 16;
                const float rinv = rtab[ui * 256 + wr * 64 + fr + ai * 128 + m * 16];
#pragma unroll
                for (int bj = 0; bj < 2; ++bj) {
                    f32x4 v0 = acc[ai][bj][m][0] * rinv + bv[bj][0], v1 = acc[ai][bj][m][1] * rinv + bv[bj][1];
                    if (pn < 12) {
                        if (act == 1) {
#pragma unroll
                            for (int q = 0; q < 4; ++q) { v0[q] = silu_f(v0[q]); v1[q] = silu_f(v1[q]); }
                        } else if (act == 2) {
#pragma unroll
                            for (int q = 0; q < 4; ++q) { v0[q] = gelu_tanh_f(v0[q]); v1[q] = gelu_tanh_f(v1[q]); }
                        }
                        u32x4 w; w.x = pk2(v0[0], v0[1]); w.y = pk2(v0[2], v0[3]); w.z = pk2(v1[0], v1[1]); w.w = pk2(v1[2], v1[3]);
                        *(u32x4*)((cheap ? dumb + (size_t)(row & 1023) * LDP : PB + (size_t)row * LDP) + cb + bj * 128) = w;
                    } else if (bj == 0 && wc == 0 && fq < 2) {
                        f32x4* bp = (f32x4*)(BA + (size_t)row * 16 + 8 * fq); bp[0] = v0; bp[1] = v1;
                    }
                }
            }
    }
};
struct Epi2 {
    static constexpr bool PERM = true;
    float* X; bf16* HB; float* RSS; const float* gate;
    const float* ng_next; const float* sc_next;
    unsigned char* dum; int dry;
    __device__ __forceinline__ void operator()(const f32x4 (&acc)[2][2][4][2], const pg8::Unit& u, int wr, int wc, int fr, int fq, int) const {
        const int pn = u.pn, j = u.pm < 32 ? 0 : 1 + ((u.pm - 32) >> 4);
        const int row0 = u.pm * 256 + wr * 64 + fr, cb = pn * 256 + wc * 32 + 8 * fq;
        f32x4 gv[2][2];
#pragma unroll
        for (int bj = 0; bj < 2; ++bj)
#pragma unroll
            for (int n = 0; n < 2; ++n) gv[bj][n] = *(const f32x4*)(gate + j * 3072 + cb + bj * 128 + 4 * n);
#pragma unroll
        for (int am = 0; am < 4; ++am) {
            const int ai = am >> 1;
            f32x4 gs[2][2];
#pragma unroll
            for (int bj = 0; bj < 2; ++bj)
#pragma unroll
                for (int n = 0; n < 2; ++n) {
                    if (ng_next) { const f32x4 ng = *(const f32x4*)(ng_next + cb + bj * 128 + 4 * n), sc = *(const f32x4*)(sc_next + j * 3072 + cb + bj * 128 + 4 * n); gs[bj][n] = ng * (sc + 1.f); }
                    else gs[bj][n] = (f32x4){0.f, 0.f, 0.f, 0.f};
                }
            f32x4 xv[4][2][2];
#pragma unroll
            for (int m = 2 * (am & 1); m < 2 * (am & 1) + 2; ++m)
#pragma unroll
                for (int bj = 0; bj < 2; ++bj) { const f32x4* xq = (const f32x4*)(X + (size_t)(row0 + ai * 128 + m * 16) * D + cb + bj * 128); xv[m][bj][0] = xq[0]; xv[m][bj][1] = xq[1]; }
#pragma unroll
            for (int m = 2 * (am & 1); m < 2 * (am & 1) + 2; ++m) {
                const int row = row0 + ai * 128 + m * 16;
                float ssq = 0.f;
#pragma unroll
                for (int bj = 0; bj < 2; ++bj) {
                    f32x4* xp = (f32x4*)(X + (size_t)row * D + cb + bj * 128);
                    const f32x4 n0 = xv[m][bj][0] + gv[bj][0] * acc[ai][bj][m][0], n1 = xv[m][bj][1] + gv[bj][1] * acc[ai][bj][m][1];
                    if (dry) xp = (f32x4*)((float*)dum + (size_t)(row & 1023) * D + cb + bj * 128);
                    xp[0] = n0; xp[1] = n1;
                    ssq += (n0.x * n0.x + n0.y * n0.y) + (n0.z * n0.z + n0.w * n0.w) + (n1.x * n1.x + n1.y * n1.y) + (n1.z * n1.z + n1.w * n1.w);
                    if (ng_next) { const f32x4 h0 = n0 * gs[bj][0], h1 = n1 * gs[bj][1];
                        u32x4 w; w.x = pk2(h0[0], h0[1]); w.y = pk2(h0[2], h0[3]); w.z = pk2(h1[0], h1[1]); w.w = pk2(h1[2], h1[3]);
                        *(u32x4*)((dry ? (bf16*)(dum + 4 * MiB) + (size_t)(row & 1023) * D : HB + (size_t)row * D) + cb + bj * 128) = w; }
                }
                ssq += __shfl_xor(ssq, 16); ssq += __shfl_xor(ssq, 32);
                if (fq == 0) (dry ? (float*)(dum + 8 * MiB) + (size_t)(row & 1023) * 16 : RSS + (size_t)row * 16)[pn * 4 + wc] = ssq;
            }
        }
    }
};

typedef short bf16x4 __attribute__((ext_vector_type(4)));
__device__ __forceinline__ f32x4 mfma16(bf16x4 a, bf16x4 b, f32x4 c) { return __builtin_amdgcn_mfma_f32_16x16x16bf16_1k(a, b, c, 0, 0, 0); }
__device__ __forceinline__ bf16x4 pack4(f32x4 v) { u32x2 w; w.x = pk2(v[0], v[1]); w.y = pk2(v[2], v[3]); return __builtin_bit_cast(bf16x4, w); }
__device__ __forceinline__ bf16x8 pack8(f32x4 lo, f32x4 hi) { u32x4 w; w.x = pk2(lo[0], lo[1]); w.y = pk2(lo[2], lo[3]); w.z = pk2(hi[0], hi[1]); w.w = pk2(hi[2], hi[3]); return __builtin_bit_cast(bf16x8, w); }
constexpr int PREP_ITEM = 5 * 4096;

__device__ __forceinline__ void prep_dinv(const LAS bf16* Ab_, LAS bf16* Dl, int lane) {
    const int blk = lane >> 4, c = lane & 15;
    unsigned ab = (unsigned)(size_t)(Ab_ + (16 * blk) * 72 + 16 * blk);
    asm volatile("" : "+v"(ab));
    const LAS bf16* Ab = (const LAS bf16*)(size_t)ab;
    float x[16];
#pragma unroll
    for (int ii = 0; ii < 16; ++ii) {
        float acc = (ii == c) ? 1.f : 0.f;
        const LAS u32x4* ar = (const LAS u32x4*)(Ab + ii * 72);
#pragma unroll
        for (int jq = 0; jq < 2; ++jq) {
            if (8 * jq < ii) {
                const u32x4 av = ar[jq];
                if (8 * jq + 0 < ii) acc += bflo(av.x) * x[8 * jq + 0];
                if (8 * jq + 1 < ii) acc += bfhi(av.x) * x[8 * jq + 1];
                if (8 * jq + 2 < ii) acc += bflo(av.y) * x[8 * jq + 2];
                if (8 * jq + 3 < ii) acc += bfhi(av.y) * x[8 * jq + 3];
                if (8 * jq + 4 < ii) acc += bflo(av.z) * x[8 * jq + 4];
                if (8 * jq + 5 < ii) acc += bfhi(av.z) * x[8 * jq + 5];
                if (8 * jq + 6 < ii) acc += bflo(av.w) * x[8 * jq + 6];
                if (8 * jq + 7 < ii) acc += bfhi(av.w) * x[8 * jq + 7];
            }
        }
        asm volatile("" : "+v"(acc) :: "memory");
        x[ii] = acc;
    }
#pragma unroll
    for (int ii = 0; ii < 16; ++ii) Dl[(blk * 16 + ii) * 24 + c] = (bf16)f2bf(x[ii]);
}

__device__ __forceinline__ void prep_item(const Args& a, LAS unsigned char* lds, int l, int sc, int h) {
    const int tid = otid(), lane = tid & 63, wave = __builtin_amdgcn_readfirstlane(tid >> 6);
    LAS float* qs = (LAS float*)lds;
    LAS float* ks = qs + 64 * 65;
    LAS float* vs = ks + 64 * 65;
    LAS bf16* Qb = (LAS bf16*)(lds + 49920);
    LAS bf16* Kb = (LAS bf16*)(lds + 59136);
    constexpr int PD = 30720;
    LAS unsigned char* dbase = lds + 68352;
    LAS float* beta = (LAS float*)(lds + 129792);
    LAS float* gcs = beta + 128;
    LAS float* egs = gcs + 128;
    LAS float* eks = egs + 128;
    const bf16* PB = (const bf16*)(a.ws + WS_PB);
    const float* BA = (const float*)(a.ws + WS_BA);
    const SeqGeo sg = seq_geo(sc);
    const int row0 = sc * 64;
    if (wave >= 6) {
        const int dir = wave - 6, tok = dir ? 63 - lane : lane;
        const float bl = BA[(size_t)(row0 + tok) * 16 + dir * 4 + h], al = BA[(size_t)(row0 + tok) * 16 + 8 + dir * 4 + h];
        const float bt = 1.f / (1.f + __expf(-bl));
        const float xx = al + a.in[I_DTB][(l * 2 + dir) * 4 + h];
        const float sp = xx > 20.f ? xx : log1pf(expf(xx));
        float g = -expf(a.in[I_ALOG][(l * 2 + dir) * 4 + h]) * sp;
#pragma unroll
        for (int o = 1; o < 64; o <<= 1) { const float t = __shfl_up(g, o); if (lane >= o) g += t; }
        const float gl = __shfl(g, 63);
        beta[dir * 64 + lane] = bt; gcs[dir * 64 + lane] = g; egs[dir * 64 + lane] = __expf(g); eks[dir * 64 + lane] = __expf(gl - g);
        if (lane == 63) ((float*)(a.ws + WS_PGL))[(sc * 4 + h) * 2 + dir] = __expf(g);
    } else {
        const int cg = tid % 24, seg = tid / 24, part = cg >> 3, d0 = (cg & 7) * 8;
        const int col = C_Q + part * 256 + h * 64 + d0, chan = part * 256 + h * 64 + d0;
        u32x4 xr[7];
#pragma unroll
        for (int i = 0; i < 7; ++i) { const int ts = sg.tseq0 + 4 * seg - 2 + i;
            xr[i] = (ts >= 0 && ts < sg.T) ? *(const u32x4*)(PB + (size_t)(sg.seq_row0 + ts) * LDP + col) : (u32x4){0u, 0u, 0u, 0u}; }
        f32x4 w0[4], w1[4];
#pragma unroll
        for (int jj = 0; jj < 4; ++jj) { w0[jj] = *(const f32x4*)(a.in[I_CONV] + (size_t)(l * 4 + jj) * 768 + chan); w1[jj] = *(const f32x4*)(a.in[I_CONV] + (size_t)(l * 4 + jj) * 768 + chan + 4); }
        float o[4][8];
#pragma unroll
        for (int j = 0; j < 4; ++j)
#pragma unroll
            for (int c = 0; c < 8; ++c) o[j][c] = 0.f;
#pragma unroll
        for (int i = 0; i < 7; ++i) {
            const float x0 = bflo(xr[i].x), x1 = bfhi(xr[i].x), x2 = bflo(xr[i].y), x3 = bfhi(xr[i].y), x4 = bflo(xr[i].z), x5 = bfhi(xr[i].z), x6 = bflo(xr[i].w), x7 = bfhi(xr[i].w);
#pragma unroll
            for (int j = 0; j < 4; ++j) { const int jj = i - j;
                if (jj >= 0 && jj < 4) {
                    o[j][0] += w0[jj].x * x0; o[j][1] += w0[jj].y * x1; o[j][2] += w0[jj].z * x2; o[j][3] += w0[jj].w * x3;
                    o[j][4] += w1[jj].x * x4; o[j][5] += w1[jj].y * x5; o[j][6] += w1[jj].z * x6; o[j][7] += w1[jj].w * x7; } }
        }
        LAS float* dst = (part == 0 ? qs : (part == 1 ? ks : vs)) + (4 * seg) * 65 + d0;
#pragma unroll
        for (int j = 0; j < 4; ++j)
#pragma unroll
            for (int c = 0; c < 8; ++c) dst[j * 65 + c] = silu_f(o[j][c]);
    }
    __syncthreads();
    {
        const int rowid = tid >> 2, seg = tid & 3, ar = rowid & 63;
        LAS float* p = (rowid < 64 ? qs : ks) + ar * 65 + seg * 16;
        float v[16]; float ss = 0.f;
#pragma unroll
        for (int c = 0; c < 16; ++c) { v[c] = p[c]; ss += v[c] * v[c]; }
        ss += __shfl_xor(ss, 1); ss += __shfl_xor(ss, 2);
        const float s = rsqrtf(ss + EPS) * (rowid < 64 ? 0.125f : 1.f);
#pragma unroll
        for (int c = 0; c < 16; ++c) { v[c] *= s; p[c] = v[c]; }
        LAS bf16* bp = (rowid < 64 ? Qb : Kb) + ar * 72 + seg * 16;
        u32x4 o0, o1; o0.x = pk2(v[0], v[1]); o0.y = pk2(v[2], v[3]); o0.z = pk2(v[4], v[5]); o0.w = pk2(v[6], v[7]);
        o1.x = pk2(v[8], v[9]); o1.y = pk2(v[10], v[11]); o1.z = pk2(v[12], v[13]); o1.w = pk2(v[14], v[15]);
        *(LAS u32x4*)bp = o0; *(LAS u32x4*)(bp + 8) = o1;
    }
    __syncthreads();
    {
        const int mt = wave >> 1, nh = wave & 1, m0 = mt * 16, r = lane & 15, kg = lane >> 4;
#pragma unroll
        for (int t = 0; t < 2; ++t) {
            const f32x4 KKa = tile_mm<2>((f32x4){0.f, 0.f, 0.f, 0.f}, Kb, 72, m0, Kb, 72, nh * 32 + 16 * t, lane);
            const f32x4 QKa = tile_mm<2>((f32x4){0.f, 0.f, 0.f, 0.f}, Qb, 72, m0, Kb, 72, nh * 32 + 16 * t, lane);
            const int bcol = nh * 32 + 16 * t + r;
#pragma unroll
            for (int dir = 0; dir < 2; ++dir) {
                LAS bf16* Ab = (LAS bf16*)(dbase + dir * PD); LAS bf16* QKl = Ab + 64 * 72;
                const int j = dir ? 63 - bcol : bcol; const float gj = gcs[dir * 64 + j];
#pragma unroll
                for (int q = 0; q < 4; ++q) {
                    const int arow = m0 + 4 * kg + q, i = dir ? 63 - arow : arow;
                    const float dec = (i >= j) ? __expf(gcs[dir * 64 + i] - gj) : 0.f;
                    const float av = (i > j) ? beta[dir * 64 + i] * KKa[q] * dec : 0.f;
                    Ab[i * 72 + j] = (bf16)f2bf(-av); QKl[i * 72 + j] = (bf16)f2bf(QKa[q] * dec);
                }
            }
        }
    }
    __syncthreads();
    bf16* PI0 = (bf16*)(a.ws + WS_PREP) + (size_t)((sc * 4 + h) * 2) * PREP_ITEM;
    if (wave < 2) prep_dinv((const LAS bf16*)(dbase + wave * PD), (LAS bf16*)(dbase + wave * PD + 3 * 9216), lane);
    for (int t = tid; t < 2048; t += NTHR) {
        const int dir = t >> 10, which = (t >> 9) & 1, rw = (t >> 3) & 63, sgp = t & 7, n0a = 32 * (sgp >> 2) + 4 * (sgp & 3), n0b = n0a + 16;
        float v[8];
        if (which == 0) {
            const int tok = dir ? 63 - rw : rw; const float e = egs[dir * 64 + rw];
#pragma unroll
            for (int c = 0; c < 4; ++c) { v[c] = qs[tok * 65 + n0a + c] * e; v[4 + c] = qs[tok * 65 + n0b + c] * e; }
        } else {
#pragma unroll
            for (int c = 0; c < 4; ++c) { const int ia = n0a + c, ib = n0b + c;
                v[c] = ks[(dir ? 63 - ia : ia) * 65 + rw] * eks[dir * 64 + ia]; v[4 + c] = ks[(dir ? 63 - ib : ib) * 65 + rw] * eks[dir * 64 + ib]; }
        }
        u32x4 o; o.x = pk2(v[0], v[1]); o.y = pk2(v[2], v[3]); o.z = pk2(v[4], v[5]); o.w = pk2(v[6], v[7]);
        *(u32x4*)(PI0 + (size_t)dir * PREP_ITEM + (1 + which) * 4096 + rw * 64 + sgp * 8) = o;
    }
    __syncthreads();
    {
        const int dir = wave >> 2, r = lane & 15, kg = lane >> 4, cc = 16 * (wave & 3) + r;
        const LAS bf16* Ab = (const LAS bf16*)(dbase + dir * PD); LAS bf16* Wl = (LAS bf16*)(dbase + dir * PD + 2 * 9216); const LAS bf16* Dl = (const LAS bf16*)(dbase + dir * PD + 3 * 9216);
        bf16* PI = PI0 + (size_t)dir * PREP_ITEM;
        f32x4 XU[4], XW[4];
#pragma unroll
        for (int b = 0; b < 4; ++b) {
            f32x4 TU, TW_;
#pragma unroll
            for (int q = 0; q < 4; ++q) { const int i = 16 * b + 4 * kg + q, tok = dir ? 63 - i : i;
                const float bt = beta[dir * 64 + i];
                TU[q] = bt * vs[tok * 65 + cc]; TW_[q] = bt * egs[dir * 64 + i] * ks[tok * 65 + cc]; }
#pragma unroll
            for (int m = 0; m < 4; ++m) if (m < b) {
                const bf16x4 af = *(const LAS bf16x4*)(Ab + (16 * b + r) * 72 + 16 * m + 4 * kg);
                TU = mfma16(af, pack4(XU[m]), TU); TW_ = mfma16(af, pack4(XW[m]), TW_);
            }
            const bf16x4 df = *(const LAS bf16x4*)(Dl + (b * 16 + r) * 24 + 4 * kg);
            XU[b] = mfma16(df, pack4(TU), (f32x4){0.f, 0.f, 0.f, 0.f});
            XW[b] = mfma16(df, pack4(TW_), (f32x4){0.f, 0.f, 0.f, 0.f});
            *(u32x2*)(PI + 4 * 4096 + cc * 64 + 16 * b + 4 * kg) = __builtin_bit_cast(u32x2, pack4(XU[b]));
#pragma unroll
            for (int q = 0; q < 4; ++q) Wl[(16 * b + 4 * kg + q) * 72 + cc] = (bf16)f2bf(XW[b][q]);
        }
    }
    __syncthreads();
    for (int t = tid; t < 2048; t += NTHR) {
        const int dir = t >> 10, which = (t >> 9) & 1, rw = (t >> 3) & 63, sgp = t & 7, n0a = 32 * (sgp >> 2) + 4 * (sgp & 3);
        const LAS bf16* src = (const LAS bf16*)(dbase + dir * PD + (which ? 1 : 2) * 9216) + rw * 72 + n0a;
        const u32x2 lo = *(const LAS u32x2*)src, hi = *(const LAS u32x2*)(src + 16);
        u32x4 o; o.x = lo.x; o.y = lo.y; o.z = hi.x; o.w = hi.y;
        *(u32x4*)(PI0 + (size_t)dir * PREP_ITEM + (which ? 3 : 0) * 4096 + rw * 64 + sgp * 8) = o;
    }
    __syncthreads();
}

__device__ __forceinline__ void sgu_item(const Args& a, LAS unsigned char* lds, int l, int ch, int g, int dry) {
    const int tid = otid(), lane = tid & 63, wave = tid >> 6;
    LAS bf16* Wl = (LAS bf16*)lds;
    LAS bf16* VT = Wl + 128 * 136;
    LAS float* rstd = (LAS float*)(VT + 64 * 136);
    bf16* PB = (bf16*)(a.ws + WS_PB);
    const int row0 = ch * 128;
    {
        const int q = tid >> 2, part = tid & 3;
        const u32x4* vp = (const u32x4*)(PB + (size_t)(row0 + q) * LDP + C_V + part * 64);
        float ss = 0.f;
#pragma unroll
        for (int i = 0; i < 8; ++i) { const u32x4 v = vp[i];
            const float f0 = bflo(v.x), f1 = bfhi(v.x), f2 = bflo(v.y), f3 = bfhi(v.y), f4 = bflo(v.z), f5 = bfhi(v.z), f6 = bflo(v.w), f7 = bfhi(v.w);
            ss += (f0 * f0 + f1 * f1) + (f2 * f2 + f3 * f3) + (f4 * f4 + f5 * f5) + (f6 * f6 + f7 * f7); }
        ss += __shfl_xor(ss, 1); ss += __shfl_xor(ss, 2);
        if (part == 0) rstd[q] = rsqrtf(ss * (1.f / 256.f) + EPS);
    }
    for (int t = tid; t < 128 * 16; t += NTHR) {
        const int p = t >> 4, q8 = t & 15;
        const f32x4* wp = (const f32x4*)(a.in[I_SGUW] + ((size_t)(l * 4 + g) * 128 + p) * 128 + q8 * 8);
        const f32x4 w0 = wp[0], w1 = wp[1];
        u32x4 o; o.x = pk2(w0.x, w0.y); o.y = pk2(w0.z, w0.w); o.z = pk2(w1.x, w1.y); o.w = pk2(w1.z, w1.w);
        *(LAS u32x4*)(Wl + p * 136 + q8 * 8) = o;
    }
    __syncthreads();
    for (int t = tid; t < 128 * 8; t += NTHR) {
        const int q = t >> 3, c0 = (t & 7) * 8;
        const u32x4 v = *(const u32x4*)(PB + (size_t)(row0 + q) * LDP + C_V + g * 64 + c0);
        const f32x4 g0 = *(const f32x4*)(a.in[I_SGUNG] + l * 256 + g * 64 + c0), g1 = *(const f32x4*)(a.in[I_SGUNG] + l * 256 + g * 64 + c0 + 4);
        const float r = rstd[q];
        VT[(c0 + 0) * 136 + q] = (bf16)f2bf(bflo(v.x) * r * g0.x); VT[(c0 + 1) * 136 + q] = (bf16)f2bf(bfhi(v.x) * r * g0.y);
        VT[(c0 + 2) * 136 + q] = (bf16)f2bf(bflo(v.y) * r * g0.z); VT[(c0 + 3) * 136 + q] = (bf16)f2bf(bfhi(v.y) * r * g0.w);
        VT[(c0 + 4) * 136 + q] = (bf16)f2bf(bflo(v.z) * r * g1.x); VT[(c0 + 5) * 136 + q] = (bf16)f2bf(bfhi(v.z) * r * g1.y);
        VT[(c0 + 6) * 136 + q] = (bf16)f2bf(bflo(v.w) * r * g1.z); VT[(c0 + 7) * 136 + q] = (bf16)f2bf(bfhi(v.w) * r * g1.w);
    }
    __syncthreads();
    {
        const int m0 = wave * 16, r = lane & 15, kg = lane >> 4;
#pragma unroll
        for (int nt = 0; nt < 4; ++nt) {
            f32x4 acc = (f32x4){0.f, 0.f, 0.f, 0.f};
            acc = tile_mm<4>(acc, Wl, 136, m0, VT, 136, nt * 16, lane);
#pragma unroll
            for (int q = 0; q < 4; ++q) {
                const int p = m0 + 4 * kg + q, c = nt * 16 + r;
                const float sv = acc[q] + a.in[I_SGUB][(l * 4 + g) * 128 + p];
                bf16* up = PB + (size_t)(row0 + p) * LDP + C_U + g * 64 + c;
                const float uu = bf2f(*up), gb = bf2f(PB[(size_t)(row0 + p) * LDP + C_GB + g * 64 + c]);
                if (dry) up = (bf16*)(a.ws + WS_DUM) + (size_t)((row0 + p) & 1023) * LDP + C_U + g * 64 + c;
                *up = (bf16)f2bf(uu * sv * gb);
            }
        }
    }
    __syncthreads();
}

__device__ __forceinline__ void pool_item(const Args& a, LAS unsigned char* lds, int l, int sc, int dry) {
    const int tid = otid();
    LAS bf16* xt = (LAS bf16*)lds;
    bf16* PB = (bf16*)(a.ws + WS_PB);
    const SeqGeo sg = seq_geo(sc);
    for (int t = tid; t < 80 * 32; t += NTHR) {
        const int r = t >> 5, c8 = t & 31, ts = sg.tseq0 - 8 + r;
        u32x4 v = (u32x4){0u, 0u, 0u, 0u};
        if (ts >= 0 && ts < sg.T) v = *(const u32x4*)(PB + (size_t)(sg.seq_row0 + ts) * LDP + C_XC + c8 * 8);
        *(LAS u32x4*)(xt + r * 264 + c8 * 8) = v;
    }
    __syncthreads();
    for (int t = tid; t < 64 * 32; t += NTHR) {
        const int tok = t >> 5, c8 = t & 31, gi = c8 >> 3, half = 1 << gi;
        const int ts = sg.tseq0 + tok;
        const int lo = (ts - half) < 0 ? 0 : ts - half, hi = (ts + half) > sg.T ? sg.T : ts + half;
        float s[8];
#pragma unroll
        for (int c = 0; c < 8; ++c) s[c] = 0.f;
        for (int tt = lo; tt < hi; ++tt) {
            const u32x4 v = *(const LAS u32x4*)(xt + (tt - sg.tseq0 + 8) * 264 + c8 * 8);
            s[0] += bflo(v.x); s[1] += bfhi(v.x); s[2] += bflo(v.y); s[3] += bfhi(v.y); s[4] += bflo(v.z); s[5] += bfhi(v.z); s[6] += bflo(v.w); s[7] += bfhi(v.w);
        }
        const float inv = 1.f / (float)(hi - lo);
        const u32x4 xv = *(const LAS u32x4*)(xt + (tok + 8) * 264 + c8 * 8);
        const float x0[8] = {bflo(xv.x), bfhi(xv.x), bflo(xv.y), bfhi(xv.y), bflo(xv.z), bfhi(xv.z), bflo(xv.w), bfhi(xv.w)};
        bf16* yp = PB + (size_t)(sg.seq_row0 + ts) * LDP + C_GC + c8 * 8;
        const u32x4 gv = *(const u32x4*)yp;
        const float gg[8] = {bflo(gv.x), bfhi(gv.x), bflo(gv.y), bfhi(gv.y), bflo(gv.z), bfhi(gv.z), bflo(gv.w), bfhi(gv.w)};
        const f32x4 p0 = *(const f32x4*)(a.in[I_POOLS] + l * 256 + c8 * 8), p1 = *(const f32x4*)(a.in[I_POOLS] + l * 256 + c8 * 8 + 4);
        const float ps[8] = {p0.x, p0.y, p0.z, p0.w, p1.x, p1.y, p1.z, p1.w};
        float y[8];
#pragma unroll
        for (int c = 0; c < 8; ++c) y[c] = (s[c] * inv - x0[c]) * ps[c] * gg[c];
        u32x4 o; o.x = pk2(y[0], y[1]); o.y = pk2(y[2], y[3]); o.z = pk2(y[4], y[5]); o.w = pk2(y[6], y[7]);
        if (dry) yp = (bf16*)(a.ws + WS_DUM) + (size_t)((sg.seq_row0 + ts) & 1023) * LDP + C_GC + c8 * 8;
        *(u32x4*)yp = o;
    }
    __syncthreads();
}

__device__ __forceinline__ void fctx_item(const Args& a, LAS unsigned char* lds, int b, int dblk, int dry) {
    const int tid = otid(), lane = tid & 63, wave = __builtin_amdgcn_readfirstlane(tid >> 6);
    LAS bf16* ZT = (LAS bf16*)lds;
    bf16* PB = (bf16*)(a.ws + WS_PB);
    const bf16* DFT = (const bf16*)(a.ws + WS_DFT);
    {
        u32x4 v[8];
#pragma unroll
        for (int i = 0; i < 8; ++i) { const int t = tid + NTHR * i, d8 = t & 7, ri = (t >> 3) & 1, tt = t >> 4;
            v[i] = *(const u32x4*)(PB + (size_t)(b * 256 + tt) * LDP + (ri ? C_QF : C_PF) + dblk * 64 + d8 * 8); }
#pragma unroll
        for (int i = 0; i < 8; ++i) { const int t = tid + NTHR * i, d8 = t & 7, ri = (t >> 3) & 1, tt = t >> 4;
            LAS bf16* dst = ZT + (d8 * 8) * 520 + ri * 256 + tt;
            dst[0 * 520] = (bf16)(v[i].x & 0xffffu); dst[1 * 520] = (bf16)(v[i].x >> 16); dst[2 * 520] = (bf16)(v[i].y & 0xffffu); dst[3 * 520] = (bf16)(v[i].y >> 16);
            dst[4 * 520] = (bf16)(v[i].z & 0xffffu); dst[5 * 520] = (bf16)(v[i].z >> 16); dst[6 * 520] = (bf16)(v[i].w & 0xffffu); dst[7 * 520] = (bf16)(v[i].w >> 16); }
    }
    __syncthreads();
    const int r = lane & 15, kg = lane >> 4;
#pragma unroll 1
    for (int mi = 0; mi < 2; ++mi) {
        const int m0 = wave * 32 + mi * 16;
        bf16 gdv[4][4];
#pragma unroll
        for (int nt = 0; nt < 4; ++nt)
#pragma unroll
            for (int q = 0; q < 4; ++q) gdv[nt][q] = PB[(size_t)(b * 256 + m0 + 4 * kg + q) * LDP + C_GD + dblk * 64 + nt * 16 + r];
        f32x4 acc[4];
#pragma unroll
        for (int nt = 0; nt < 4; ++nt) acc[nt] = (f32x4){0.f, 0.f, 0.f, 0.f};
#pragma unroll
        for (int kh = 0; kh < 2; ++kh) {
            bf16x8 af[8];
#pragma unroll
            for (int ksx = 0; ksx < 8; ++ksx) af[ksx] = *(const bf16x8*)(DFT + (size_t)(m0 + r) * 512 + (kh * 8 + ksx) * 32 + kg * 8);
#pragma unroll
            for (int nt = 0; nt < 4; ++nt) {
#pragma unroll
                for (int ksx = 0; ksx < 8; ++ksx) {
                    const bf16x8 bfr = *(const LAS bf16x8*)(ZT + (nt * 16 + r) * 520 + (kh * 8 + ksx) * 32 + kg * 8);
                    acc[nt] = __builtin_amdgcn_mfma_f32_16x16x32_bf16(af[ksx], bfr, acc[nt], 0, 0, 0);
                }
                __builtin_amdgcn_sched_barrier(0);
            }
        }
#pragma unroll
        for (int nt = 0; nt < 4; ++nt)
#pragma unroll
            for (int q = 0; q < 4; ++q) {
                const int k = m0 + 4 * kg + q, d = nt * 16 + r;
                bf16* yp = (dry ? (bf16*)(a.ws + WS_DUM) + (size_t)((b * 256 + k) & 1023) * LDP : PB + (size_t)(b * 256 + k) * LDP) + C_GD + dblk * 64 + d;
                *yp = (bf16)f2bf(acc[nt][q] * bf2f(gdv[nt][q]));
            }
    }
    __syncthreads();
}

__device__ __forceinline__ void fsmp_item(const Args& a, LAS unsigned char* lds, int b, int ds, int dry) {
    const int tid = otid(), lane = tid & 63, wave = __builtin_amdgcn_readfirstlane(tid >> 6);
    LAS bf16* ZT = (LAS bf16*)lds;
    LAS bf16* B2 = ZT + 256 * 136;
    bf16* PB = (bf16*)(a.ws + WS_PB);
    const bf16* M1 = (const bf16*)(a.ws + WS_M1);
    const bf16* M2 = (const bf16*)(a.ws + WS_M2);
    const int d0 = ds * 4;
    const size_t rowb = (size_t)M_CTX + (size_t)b * 4096;
    const int r = lane & 15, kg = lane >> 4, mp = wave & 3, nb = wave >> 2;
    {
        u32x2 v[16];
#pragma unroll
        for (int i = 0; i < 16; ++i) { const int t = tid + NTHR * i, ri = t & 1, tt = t >> 1;
            v[i] = *(const u32x2*)(PB + (rowb + tt) * LDP + (ri ? C_QF : C_PF) + d0); }
#pragma unroll
        for (int i = 0; i < 16; ++i) { const int t = tid + NTHR * i, ri = t & 1, tt = t >> 1, t1 = tt >> 6, t2 = tt & 63;
            LAS bf16* dst = ZT + (t2 * 4) * 136 + ri * 64 + t1;
            dst[0] = (bf16)(v[i].x & 0xffffu); dst[136] = (bf16)(v[i].x >> 16); dst[272] = (bf16)(v[i].y & 0xffffu); dst[408] = (bf16)(v[i].y >> 16); }
    }
    bf16x8 aRe[4], aIm[4], a2[4];
#pragma unroll
    for (int ksx = 0; ksx < 4; ++ksx) {
        aRe[ksx] = *(const bf16x8*)(M1 + (16 * mp + r) * 128 + ksx * 32 + kg * 8);
        aIm[ksx] = *(const bf16x8*)(M1 + (64 + 16 * mp + r) * 128 + ksx * 32 + kg * 8);
        a2[ksx] = *(const bf16x8*)(M2 + (16 * mp + r) * 128 + ksx * 32 + kg * 8);
    }
    bf16 gdv[8][4];
#pragma unroll
    for (int jb = 0; jb < 8; ++jb) { const int n = 16 * (nb + 2 * jb) + r, k1 = n >> 2, dd = n & 3;
#pragma unroll
        for (int q = 0; q < 4; ++q) gdv[jb][q] = PB[(rowb + k1 + 64 * (16 * mp + 4 * kg + q)) * LDP + C_GD + d0 + dd]; }
    __syncthreads();
#pragma unroll 2
    for (int jb = 0; jb < 8; ++jb) {
        const int nt = nb + 2 * jb;
        f32x4 ar = (f32x4){0.f, 0.f, 0.f, 0.f}, ai = (f32x4){0.f, 0.f, 0.f, 0.f};
#pragma unroll
        for (int ksx = 0; ksx < 4; ++ksx) {
            const bf16x8 z = *(const LAS bf16x8*)(ZT + (16 * nt + r) * 136 + ksx * 32 + kg * 8);
            ar = __builtin_amdgcn_mfma_f32_16x16x32_bf16(aRe[ksx], z, ar, 0, 0, 0);
            ai = __builtin_amdgcn_mfma_f32_16x16x32_bf16(aIm[ksx], z, ai, 0, 0, 0);
        }
        const int n = 16 * nt + r, t2 = n >> 2, dd = n & 3;
#pragma unroll
        for (int q = 0; q < 4; ++q) {
            const int k1 = 16 * mp + 4 * kg + q;
            const float rev = (float)((k1 * t2) & 4095) * (1.f / 4096.f);
            const float cw = __builtin_amdgcn_cosf(rev), sw = __builtin_amdgcn_sinf(rev);
            const float xr = ar[q] * cw - ai[q] * sw, xi = ar[q] * sw + ai[q] * cw;
            B2[(k1 * 4 + dd) * 136 + t2] = (bf16)f2bf(xr);
            B2[(k1 * 4 + dd) * 136 + 64 + t2] = (bf16)f2bf(xi);
        }
    }
    __syncthreads();
#pragma unroll 2
    for (int jb = 0; jb < 8; ++jb) {
        const int nt = nb + 2 * jb;
        f32x4 acc = (f32x4){0.f, 0.f, 0.f, 0.f};
#pragma unroll
        for (int ksx = 0; ksx < 4; ++ksx) {
            const bf16x8 z = *(const LAS bf16x8*)(B2 + (16 * nt + r) * 136 + ksx * 32 + kg * 8);
            acc = __builtin_amdgcn_mfma_f32_16x16x32_bf16(a2[ksx], z, acc, 0, 0, 0);
        }
        const int n = 16 * nt + r, k1 = n >> 2, dd = n & 3;
#pragma unroll
        for (int q = 0; q < 4; ++q) {
            const int k2 = 16 * mp + 4 * kg + q, kk = k1 + 64 * k2;
            bf16* yp = (dry ? (bf16*)(a.ws + WS_DUM) + (size_t)(kk & 1023) * LDP : PB + (rowb + kk) * LDP) + C_GD + d0 + dd;
            *yp = (bf16)f2bf(acc[q] * bf2f(gdv[jb][q]));
        }
    }
    __syncthreads();
}

constexpr int SC_MAT = 64 * 72 * 2;
constexpr int SC_BUF = 5 * SC_MAT + 16;
constexpr int SC_OT = 2 * SC_BUF;
__device__ __forceinline__ void scan_item(const Args& a, LAS unsigned char* lds, int l, int seq, int h, int dir) {
    const int tid = otid(), lane = tid & 63, wave = __builtin_amdgcn_readfirstlane(tid >> 6);
    bf16* PB = (bf16*)(a.ws + WS_PB);
    const int nch = seq < 32 ? 4 : 64;
    const int sc0 = seq < 32 ? seq * 4 : 128 + (seq - 32) * 64;
    const int r = lane & 15, kg = lane >> 4;
    if (wave >= 4) {
        const int ht = tid - 256;
        u32x4 pre[10]; float pgl = 0.f;
#define SC_ISSUE(ss) do { const int c_ = dir ? nch - 1 - (ss) : (ss); const size_t pid_ = (size_t)((sc0 + c_) * 4 + h) * 2 + dir; \
            const u32x4* src_ = (const u32x4*)((const bf16*)(a.ws + WS_PREP) + pid_ * PREP_ITEM) + ht; \
            _Pragma("unroll") for (int i_ = 0; i_ < 10; ++i_) pre[i_] = src_[256 * i_]; \
            pgl = ((const float*)(a.ws + WS_PGL))[pid_]; } while (0)
#define SC_WRITE(bb) do { LAS unsigned char* B_ = lds + (bb) * SC_BUF; \
            _Pragma("unroll") for (int i_ = 0; i_ < 10; ++i_) { const int ch_ = ht + 256 * i_; \
                *(LAS u32x4*)(B_ + (ch_ >> 9) * SC_MAT + ((ch_ >> 3) & 63) * 144 + (ch_ & 7) * 16) = pre[i_]; } \
            if (ht == 0) *(LAS float*)(B_ + 5 * SC_MAT) = pgl; } while (0)
#define SC_OSTORE(ss) do { const int c_ = dir ? nch - 1 - (ss) : (ss); const LAS unsigned char* O_ = lds + SC_OT + ((ss) & 1) * SC_MAT; \
            _Pragma("unroll") for (int i_ = 0; i_ < 2; ++i_) { const int ch_ = ht + 256 * i_, rw_ = ch_ >> 3, c8_ = ch_ & 7; \
                const u32x4 v_ = *(const LAS u32x4*)(O_ + rw_ * 144 + c8_ * 16); \
                *(u32x4*)(PB + (size_t)((sc0 + c_) * 64 + (dir ? 63 - rw_ : rw_)) * LDP + (dir ? C_K : C_Q) + h * 64 + c8_ * 8) = v_; } } while (0)
        SC_ISSUE(0);
        SC_WRITE(0);
        { const int sn = nch > 1 ? 1 : 0; SC_ISSUE(sn); }
        __syncthreads();
#pragma unroll 1
        for (int s = 0; s < nch; ++s) {
            SC_WRITE((s + 1) & 1);
            if (s > 0) SC_OSTORE(s - 1);
            { const int sn = (s + 2 < nch) ? s + 2 : nch - 1; SC_ISSUE(sn); }
            __syncthreads();
        }
        SC_OSTORE(nch - 1);
#undef SC_ISSUE
#undef SC_WRITE
#undef SC_OSTORE
    } else {
        const int e = 16 * wave + r;
        f32x4 S[4];
#pragma unroll
        for (int t = 0; t < 4; ++t)
#pragma unroll
            for (int q = 0; q < 4; ++q) {
                const int d = 16 * t + 4 * kg + q;
                S[t][q] = (seq < 32) ? 0.f : a.in[I_STATE][((size_t)(((seq - 32) * 4 + l) * 2 + dir) * 4 + h) * 4096 + d * 64 + e];
            }
        __syncthreads();
#pragma unroll 1
        for (int s = 0; s < nch; ++s) {
            const LAS unsigned char* B = lds + (s & 1) * SC_BUF;
            const LAS bf16* Wm = (const LAS bf16*)B; const LAS bf16* Qd = Wm + 64 * 72; const LAS bf16* KdT = Qd + 64 * 72; const LAS bf16* QKm = KdT + 64 * 72; const LAS bf16* UT = QKm + 64 * 72;
            const float egl = *(const LAS float*)(B + 5 * SC_MAT);
            LAS bf16* OT = (LAS bf16*)(lds + SC_OT + (s & 1) * SC_MAT);
            bf16x8 bS[2];
            bS[0] = pack8(S[0], S[1]); bS[1] = pack8(S[2], S[3]);
            f32x4 a1[4], oo[4];
#pragma unroll
            for (int t = 0; t < 4; ++t) {
                a1[t] = (f32x4){0.f, 0.f, 0.f, 0.f}; oo[t] = (f32x4){0.f, 0.f, 0.f, 0.f};
#pragma unroll
                for (int ksx = 0; ksx < 2; ++ksx) {
                    const bf16x8 wf = *(const LAS bf16x8*)(Wm + (16 * t + r) * 72 + ksx * 32 + kg * 8);
                    const bf16x8 qf = *(const LAS bf16x8*)(Qd + (16 * t + r) * 72 + ksx * 32 + kg * 8);
                    a1[t] = __builtin_amdgcn_mfma_f32_16x16x32_bf16(wf, bS[ksx], a1[t], 0, 0, 0);
                    oo[t] = __builtin_amdgcn_mfma_f32_16x16x32_bf16(qf, bS[ksx], oo[t], 0, 0, 0);
                }
            }
            f32x4 vn[4];
#pragma unroll
            for (int t = 0; t < 4; ++t) {
                const u32x2 uu = *(const LAS u32x2*)(UT + e * 72 + 16 * t + 4 * kg);
                vn[t][0] = bflo(uu.x) - a1[t][0]; vn[t][1] = bfhi(uu.x) - a1[t][1]; vn[t][2] = bflo(uu.y) - a1[t][2]; vn[t][3] = bfhi(uu.y) - a1[t][3];
            }
            bf16x8 bV[2];
            bV[0] = pack8(vn[0], vn[1]); bV[1] = pack8(vn[2], vn[3]);
#pragma unroll
            for (int t = 0; t < 4; ++t) {
                f32x4 as = (f32x4){0.f, 0.f, 0.f, 0.f};
#pragma unroll
                for (int ksx = 0; ksx < 2; ++ksx) {
                    const bf16x8 kf = *(const LAS bf16x8*)(QKm + (16 * t + r) * 72 + ksx * 32 + kg * 8);
                    const bf16x8 df = *(const LAS bf16x8*)(KdT + (16 * t + r) * 72 + ksx * 32 + kg * 8);
                    oo[t] = __builtin_amdgcn_mfma_f32_16x16x32_bf16(kf, bV[ksx], oo[t], 0, 0, 0);
                    as = __builtin_amdgcn_mfma_f32_16x16x32_bf16(df, bV[ksx], as, 0, 0, 0);
                }
                S[t] = S[t] * egl + as;
            }
#pragma unroll
            for (int t = 0; t < 4; ++t)
#pragma unroll
                for (int q = 0; q < 4; ++q) OT[(16 * t + 4 * kg + q) * 72 + e] = (bf16)f2bf(oo[t][q]);
            __syncthreads();
        }
        if (seq < 32) {
            float* ns = a.out + (size_t)M * D + ((size_t)((seq * 4 + l) * 2 + dir) * 4 + h) * 4096;
#pragma unroll
            for (int t = 0; t < 4; ++t)
#pragma unroll
                for (int q = 0; q < 4; ++q) ns[(16 * t + 4 * kg + q) * 64 + e] = S[t][q];
        }
    }
    __syncthreads();
}

__device__ __forceinline__ void phase_combine(const Args& a, int l, int dry) {
    const int tid = otid(), lane = tid & 63, wave = tid >> 6, G = gridDim.x, bid = obid();
    bf16* PB = (bf16*)(a.ws + WS_PB);
    const f32x4 ng = *(const f32x4*)(a.in[I_DNG] + l * 64 + (lane & 15) * 4);
    for (int row = bid * NWAVES + wave; row < M; row += G * NWAVES) {
        bf16* rp = PB + (size_t)row * LDP;
        const u32x2 of = *((const u32x2*)(rp + C_Q) + lane), ob = *((const u32x2*)(rp + C_K) + lane), ga = *((const u32x2*)(rp + C_GA) + lane);
        const float o0 = bflo(of.x) + bflo(ob.x), o1 = bfhi(of.x) + bfhi(ob.x), o2 = bflo(of.y) + bflo(ob.y), o3 = bfhi(of.y) + bfhi(ob.y);
        float ss = (o0 * o0 + o1 * o1) + (o2 * o2 + o3 * o3);
        ss += __shfl_xor(ss, 1); ss += __shfl_xor(ss, 2); ss += __shfl_xor(ss, 4); ss += __shfl_xor(ss, 8);
        const float rinv = rsqrtf(ss * (1.f / 64.f) + EPS);
        u32x2 y; y.x = pk2(o0 * rinv * ng.x * bflo(ga.x), o1 * rinv * ng.y * bfhi(ga.x)); y.y = pk2(o2 * rinv * ng.z * bflo(ga.y), o3 * rinv * ng.w * bfhi(ga.y));
        if (dry) rp = (bf16*)(a.ws + WS_DUM) + (size_t)(row & 1023) * LDP;
        *((u32x2*)(rp + C_GA) + lane) = y;
    }
}

__device__ __forceinline__ void phase_final(const Args& a) {
    const int tid = otid(), lane = tid & 63, wave = tid >> 6, G = gridDim.x, bid = obid();
    const float* RSS = (const float*)(a.ws + WS_RSS);
    f32x4 fg[4];
#pragma unroll
    for (int q = 0; q < 4; ++q) fg[q] = *((const f32x4*)(a.in[I_FNG] + 256 * q) + lane);
    for (int row = bid * NWAVES + wave; row < M; row += G * NWAVES) {
        float p = (lane < 16) ? RSS[(size_t)row * 16 + lane] : 0.f;
        p += __shfl_xor(p, 1); p += __shfl_xor(p, 2); p += __shfl_xor(p, 4); p += __shfl_xor(p, 8);
        const float ss = __shfl(p, 0);
        const float rinv = rsqrtf(ss * (1.f / 1024.f) + EPS);
        f32x4* orow = (f32x4*)(a.out + (size_t)row * D) + lane;
#pragma unroll
        for (int q = 0; q < 4; ++q) { const f32x4 v = orow[64 * q]; orow[64 * q] = v * rinv * fg[q]; }
    }
}

__device__ __forceinline__ void skinny_ba(const Args& a, int l, int pm) {
    const int tid = otid(), lane = tid & 63, wave = __builtin_amdgcn_readfirstlane(tid >> 6), r = lane & 15, kg = lane >> 4;
    const bf16* A = (const bf16*)(a.ws + WS_HB) + (size_t)(pm * 256 + wave * 32 + r) * 1024 + kg * 8;
    const bf16* Bw = (const bf16*)(a.ws + WS_W1T) + ((size_t)l * N1 + 3072 + r) * 1024 + kg * 8;
    f32x4 acc0 = (f32x4){0.f, 0.f, 0.f, 0.f}, acc1 = acc0;
    bf16x8 a0[2][4], a1[2][4], bw[2][4];
#define SK_LOAD(buf, kc_) do { _Pragma("unroll") for (int ksx = 0; ksx < 4; ++ksx) { const int k = ((kc_) * 4 + ksx) * 32; \
        a0[buf][ksx] = *(const bf16x8*)(A + k); a1[buf][ksx] = *(const bf16x8*)(A + 16 * 1024 + k); bw[buf][ksx] = *(const bf16x8*)(Bw + k); } } while (0)
#define SK_MMA(buf) do { _Pragma("unroll") for (int ksx = 0; ksx < 4; ++ksx) { \
        acc0 = __builtin_amdgcn_mfma_f32_16x16x32_bf16(a0[buf][ksx], bw[buf][ksx], acc0, 0, 0, 0); \
        acc1 = __builtin_amdgcn_mfma_f32_16x16x32_bf16(a1[buf][ksx], bw[buf][ksx], acc1, 0, 0, 0); } } while (0)
    SK_LOAD(0, 0); SK_LOAD(1, 1);
    SK_MMA(0); SK_LOAD(0, 2); SK_MMA(1); SK_LOAD(1, 3); SK_MMA(0); SK_LOAD(0, 4); SK_MMA(1); SK_LOAD(1, 5);
    SK_MMA(0); SK_LOAD(0, 6); SK_MMA(1); SK_LOAD(1, 7); SK_MMA(0); SK_MMA(1);
#undef SK_LOAD
#undef SK_MMA
    const int j = pm < 32 ? 0 : 1 + ((pm - 32) >> 4);
    const float sw = ((const float*)(a.ws + WS_SW))[((size_t)l * 9 + j) * N1 + 3072 + r];
    const float* RSS = (const float*)(a.ws + WS_RSS);
    float* BA = (float*)(a.ws + WS_BA);
#pragma unroll
    for (int mi = 0; mi < 2; ++mi)
#pragma unroll
        for (int q = 0; q < 4; ++q) {
            const int row = pm * 256 + wave * 32 + mi * 16 + 4 * kg + q;
            const f32x4* rp = (const f32x4*)(RSS + (size_t)row * 16);
            const f32x4 r0 = rp[0], r1 = rp[1], r2 = rp[2], r3 = rp[3];
            const float ss = ((r0.x + r0.y) + (r0.z + r0.w)) + ((r1.x + r1.y) + (r1.z + r1.w)) + ((r2.x + r2.y) + (r2.z + r2.w)) + ((r3.x + r3.y) + (r3.z + r3.w));
            const float rinv = rsqrtf(ss * (1.f / 1024.f) + EPS);
            BA[(size_t)row * 16 + r] = (mi ? acc1[q] : acc0[q]) * rinv + sw;
        }
}

constexpr int NPHASE = 24;
__global__ void __launch_bounds__(NTHR, 2) fwd_kernel(Args args) {
    extern __shared__ __attribute__((aligned(16))) unsigned char lds_raw[];
    LAS unsigned char* lds = (LAS unsigned char*)lds_raw;
#if !MK_MULTI
    volatile LAS unsigned* MISC = (volatile LAS unsigned*)(lds + MISC_OFF);
    if (threadIdx.x < 64) MISC[threadIdx.x] = 0u;
    __syncthreads();
    XcdBarrier bar = xcd_barrier_post((unsigned*)(args.ws + WS_CTL) + CW_BAR, MISC + 8);
#define GRID_BAR() xcd_barrier(bar)
#else
#define GRID_BAR() do { } while (0)
#endif
    const int G = gridDim.x, bid = blockIdx.x;
    for (int pass = (PRE_HI > 0 ? 0 : 1); pass < 2; ++pass)
    for (int ph = args.ph_lo; ph < (pass == 0 ? args.pad : args.ph_hi); ++ph) {
        if (ph == 0) { if (EN(0)) for (int rep = 0; rep < REP_P0; ++rep) phase_0a(args, lds); }
        else if (ph == 1) { if (EN(1)) for (int rep = 0; rep < REP_P0; ++rep) phase_0b(args); }
        else if (ph == 2) { if (EN(2)) phase_0c(args); }
        else if (ph == 23) { if (EN(3)) phase_final(args); }
        else {
            const int l = (ph - 3) / 5, sub = (ph - 3) % 5;
            if (sub == 0) { if (EN(4)) {
                pg8::Gemm g{(const bf16*)(args.ws + WS_HB), (const bf16*)(args.ws + WS_W1T) + (size_t)l * N1 * 1024, M, LDP, 1024, 1024};
                pg8::StaticOrder S; S.init(M, LDP, G, bid);
                Epi1 E{(bf16*)(args.ws + WS_PB), (float*)(args.ws + WS_BA), (const float*)(args.ws + WS_RSS), (const float*)(args.ws + WS_SW) + (size_t)l * 9 * N1, 0, (bf16*)(args.ws + WS_DUM), (const LAS float*)(lds + 131072)};
                {
                    LAS float* rtab = (LAS float*)(lds + 131072); const float* RSSp = (const float*)(args.ws + WS_RSS);
                    for (int idx = otid(); idx < 8 * 256; idx += NTHR) { pg8::Unit u;
                        if (S.next(idx >> 8, u)) { const f32x4* rp = (const f32x4*)(RSSp + (size_t)(u.pm * 256 + (idx & 255)) * 16);
                            const f32x4 r0 = rp[0], r1 = rp[1], r2 = rp[2], r3 = rp[3];
                            const float ss = ((r0.x + r0.y) + (r0.z + r0.w)) + ((r1.x + r1.y) + (r1.z + r1.w)) + ((r2.x + r2.y) + (r2.z + r2.w)) + ((r3.x + r3.y) + (r3.z + r3.w));
                            rtab[idx] = rsqrtf(ss * (1.f / 1024.f) + EPS); } }
                    __syncthreads();
                }
                for (int rep = 0; rep < REP_G1; ++rep) { if (rep && G1CHEAP) E.cheap = args.one * G1CHEAP; pg8::gemm_phase<Epi1>(lds, g, S, E); if (rep && G1CHEAP) continue;
                    if (bid >= 128) for (int pm = bid - 128; pm < 160; pm += 128) skinny_ba(args, l, pm); } }
            } else if (sub == 1) {
                for (int it = bid; it < 2560; it += G) { if (EN(5)) for (int rep = 0; rep < REP_PREP; ++rep) prep_item(args, lds, l, it >> 2, it & 3); }
            } else if (sub == 2) {
                if (bid < 64) { if (EN(10)) for (int rep = 0; rep < REP_SCAN; ++rep) scan_item(args, lds, l, 32 + (bid >> 3), (bid >> 1) & 3, bid & 1); }
                unsigned* qc = (unsigned*)(args.ws + WS_CTL) + CW_Q + 64 * l + 256 * pass;
                volatile LAS unsigned* qslot = (volatile LAS unsigned*)(lds + MISC_OFF) + 16;
                for (;;) {
                    if (otid() == 0) qslot[0] = atomicAdd(qc, 1u);
                    __syncthreads();
                    const int it = (int)qslot[0];
                    __syncthreads();
                    if (it >= 2816) break;
                    if (it < 512) { if (EN(9)) fsmp_item(args, lds, it >> 6, it & 63, 0); }
                    else if (it < 640) { const int i2 = it - 512; if (EN(8)) fctx_item(args, lds, i2 >> 2, i2 & 3, 0); }
                    else if (it < 896) { const int i2 = it - 640; if (EN(10)) for (int rep = 0; rep < REP_SCAN; ++rep) scan_item(args, lds, l, i2 >> 3, (i2 >> 1) & 3, i2 & 1); }
                    else if (it < 2176) { const int i2 = it - 896; if (EN(6)) sgu_item(args, lds, l, i2 >> 2, i2 & 3, 0); }
                    else { if (EN(7)) pool_item(args, lds, l, it - 2176, 0); }
                }
            } else if (sub == 3) {
                if (EN(11)) for (int rep = 0; rep < REP_COMB; ++rep) phase_combine(args, l, rep ? args.one : 0);
            } else if (EN(12)) {
                pg8::Gemm g{(const bf16*)(args.ws + WS_PB), (const bf16*)(args.ws + WS_W2T) + (size_t)l * 1024 * 1024, M, 1024, 1024, LDP};
                pg8::StaticOrder S; S.init(M, 1024, G, bid);
                const float* MOD = (const float*)(args.ws + WS_MOD);
                Epi2 E{args.out, (bf16*)(args.ws + WS_HB), (float*)(args.ws + WS_RSS), MOD + (size_t)l * 9 * 3072 + 2048,
                       l < 3 ? args.in[I_NORMG] + (l + 1) * 1024 : nullptr, l < 3 ? MOD + (size_t)(l + 1) * 9 * 3072 + 1024 : nullptr, args.ws + WS_DUM, 0};
                pg8::gemm_phase<Epi2>(lds, g, S, E);
                for (int rep = 1; rep < REP_G2; ++rep) { Epi2 E2 = E; E2.dry = args.one; pg8::gemm_phase<Epi2>(lds, g, S, E2); }
            }
        }
        if (ph + 1 < args.ph_hi || pass == 0) { GRID_BAR(); for (int rb = 1; rb < REP_BAR; ++rb) GRID_BAR(); }
    }
}

extern "C" void kernel_launch(void* const* d_in, const int* in_sizes, int n_in, void* d_out, int out_size, void* d_ws, size_t ws_size, hipStream_t stream) {
    static int grid = 0;
    if (grid == 0) {
        if (n_in != 21 || ws_size < WS_DUM + 16 * MiB) { fprintf(stderr, "kernel_launch: unexpected n_in %d or ws_size %zu (< %zu)\n", n_in, ws_size, (size_t)WS_END); grid = -1; return; }
        int dev = 0, cus = 0, per_cu = 0;
        if (hipGetDevice(&dev) != hipSuccess || hipDeviceGetAttribute(&cus, hipDeviceAttributeMultiprocessorCount, dev) != hipSuccess) { grid = -1; return; }
        if (hipFuncSetAttribute((const void*)fwd_kernel, hipFuncAttributeMaxDynamicSharedMemorySize, LDS_BYTES) != hipSuccess) { fprintf(stderr, "kernel_launch: hipFuncSetAttribute failed\n"); grid = -1; return; }
        if (hipOccupancyMaxActiveBlocksPerMultiprocessor(&per_cu, (const void*)fwd_kernel, NTHR, LDS_BYTES) != hipSuccess || per_cu < 1) { fprintf(stderr, "kernel_launch: occupancy query failed (%d)\n", per_cu); (void)hipGetLastError(); per_cu = 1; }
        grid = cus * 1;
    }
    if (grid < 0) return;
    Args a{};
    for (int i = 0; i < 21; ++i) a.in[i] = (const float*)d_in[i];
    a.out = (float*)d_out; a.ws = (unsigned char*)d_ws; a.one = 1; a.pad = PRE_HI;
    (void)hipMemsetAsync((char*)d_ws + WS_CTL, 0, CTL_ZERO_BYTES, stream);
#if MK_MULTI
    for (int ph = 0; ph < NPHASE; ++ph) {
        a.ph_lo = ph; a.ph_hi = ph + 1;
        hipLaunchKernelGGL(fwd_kernel, dim3(grid), dim3(NTHR), LDS_BYTES, stream, a);
    }
#else
    a.ph_lo = 0; a.ph_hi = NPHASE;
    void* kargs[] = {&a};
    hipError_t e = hipLaunchCooperativeKernel((const void*)fwd_kernel, dim3(grid), dim3(NTHR), kargs, LDS_BYTES, stream);
    if (e != hipSuccess) fprintf(stderr, "kernel_launch: cooperative launch failed: %s (grid %d)\n", hipGetErrorString(e), grid);
#endif
}
```

```cpp
#include <hip/hip_runtime.h>
#include <cstdio>
#include <cstdint>

#ifndef MK_MULTI
#define MK_MULTI 0
#endif
#ifndef NAIVE_MM
#define NAIVE_MM 0
#endif
#ifndef ONLY
#define ONLY -1
#endif
#define EN(k) (ONLY < 0 || ONLY == (k))
#ifndef REP_G1
#define REP_G1 1
#endif
#ifndef REP_PREP
#define REP_PREP 1
#endif
#ifndef REP_SCAN
#define REP_SCAN 1
#endif
#ifndef REP_P0
#define REP_P0 1
#endif
#ifndef REP_MIX
#define REP_MIX 1
#endif
#ifndef REP_COMB
#define REP_COMB 1
#endif
#ifndef REP_G2
#define REP_G2 1
#endif
#ifndef MIXSEL
#define MIXSEL 15
#endif
#ifndef G1CHEAP
#define G1CHEAP 0
#endif
#ifndef REP_BAR
#define REP_BAR 1
#endif
#ifndef PRE_HI
#define PRE_HI 0
#endif

#define LAS __attribute__((address_space(3)))
#define GAS __attribute__((address_space(1)))
typedef unsigned short bf16;
typedef short bf16x8 __attribute__((ext_vector_type(8)));
typedef float f32x4 __attribute__((ext_vector_type(4)));
typedef float f32x2 __attribute__((ext_vector_type(2)));
typedef unsigned u32x4 __attribute__((ext_vector_type(4)));
typedef unsigned u32x2 __attribute__((ext_vector_type(2)));

constexpr int D = 1024, NL = 4, NCOND = 9;
constexpr int M_CTX = 8192, M = 40960;
constexpr int PIN = 2832;
constexpr int N1 = 3328, LDP = 3072;
constexpr float EPS = 1e-6f;
constexpr int C_GA = 0, C_U = 256, C_GC = 512, C_GD = 768, C_V = 1024, C_GB = 1280, C_XC = 1536, C_PF = 1792, C_QF = 2048, C_Q = 2304, C_K = 2560, C_VV = 2816;

constexpr size_t MiB = 1u << 20;
constexpr size_t WS_CTL = 0, CTL_ZERO_BYTES = 1 * MiB;
constexpr size_t WS_MOD = 1 * MiB;
constexpr size_t WS_SW = WS_MOD + 512 * 1024;
constexpr size_t WS_GMAT = 2 * MiB;
constexpr size_t WS_POS = WS_GMAT + 512 * 1024;
constexpr size_t WS_DFT = WS_POS + 256 * 1024;
constexpr size_t WS_M1 = 3 * MiB;
constexpr size_t WS_M2 = WS_M1 + 32 * 1024;
constexpr size_t WS_TW = WS_M1 + 64 * 1024;
constexpr size_t WS_W1T = 4 * MiB;
constexpr size_t WS_W2T = 30 * MiB;
constexpr size_t WS_BA = 38 * MiB;
constexpr size_t WS_RSS = 41 * MiB;
constexpr size_t WS_PB = 44 * MiB;
constexpr size_t WS_HB = 284 * MiB;
constexpr size_t WS_PREP = 284 * MiB;
constexpr size_t WS_PGL = 484 * MiB;
constexpr size_t WS_END = 485 * MiB;
constexpr size_t WS_DUM = 486 * MiB;
constexpr int CW_BAR = 4096, CW_Q = 8192;

constexpr int LDS_BYTES = 147456;
constexpr int MISC_OFF = 144 * 1024 - 256;
constexpr int NWAVES = 8, NTHR = 512;

typedef __bf16 hwbf16x2 __attribute__((ext_vector_type(2)));
__device__ __forceinline__ unsigned f2bf(float f) { return (unsigned)__builtin_bit_cast(unsigned short, (__bf16)f); }
__device__ __forceinline__ float bf2f(unsigned b) { return __builtin_bit_cast(float, (b & 0xffffu) << 16); }
__device__ __forceinline__ unsigned pk2(float lo, float hi) { const f32x2 v = {lo, hi}; return __builtin_bit_cast(unsigned, __builtin_convertvector(v, hwbf16x2)); }
__device__ __forceinline__ float bflo(unsigned w) { return __builtin_bit_cast(float, w << 16); }
__device__ __forceinline__ float bfhi(unsigned w) { return __builtin_bit_cast(float, w & 0xffff0000u); }
__device__ __forceinline__ float silu_f(float x) { return x * __builtin_amdgcn_rcpf(1.f + __builtin_amdgcn_exp2f(-1.4426950408889634f * x)); }
__device__ __forceinline__ float gelu_tanh_f(float x) { const float z = (-1.5957691216057308f * 1.4426950408889634f) * (x + 0.044715f * x * x * x); return x * __builtin_amdgcn_rcpf(1.f + __builtin_amdgcn_exp2f(z)); }
__device__ __forceinline__ float wave_sum(float v) {
#pragma unroll
    for (int o = 1; o < 64; o <<= 1) v += __shfl_xor(v, o);
    return v;
}
__device__ __forceinline__ int otid() { int t = threadIdx.x; asm volatile("" : "+v"(t)); return t; }
__device__ __forceinline__ int obid() { int b = blockIdx.x; asm volatile("" : "+s"(b)); return b; }
#define LDS_WAIT() asm volatile("s_waitcnt lgkmcnt(0)" ::: "memory")

namespace pg8 {
constexpr int BM = 256, BK = 64, HALF = 128, HTB = HALF * BK * 2, STAGE_BYTES = 8 * HTB, NXCD = 8, WGM = 8;
__host__ __device__ __forceinline__ int lds_byte(int r, int c) { const int st = (r >> 4) * 2 + (c >> 5), rr = r & 15, cc = c & 31, ob = rr * 64 + cc * 2; return st * 1024 + (ob ^ (((ob >> 9) & 1) << 5)); }
__host__ __device__ __forceinline__ void stage_rc(int b, int& R, int& C) { const int st = b / 1024, sb = b % 1024, swz = sb ^ (((sb >> 9) & 1) << 5); R = (st >> 1) * 16 + swz / 64; C = (st & 1) * 32 + (swz % 64) / 2; }
__host__ __device__ __forceinline__ int perm32(int rho) { const int n = rho >> 4, i = rho & 15; return 8 * (i >> 2) + 4 * n + (i & 3); }

struct Unit { int pm, pn; };
struct Gemm { const bf16* A; const bf16* Bt; int M, N, K, lda; };

struct StaticOrder {
    int nM, nN, nwg, G, c;
    __host__ __device__ void init(int M_, int N_, int G_, int c_) { nM = M_ / BM; nN = N_ / BM; nwg = nM * nN; G = G_; c = c_; }
    __host__ __device__ bool next(int i, Unit& u) const {
        const long L = (long)i * G + c; if (L >= nwg) return false;
        int wgid = (int)L; { const int q = nwg / NXCD, r = nwg % NXCD, xcd = wgid % NXCD, off = wgid / NXCD; wgid = (xcd < r ? xcd * (q + 1) : r * (q + 1) + (xcd - r) * q) + off; }
        const int nig = WGM * nN, gid = wgid / nig, fm = gid * WGM, gsz = (nM - fm) < WGM ? (nM - fm) : WGM;
        u.pm = fm + ((wgid % nig) % gsz); u.pn = (wgid % nig) / gsz; return true;
    }
};

template <class Epi>
__device__ __forceinline__ void gemm_phase(LAS unsigned char* lds, const Gemm g, const StaticOrder& S, const Epi& E) {
    const int tid = otid(), wid = __builtin_amdgcn_readfirstlane(tid >> 6), lane = tid & 63, wr = wid >> 2, wc = wid & 3, fr = lane & 15, fq = lane >> 4;
    const int K = g.K, nt = K / BK, lda = g.lda;
    unsigned voffA[2], voffB[2];
#pragma unroll
    for (int i = 0; i < 2; ++i) { int R, C; stage_rc(tid * 16 + i * 8192, R, C); const int Rb = Epi::PERM ? ((R & ~31) + perm32(R & 31)) : R;
        voffA[i] = (unsigned)(R * lda + C) * 2u; voffB[i] = (unsigned)(Rb * K + C) * 2u; }
    const size_t kstep = (size_t)(BK * 2);
    const size_t hstepA = (size_t)HALF * lda * 2, hstepB = (size_t)HALF * K * 2;
    const size_t tstepA = 2 * hstepA, tstepB = 2 * hstepB;
    const unsigned ldsw = (unsigned)wid * 1024u;
    const int aoff = lds_byte(wr * 64 + fr, fq * 8), boff = lds_byte(wc * 32 + fr, fq * 8);
#define PG8_SA(b, h) (((b) * 2 + (h)) * HTB)
#define PG8_SB(b, h) ((4 + (b) * 2 + (h)) * HTB)
#define PG8_STAGE(bufoff, gbase, voff) do { _Pragma("unroll") for (int _i = 0; _i < 2; ++_i) \
        __builtin_amdgcn_global_load_lds((const unsigned*)((const char*)(gbase) + (voff)[_i]), (LAS unsigned*)(lds + (bufoff) + ldsw + _i * 8192), 16, 0, 0); } while (0)
#define PG8_LDA(dst, b, h) do { _Pragma("unroll") for (int m = 0; m < 4; ++m) _Pragma("unroll") for (int k = 0; k < 2; ++k) dst[m][k] = *(const LAS bf16x8*)(lds + PG8_SA(b, h) + aoff + m * 2048 + k * 1024); } while (0)
#define PG8_LDB(dst, b, h) do { _Pragma("unroll") for (int n = 0; n < 2; ++n) _Pragma("unroll") for (int k = 0; k < 2; ++k) dst[n][k] = *(const LAS bf16x8*)(lds + PG8_SB(b, h) + boff + n * 2048 + k * 1024); } while (0)
#define PG8_MMA(ai, bj, At, Bt) do { __builtin_amdgcn_s_setprio(1); _Pragma("unroll") for (int m = 0; m < 4; ++m) _Pragma("unroll") for (int n = 0; n < 2; ++n) _Pragma("unroll") for (int k = 0; k < 2; ++k) \
        acc[ai][bj][m][n] = __builtin_amdgcn_mfma_f32_16x16x32_bf16(Bt[n][k], At[m][k], acc[ai][bj][m][n], 0, 0, 0); __builtin_amdgcn_s_setprio(0); } while (0)
#define PG8_WAIT_V(n) asm volatile("s_waitcnt vmcnt(" #n ")" ::: "memory")
#define PG8_WAIT_L(n) asm volatile("s_waitcnt lgkmcnt(" #n ")" ::: "memory")
#define PG8_BAR __builtin_amdgcn_s_barrier()
#define PG8_SCHED __builtin_amdgcn_sched_barrier(0)
    Unit cur, nxt; int ui = 0;
    if (!S.next(0, cur)) return;
    f32x4 acc[2][2][4][2];
#pragma unroll
    for (int a = 0; a < 2; ++a)
#pragma unroll
        for (int b = 0; b < 2; ++b)
#pragma unroll
            for (int m = 0; m < 4; ++m)
#pragma unroll
                for (int n = 0; n < 2; ++n) acc[a][b][m][n] = (f32x4){0.f, 0.f, 0.f, 0.f};
    bf16x8 At[4][2], B0[2][2], B1[2][2];
    const char* cA = (const char*)g.A + (size_t)cur.pm * tstepA; const char* cB = (const char*)g.Bt + (size_t)cur.pn * tstepB;
    PG8_STAGE(PG8_SB(0, 0), cB, voffB); PG8_STAGE(PG8_SA(0, 0), cA, voffA); PG8_STAGE(PG8_SB(0, 1), cB + hstepB, voffB); PG8_STAGE(PG8_SA(0, 1), cA + hstepA, voffA);
    if (wr == 1) PG8_BAR;
    PG8_WAIT_V(4); PG8_BAR;
    PG8_STAGE(PG8_SB(1, 0), cB + kstep, voffB); PG8_STAGE(PG8_SA(1, 0), cA + kstep, voffA); PG8_STAGE(PG8_SB(1, 1), cB + hstepB + kstep, voffB);
    PG8_WAIT_V(6); PG8_BAR;
    for (;;) {
        const bool has_next = S.next(ui + 1, nxt);
        const char* nA = has_next ? (const char*)g.A + (size_t)nxt.pm * tstepA : cA; const char* nB = has_next ? (const char*)g.Bt + (size_t)nxt.pn * tstepB : cB;
        for (int t = 0; t < nt; t += 2) {
            const bool last = (t == nt - 2);
            const char* a1 = cA + (size_t)(t + 1) * kstep;
            const char* a2 = last ? nA : cA + (size_t)(t + 2) * kstep; const char* b2 = last ? nB : cB + (size_t)(t + 2) * kstep;
            const char* a3 = a2 + kstep; const char* b3 = b2 + kstep;
            PG8_LDB(B0, 0, 0); PG8_SCHED; PG8_LDA(At, 0, 0); PG8_STAGE(PG8_SA(1, 1), a1 + hstepA, voffA);
            PG8_WAIT_L(8); PG8_BAR; PG8_WAIT_L(0); PG8_MMA(0, 0, At, B0); PG8_BAR; PG8_SCHED;
            PG8_LDB(B1, 0, 1); PG8_STAGE(PG8_SB(0, 0), b2, voffB);
            PG8_BAR; PG8_WAIT_L(0); PG8_MMA(0, 1, At, B1); PG8_BAR;
            PG8_LDA(At, 0, 1); PG8_STAGE(PG8_SA(0, 0), a2, voffA);
            PG8_BAR; PG8_WAIT_L(0); PG8_MMA(1, 0, At, B0); PG8_BAR; PG8_SCHED;
            PG8_STAGE(PG8_SB(0, 1), b2 + hstepB, voffB);
            PG8_WAIT_V(6); PG8_BAR; PG8_MMA(1, 1, At, B1); PG8_BAR;
            PG8_LDB(B0, 1, 0); PG8_SCHED; PG8_LDA(At, 1, 0); PG8_STAGE(PG8_SA(0, 1), a2 + hstepA, voffA);
            PG8_WAIT_L(8); PG8_BAR; PG8_WAIT_L(0); PG8_MMA(0, 0, At, B0); PG8_BAR; PG8_SCHED;
            PG8_LDB(B1, 1, 1); PG8_STAGE(PG8_SB(1, 0), b3, voffB);
            PG8_BAR; PG8_WAIT_L(0); PG8_MMA(0, 1, At, B1); PG8_BAR;
            PG8_LDA(At, 1, 1); PG8_STAGE(PG8_SA(1, 0), a3, voffA);
            PG8_BAR; PG8_WAIT_L(0); PG8_MMA(1, 0, At, B0); PG8_BAR; PG8_SCHED;
            PG8_STAGE(PG8_SB(1, 1), b3 + hstepB, voffB);
            PG8_WAIT_V(6); PG8_BAR; PG8_MMA(1, 1, At, B1); PG8_BAR;
        }
        E(acc, cur, wr, wc, fr, fq, ui);
        if (!has_next) break;
#pragma unroll
        for (int a = 0; a < 2; ++a)
#pragma unroll
            for (int b = 0; b < 2; ++b)
#pragma unroll
                for (int m = 0; m < 4; ++m)
#pragma unroll
                    for (int n = 0; n < 2; ++n) acc[a][b][m][n] = (f32x4){0.f, 0.f, 0.f, 0.f};
        cur = nxt; cA = nA; cB = nB; ++ui;
    }
    PG8_WAIT_V(0);
    if (wr == 0) PG8_BAR;
    PG8_BAR;
#undef PG8_SA
#undef PG8_SB
#undef PG8_STAGE
#undef PG8_LDA
#undef PG8_LDB
#undef PG8_MMA
#undef PG8_WAIT_V
#undef PG8_WAIT_L
#undef PG8_BAR
#undef PG8_SCHED
}
}

#define XB_TMO      128
#define XB_XCNT(j)  (256  + 64 * (j))
#define XB_XSUB(j)  (1280 + 64 * (j))
#define XB_XGEN(j)  (2304 + 64 * (j))
#define XB_TOP      3328
#define XB_TOPGEN   3392
#define XCD_BAR_WORDS 3456
#define XB_SPIN_CAP (1u << 18)
__device__ __forceinline__ unsigned xb_ld(unsigned* p)              { return __hip_atomic_load(p, __ATOMIC_RELAXED, __HIP_MEMORY_SCOPE_AGENT); }
__device__ __forceinline__ unsigned xb_add(unsigned* p, unsigned v) { return __hip_atomic_fetch_add(p, v, __ATOMIC_RELAXED, __HIP_MEMORY_SCOPE_AGENT); }
__device__ __forceinline__ unsigned xb_xcc_id() { return (unsigned)__builtin_amdgcn_s_getreg((3 << 11) | 20) & 0xFu; }
#define XB_SPIN(cond, bar) do { unsigned _sp = 0; while (cond) { __builtin_amdgcn_s_sleep(1); \
    if ((++_sp & 255u) == 0u) { if (xb_ld(&(bar)[XB_TMO])) break; if (_sp > XB_SPIN_CAP) { atomicAdd(&(bar)[XB_TMO], 1u); break; } } } } while (0)
struct XcdBarrier { unsigned* bar; unsigned x; volatile LAS unsigned* st; };
__device__ __forceinline__ XcdBarrier xcd_barrier_post(unsigned* bar, volatile LAS unsigned* st) {
    XcdBarrier b; b.bar = bar; b.x = xb_xcc_id(); b.st = st;
    if (threadIdx.x == 0) (void)xb_add(&bar[XB_XCNT(b.x)], 1u);
    return b;
}
__device__ __forceinline__ void xcd_barrier_complete(unsigned* bar, unsigned x, unsigned& nloc, unsigned& nx) {
    const unsigned G = gridDim.x * gridDim.y * gridDim.z;
    unsigned sum, cnt, mine, sp = 0u;
    for (;;) {
        sum = 0u; cnt = 0u; mine = 0u;
#pragma unroll
        for (unsigned j = 0; j < 16; ++j) { const unsigned c = xb_ld(&bar[XB_XCNT(j)]); sum += c; cnt += (c > 0u) ? 1u : 0u; mine = (j == x) ? c : mine; }
        if (sum == G) break;
        __builtin_amdgcn_s_sleep(1);
        if ((++sp & 255u) == 0u) { if (xb_ld(&bar[XB_TMO])) break; if (sp > XB_SPIN_CAP) { atomicAdd(&bar[XB_TMO], 1u); break; } }
    }
    nloc = mine > 0u ? mine : 1u; nx = cnt > 0u ? cnt : 1u;
}
__device__ __forceinline__ void xcd_barrier(const XcdBarrier& b) {
    asm volatile("s_waitcnt vmcnt(0)" ::: "memory");
    __syncthreads();
    if (threadIdx.x == 0) {
        unsigned* bar = b.bar;
        __builtin_amdgcn_s_waitcnt(0);
        unsigned nloc = b.st[0], nx = b.st[1];
        if (nloc == 0u) { xcd_barrier_complete(bar, b.x, nloc, nx); b.st[0] = nloc; b.st[1] = nx; }
        const unsigned old = xb_add(&bar[XB_XSUB(b.x)], 1u);
        const unsigned gen = old / nloc;
        if (old + 1u == (gen + 1u) * nloc) {
            __builtin_amdgcn_fence(__ATOMIC_RELEASE, "agent");
            asm volatile("s_waitcnt vmcnt(0)" ::: "memory");
            const unsigned og = xb_add(&bar[XB_TOP], 1u);
            const unsigned tg = og / nx;
            if (og + 1u == (tg + 1u) * nx) xb_add(&bar[XB_TOPGEN], 1u);
            else XB_SPIN(xb_ld(&bar[XB_TOPGEN]) == tg, bar);
            __builtin_amdgcn_fence(__ATOMIC_ACQUIRE, "agent");
            xb_add(&bar[XB_XGEN(b.x)], 1u);
            asm volatile("s_waitcnt vmcnt(0)" ::: "memory");
        } else {
            XB_SPIN(xb_ld(&bar[XB_XGEN(b.x)]) == gen, bar);
            __builtin_amdgcn_fence(__ATOMIC_ACQUIRE, "agent");
            asm volatile("s_waitcnt vmcnt(0)" ::: "memory");
        }
    }
    __syncthreads();
}

template <int KS>
__device__ __forceinline__ f32x4 tile_mm(f32x4 acc, const LAS bf16* A, int lda, int m0, const LAS bf16* Bt, int ldb, int n0, int lane) {
    const int r = lane & 15, kg = lane >> 4;
#if NAIVE_MM
#pragma unroll 1
    for (int k = 0; k < KS * 32; ++k) {
        const float b = bf2f(Bt[(n0 + r) * ldb + k]);
#pragma unroll
        for (int q = 0; q < 4; ++q) acc[q] += bf2f(A[(m0 + 4 * kg + q) * lda + k]) * b;
    }
#else
#pragma unroll
    for (int ks = 0; ks < KS; ++ks) {
        const bf16x8 a = *(const LAS bf16x8*)(A + (m0 + r) * lda + ks * 32 + kg * 8);
        const bf16x8 b = *(const LAS bf16x8*)(Bt + (n0 + r) * ldb + ks * 32 + kg * 8);
        acc = __builtin_amdgcn_mfma_f32_16x16x32_bf16(a, b, acc, 0, 0, 0);
    }
#endif
    return acc;
}
template <int KS>
__device__ __forceinline__ f32x4 tile_mm_g(f32x4 acc, const bf16* A, int lda, int m0, const LAS bf16* Bt, int ldb, int n0, int lane) {
    const int r = lane & 15, kg = lane >> 4;
#if NAIVE_MM
#pragma unroll 1
    for (int k = 0; k < KS * 32; ++k) {
        const float b = bf2f(Bt[(n0 + r) * ldb + k]);
#pragma unroll
        for (int q = 0; q < 4; ++q) acc[q] += bf2f(A[(m0 + 4 * kg + q) * lda + k]) * b;
    }
#else
#pragma unroll
    for (int ks = 0; ks < KS; ++ks) {
        const bf16x8 a = *(const bf16x8*)(A + (size_t)(m0 + r) * lda + ks * 32 + kg * 8);
        const bf16x8 b = *(const LAS bf16x8*)(Bt + (n0 + r) * ldb + ks * 32 + kg * 8);
        acc = __builtin_amdgcn_mfma_f32_16x16x32_bf16(a, b, acc, 0, 0, 0);
    }
#endif
    return acc;
}

struct Args { const float* in[21]; float* out; unsigned char* ws; int ph_lo, ph_hi, one, pad; };
enum { I_XP = 0, I_XS, I_STATE, I_C, I_CCTX, I_ADAW, I_ADAB, I_NORMG, I_WIN, I_CONV, I_ALOG, I_DTB, I_DNG, I_SGUNG, I_SGUW, I_SGUB, I_POOLW, I_POOLS, I_FW, I_WOUT, I_FNG };

struct SeqGeo { int T, tseq0, seq_row0; };
__device__ __forceinline__ SeqGeo seq_geo(int sc) {
    SeqGeo g;
    if (sc < 128) { g.T = 256; g.tseq0 = (sc & 3) * 64; g.seq_row0 = (sc >> 2) * 256; }
    else { const int s = sc - 128; g.T = 4096; g.tseq0 = (s & 63) * 64; g.seq_row0 = M_CTX + (s >> 6) * 4096; }
    return g;
}
__device__ __forceinline__ int cond_of_row(int row) { return row < M_CTX ? 0 : 1 + ((row - M_CTX) >> 12); }

__device__ __forceinline__ int srccol(int n) {
    if (n < 256) return 768 + n;
    if (n < 512) return 1040 + (n - 256);
    if (n < 768) return 2064 + (n - 512);
    if (n < 1024) return 2576 + (n - 768);
    if (n < 1280) return 1296 + (n - 1024);
    if (n < 1536) return 1552 + (n - 1280);
    if (n < 2304) return -2;
    if (n < 3072) return n - 2304;
    if (n < 3088) return 1024 + (n - 3072);
    return -1;
}

__device__ __forceinline__ void phase_0a(const Args& a, LAS unsigned char* lds) {
    const int tid = otid(), lane = tid & 63, wave = tid >> 6, G = gridDim.x, bid = obid();
    float* MOD = (float*)(a.ws + WS_MOD);
    if (bid < 192) {
        LAS float* sc = (LAS float*)lds;
        LAS float* red = (LAS float*)(lds + 9 * 1024 * 4);
        for (int i = tid; i < 9 * 1024; i += NTHR) { const int j = i >> 10, k = i & 1023; const float c = (j == 0) ? a.in[I_CCTX][k] : a.in[I_C][(j - 1) * 1024 + k]; sc[i] = silu_f(c); }
        __syncthreads();
        for (int it = bid; it < 192; it += G) {
            const int l = it / 48, cb = it % 48, col = cb * 64 + lane;
            float acc[9];
#pragma unroll
            for (int j = 0; j < 9; ++j) acc[j] = 0.f;
            const float* wp = a.in[I_ADAW] + ((size_t)l * 1024 + wave * 128) * 3072 + col;
#pragma unroll 8
            for (int k = 0; k < 128; ++k) { const float wv = wp[(size_t)k * 3072];
#pragma unroll
                for (int j = 0; j < 9; ++j) acc[j] += sc[j * 1024 + wave * 128 + k] * wv; }
#pragma unroll
            for (int j = 0; j < 9; ++j) red[(wave * 9 + j) * 64 + lane] = acc[j];
            __syncthreads();
            for (int i = tid; i < 576; i += NTHR) { const int j = i >> 6, ln = i & 63; float s = 0.f;
#pragma unroll
                for (int w = 0; w < 8; ++w) s += red[(w * 9 + j) * 64 + ln];
                MOD[(l * 9 + j) * 3072 + cb * 64 + ln] = s + a.in[I_ADAB][l * 3072 + cb * 64 + ln]; }
            __syncthreads();
        }
    }
    const int gtid = bid * NTHR + tid, GT = G * NTHR;
    float* GM = (float*)(a.ws + WS_GMAT);
    for (int t = gtid; t < 4 * 4 * 2 * 4096; t += GT) {
        const int d = t & 63, c = (t >> 6) & 63, cs = (t >> 12) & 1, g = (t >> 13) & 3, l = t >> 15;
        const float* fw = a.in[I_FW] + ((size_t)(l * 4 + g) * 64) * 64 + d;
        float s = 0.f;
        for (int m = 0; m < 64; ++m) { const float ph = (float)((m * c) & 63) * (1.f / 32.f); s += (cs ? sinpif(ph) : cospif(ph)) * fw[m * 64]; }
        GM[t] = s * 0.125f;
    }
    bf16* W1T = (bf16*)(a.ws + WS_W1T);
    for (int t = gtid; t < 4 * 128 * N1; t += GT) {
        const int n = t % N1, k8 = (t / N1) & 127, l = t / (N1 * 128);
        const int sc = srccol(n);
        if (sc == -2) continue;
        u32x4 o = (u32x4){0u, 0u, 0u, 0u};
        if (sc >= 0) { const float* wp = a.in[I_WIN] + ((size_t)l * 1024 + k8 * 8) * PIN + sc;
            o.x = pk2(wp[0], wp[PIN]); o.y = pk2(wp[2 * PIN], wp[3 * PIN]); o.z = pk2(wp[4 * PIN], wp[5 * PIN]); o.w = pk2(wp[6 * PIN], wp[7 * PIN]); }
        *(u32x4*)(W1T + ((size_t)l * N1 + n) * 1024 + k8 * 8) = o;
    }
    bf16* W2T = (bf16*)(a.ws + WS_W2T);
    for (int t = gtid; t < 4 * 128 * 1024; t += GT) {
        const int n = t & 1023, k8 = (t >> 10) & 127, l = t >> 17;
        const float* wp = a.in[I_WOUT] + ((size_t)l * 1024 + k8 * 8) * 1024 + n;
        u32x4 o; o.x = pk2(wp[0], wp[1024]); o.y = pk2(wp[2048], wp[3072]); o.z = pk2(wp[4096], wp[5120]); o.w = pk2(wp[6144], wp[7168]);
        *(u32x4*)(W2T + ((size_t)l * 1024 + n) * 1024 + k8 * 8) = o;
    }
    float* POS = (float*)(a.ws + WS_POS);
    for (int t = gtid; t < 64 * 256; t += GT) { const int f = t & 255, i = t >> 8; const float fr = powf(10000.f, -(float)f / 256.f); const float ang = (float)i * fr;
        POS[t] = sinf(ang); POS[64 * 256 + t] = cosf(ang); }
    bf16* DFT = (bf16*)(a.ws + WS_DFT);
    for (int t = gtid; t < 256 * 512; t += GT) { const int tp = t & 511, k = t >> 9, tt = tp & 255; const float ph = (float)((k * tt) & 255) * (1.f / 128.f);
        DFT[t] = (bf16)f2bf((tp < 256 ? cospif(ph) : -sinpif(ph)) * (1.f / 16.f)); }
    bf16* M1 = (bf16*)(a.ws + WS_M1);
    for (int t = gtid; t < 128 * 128; t += GT) { const int kk = t & 127, m = t >> 7, k1 = m & 63, t1 = kk & 63; const float ph = (float)((k1 * t1) & 63) * (1.f / 32.f);
        const float c = cospif(ph), s = sinpif(ph); float v;
        if (m < 64) v = (kk < 64) ? c : -s; else v = (kk < 64) ? s : c;
        M1[t] = (bf16)f2bf(v); }
    bf16* M2 = (bf16*)(a.ws + WS_M2);
    for (int t = gtid; t < 64 * 128; t += GT) { const int kk = t & 127, k2 = t >> 7, t2 = kk & 63; const float ph = (float)((k2 * t2) & 63) * (1.f / 32.f);
        M2[t] = (bf16)f2bf((kk < 64 ? cospif(ph) : -sinpif(ph)) * (1.f / 64.f)); }
    float* TW = (float*)(a.ws + WS_TW);
    for (int t = gtid; t < 64 * 64; t += GT) { const int t2 = t & 63, k1 = t >> 6; const float ph = (float)(k1 * t2) * (1.f / 2048.f); TW[2 * t] = cospif(ph); TW[2 * t + 1] = sinpif(ph); }
}

__device__ __forceinline__ void phase_0b(const Args& a, LAS unsigned char* lds) {
    const int tid = otid(), lane = tid & 63, wave = tid >> 6, G = gridDim.x, bid = obid();
    const int gtid = bid * NTHR + tid, GT = G * NTHR;
    const float* MOD = (const float*)(a.ws + WS_MOD);
    const float* GM = (const float*)(a.ws + WS_GMAT);
    bf16* W1T = (bf16*)(a.ws + WS_W1T);
    for (int it = bid; it < 384; it += G) {
        const int kblk = it & 7, g = (it >> 3) & 3, kind = (it >> 5) % 3, l = it / 96;
        LAS bf16* Al = (LAS bf16*)lds; LAS bf16* Bl = Al + 128 * 72;
        const int base = (kind == 0 ? 1808 : 2320) + 64 * g;
        const float* Gm = (kind == 0) ? (a.in[I_POOLW] + (size_t)(l * 4 + g) * 4096) : (GM + (size_t)((l * 4 + g) * 2 + (kind - 1)) * 4096);
        {
            const int row = tid >> 2, c0 = (tid & 3) * 16;
            const f32x4* wp = (const f32x4*)(a.in[I_WIN] + ((size_t)l * 1024 + kblk * 128 + row) * PIN + base + c0);
            const f32x4 w0 = wp[0], w1 = wp[1], w2 = wp[2], w3 = wp[3];
            u32x4 o0, o1; o0.x = pk2(w0.x, w0.y); o0.y = pk2(w0.z, w0.w); o0.z = pk2(w1.x, w1.y); o0.w = pk2(w1.z, w1.w);
            o1.x = pk2(w2.x, w2.y); o1.y = pk2(w2.z, w2.w); o1.z = pk2(w3.x, w3.y); o1.w = pk2(w3.z, w3.w);
            *(LAS u32x4*)(Al + row * 72 + c0) = o0; *(LAS u32x4*)(Al + row * 72 + c0 + 8) = o1;
            const int c = tid >> 3, d0 = (tid & 7) * 8;
            const f32x4 g0 = *(const f32x4*)(Gm + c * 64 + d0), g1 = *(const f32x4*)(Gm + c * 64 + d0 + 4);
            Bl[(d0 + 0) * 72 + c] = (bf16)f2bf(g0.x); Bl[(d0 + 1) * 72 + c] = (bf16)f2bf(g0.y); Bl[(d0 + 2) * 72 + c] = (bf16)f2bf(g0.z); Bl[(d0 + 3) * 72 + c] = (bf16)f2bf(g0.w);
            Bl[(d0 + 4) * 72 + c] = (bf16)f2bf(g1.x); Bl[(d0 + 5) * 72 + c] = (bf16)f2bf(g1.y); Bl[(d0 + 6) * 72 + c] = (bf16)f2bf(g1.z); Bl[(d0 + 7) * 72 + c] = (bf16)f2bf(g1.w);
        }
        __syncthreads();
        {
            const int m0 = wave * 16, r = lane & 15, kg = lane >> 4;
#pragma unroll
            for (int nt = 0; nt < 4; ++nt) {
                const f32x4 acc = tile_mm<2>((f32x4){0.f, 0.f, 0.f, 0.f}, Al, 72, m0, Bl, 72, nt * 16, lane);
                u32x2 o; o.x = pk2(acc[0], acc[1]); o.y = pk2(acc[2], acc[3]);
                *(u32x2*)(W1T + ((size_t)l * N1 + 1536 + kind * 256 + g * 64 + nt * 16 + r) * 1024 + kblk * 128 + m0 + 4 * kg) = o;
            }
        }
        __syncthreads();
    }
    const float* POS = (const float*)(a.ws + WS_POS);
    bf16* HB = (bf16*)a.out;
    bf16* XB = (bf16*)a.out + (size_t)M * D;
    float* RSS = (float*)(a.ws + WS_RSS);
    for (int row = bid * NWAVES + wave; row < M; row += G * NWAVES) {
        f32x4 v[4];
        const int j = cond_of_row(row);
        if (row < M_CTX) {
            const f32x4* xr = (const f32x4*)(a.in[I_XP] + (size_t)row * D) + lane;
#pragma unroll
            for (int q = 0; q < 4; ++q) v[q] = xr[64 * q];
        } else {
            const int rs = row - M_CTX, t = rs & 4095, gr = t >> 6, gc = t & 63;
            const f32x4* xr = (const f32x4*)(a.in[I_XS] + (size_t)rs * D) + lane;
            const f32x4 p0 = *((const f32x4*)(POS + gr * 256) + lane), p1 = *((const f32x4*)(POS + 64 * 256 + gr * 256) + lane);
            const f32x4 p2 = *((const f32x4*)(POS + gc * 256) + lane), p3 = *((const f32x4*)(POS + 64 * 256 + gc * 256) + lane);
            v[0] = xr[0] + p0; v[1] = xr[64] + p1; v[2] = xr[128] + p2; v[3] = xr[192] + p3;
        }
        float ss = 0.f;
#pragma unroll
        for (int q = 0; q < 4; ++q) ss += (v[q].x * v[q].x + v[q].y * v[q].y) + (v[q].z * v[q].z + v[q].w * v[q].w);
        ss = wave_sum(ss);
        u32x2* xrow = (u32x2*)(XB + (size_t)row * D) + lane;
        u32x2* hrow = (u32x2*)(HB + (size_t)row * D) + lane;
#pragma unroll
        for (int q = 0; q < 4; ++q) {
            u32x2 xb; xb.x = pk2(v[q].x, v[q].y); xb.y = pk2(v[q].z, v[q].w);
            xrow[64 * q] = xb;
            const f32x4 ng = *((const f32x4*)(a.in[I_NORMG] + 256 * q) + lane);
            const f32x4 sc = *((const f32x4*)(MOD + (0 * 9 + j) * 3072 + 1024 + 256 * q) + lane);
            u32x2 h; h.x = pk2(v[q].x * ng.x * (1.f + sc.x), v[q].y * ng.y * (1.f + sc.y)); h.y = pk2(v[q].z * ng.z * (1.f + sc.z), v[q].w * ng.w * (1.f + sc.w));
            hrow[64 * q] = h;
        }
        if (lane < 16) RSS[(size_t)row * 16 + lane] = (lane == 0) ? ss : 0.f;
    }
}

__device__ __forceinline__ void phase_0c(const Args& a) {
    const int tid = otid(), lane = tid & 63, wave = tid >> 6, G = gridDim.x, bid = obid();
    const float* MOD = (const float*)(a.ws + WS_MOD);
    const bf16* W1T = (const bf16*)(a.ws + WS_W1T);
    float* SW = (float*)(a.ws + WS_SW);
    for (int it = bid * NWAVES + wave; it < 4 * N1; it += G * NWAVES) {
        const int l = it / N1, n = it % N1;
        const u32x4* wr = (const u32x4*)(W1T + ((size_t)l * N1 + n) * 1024) + lane * 2;
        const u32x4 w0 = wr[0], w1 = wr[1];
        float w[16];
        w[0] = bflo(w0.x); w[1] = bfhi(w0.x); w[2] = bflo(w0.y); w[3] = bfhi(w0.y); w[4] = bflo(w0.z); w[5] = bfhi(w0.z); w[6] = bflo(w0.w); w[7] = bfhi(w0.w);
        w[8] = bflo(w1.x); w[9] = bfhi(w1.x); w[10] = bflo(w1.y); w[11] = bfhi(w1.y); w[12] = bflo(w1.z); w[13] = bfhi(w1.z); w[14] = bflo(w1.w); w[15] = bfhi(w1.w);
#pragma unroll
        for (int j = 0; j < 9; ++j) {
            const f32x4* sp = (const f32x4*)(MOD + (l * 9 + j) * 3072) + lane * 4;
            float s = 0.f;
#pragma unroll
            for (int q = 0; q < 4; ++q) { const f32x4 sv = sp[q]; s += sv.x * w[4 * q] + sv.y * w[4 * q + 1] + sv.z * w[4 * q + 2] + sv.w * w[4 * q + 3]; }
            s = wave_sum(s);
            if (lane == 0) SW[(l * 9 + j) * N1 + n] = s;
        }
    }
}

struct Epi1 {
    static constexpr bool PERM = true;
    bf16* PB; float* BA; const float* RSS; const float* SW;
    int cheap; bf16* dumb;
    const LAS float* rtab;
    __device__ __forceinline__ void operator()(const f32x4 (&acc)[2][2][4][2], const pg8::Unit& u, int wr, int wc, int fr, int fq, int ui) const {
        const int pn = u.pn, j = u.pm < 32 ? 0 : 1 + ((u.pm - 32) >> 4);
        const int row0 = u.pm * 256 + wr * 64 + fr, cb = pn * 256 + wc * 32 + 8 * fq;
        if (cheap == 1) {
#pragma unroll
            for (int ai = 0; ai < 2; ++ai)
#pragma unroll
                for (int m = 0; m < 4; ++m)
#pragma unroll
                    for (int bj = 0; bj < 2; ++bj) { const f32x4 v0 = acc[ai][bj][m][0], v1 = acc[ai][bj][m][1];
                        u32x4 w; w.x = pk2(v0[0], v0[1]); w.y = pk2(v0[2], v0[3]); w.z = pk2(v1[0], v1[1]); w.w = pk2(v1[2], v1[3]);
                        *(u32x4*)(dumb + (size_t)((row0 + ai * 128 + m * 16) & 1023) * LDP + cb + bj * 128) = w; }
            return;
        }
        const int act = (pn == 0 || pn == 2 || pn == 3 || pn == 5) ? 1 : ((pn == 1 || pn == 4) ? 2 : 0);
        f32x4 bv[2][2];
#pragma unroll
        for (int bj = 0; bj < 2; ++bj)
#pragma unroll
            for (int n = 0; n < 2; ++n) bv[bj][n] = *(const f32x4*)(SW + j * N1 + cb + bj * 128 + 4 * n);
#pragma unroll
        for (int ai = 0; ai < 2; ++ai)
#pragma unroll
            for (int m = 0; m < 4; ++m) {
                const int row = row0 + ai * 128 + m * 16;
                const float rinv = rtab[ui * 256 + wr * 64 + fr + ai * 128 + m * 16];
#pragma unroll
                for (int bj = 0; bj < 2; ++bj) {
                    f32x4 v0 = acc[ai][bj][m][0] * rinv + bv[bj][0], v1 = acc[ai][bj][m][1] * rinv + bv[bj][1];
                    if (pn < 12) {
                        if (act == 1) {
#pragma unroll
                            for (int q = 0; q < 4; ++q) { v0[q] = silu_f(v0[q]); v1[q] = silu_f(v1[q]); }
                        } else if (act == 2) {
#pragma unroll
                            for (int q = 0; q < 4; ++q) { v0[q] = gelu_tanh_f(v0[q]); v1[q] = gelu_tanh_f(v1[q]); }
                        }
                        u32x4 w; w.x = pk2(v0[0], v0[1]); w.y = pk2(v0[2], v0[3]); w.z = pk2(v1[0], v1[1]); w.w = pk2(v1[2], v1[3]);
                        *(u32x4*)((cheap ? dumb + (size_t)(row & 1023) * LDP : PB + (size_t)row * LDP) + cb + bj * 128) = w;
                    } else if (bj == 0 && wc == 0 && fq < 2) {
                        f32x4* bp = (f32x4*)(BA + (size_t)row * 16 + 8 * fq); bp[0] = v0; bp[1] = v1;
                    }
                }
            }
    }
};
struct Epi2 {
    static constexpr bool PERM = true;
    bf16* XB; bf16* HB; float* RSS; const float* gate;
    const float* ng_next; const float* sc_next;
    unsigned char* dum; int dry;
    __device__ __forceinline__ void operator()(const f32x4 (&acc)[2][2][4][2], const pg8::Unit& u, int wr, int wc, int fr, int fq, int) const {
        const int pn = u.pn, j = u.pm < 32 ? 0 : 1 + ((u.pm - 32) >> 4);
        const int row0 = u.pm * 256 + wr * 64 + fr, cb = pn * 256 + wc * 32 + 8 * fq;
        f32x4 gv[2][2];
#pragma unroll
        for (int bj = 0; bj < 2; ++bj)
#pragma unroll
            for (int n = 0; n < 2; ++n) gv[bj][n] = *(const f32x4*)(gate + j * 3072 + cb + bj * 128 + 4 * n);
#pragma unroll
        for (int am = 0; am < 4; ++am) {
            const int ai = am >> 1;
            u32x4 xv[4][2];
            f32x4 gs[2][2];
#pragma unroll
            for (int m = 2 * (am & 1); m < 2 * (am & 1) + 2; ++m)
#pragma unroll
                for (int bj = 0; bj < 2; ++bj) xv[m][bj] = *(const u32x4*)(XB + (size_t)(row0 + ai * 128 + m * 16) * D + cb + bj * 128);
#pragma unroll
            for (int bj = 0; bj < 2; ++bj)
#pragma unroll
                for (int n = 0; n < 2; ++n) {
                    if (ng_next) { const f32x4 ng = *(const f32x4*)(ng_next + cb + bj * 128 + 4 * n), sc = *(const f32x4*)(sc_next + j * 3072 + cb + bj * 128 + 4 * n); gs[bj][n] = ng * (sc + 1.f); }
                    else gs[bj][n] = (f32x4){0.f, 0.f, 0.f, 0.f};
                }
#pragma unroll
            for (int m = 2 * (am & 1); m < 2 * (am & 1) + 2; ++m) {
                const int row = row0 + ai * 128 + m * 16;
                float ssq = 0.f;
#pragma unroll
                for (int bj = 0; bj < 2; ++bj) {
                    const u32x4 xq = xv[m][bj];
                    const f32x4 x0 = (f32x4){bflo(xq.x), bfhi(xq.x), bflo(xq.y), bfhi(xq.y)}, x1 = (f32x4){bflo(xq.z), bfhi(xq.z), bflo(xq.w), bfhi(xq.w)};
                    const f32x4 n0 = x0 + gv[bj][0] * acc[ai][bj][m][0], n1 = x1 + gv[bj][1] * acc[ai][bj][m][1];
                    u32x4 xw; xw.x = pk2(n0[0], n0[1]); xw.y = pk2(n0[2], n0[3]); xw.z = pk2(n1[0], n1[1]); xw.w = pk2(n1[2], n1[3]);
                    *(u32x4*)((dry ? (bf16*)dum + (size_t)(row & 1023) * D : XB + (size_t)row * D) + cb + bj * 128) = xw;
                    ssq += (n0.x * n0.x + n0.y * n0.y) + (n0.z * n0.z + n0.w * n0.w) + (n1.x * n1.x + n1.y * n1.y) + (n1.z * n1.z + n1.w * n1.w);
                    if (ng_next) { const f32x4 h0 = n0 * gs[bj][0], h1 = n1 * gs[bj][1];
                        u32x4 w; w.x = pk2(h0[0], h0[1]); w.y = pk2(h0[2], h0[3]); w.z = pk2(h1[0], h1[1]); w.w = pk2(h1[2], h1[3]);
                        *(u32x4*)((dry ? (bf16*)(dum + 4 * MiB) + (size_t)(row & 1023) * D : HB + (size_t)row * D) + cb + bj * 128) = w; }
                }
                ssq += __shfl_xor(ssq, 16); ssq += __shfl_xor(ssq, 32);
                if (fq == 0) (dry ? (float*)(dum + 8 * MiB) + (size_t)(row & 1023) * 16 : RSS + (size_t)row * 16)[pn * 4 + wc] = ssq;
            }
        }
    }
};

typedef short bf16x4 __attribute__((ext_vector_type(4)));
__device__ __forceinline__ f32x4 mfma16(bf16x4 a, bf16x4 b, f32x4 c) { return __builtin_amdgcn_mfma_f32_16x16x16bf16_1k(a, b, c, 0, 0, 0); }
__device__ __forceinline__ bf16x4 pack4(f32x4 v) { u32x2 w; w.x = pk2(v[0], v[1]); w.y = pk2(v[2], v[3]); return __builtin_bit_cast(bf16x4, w); }
__device__ __forceinline__ bf16x8 pack8(f32x4 lo, f32x4 hi) { u32x4 w; w.x = pk2(lo[0], lo[1]); w.y = pk2(lo[2], lo[3]); w.z = pk2(hi[0], hi[1]); w.w = pk2(hi[2], hi[3]); return __builtin_bit_cast(bf16x8, w); }
constexpr int PREP_ITEM = 5 * 4096;

__device__ __forceinline__ void prep_dinv(const LAS bf16* Ab_, LAS bf16* Dl, int lane) {
    const int blk = lane >> 4, c = lane & 15;
    unsigned ab = (unsigned)(size_t)(Ab_ + (16 * blk) * 72 + 16 * blk);
    asm volatile("" : "+v"(ab));
    const LAS bf16* Ab = (const LAS bf16*)(size_t)ab;
    float x[16];
#pragma unroll
    for (int ii = 0; ii < 16; ++ii) {
        float acc = (ii == c) ? 1.f : 0.f;
        const LAS u32x4* ar = (const LAS u32x4*)(Ab + ii * 72);
#pragma unroll
        for (int jq = 0; jq < 2; ++jq) {
            if (8 * jq < ii) {
                const u32x4 av = ar[jq];
                if (8 * jq + 0 < ii) acc += bflo(av.x) * x[8 * jq + 0];
                if (8 * jq + 1 < ii) acc += bfhi(av.x) * x[8 * jq + 1];
                if (8 * jq + 2 < ii) acc += bflo(av.y) * x[8 * jq + 2];
                if (8 * jq + 3 < ii) acc += bfhi(av.y) * x[8 * jq + 3];
                if (8 * jq + 4 < ii) acc += bflo(av.z) * x[8 * jq + 4];
                if (8 * jq + 5 < ii) acc += bfhi(av.z) * x[8 * jq + 5];
                if (8 * jq + 6 < ii) acc += bflo(av.w) * x[8 * jq + 6];
                if (8 * jq + 7 < ii) acc += bfhi(av.w) * x[8 * jq + 7];
            }
        }
        asm volatile("" : "+v"(acc) :: "memory");
        x[ii] = acc;
    }
#pragma unroll
    for (int ii = 0; ii < 16; ++ii) Dl[(blk * 16 + ii) * 24 + c] = (bf16)f2bf(x[ii]);
}

__device__ __forceinline__ void prep_item(const Args& a, LAS unsigned char* lds, int l, int sc, int h) {
    const int tid = otid(), lane = tid & 63, wave = __builtin_amdgcn_readfirstlane(tid >> 6);
    LAS float* qs = (LAS float*)lds;
    LAS float* ks = qs + 64 * 65;
    LAS float* vs = ks + 64 * 65;
    LAS bf16* Qb = (LAS bf16*)(lds + 49920);
    LAS bf16* Kb = (LAS bf16*)(lds + 59136);
    constexpr int PD = 30720;
    LAS unsigned char* dbase = lds + 68352;
    LAS float* beta = (LAS float*)(lds + 129792);
    LAS float* gcs = beta + 128;
    LAS float* egs = gcs + 128;
    LAS float* eks = egs + 128;
    const bf16* PB = (const bf16*)(a.ws + WS_PB);
    const float* BA = (const float*)(a.ws + WS_BA);
    const SeqGeo sg = seq_geo(sc);
    const int row0 = sc * 64;
    if (wave >= 6) {
        const int dir = wave - 6, tok = dir ? 63 - lane : lane;
        const float bl = BA[(size_t)(row0 + tok) * 16 + dir * 4 + h], al = BA[(size_t)(row0 + tok) * 16 + 8 + dir * 4 + h];
        const float bt = 1.f / (1.f + __expf(-bl));
        const float xx = al + a.in[I_DTB][(l * 2 + dir) * 4 + h];
        const float sp = xx > 20.f ? xx : log1pf(expf(xx));
        float g = -expf(a.in[I_ALOG][(l * 2 + dir) * 4 + h]) * sp;
#pragma unroll
        for (int o = 1; o < 64; o <<= 1) { const float t = __shfl_up(g, o); if (lane >= o) g += t; }
        const float gl = __shfl(g, 63);
        beta[dir * 64 + lane] = bt; gcs[dir * 64 + lane] = g; egs[dir * 64 + lane] = __expf(g); eks[dir * 64 + lane] = __expf(gl - g);
        if (lane == 63) ((float*)(a.ws + WS_PGL))[(sc * 4 + h) * 2 + dir] = __expf(g);
    } else {
        const int cg = tid % 24, seg = tid / 24, part = cg >> 3, d0 = (cg & 7) * 8;
        const int col = C_Q + part * 256 + h * 64 + d0, chan = part * 256 + h * 64 + d0;
        u32x4 xr[7];
#pragma unroll
        for (int i = 0; i < 7; ++i) { const int ts = sg.tseq0 + 4 * seg - 2 + i;
            xr[i] = (ts >= 0 && ts < sg.T) ? *(const u32x4*)(PB + (size_t)(sg.seq_row0 + ts) * LDP + col) : (u32x4){0u, 0u, 0u, 0u}; }
        f32x4 w0[4], w1[4];
#pragma unroll
        for (int jj = 0; jj < 4; ++jj) { w0[jj] = *(const f32x4*)(a.in[I_CONV] + (size_t)(l * 4 + jj) * 768 + chan); w1[jj] = *(const f32x4*)(a.in[I_CONV] + (size_t)(l * 4 + jj) * 768 + chan + 4); }
        float o[4][8];
#pragma unroll
        for (int j = 0; j < 4; ++j)
#pragma unroll
            for (int c = 0; c < 8; ++c) o[j][c] = 0.f;
#pragma unroll
        for (int i = 0; i < 7; ++i) {
            const float x0 = bflo(xr[i].x), x1 = bfhi(xr[i].x), x2 = bflo(xr[i].y), x3 = bfhi(xr[i].y), x4 = bflo(xr[i].z), x5 = bfhi(xr[i].z), x6 = bflo(xr[i].w), x7 = bfhi(xr[i].w);
#pragma unroll
            for (int j = 0; j < 4; ++j) { const int jj = i - j;
                if (jj >= 0 && jj < 4) {
                    o[j][0] += w0[jj].x * x0; o[j][1] += w0[jj].y * x1; o[j][2] += w0[jj].z * x2; o[j][3] += w0[jj].w * x3;
                    o[j][4] += w1[jj].x * x4; o[j][5] += w1[jj].y * x5; o[j][6] += w1[jj].z * x6; o[j][7] += w1[jj].w * x7; } }
        }
        LAS float* dst = (part == 0 ? qs : (part == 1 ? ks : vs)) + (4 * seg) * 65 + d0;
#pragma unroll
        for (int j = 0; j < 4; ++j)
#pragma unroll
            for (int c = 0; c < 8; ++c) dst[j * 65 + c] = silu_f(o[j][c]);
    }
    __syncthreads();
    {
        const int rowid = tid >> 2, seg = tid & 3, ar = rowid & 63;
        LAS float* p = (rowid < 64 ? qs : ks) + ar * 65 + seg * 16;
        float v[16]; float ss = 0.f;
#pragma unroll
        for (int c = 0; c < 16; ++c) { v[c] = p[c]; ss += v[c] * v[c]; }
        ss += __shfl_xor(ss, 1); ss += __shfl_xor(ss, 2);
        const float s = rsqrtf(ss + EPS) * (rowid < 64 ? 0.125f : 1.f);
#pragma unroll
        for (int c = 0; c < 16; ++c) { v[c] *= s; p[c] = v[c]; }
        LAS bf16* bp = (rowid < 64 ? Qb : Kb) + ar * 72 + seg * 16;
        u32x4 o0, o1; o0.x = pk2(v[0], v[1]); o0.y = pk2(v[2], v[3]); o0.z = pk2(v[4], v[5]); o0.w = pk2(v[6], v[7]);
        o1.x = pk2(v[8], v[9]); o1.y = pk2(v[10], v[11]); o1.z = pk2(v[12], v[13]); o1.w = pk2(v[14], v[15]);
        *(LAS u32x4*)bp = o0; *(LAS u32x4*)(bp + 8) = o1;
    }
    __syncthreads();
    {
        const int mt = wave >> 1, nh = wave & 1, m0 = mt * 16, r = lane & 15, kg = lane >> 4;
#pragma unroll
        for (int t = 0; t < 2; ++t) {
            const f32x4 KKa = tile_mm<2>((f32x4){0.f, 0.f, 0.f, 0.f}, Kb, 72, m0, Kb, 72, nh * 32 + 16 * t, lane);
            const f32x4 QKa = tile_mm<2>((f32x4){0.f, 0.f, 0.f, 0.f}, Qb, 72, m0, Kb, 72, nh * 32 + 16 * t, lane);
            const int bcol = nh * 32 + 16 * t + r;
#pragma unroll
            for (int dir = 0; dir < 2; ++dir) {
                LAS bf16* Ab = (LAS bf16*)(dbase + dir * PD); LAS bf16* QKl = Ab + 64 * 72;
                const int j = dir ? 63 - bcol : bcol; const float gj = gcs[dir * 64 + j];
#pragma unroll
                for (int q = 0; q < 4; ++q) {
                    const int arow = m0 + 4 * kg + q, i = dir ? 63 - arow : arow;
                    const float dec = (i >= j) ? __expf(gcs[dir * 64 + i] - gj) : 0.f;
                    const float av = (i > j) ? beta[dir * 64 + i] * KKa[q] * dec : 0.f;
                    Ab[i * 72 + j] = (bf16)f2bf(-av); QKl[i * 72 + j] = (bf16)f2bf(QKa[q] * dec);
                }
            }
        }
    }
    __syncthreads();
    bf16* PI0 = (bf16*)(a.ws + WS_PREP) + (size_t)((sc * 4 + h) * 2) * PREP_ITEM;
    if (wave < 2) prep_dinv((const LAS bf16*)(dbase + wave * PD), (LAS bf16*)(dbase + wave * PD + 3 * 9216), lane);
    for (int t = tid; t < 2048; t += NTHR) {
        const int dir = t >> 10, which = (t >> 9) & 1, rw = (t >> 3) & 63, sgp = t & 7, n0a = 32 * (sgp >> 2) + 4 * (sgp & 3), n0b = n0a + 16;
        float v[8];
        if (which == 0) {
            const int tok = dir ? 63 - rw : rw; const float e = egs[dir * 64 + rw];
#pragma unroll
            for (int c = 0; c < 4; ++c) { v[c] = qs[tok * 65 + n0a + c] * e; v[4 + c] = qs[tok * 65 + n0b + c] * e; }
        } else {
#pragma unroll
            for (int c = 0; c < 4; ++c) { const int ia = n0a + c, ib = n0b + c;
                v[c] = ks[(dir ? 63 - ia : ia) * 65 + rw] * eks[dir * 64 + ia]; v[4 + c] = ks[(dir ? 63 - ib : ib) * 65 + rw] * eks[dir * 64 + ib]; }
        }
        u32x4 o; o.x = pk2(v[0], v[1]); o.y = pk2(v[2], v[3]); o.z = pk2(v[4], v[5]); o.w = pk2(v[6], v[7]);
        *(u32x4*)(PI0 + (size_t)dir * PREP_ITEM + (1 + which) * 4096 + rw * 64 + sgp * 8) = o;
    }
    __syncthreads();
    {
        const int dir = wave >> 2, r = lane & 15, kg = lane >> 4, cc = 16 * (wave & 3) + r;
        const LAS bf16* Ab = (const LAS bf16*)(dbase + dir * PD); LAS bf16* Wl = (LAS bf16*)(dbase + dir * PD + 2 * 9216); const LAS bf16* Dl = (const LAS bf16*)(dbase + dir * PD + 3 * 9216);
        bf16* PI = PI0 + (size_t)dir * PREP_ITEM;
        f32x4 XU[4], XW[4];
#pragma unroll
        for (int b = 0; b < 4; ++b) {
            f32x4 TU, TW_;
#pragma unroll
            for (int q = 0; q < 4; ++q) { const int i = 16 * b + 4 * kg + q, tok = dir ? 63 - i : i;
                const float bt = beta[dir * 64 + i];
                TU[q] = bt * vs[tok * 65 + cc]; TW_[q] = bt * egs[dir * 64 + i] * ks[tok * 65 + cc]; }
#pragma unroll
            for (int m = 0; m < 4; ++m) if (m < b) {
                const bf16x4 af = *(const LAS bf16x4*)(Ab + (16 * b + r) * 72 + 16 * m + 4 * kg);
                TU = mfma16(af, pack4(XU[m]), TU); TW_ = mfma16(af, pack4(XW[m]), TW_);
            }
            const bf16x4 df = *(const LAS bf16x4*)(Dl + (b * 16 + r) * 24 + 4 * kg);
            XU[b] = mfma16(df, pack4(TU), (f32x4){0.f, 0.f, 0.f, 0.f});
            XW[b] = mfma16(df, pack4(TW_), (f32x4){0.f, 0.f, 0.f, 0.f});
            *(u32x2*)(PI + 4 * 4096 + cc * 64 + 16 * b + 4 * kg) = __builtin_bit_cast(u32x2, pack4(XU[b]));
#pragma unroll
            for (int q = 0; q < 4; ++q) Wl[(16 * b + 4 * kg + q) * 72 + cc] = (bf16)f2bf(XW[b][q]);
        }
    }
    __syncthreads();
    for (int t = tid; t < 2048; t += NTHR) {
        const int dir = t >> 10, which = (t >> 9) & 1, rw = (t >> 3) & 63, sgp = t & 7, n0a = 32 * (sgp >> 2) + 4 * (sgp & 3);
        const LAS bf16* src = (const LAS bf16*)(dbase + dir * PD + (which ? 1 : 2) * 9216) + rw * 72 + n0a;
        const u32x2 lo = *(const LAS u32x2*)src, hi = *(const LAS u32x2*)(src + 16);
        u32x4 o; o.x = lo.x; o.y = lo.y; o.z = hi.x; o.w = hi.y;
        *(u32x4*)(PI0 + (size_t)dir * PREP_ITEM + (which ? 3 : 0) * 4096 + rw * 64 + sgp * 8) = o;
    }
    __syncthreads();
}

__device__ __forceinline__ void sgu_item(const Args& a, LAS unsigned char* lds, int l, int ch, int g, int dry) {
    const int tid = otid(), lane = tid & 63, wave = tid >> 6;
    LAS bf16* Wl = (LAS bf16*)lds;
    LAS bf16* VT = Wl + 128 * 136;
    LAS float* rstd = (LAS float*)(VT + 64 * 136);
    bf16* PB = (bf16*)(a.ws + WS_PB);
    const int row0 = ch * 128;
    {
        const int q = tid >> 2, part = tid & 3;
        const u32x4* vp = (const u32x4*)(PB + (size_t)(row0 + q) * LDP + C_V + part * 64);
        float ss = 0.f;
#pragma unroll
        for (int i = 0; i < 8; ++i) { const u32x4 v = vp[i];
            const float f0 = bflo(v.x), f1 = bfhi(v.x), f2 = bflo(v.y), f3 = bfhi(v.y), f4 = bflo(v.z), f5 = bfhi(v.z), f6 = bflo(v.w), f7 = bfhi(v.w);
            ss += (f0 * f0 + f1 * f1) + (f2 * f2 + f3 * f3) + (f4 * f4 + f5 * f5) + (f6 * f6 + f7 * f7); }
        ss += __shfl_xor(ss, 1); ss += __shfl_xor(ss, 2);
        if (part == 0) rstd[q] = rsqrtf(ss * (1.f / 256.f) + EPS);
    }
    for (int t = tid; t < 128 * 16; t += NTHR) {
        const int p = t >> 4, q8 = t & 15;
        const f32x4* wp = (const f32x4*)(a.in[I_SGUW] + ((size_t)(l * 4 + g) * 128 + p) * 128 + q8 * 8);
        const f32x4 w0 = wp[0], w1 = wp[1];
        u32x4 o; o.x = pk2(w0.x, w0.y); o.y = pk2(w0.z, w0.w); o.z = pk2(w1.x, w1.y); o.w = pk2(w1.z, w1.w);
        *(LAS u32x4*)(Wl + p * 136 + q8 * 8) = o;
    }
    __syncthreads();
    for (int t = tid; t < 128 * 8; t += NTHR) {
        const int q = t >> 3, c0 = (t & 7) * 8;
        const u32x4 v = *(const u32x4*)(PB + (size_t)(row0 + q) * LDP + C_V + g * 64 + c0);
        const f32x4 g0 = *(const f32x4*)(a.in[I_SGUNG] + l * 256 + g * 64 + c0), g1 = *(const f32x4*)(a.in[I_SGUNG] + l * 256 + g * 64 + c0 + 4);
        const float r = rstd[q];
        VT[(c0 + 0) * 136 + q] = (bf16)f2bf(bflo(v.x) * r * g0.x); VT[(c0 + 1) * 136 + q] = (bf16)f2bf(bfhi(v.x) * r * g0.y);
        VT[(c0 + 2) * 136 + q] = (bf16)f2bf(bflo(v.y) * r * g0.z); VT[(c0 + 3) * 136 + q] = (bf16)f2bf(bfhi(v.y) * r * g0.w);
        VT[(c0 + 4) * 136 + q] = (bf16)f2bf(bflo(v.z) * r * g1.x); VT[(c0 + 5) * 136 + q] = (bf16)f2bf(bfhi(v.z) * r * g1.y);
        VT[(c0 + 6) * 136 + q] = (bf16)f2bf(bflo(v.w) * r * g1.z); VT[(c0 + 7) * 136 + q] = (bf16)f2bf(bfhi(v.w) * r * g1.w);
    }
    __syncthreads();
    {
        const int m0 = wave * 16, r = lane & 15, kg = lane >> 4;
#pragma unroll
        for (int nt = 0; nt < 4; ++nt) {
            f32x4 acc = (f32x4){0.f, 0.f, 0.f, 0.f};
            acc = tile_mm<4>(acc, Wl, 136, m0, VT, 136, nt * 16, lane);
#pragma unroll
            for (int q = 0; q < 4; ++q) {
                const int p = m0 + 4 * kg + q, c = nt * 16 + r;
                const float sv = acc[q] + a.in[I_SGUB][(l * 4 + g) * 128 + p];
                bf16* up = PB + (size_t)(row0 + p) * LDP + C_U + g * 64 + c;
                const float uu = bf2f(*up), gb = bf2f(PB[(size_t)(row0 + p) * LDP + C_GB + g * 64 + c]);
                if (dry) up = (bf16*)(a.ws + WS_DUM) + (size_t)((row0 + p) & 1023) * LDP + C_U + g * 64 + c;
                *up = (bf16)f2bf(uu * sv * gb);
            }
        }
    }
    __syncthreads();
}

__device__ __forceinline__ void pool_item(const Args& a, LAS unsigned char* lds, int l, int sc, int dry) {
    const int tid = otid();
    LAS bf16* xt = (LAS bf16*)lds;
    bf16* PB = (bf16*)(a.ws + WS_PB);
    const SeqGeo sg = seq_geo(sc);
    for (int t = tid; t < 80 * 32; t += NTHR) {
        const int r = t >> 5, c8 = t & 31, ts = sg.tseq0 - 8 + r;
        u32x4 v = (u32x4){0u, 0u, 0u, 0u};
        if (ts >= 0 && ts < sg.T) v = *(const u32x4*)(PB + (size_t)(sg.seq_row0 + ts) * LDP + C_XC + c8 * 8);
        *(LAS u32x4*)(xt + r * 264 + c8 * 8) = v;
    }
    __syncthreads();
    for (int t = tid; t < 64 * 32; t += NTHR) {
        const int tok = t >> 5, c8 = t & 31, gi = c8 >> 3, half = 1 << gi;
        const int ts = sg.tseq0 + tok;
        const int lo = (ts - half) < 0 ? 0 : ts - half, hi = (ts + half) > sg.T ? sg.T : ts + half;
        float s[8];
#pragma unroll
        for (int c = 0; c < 8; ++c) s[c] = 0.f;
        for (int tt = lo; tt < hi; ++tt) {
            const u32x4 v = *(const LAS u32x4*)(xt + (tt - sg.tseq0 + 8) * 264 + c8 * 8);
            s[0] += bflo(v.x); s[1] += bfhi(v.x); s[2] += bflo(v.y); s[3] += bfhi(v.y); s[4] += bflo(v.z); s[5] += bfhi(v.z); s[6] += bflo(v.w); s[7] += bfhi(v.w);
        }
        const float inv = 1.f / (float)(hi - lo);
        const u32x4 xv = *(const LAS u32x4*)(xt + (tok + 8) * 264 + c8 * 8);
        const float x0[8] = {bflo(xv.x), bfhi(xv.x), bflo(xv.y), bfhi(xv.y), bflo(xv.z), bfhi(xv.z), bflo(xv.w), bfhi(xv.w)};
        bf16* yp = PB + (size_t)(sg.seq_row0 + ts) * LDP + C_GC + c8 * 8;
        const u32x4 gv = *(const u32x4*)yp;
        const float gg[8] = {bflo(gv.x), bfhi(gv.x), bflo(gv.y), bfhi(gv.y), bflo(gv.z), bfhi(gv.z), bflo(gv.w), bfhi(gv.w)};
        const f32x4 p0 = *(const f32x4*)(a.in[I_POOLS] + l * 256 + c8 * 8), p1 = *(const f32x4*)(a.in[I_POOLS] + l * 256 + c8 * 8 + 4);
        const float ps[8] = {p0.x, p0.y, p0.z, p0.w, p1.x, p1.y, p1.z, p1.w};
        float y[8];
#pragma unroll
        for (int c = 0; c < 8; ++c) y[c] = (s[c] * inv - x0[c]) * ps[c] * gg[c];
        u32x4 o; o.x = pk2(y[0], y[1]); o.y = pk2(y[2], y[3]); o.z = pk2(y[4], y[5]); o.w = pk2(y[6], y[7]);
        if (dry) yp = (bf16*)(a.ws + WS_DUM) + (size_t)((sg.seq_row0 + ts) & 1023) * LDP + C_GC + c8 * 8;
        *(u32x4*)yp = o;
    }
    __syncthreads();
}

__device__ __forceinline__ void fctx_item(const Args& a, LAS unsigned char* lds, int b, int dblk, int dry) {
    const int tid = otid(), lane = tid & 63, wave = __builtin_amdgcn_readfirstlane(tid >> 6);
    LAS bf16* ZT = (LAS bf16*)lds;
    bf16* PB = (bf16*)(a.ws + WS_PB);
    const bf16* DFT = (const bf16*)(a.ws + WS_DFT);
    {
        u32x4 v[8];
#pragma unroll
        for (int i = 0; i < 8; ++i) { const int t = tid + NTHR * i, d8 = t & 7, ri = (t >> 3) & 1, tt = t >> 4;
            v[i] = *(const u32x4*)(PB + (size_t)(b * 256 + tt) * LDP + (ri ? C_QF : C_PF) + dblk * 64 + d8 * 8); }
#pragma unroll
        for (int i = 0; i < 8; ++i) { const int t = tid + NTHR * i, d8 = t & 7, ri = (t >> 3) & 1, tt = t >> 4;
            LAS bf16* dst = ZT + (d8 * 8) * 520 + ri * 256 + tt;
            dst[0 * 520] = (bf16)(v[i].x & 0xffffu); dst[1 * 520] = (bf16)(v[i].x >> 16); dst[2 * 520] = (bf16)(v[i].y & 0xffffu); dst[3 * 520] = (bf16)(v[i].y >> 16);
            dst[4 * 520] = (bf16)(v[i].z & 0xffffu); dst[5 * 520] = (bf16)(v[i].z >> 16); dst[6 * 520] = (bf16)(v[i].w & 0xffffu); dst[7 * 520] = (bf16)(v[i].w >> 16); }
    }
    __syncthreads();
    const int r = lane & 15, kg = lane >> 4;
#pragma unroll 1
    for (int mi = 0; mi < 2; ++mi) {
        const int m0 = wave * 32 + mi * 16;
        bf16 gdv[4][4];
#pragma unroll
        for (int nt = 0; nt < 4; ++nt)
#pragma unroll
            for (int q = 0; q < 4; ++q) gdv[nt][q] = PB[(size_t)(b * 256 + m0 + 4 * kg + q) * LDP + C_GD + dblk * 64 + nt * 16 + r];
        f32x4 acc[4];
#pragma unroll
        for (int nt = 0; nt < 4; ++nt) acc[nt] = (f32x4){0.f, 0.f, 0.f, 0.f};
#pragma unroll
        for (int kh = 0; kh < 2; ++kh) {
            bf16x8 af[8];
#pragma unroll
            for (int ksx = 0; ksx < 8; ++ksx) af[ksx] = *(const bf16x8*)(DFT + (size_t)(m0 + r) * 512 + (kh * 8 + ksx) * 32 + kg * 8);
#pragma unroll
            for (int nt = 0; nt < 4; ++nt) {
#pragma unroll
                for (int ksx = 0; ksx < 8; ++ksx) {
                    const bf16x8 bfr = *(const LAS bf16x8*)(ZT + (nt * 16 + r) * 520 + (kh * 8 + ksx) * 32 + kg * 8);
                    acc[nt] = __builtin_amdgcn_mfma_f32_16x16x32_bf16(af[ksx], bfr, acc[nt], 0, 0, 0);
                }
                __builtin_amdgcn_sched_barrier(0);
            }
        }
#pragma unroll
        for (int nt = 0; nt < 4; ++nt)
#pragma unroll
            for (int q = 0; q < 4; ++q) {
                const int k = m0 + 4 * kg + q, d = nt * 16 + r;
                bf16* yp = (dry ? (bf16*)(a.ws + WS_DUM) + (size_t)((b * 256 + k) & 1023) * LDP : PB + (size_t)(b * 256 + k) * LDP) + C_GD + dblk * 64 + d;
                *yp = (bf16)f2bf(acc[nt][q] * bf2f(gdv[nt][q]));
            }
    }
    __syncthreads();
}

__device__ __forceinline__ void fsmp_item(const Args& a, LAS unsigned char* lds, int b, int ds, int dry) {
    const int tid = otid(), lane = tid & 63, wave = __builtin_amdgcn_readfirstlane(tid >> 6);
    LAS bf16* ZT = (LAS bf16*)lds;
    LAS bf16* B2 = ZT + 256 * 136;
    bf16* PB = (bf16*)(a.ws + WS_PB);
    const bf16* M1 = (const bf16*)(a.ws + WS_M1);
    const bf16* M2 = (const bf16*)(a.ws + WS_M2);
    const int d0 = ds * 4;
    const size_t rowb = (size_t)M_CTX + (size_t)b * 4096;
    const int r = lane & 15, kg = lane >> 4, mp = wave & 3, nb = wave >> 2;
    {
        u32x2 v[16];
#pragma unroll
        for (int i = 0; i < 16; ++i) { const int t = tid + NTHR * i, ri = t & 1, tt = t >> 1;
            v[i] = *(const u32x2*)(PB + (rowb + tt) * LDP + (ri ? C_QF : C_PF) + d0); }
#pragma unroll
        for (int i = 0; i < 16; ++i) { const int t = tid + NTHR * i, ri = t & 1, tt = t >> 1, t1 = tt >> 6, t2 = tt & 63;
            LAS bf16* dst = ZT + (t2 * 4) * 136 + ri * 64 + t1;
            dst[0] = (bf16)(v[i].x & 0xffffu); dst[136] = (bf16)(v[i].x >> 16); dst[272] = (bf16)(v[i].y & 0xffffu); dst[408] = (bf16)(v[i].y >> 16); }
    }
    bf16x8 aRe[4], aIm[4], a2[4];
#pragma unroll
    for (int ksx = 0; ksx < 4; ++ksx) {
        aRe[ksx] = *(const bf16x8*)(M1 + (16 * mp + r) * 128 + ksx * 32 + kg * 8);
        aIm[ksx] = *(const bf16x8*)(M1 + (64 + 16 * mp + r) * 128 + ksx * 32 + kg * 8);
        a2[ksx] = *(const bf16x8*)(M2 + (16 * mp + r) * 128 + ksx * 32 + kg * 8);
    }
    bf16 gdv[8][4];
#pragma unroll
    for (int jb = 0; jb < 8; ++jb) { const int n = 16 * (nb + 2 * jb) + r, k1 = n >> 2, dd = n & 3;
#pragma unroll
        for (int q = 0; q < 4; ++q) gdv[jb][q] = PB[(rowb + k1 + 64 * (16 * mp + 4 * kg + q)) * LDP + C_GD + d0 + dd]; }
    __syncthreads();
#pragma unroll 2
    for (int jb = 0; jb < 8; ++jb) {
        const int nt = nb + 2 * jb;
        f32x4 ar = (f32x4){0.f, 0.f, 0.f, 0.f}, ai = (f32x4){0.f, 0.f, 0.f, 0.f};
#pragma unroll
        for (int ksx = 0; ksx < 4; ++ksx) {
            const bf16x8 z = *(const LAS bf16x8*)(ZT + (16 * nt + r) * 136 + ksx * 32 + kg * 8);
            ar = __builtin_amdgcn_mfma_f32_16x16x32_bf16(aRe[ksx], z, ar, 0, 0, 0);
            ai = __builtin_amdgcn_mfma_f32_16x16x32_bf16(aIm[ksx], z, ai, 0, 0, 0);
        }
        const int n = 16 * nt + r, t2 = n >> 2, dd = n & 3;
#pragma unroll
        for (int q = 0; q < 4; ++q) {
            const int k1 = 16 * mp + 4 * kg + q;
            const float rev = (float)((k1 * t2) & 4095) * (1.f / 4096.f);
            const float cw = __builtin_amdgcn_cosf(rev), sw = __builtin_amdgcn_sinf(rev);
            const float xr = ar[q] * cw - ai[q] * sw, xi = ar[q] * sw + ai[q] * cw;
            B2[(k1 * 4 + dd) * 136 + t2] = (bf16)f2bf(xr);
            B2[(k1 * 4 + dd) * 136 + 64 + t2] = (bf16)f2bf(xi);
        }
    }
    __syncthreads();
#pragma unroll 2
    for (int jb = 0; jb < 8; ++jb) {
        const int nt = nb + 2 * jb;
        f32x4 acc = (f32x4){0.f, 0.f, 0.f, 0.f};
#pragma unroll
        for (int ksx = 0; ksx < 4; ++ksx) {
            const bf16x8 z = *(const LAS bf16x8*)(B2 + (16 * nt + r) * 136 + ksx * 32 + kg * 8);
            acc = __builtin_amdgcn_mfma_f32_16x16x32_bf16(a2[ksx], z, acc, 0, 0, 0);
        }
        const int n = 16 * nt + r, k1 = n >> 2, dd = n & 3;
#pragma unroll
        for (int q = 0; q < 4; ++q) {
            const int k2 = 16 * mp + 4 * kg + q, kk = k1 + 64 * k2;
            bf16* yp = (dry ? (bf16*)(a.ws + WS_DUM) + (size_t)(kk & 1023) * LDP : PB + (rowb + kk) * LDP) + C_GD + d0 + dd;
            *yp = (bf16)f2bf(acc[q] * bf2f(gdv[jb][q]));
        }
    }
    __syncthreads();
}

constexpr int SC_MAT = 64 * 72 * 2;
constexpr int SC_BUF = 5 * SC_MAT + 16;
constexpr int SC_OT = 2 * SC_BUF;
__device__ __forceinline__ void scan_item(const Args& a, LAS unsigned char* lds, int l, int seq, int h, int dir) {
    const int tid = otid(), lane = tid & 63, wave = __builtin_amdgcn_readfirstlane(tid >> 6);
    bf16* PB = (bf16*)(a.ws + WS_PB);
    const int nch = seq < 32 ? 4 : 64;
    const int sc0 = seq < 32 ? seq * 4 : 128 + (seq - 32) * 64;
    const int r = lane & 15, kg = lane >> 4;
    if (wave >= 4) {
        const int ht = tid - 256;
        u32x4 pre[10]; float pgl = 0.f;
#define SC_ISSUE(ss) do { const int c_ = dir ? nch - 1 - (ss) : (ss); const size_t pid_ = (size_t)((sc0 + c_) * 4 + h) * 2 + dir; \
            const u32x4* src_ = (const u32x4*)((const bf16*)(a.ws + WS_PREP) + pid_ * PREP_ITEM) + ht; \
            _Pragma("unroll") for (int i_ = 0; i_ < 10; ++i_) pre[i_] = src_[256 * i_]; \
            pgl = ((const float*)(a.ws + WS_PGL))[pid_]; } while (0)
#define SC_WRITE(bb) do { LAS unsigned char* B_ = lds + (bb) * SC_BUF; \
            _Pragma("unroll") for (int i_ = 0; i_ < 10; ++i_) { const int ch_ = ht + 256 * i_; \
                *(LAS u32x4*)(B_ + (ch_ >> 9) * SC_MAT + ((ch_ >> 3) & 63) * 144 + (ch_ & 7) * 16) = pre[i_]; } \
            if (ht == 0) *(LAS float*)(B_ + 5 * SC_MAT) = pgl; } while (0)
#define SC_OSTORE(ss) do { const int c_ = dir ? nch - 1 - (ss) : (ss); const LAS unsigned char* O_ = lds + SC_OT + ((ss) & 1) * SC_MAT; \
            _Pragma("unroll") for (int i_ = 0; i_ < 2; ++i_) { const int ch_ = ht + 256 * i_, rw_ = ch_ >> 3, c8_ = ch_ & 7; \
                const u32x4 v_ = *(const LAS u32x4*)(O_ + rw_ * 144 + c8_ * 16); \
                *(u32x4*)(PB + (size_t)((sc0 + c_) * 64 + (dir ? 63 - rw_ : rw_)) * LDP + (dir ? C_K : C_Q) + h * 64 + c8_ * 8) = v_; } } while (0)
        SC_ISSUE(0);
        SC_WRITE(0);
        { const int sn = nch > 1 ? 1 : 0; SC_ISSUE(sn); }
        __syncthreads();
#pragma unroll 1
        for (int s = 0; s < nch; ++s) {
            SC_WRITE((s + 1) & 1);
            if (s > 0) SC_OSTORE(s - 1);
            { const int sn = (s + 2 < nch) ? s + 2 : nch - 1; SC_ISSUE(sn); }
            __syncthreads();
        }
        SC_OSTORE(nch - 1);
#undef SC_ISSUE
#undef SC_WRITE
#undef SC_OSTORE
    } else {
        const int e = 16 * wave + r;
        f32x4 S[4];
#pragma unroll
        for (int t = 0; t < 4; ++t)
#pragma unroll
            for (int q = 0; q < 4; ++q) {
                const int d = 16 * t + 4 * kg + q;
                S[t][q] = (seq < 32) ? 0.f : a.in[I_STATE][((size_t)(((seq - 32) * 4 + l) * 2 + dir) * 4 + h) * 4096 + d * 64 + e];
            }
        __syncthreads();
#pragma unroll 1
        for (int s = 0; s < nch; ++s) {
            const LAS unsigned char* B = lds + (s & 1) * SC_BUF;
            const LAS bf16* Wm = (const LAS bf16*)B; const LAS bf16* Qd = Wm + 64 * 72; const LAS bf16* KdT = Qd + 64 * 72; const LAS bf16* QKm = KdT + 64 * 72; const LAS bf16* UT = QKm + 64 * 72;
            const float egl = *(const LAS float*)(B + 5 * SC_MAT);
            LAS bf16* OT = (LAS bf16*)(lds + SC_OT + (s & 1) * SC_MAT);
            bf16x8 bS[2];
            bS[0] = pack8(S[0], S[1]); bS[1] = pack8(S[2], S[3]);
            f32x4 a1[4], oo[4];
#pragma unroll
            for (int t = 0; t < 4; ++t) {
                a1[t] = (f32x4){0.f, 0.f, 0.f, 0.f}; oo[t] = (f32x4){0.f, 0.f, 0.f, 0.f};
#pragma unroll
                for (int ksx = 0; ksx < 2; ++ksx) {
                    const bf16x8 wf = *(const LAS bf16x8*)(Wm + (16 * t + r) * 72 + ksx * 32 + kg * 8);
                    const bf16x8 qf = *(const LAS bf16x8*)(Qd + (16 * t + r) * 72 + ksx * 32 + kg * 8);
                    a1[t] = __builtin_amdgcn_mfma_f32_16x16x32_bf16(wf, bS[ksx], a1[t], 0, 0, 0);
                    oo[t] = __builtin_amdgcn_mfma_f32_16x16x32_bf16(qf, bS[ksx], oo[t], 0, 0, 0);
                }
            }
            f32x4 vn[4];
#pragma unroll
            for (int t = 0; t < 4; ++t) {
                const u32x2 uu = *(const LAS u32x2*)(UT + e * 72 + 16 * t + 4 * kg);
                vn[t][0] = bflo(uu.x) - a1[t][0]; vn[t][1] = bfhi(uu.x) - a1[t][1]; vn[t][2] = bflo(uu.y) - a1[t][2]; vn[t][3] = bfhi(uu.y) - a1[t][3];
            }
            bf16x8 bV[2];
            bV[0] = pack8(vn[0], vn[1]); bV[1] = pack8(vn[2], vn[3]);
#pragma unroll
            for (int t = 0; t < 4; ++t) {
                f32x4 as = (f32x4){0.f, 0.f, 0.f, 0.f};
#pragma unroll
                for (int ksx = 0; ksx < 2; ++ksx) {
                    const bf16x8 kf = *(const LAS bf16x8*)(QKm + (16 * t + r) * 72 + ksx * 32 + kg * 8);
                    const bf16x8 df = *(const LAS bf16x8*)(KdT + (16 * t + r) * 72 + ksx * 32 + kg * 8);
                    oo[t] = __builtin_amdgcn_mfma_f32_16x16x32_bf16(kf, bV[ksx], oo[t], 0, 0, 0);
                    as = __builtin_amdgcn_mfma_f32_16x16x32_bf16(df, bV[ksx], as, 0, 0, 0);
                }
                S[t] = S[t] * egl + as;
            }
#pragma unroll
            for (int t = 0; t < 4; ++t)
#pragma unroll
                for (int q = 0; q < 4; ++q) OT[(16 * t + 4 * kg + q) * 72 + e] = (bf16)f2bf(oo[t][q]);
            __syncthreads();
        }
        if (seq < 32) {
            float* ns = a.out + (size_t)M * D + ((size_t)((seq * 4 + l) * 2 + dir) * 4 + h) * 4096;
#pragma unroll
            for (int t = 0; t < 4; ++t)
#pragma unroll
                for (int q = 0; q < 4; ++q) ns[(16 * t + 4 * kg + q) * 64 + e] = S[t][q];
        }
    }
    __syncthreads();
}

__device__ __forceinline__ void phase_combine(const Args& a, int l, int dry) {
    const int tid = otid(), lane = tid & 63, wave = tid >> 6, G = gridDim.x, bid = obid();
    bf16* PB = (bf16*)(a.ws + WS_PB);
    const f32x4 ng = *(const f32x4*)(a.in[I_DNG] + l * 64 + (lane & 15) * 4);
    for (int row = bid * NWAVES + wave; row < M; row += G * NWAVES) {
        bf16* rp = PB + (size_t)row * LDP;
        const u32x2 of = *((const u32x2*)(rp + C_Q) + lane), ob = *((const u32x2*)(rp + C_K) + lane), ga = *((const u32x2*)(rp + C_GA) + lane);
        const float o0 = bflo(of.x) + bflo(ob.x), o1 = bfhi(of.x) + bfhi(ob.x), o2 = bflo(of.y) + bflo(ob.y), o3 = bfhi(of.y) + bfhi(ob.y);
        float ss = (o0 * o0 + o1 * o1) + (o2 * o2 + o3 * o3);
        ss += __shfl_xor(ss, 1); ss += __shfl_xor(ss, 2); ss += __shfl_xor(ss, 4); ss += __shfl_xor(ss, 8);
        const float rinv = rsqrtf(ss * (1.f / 64.f) + EPS);
        u32x2 y; y.x = pk2(o0 * rinv * ng.x * bflo(ga.x), o1 * rinv * ng.y * bfhi(ga.x)); y.y = pk2(o2 * rinv * ng.z * bflo(ga.y), o3 * rinv * ng.w * bfhi(ga.y));
        if (dry) rp = (bf16*)(a.ws + WS_DUM) + (size_t)(row & 1023) * LDP;
        *((u32x2*)(rp + C_GA) + lane) = y;
    }
}

constexpr int PF_ROWS = 10;
struct FinalRegs { u32x4 x[PF_ROWS][2]; float rinv[PF_ROWS]; };
__device__ __forceinline__ void final_load(const Args& a, FinalRegs& R, int rnd) {
    const int tid = otid(), lane = tid & 63, wave = tid >> 6, G = gridDim.x, bid = obid();
    const float* RSS = (const float*)(a.ws + WS_RSS);
    const bf16* XB = (const bf16*)a.out + (size_t)M * D;
#pragma unroll
    for (int i = 0; i < PF_ROWS; ++i) {
        const int row = bid * NWAVES + wave + G * NWAVES * (i + PF_ROWS * rnd);
        if (row < M) {
            const u32x4* xr = (const u32x4*)(XB + (size_t)row * D) + lane * 2;
            R.x[i][0] = xr[0]; R.x[i][1] = xr[1];
            float p = (lane < 16) ? RSS[(size_t)row * 16 + lane] : 0.f;
            p += __shfl_xor(p, 1); p += __shfl_xor(p, 2); p += __shfl_xor(p, 4); p += __shfl_xor(p, 8);
            R.rinv[i] = rsqrtf(__shfl(p, 0) * (1.f / 1024.f) + EPS);
        } else { R.x[i][0] = (u32x4){0u, 0u, 0u, 0u}; R.x[i][1] = R.x[i][0]; R.rinv[i] = 0.f; }
    }
}
__device__ __forceinline__ void final_store(const Args& a, const FinalRegs& R, int rnd) {
    const int tid = otid(), lane = tid & 63, wave = tid >> 6, G = gridDim.x, bid = obid();
    f32x4 fg[4];
#pragma unroll
    for (int q = 0; q < 4; ++q) fg[q] = *((const f32x4*)(a.in[I_FNG]) + lane * 4 + q);
#pragma unroll
    for (int i = 0; i < PF_ROWS; ++i) {
        const int row = bid * NWAVES + wave + G * NWAVES * (i + PF_ROWS * rnd);
        if (row < M) {
            f32x4* orow = (f32x4*)(a.out + (size_t)row * D) + lane * 4;
            const u32x4 x0 = R.x[i][0], x1 = R.x[i][1]; const float ri = R.rinv[i];
            orow[0] = (f32x4){bflo(x0.x), bfhi(x0.x), bflo(x0.y), bfhi(x0.y)} * ri * fg[0];
            orow[1] = (f32x4){bflo(x0.z), bfhi(x0.z), bflo(x0.w), bfhi(x0.w)} * ri * fg[1];
            orow[2] = (f32x4){bflo(x1.x), bfhi(x1.x), bflo(x1.y), bfhi(x1.y)} * ri * fg[2];
            orow[3] = (f32x4){bflo(x1.z), bfhi(x1.z), bflo(x1.w), bfhi(x1.w)} * ri * fg[3];
        }
    }
}

__device__ __forceinline__ void skinny_ba(const Args& a, int l, int pm) {
    const int tid = otid(), lane = tid & 63, wave = __builtin_amdgcn_readfirstlane(tid >> 6), r = lane & 15, kg = lane >> 4;
    const bf16* A = (const bf16*)a.out + (size_t)(pm * 256 + wave * 32 + r) * 1024 + kg * 8;
    const bf16* Bw = (const bf16*)(a.ws + WS_W1T) + ((size_t)l * N1 + 3072 + r) * 1024 + kg * 8;
    f32x4 acc0 = (f32x4){0.f, 0.f, 0.f, 0.f}, acc1 = acc0;
    bf16x8 a0[2][4], a1[2][4], bw[2][4];
#define SK_LOAD(buf, kc_) do { _Pragma("unroll") for (int ksx = 0; ksx < 4; ++ksx) { const int k = ((kc_) * 4 + ksx) * 32; \
        a0[buf][ksx] = *(const bf16x8*)(A + k); a1[buf][ksx] = *(const bf16x8*)(A + 16 * 1024 + k); bw[buf][ksx] = *(const bf16x8*)(Bw + k); } } while (0)
#define SK_MMA(buf) do { _Pragma("unroll") for (int ksx = 0; ksx < 4; ++ksx) { \
        acc0 = __builtin_amdgcn_mfma_f32_16x16x32_bf16(a0[buf][ksx], bw[buf][ksx], acc0, 0, 0, 0); \
        acc1 = __builtin_amdgcn_mfma_f32_16x16x32_bf16(a1[buf][ksx], bw[buf][ksx], acc1, 0, 0, 0); } } while (0)
    SK_LOAD(0, 0); SK_LOAD(1, 1);
    SK_MMA(0); SK_LOAD(0, 2); SK_MMA(1); SK_LOAD(1, 3); SK_MMA(0); SK_LOAD(0, 4); SK_MMA(1); SK_LOAD(1, 5);
    SK_MMA(0); SK_LOAD(0, 6); SK_MMA(1); SK_LOAD(1, 7); SK_MMA(0); SK_MMA(1);
#undef SK_LOAD
#undef SK_MMA
    const int j = pm < 32 ? 0 : 1 + ((pm - 32) >> 4);
    const float sw = ((const float*)(a.ws + WS_SW))[((size_t)l * 9 + j) * N1 + 3072 + r];
    const float* RSS = (const float*)(a.ws + WS_RSS);
    float* BA = (float*)(a.ws + WS_BA);
#pragma unroll
    for (int mi = 0; mi < 2; ++mi)
#pragma unroll
        for (int q = 0; q < 4; ++q) {
            const int row = pm * 256 + wave * 32 + mi * 16 + 4 * kg + q;
            const f32x4* rp = (const f32x4*)(RSS + (size_t)row * 16);
            const f32x4 r0 = rp[0], r1 = rp[1], r2 = rp[2], r3 = rp[3];
            const float ss = ((r0.x + r0.y) + (r0.z + r0.w)) + ((r1.x + r1.y) + (r1.z + r1.w)) + ((r2.x + r2.y) + (r2.z + r2.w)) + ((r3.x + r3.y) + (r3.z + r3.w));
            const float rinv = rsqrtf(ss * (1.f / 1024.f) + EPS);
            BA[(size_t)row * 16 + r] = (mi ? acc1[q] : acc0[q]) * rinv + sw;
        }
}

constexpr int NPHASE = 24;
__global__ void __launch_bounds__(NTHR, 2) fwd_kernel(Args args) {
    extern __shared__ __attribute__((aligned(16))) unsigned char lds_raw[];
    LAS unsigned char* lds = (LAS unsigned char*)lds_raw;
#if !MK_MULTI
    volatile LAS unsigned* MISC = (volatile LAS unsigned*)(lds + MISC_OFF);
    if (threadIdx.x < 64) MISC[threadIdx.x] = 0u;
    __syncthreads();
    XcdBarrier bar = xcd_barrier_post((unsigned*)(args.ws + WS_CTL) + CW_BAR, MISC + 8);
#define GRID_BAR() xcd_barrier(bar)
#else
#define GRID_BAR() do { } while (0)
#endif
    const int G = gridDim.x, bid = blockIdx.x;
    for (int pass = (PRE_HI > 0 ? 0 : 1); pass < 2; ++pass)
    for (int ph = args.ph_lo; ph < (pass == 0 ? args.pad : args.ph_hi); ++ph) {
        if (ph == 0) { if (EN(0)) for (int rep = 0; rep < REP_P0; ++rep) phase_0a(args, lds); }
        else if (ph == 1) { if (EN(1)) for (int rep = 0; rep < REP_P0; ++rep) phase_0b(args, lds); }
        else if (ph == 2) { if (EN(2)) phase_0c(args); }
        else if (ph == 23) { if (EN(3) && pass == 1) { for (int rnd = 0; rnd < 2; ++rnd) { FinalRegs R; final_load(args, R, rnd); GRID_BAR(); final_store(args, R, rnd); } } }
        else {
            const int l = (ph - 3) / 5, sub = (ph - 3) % 5;
            if (sub == 0) { if (EN(4)) {
                pg8::Gemm g{(const bf16*)args.out, (const bf16*)(args.ws + WS_W1T) + (size_t)l * N1 * 1024, M, LDP, 1024, 1024};
                pg8::StaticOrder S; S.init(M, LDP, G, bid);
                Epi1 E{(bf16*)(args.ws + WS_PB), (float*)(args.ws + WS_BA), (const float*)(args.ws + WS_RSS), (const float*)(args.ws + WS_SW) + (size_t)l * 9 * N1, 0, (bf16*)(args.ws + WS_DUM), (const LAS float*)(lds + 131072)};
                {
                    LAS float* rtab = (LAS float*)(lds + 131072); const float* RSSp = (const float*)(args.ws + WS_RSS);
                    for (int idx = otid(); idx < 8 * 256; idx += NTHR) { pg8::Unit u;
                        if (S.next(idx >> 8, u)) { const f32x4* rp = (const f32x4*)(RSSp + (size_t)(u.pm * 256 + (idx & 255)) * 16);
                            const f32x4 r0 = rp[0], r1 = rp[1], r2 = rp[2], r3 = rp[3];
                            const float ss = ((r0.x + r0.y) + (r0.z + r0.w)) + ((r1.x + r1.y) + (r1.z + r1.w)) + ((r2.x + r2.y) + (r2.z + r2.w)) + ((r3.x + r3.y) + (r3.z + r3.w));
                            rtab[idx] = rsqrtf(ss * (1.f / 1024.f) + EPS); } }
                    __syncthreads();
                }
                for (int rep = 0; rep < REP_G1; ++rep) { if (rep && G1CHEAP) E.cheap = args.one * G1CHEAP; pg8::gemm_phase<Epi1>(lds, g, S, E); if (rep && G1CHEAP) continue;
                    if (bid >= 128) for (int pm = bid - 128; pm < 160; pm += 128) skinny_ba(args, l, pm); } }
            } else if (sub == 1) {
                for (int it = bid; it < 2560; it += G) { if (EN(5)) for (int rep = 0; rep < REP_PREP; ++rep) prep_item(args, lds, l, it >> 2, it & 3); }
            } else if (sub == 2) {
                if (bid < 64) { if (EN(10)) for (int rep = 0; rep < REP_SCAN; ++rep) scan_item(args, lds, l, 32 + (bid >> 3), (bid >> 1) & 3, bid & 1); }
                unsigned* qc = (unsigned*)(args.ws + WS_CTL) + CW_Q + 64 * l + 256 * pass;
                volatile LAS unsigned* qslot = (volatile LAS unsigned*)(lds + MISC_OFF) + 16;
                for (;;) {
                    if (otid() == 0) qslot[0] = atomicAdd(qc, 1u);
                    __syncthreads();
                    const int it = (int)qslot[0];
                    __syncthreads();
                    if (it >= 2816) break;
                    if (it < 512) { if (EN(9)) fsmp_item(args, lds, it >> 6, it & 63, 0); }
                    else if (it < 640) { const int i2 = it - 512; if (EN(8)) fctx_item(args, lds, i2 >> 2, i2 & 3, 0); }
                    else if (it < 896) { const int i2 = it - 640; if (EN(10)) for (int rep = 0; rep < REP_SCAN; ++rep) scan_item(args, lds, l, i2 >> 3, (i2 >> 1) & 3, i2 & 1); }
                    else if (it < 2176) { const int i2 = it - 896; if (EN(6)) sgu_item(args, lds, l, i2 >> 2, i2 & 3, 0); }
                    else { if (EN(7)) pool_item(args, lds, l, it - 2176, 0); }
                }
            } else if (sub == 3) {
                if (EN(11)) for (int rep = 0; rep < REP_COMB; ++rep) phase_combine(args, l, rep ? args.one : 0);
            } else if (EN(12)) {
                pg8::Gemm g{(const bf16*)(args.ws + WS_PB), (const bf16*)(args.ws + WS_W2T) + (size_t)l * 1024 * 1024, M, 1024, 1024, LDP};
                pg8::StaticOrder S; S.init(M, 1024, G, bid);
                const float* MOD = (const float*)(args.ws + WS_MOD);
                Epi2 E{(bf16*)args.out + (size_t)M * D, (bf16*)args.out, (float*)(args.ws + WS_RSS), MOD + (size_t)l * 9 * 3072 + 2048,
                       l < 3 ? args.in[I_NORMG] + (l + 1) * 1024 : nullptr, l < 3 ? MOD + (size_t)(l + 1) * 9 * 3072 + 1024 : nullptr, args.ws + WS_DUM, 0};
                pg8::gemm_phase<Epi2>(lds, g, S, E);
                for (int rep = 1; rep < REP_G2; ++rep) { Epi2 E2 = E; E2.dry = args.one; pg8::gemm_phase<Epi2>(lds, g, S, E2); }
            }
        }
        if (ph + 1 < args.ph_hi || pass == 0) { GRID_BAR(); for (int rb = 1; rb < REP_BAR; ++rb) GRID_BAR(); }
    }
}

extern "C" void kernel_launch(void* const* d_in, const int* in_sizes, int n_in, void* d_out, int out_size, void* d_ws, size_t ws_size, hipStream_t stream) {
    static int grid = 0;
    if (grid == 0) {
        if (n_in != 21 || ws_size < WS_DUM + 16 * MiB) { fprintf(stderr, "kernel_launch: unexpected n_in %d or ws_size %zu (< %zu)\n", n_in, ws_size, (size_t)WS_END); grid = -1; return; }
        int dev = 0, cus = 0, per_cu = 0;
        if (hipGetDevice(&dev) != hipSuccess || hipDeviceGetAttribute(&cus, hipDeviceAttributeMultiprocessorCount, dev) != hipSuccess) { grid = -1; return; }
        if (hipFuncSetAttribute((const void*)fwd_kernel, hipFuncAttributeMaxDynamicSharedMemorySize, LDS_BYTES) != hipSuccess) { fprintf(stderr, "kernel_launch: hipFuncSetAttribute failed\n"); grid = -1; return; }
        if (hipOccupancyMaxActiveBlocksPerMultiprocessor(&per_cu, (const void*)fwd_kernel, NTHR, LDS_BYTES) != hipSuccess || per_cu < 1) { fprintf(stderr, "kernel_launch: occupancy query failed (%d)\n", per_cu); (void)hipGetLastError(); per_cu = 1; }
        grid = cus * 1;
    }
    if (grid < 0) return;
    Args a{};
    for (int i = 0; i < 21; ++i) a.in[i] = (const float*)d_in[i];
    a.out = (float*)d_out; a.ws = (unsigned char*)d_ws; a.one = 1; a.pad = PRE_HI;
    (void)hipMemsetAsync((char*)d_ws + WS_CTL, 0, CTL_ZERO_BYTES, stream);
#if MK_MULTI
    for (int ph = 0; ph < NPHASE; ++ph) {
        a.ph_lo = ph; a.ph_hi = ph + 1;
        hipLaunchKernelGGL(fwd_kernel, dim3(grid), dim3(NTHR), LDS_BYTES, stream, a);
    }
#else
    a.ph_lo = 0; a.ph_hi = NPHASE;
    void* kargs[] = {&a};
    hipError_t e = hipLaunchCooperativeKernel((const void*)fwd_kernel, dim3(grid), dim3(NTHR), kargs, LDS_BYTES, stream);
    if (e != hipSuccess) fprintf(stderr, "kernel_launch: cooperative launch failed: %s (grid %d)\n", hipGetErrorString(e), grid);
#endif
}
```

```cpp
#include <hip/hip_runtime.h>
#include <cstdio>
#include <cstdint>

#ifndef MK_MULTI
#define MK_MULTI 0
#endif
#ifndef NAIVE_MM
#define NAIVE_MM 0
#endif
#ifndef ONLY
#define ONLY -1
#endif
#define EN(k) (ONLY < 0 || ONLY == (k))
#ifndef REP_G1
#define REP_G1 1
#endif
#ifndef REP_PREP
#define REP_PREP 1
#endif
#ifndef REP_SCAN
#define REP_SCAN 1
#endif
#ifndef REP_P0
#define REP_P0 1
#endif
#ifndef REP_MIX
#define REP_MIX 1
#endif
#ifndef REP_COMB
#define REP_COMB 1
#endif
#ifndef REP_G2
#define REP_G2 1
#endif
#ifndef MIXSEL
#define MIXSEL 15
#endif
#ifndef G1CHEAP
#define G1CHEAP 0
#endif
#ifndef REP_BAR
#define REP_BAR 1
#endif
#ifndef PRE_HI
#define PRE_HI 0
#endif
#ifndef PREP_PREFETCH
#define PREP_PREFETCH 0
#endif
#ifndef PRE_SKIP
#define PRE_SKIP 0
#endif
#define PSK(b) (pass == 0 && (PRE_SKIP & (b)))

#define LAS __attribute__((address_space(3)))
#define GAS __attribute__((address_space(1)))
typedef unsigned short bf16;
typedef short bf16x8 __attribute__((ext_vector_type(8)));
typedef float f32x4 __attribute__((ext_vector_type(4)));
typedef float f32x2 __attribute__((ext_vector_type(2)));
typedef unsigned u32x4 __attribute__((ext_vector_type(4)));
typedef unsigned u32x2 __attribute__((ext_vector_type(2)));

constexpr int D = 1024, NL = 4, NCOND = 9;
constexpr int M_CTX = 8192, M = 40960;
constexpr int PIN = 2832;
constexpr int N1 = 3328, LDP = 3072;
constexpr float EPS = 1e-6f;
constexpr int C_GA = 0, C_U = 256, C_GC = 512, C_GD = 768, C_V = 1024, C_GB = 1280, C_XC = 1536, C_PF = 1792, C_QF = 2048, C_Q = 2304, C_K = 2560, C_VV = 2816;

constexpr size_t MiB = 1u << 20;
constexpr size_t WS_CTL = 0, CTL_ZERO_BYTES = 1 * MiB;
constexpr size_t WS_MOD = 1 * MiB;
constexpr size_t WS_SW = WS_MOD + 512 * 1024;
constexpr size_t WS_GMAT = 2 * MiB;
constexpr size_t WS_POS = WS_GMAT + 512 * 1024;
constexpr size_t WS_DFT = WS_POS + 256 * 1024;
constexpr size_t WS_M1 = 3 * MiB;
constexpr size_t WS_M2 = WS_M1 + 32 * 1024;
constexpr size_t WS_TW = WS_M1 + 64 * 1024;
constexpr size_t WS_W1T = 4 * MiB;
constexpr size_t WS_W2T = 30 * MiB;
constexpr size_t WS_BA = 38 * MiB;
constexpr size_t WS_RSS = 41 * MiB;
constexpr size_t WS_PB = 44 * MiB;
constexpr size_t WS_HB = 284 * MiB;
constexpr size_t WS_PREP = 284 * MiB;
constexpr size_t WS_PGL = 484 * MiB;
constexpr size_t WS_END = 485 * MiB;
constexpr size_t WS_DUM = 486 * MiB;
constexpr int CW_BAR = 4096, CW_Q = 8192;

constexpr int LDS_BYTES = 147456;
constexpr int MISC_OFF = 144 * 1024 - 256;
constexpr int NWAVES = 8, NTHR = 512;

typedef __bf16 hwbf16x2 __attribute__((ext_vector_type(2)));
__device__ __forceinline__ unsigned f2bf(float f) { return (unsigned)__builtin_bit_cast(unsigned short, (__bf16)f); }
__device__ __forceinline__ float bf2f(unsigned b) { return __builtin_bit_cast(float, (b & 0xffffu) << 16); }
__device__ __forceinline__ unsigned pk2(float lo, float hi) { const f32x2 v = {lo, hi}; return __builtin_bit_cast(unsigned, __builtin_convertvector(v, hwbf16x2)); }
__device__ __forceinline__ float bflo(unsigned w) { return __builtin_bit_cast(float, w << 16); }
__device__ __forceinline__ float bfhi(unsigned w) { return __builtin_bit_cast(float, w & 0xffff0000u); }
__device__ __forceinline__ float silu_f(float x) { return x * __builtin_amdgcn_rcpf(1.f + __builtin_amdgcn_exp2f(-1.4426950408889634f * x)); }
__device__ __forceinline__ float gelu_tanh_f(float x) { const float z = (-1.5957691216057308f * 1.4426950408889634f) * (x + 0.044715f * x * x * x); return x * __builtin_amdgcn_rcpf(1.f + __builtin_amdgcn_exp2f(z)); }
__device__ __forceinline__ float wave_sum(float v) {
#pragma unroll
    for (int o = 1; o < 64; o <<= 1) v += __shfl_xor(v, o);
    return v;
}
__device__ __forceinline__ int otid() { int t = threadIdx.x; asm volatile("" : "+v"(t)); return t; }
__device__ __forceinline__ int obid() { int b = blockIdx.x; asm volatile("" : "+s"(b)); return b; }
#define LDS_WAIT() asm volatile("s_waitcnt lgkmcnt(0)" ::: "memory")

namespace pg8 {
constexpr int BM = 256, BK = 64, HALF = 128, HTB = HALF * BK * 2, STAGE_BYTES = 8 * HTB, NXCD = 8, WGM = 8;
__host__ __device__ __forceinline__ int lds_byte(int r, int c) { const int st = (r >> 4) * 2 + (c >> 5), rr = r & 15, cc = c & 31, ob = rr * 64 + cc * 2; return st * 1024 + (ob ^ (((ob >> 9) & 1) << 5)); }
__host__ __device__ __forceinline__ void stage_rc(int b, int& R, int& C) { const int st = b / 1024, sb = b % 1024, swz = sb ^ (((sb >> 9) & 1) << 5); R = (st >> 1) * 16 + swz / 64; C = (st & 1) * 32 + (swz % 64) / 2; }
__host__ __device__ __forceinline__ int perm32(int rho) { const int n = rho >> 4, i = rho & 15; return 8 * (i >> 2) + 4 * n + (i & 3); }

struct Unit { int pm, pn; };
struct Gemm { const bf16* A; const bf16* Bt; int M, N, K, lda; };

struct StaticOrder {
    int nM, nN, nwg, G, c;
    __host__ __device__ void init(int M_, int N_, int G_, int c_) { nM = M_ / BM; nN = N_ / BM; nwg = nM * nN; G = G_; c = c_; }
    __host__ __device__ bool next(int i, Unit& u) const {
        const long L = (long)i * G + c; if (L >= nwg) return false;
        int wgid = (int)L; { const int q = nwg / NXCD, r = nwg % NXCD, xcd = wgid % NXCD, off = wgid / NXCD; wgid = (xcd < r ? xcd * (q + 1) : r * (q + 1) + (xcd - r) * q) + off; }
        const int nig = WGM * nN, gid = wgid / nig, fm = gid * WGM, gsz = (nM - fm) < WGM ? (nM - fm) : WGM;
        u.pm = fm + ((wgid % nig) % gsz); u.pn = (wgid % nig) / gsz; return true;
    }
};

template <class Epi>
__device__ __forceinline__ void gemm_phase(LAS unsigned char* lds, const Gemm g, const StaticOrder& S, const Epi& E) {
    const int tid = otid(), wid = __builtin_amdgcn_readfirstlane(tid >> 6), lane = tid & 63, wr = wid >> 2, wc = wid & 3, fr = lane & 15, fq = lane >> 4;
    const int K = g.K, nt = K / BK, lda = g.lda;
    unsigned voffA[2], voffB[2];
#pragma unroll
    for (int i = 0; i < 2; ++i) { int R, C; stage_rc(tid * 16 + i * 8192, R, C); const int Rb = Epi::PERM ? ((R & ~31) + perm32(R & 31)) : R;
        voffA[i] = (unsigned)(R * lda + C) * 2u; voffB[i] = (unsigned)(Rb * K + C) * 2u; }
    const size_t kstep = (size_t)(BK * 2);
    const size_t hstepA = (size_t)HALF * lda * 2, hstepB = (size_t)HALF * K * 2;
    const size_t tstepA = 2 * hstepA, tstepB = 2 * hstepB;
    const unsigned ldsw = (unsigned)wid * 1024u;
    const int aoff = lds_byte(wr * 64 + fr, fq * 8), boff = lds_byte(wc * 32 + fr, fq * 8);
#define PG8_SA(b, h) (((b) * 2 + (h)) * HTB)
#define PG8_SB(b, h) ((4 + (b) * 2 + (h)) * HTB)
#define PG8_STAGE(bufoff, gbase, voff) do { _Pragma("unroll") for (int _i = 0; _i < 2; ++_i) \
        __builtin_amdgcn_global_load_lds((const unsigned*)((const char*)(gbase) + (voff)[_i]), (LAS unsigned*)(lds + (bufoff) + ldsw + _i * 8192), 16, 0, 0); } while (0)
#define PG8_LDA(dst, b, h) do { _Pragma("unroll") for (int m = 0; m < 4; ++m) _Pragma("unroll") for (int k = 0; k < 2; ++k) dst[m][k] = *(const LAS bf16x8*)(lds + PG8_SA(b, h) + aoff + m * 2048 + k * 1024); } while (0)
#define PG8_LDB(dst, b, h) do { _Pragma("unroll") for (int n = 0; n < 2; ++n) _Pragma("unroll") for (int k = 0; k < 2; ++k) dst[n][k] = *(const LAS bf16x8*)(lds + PG8_SB(b, h) + boff + n * 2048 + k * 1024); } while (0)
#define PG8_MMA(ai, bj, At, Bt) do { __builtin_amdgcn_s_setprio(1); _Pragma("unroll") for (int m = 0; m < 4; ++m) _Pragma("unroll") for (int n = 0; n < 2; ++n) _Pragma("unroll") for (int k = 0; k < 2; ++k) \
        acc[ai][bj][m][n] = __builtin_amdgcn_mfma_f32_16x16x32_bf16(Bt[n][k], At[m][k], acc[ai][bj][m][n], 0, 0, 0); __builtin_amdgcn_s_setprio(0); } while (0)
#define PG8_WAIT_V(n) asm volatile("s_waitcnt vmcnt(" #n ")" ::: "memory")
#define PG8_WAIT_L(n) asm volatile("s_waitcnt lgkmcnt(" #n ")" ::: "memory")
#define PG8_BAR __builtin_amdgcn_s_barrier()
#define PG8_SCHED __builtin_amdgcn_sched_barrier(0)
    Unit cur, nxt; int ui = 0;
    if (!S.next(0, cur)) return;
    f32x4 acc[2][2][4][2];
#pragma unroll
    for (int a = 0; a < 2; ++a)
#pragma unroll
        for (int b = 0; b < 2; ++b)
#pragma unroll
            for (int m = 0; m < 4; ++m)
#pragma unroll
                for (int n = 0; n < 2; ++n) acc[a][b][m][n] = (f32x4){0.f, 0.f, 0.f, 0.f};
    bf16x8 At[4][2], B0[2][2], B1[2][2];
    const char* cA = (const char*)g.A + (size_t)cur.pm * tstepA; const char* cB = (const char*)g.Bt + (size_t)cur.pn * tstepB;
    PG8_STAGE(PG8_SB(0, 0), cB, voffB); PG8_STAGE(PG8_SA(0, 0), cA, voffA); PG8_STAGE(PG8_SB(0, 1), cB + hstepB, voffB); PG8_STAGE(PG8_SA(0, 1), cA + hstepA, voffA);
    if (wr == 1) PG8_BAR;
    PG8_WAIT_V(4); PG8_BAR;
    PG8_STAGE(PG8_SB(1, 0), cB + kstep, voffB); PG8_STAGE(PG8_SA(1, 0), cA + kstep, voffA); PG8_STAGE(PG8_SB(1, 1), cB + hstepB + kstep, voffB);
    PG8_WAIT_V(6); PG8_BAR;
    for (;;) {
        const bool has_next = S.next(ui + 1, nxt);
        const char* nA = has_next ? (const char*)g.A + (size_t)nxt.pm * tstepA : cA; const char* nB = has_next ? (const char*)g.Bt + (size_t)nxt.pn * tstepB : cB;
        for (int t = 0; t < nt; t += 2) {
            const bool last = (t == nt - 2);
            const char* a1 = cA + (size_t)(t + 1) * kstep;
            const char* a2 = last ? nA : cA + (size_t)(t + 2) * kstep; const char* b2 = last ? nB : cB + (size_t)(t + 2) * kstep;
            const char* a3 = a2 + kstep; const char* b3 = b2 + kstep;
            PG8_LDB(B0, 0, 0); PG8_SCHED; PG8_LDA(At, 0, 0); PG8_STAGE(PG8_SA(1, 1), a1 + hstepA, voffA);
            PG8_WAIT_L(8); PG8_BAR; PG8_WAIT_L(0); PG8_MMA(0, 0, At, B0); PG8_BAR; PG8_SCHED;
            PG8_LDB(B1, 0, 1); PG8_STAGE(PG8_SB(0, 0), b2, voffB);
            PG8_BAR; PG8_WAIT_L(0); PG8_MMA(0, 1, At, B1); PG8_BAR;
            PG8_LDA(At, 0, 1); PG8_STAGE(PG8_SA(0, 0), a2, voffA);
            PG8_BAR; PG8_WAIT_L(0); PG8_MMA(1, 0, At, B0); PG8_BAR; PG8_SCHED;
            PG8_STAGE(PG8_SB(0, 1), b2 + hstepB, voffB);
            PG8_WAIT_V(6); PG8_BAR; PG8_MMA(1, 1, At, B1); PG8_BAR;
            PG8_LDB(B0, 1, 0); PG8_SCHED; PG8_LDA(At, 1, 0); PG8_STAGE(PG8_SA(0, 1), a2 + hstepA, voffA);
            PG8_WAIT_L(8); PG8_BAR; PG8_WAIT_L(0); PG8_MMA(0, 0, At, B0); PG8_BAR; PG8_SCHED;
            PG8_LDB(B1, 1, 1); PG8_STAGE(PG8_SB(1, 0), b3, voffB);
            PG8_BAR; PG8_WAIT_L(0); PG8_MMA(0, 1, At, B1); PG8_BAR;
            PG8_LDA(At, 1, 1); PG8_STAGE(PG8_SA(1, 0), a3, voffA);
            PG8_BAR; PG8_WAIT_L(0); PG8_MMA(1, 0, At, B0); PG8_BAR; PG8_SCHED;
            PG8_STAGE(PG8_SB(1, 1), b3 + hstepB, voffB);
            PG8_WAIT_V(6); PG8_BAR; PG8_MMA(1, 1, At, B1); PG8_BAR;
        }
        E(acc, cur, wr, wc, fr, fq, ui);
        if (!has_next) break;
#pragma unroll
        for (int a = 0; a < 2; ++a)
#pragma unroll
            for (int b = 0; b < 2; ++b)
#pragma unroll
                for (int m = 0; m < 4; ++m)
#pragma unroll
                    for (int n = 0; n < 2; ++n) acc[a][b][m][n] = (f32x4){0.f, 0.f, 0.f, 0.f};
        cur = nxt; cA = nA; cB = nB; ++ui;
    }
    PG8_WAIT_V(0);
    if (wr == 0) PG8_BAR;
    PG8_BAR;
#undef PG8_SA
#undef PG8_SB
#undef PG8_STAGE
#undef PG8_LDA
#undef PG8_LDB
#undef PG8_MMA
#undef PG8_WAIT_V
#undef PG8_WAIT_L
#undef PG8_BAR
#undef PG8_SCHED
}
}

#define XB_TMO      128
#define XB_XCNT(j)  (256  + 64 * (j))
#define XB_XSUB(j)  (1280 + 64 * (j))
#define XB_XGEN(j)  (2304 + 64 * (j))
#define XB_TOP      3328
#define XB_TOPGEN   3392
#define XCD_BAR_WORDS 3456
#define XB_SPIN_CAP (1u << 18)
__device__ __forceinline__ unsigned xb_ld(unsigned* p)              { return __hip_atomic_load(p, __ATOMIC_RELAXED, __HIP_MEMORY_SCOPE_AGENT); }
__device__ __forceinline__ unsigned xb_add(unsigned* p, unsigned v) { return __hip_atomic_fetch_add(p, v, __ATOMIC_RELAXED, __HIP_MEMORY_SCOPE_AGENT); }
__device__ __forceinline__ unsigned xb_xcc_id() { return (unsigned)__builtin_amdgcn_s_getreg((3 << 11) | 20) & 0xFu; }
#define XB_SPIN(cond, bar) do { unsigned _sp = 0; while (cond) { __builtin_amdgcn_s_sleep(1); \
    if ((++_sp & 255u) == 0u) { if (xb_ld(&(bar)[XB_TMO])) break; if (_sp > XB_SPIN_CAP) { atomicAdd(&(bar)[XB_TMO], 1u); break; } } } } while (0)
struct XcdBarrier { unsigned* bar; unsigned x; volatile LAS unsigned* st; };
__device__ __forceinline__ XcdBarrier xcd_barrier_post(unsigned* bar, volatile LAS unsigned* st) {
    XcdBarrier b; b.bar = bar; b.x = xb_xcc_id(); b.st = st;
    if (threadIdx.x == 0) (void)xb_add(&bar[XB_XCNT(b.x)], 1u);
    return b;
}
__device__ __forceinline__ void xcd_barrier_complete(unsigned* bar, unsigned x, unsigned& nloc, unsigned& nx) {
    const unsigned G = gridDim.x * gridDim.y * gridDim.z;
    unsigned sum, cnt, mine, sp = 0u;
    for (;;) {
        sum = 0u; cnt = 0u; mine = 0u;
#pragma unroll
        for (unsigned j = 0; j < 16; ++j) { const unsigned c = xb_ld(&bar[XB_XCNT(j)]); sum += c; cnt += (c > 0u) ? 1u : 0u; mine = (j == x) ? c : mine; }
        if (sum == G) break;
        __builtin_amdgcn_s_sleep(1);
        if ((++sp & 255u) == 0u) { if (xb_ld(&bar[XB_TMO])) break; if (sp > XB_SPIN_CAP) { atomicAdd(&bar[XB_TMO], 1u); break; } }
    }
    nloc = mine > 0u ? mine : 1u; nx = cnt > 0u ? cnt : 1u;
}
__device__ __forceinline__ void xcd_barrier(const XcdBarrier& b) {
    asm volatile("s_waitcnt vmcnt(0)" ::: "memory");
    __syncthreads();
    if (threadIdx.x == 0) {
        unsigned* bar = b.bar;
        __builtin_amdgcn_s_waitcnt(0);
        unsigned nloc = b.st[0], nx = b.st[1];
        if (nloc == 0u) { xcd_barrier_complete(bar, b.x, nloc, nx); b.st[0] = nloc; b.st[1] = nx; }
        const unsigned old = xb_add(&bar[XB_XSUB(b.x)], 1u);
        const unsigned gen = old / nloc;
        if (old + 1u == (gen + 1u) * nloc) {
            __builtin_amdgcn_fence(__ATOMIC_RELEASE, "agent");
            asm volatile("s_waitcnt vmcnt(0)" ::: "memory");
            const unsigned og = xb_add(&bar[XB_TOP], 1u);
            const unsigned tg = og / nx;
            if (og + 1u == (tg + 1u) * nx) xb_add(&bar[XB_TOPGEN], 1u);
            else XB_SPIN(xb_ld(&bar[XB_TOPGEN]) == tg, bar);
            __builtin_amdgcn_fence(__ATOMIC_ACQUIRE, "agent");
            xb_add(&bar[XB_XGEN(b.x)], 1u);
            asm volatile("s_waitcnt vmcnt(0)" ::: "memory");
        } else {
            XB_SPIN(xb_ld(&bar[XB_XGEN(b.x)]) == gen, bar);
            __builtin_amdgcn_fence(__ATOMIC_ACQUIRE, "agent");
            asm volatile("s_waitcnt vmcnt(0)" ::: "memory");
        }
    }
    __syncthreads();
}

template <int KS>
__device__ __forceinline__ f32x4 tile_mm(f32x4 acc, const LAS bf16* A, int lda, int m0, const LAS bf16* Bt, int ldb, int n0, int lane) {
    const int r = lane & 15, kg = lane >> 4;
#if NAIVE_MM
#pragma unroll 1
    for (int k = 0; k < KS * 32; ++k) {
        const float b = bf2f(Bt[(n0 + r) * ldb + k]);
#pragma unroll
        for (int q = 0; q < 4; ++q) acc[q] += bf2f(A[(m0 + 4 * kg + q) * lda + k]) * b;
    }
#else
#pragma unroll
    for (int ks = 0; ks < KS; ++ks) {
        const bf16x8 a = *(const LAS bf16x8*)(A + (m0 + r) * lda + ks * 32 + kg * 8);
        const bf16x8 b = *(const LAS bf16x8*)(Bt + (n0 + r) * ldb + ks * 32 + kg * 8);
        acc = __builtin_amdgcn_mfma_f32_16x16x32_bf16(a, b, acc, 0, 0, 0);
    }
#endif
    return acc;
}
template <int KS>
__device__ __forceinline__ f32x4 tile_mm_g(f32x4 acc, const bf16* A, int lda, int m0, const LAS bf16* Bt, int ldb, int n0, int lane) {
    const int r = lane & 15, kg = lane >> 4;
#if NAIVE_MM
#pragma unroll 1
    for (int k = 0; k < KS * 32; ++k) {
        const float b = bf2f(Bt[(n0 + r) * ldb + k]);
#pragma unroll
        for (int q = 0; q < 4; ++q) acc[q] += bf2f(A[(m0 + 4 * kg + q) * lda + k]) * b;
    }
#else
#pragma unroll
    for (int ks = 0; ks < KS; ++ks) {
        const bf16x8 a = *(const bf16x8*)(A + (size_t)(m0 + r) * lda + ks * 32 + kg * 8);
        const bf16x8 b = *(const LAS bf16x8*)(Bt + (n0 + r) * ldb + ks * 32 + kg * 8);
        acc = __builtin_amdgcn_mfma_f32_16x16x32_bf16(a, b, acc, 0, 0, 0);
    }
#endif
    return acc;
}

struct Args { const float* in[21]; float* out; unsigned char* ws; int ph_lo, ph_hi, one, pad; };
enum { I_XP = 0, I_XS, I_STATE, I_C, I_CCTX, I_ADAW, I_ADAB, I_NORMG, I_WIN, I_CONV, I_ALOG, I_DTB, I_DNG, I_SGUNG, I_SGUW, I_SGUB, I_POOLW, I_POOLS, I_FW, I_WOUT, I_FNG };

struct SeqGeo { int T, tseq0, seq_row0; };
__device__ __forceinline__ SeqGeo seq_geo(int sc) {
    SeqGeo g;
    if (sc < 128) { g.T = 256; g.tseq0 = (sc & 3) * 64; g.seq_row0 = (sc >> 2) * 256; }
    else { const int s = sc - 128; g.T = 4096; g.tseq0 = (s & 63) * 64; g.seq_row0 = M_CTX + (s >> 6) * 4096; }
    return g;
}
__device__ __forceinline__ int cond_of_row(int row) { return row < M_CTX ? 0 : 1 + ((row - M_CTX) >> 12); }

__device__ __forceinline__ int srccol(int n) {
    if (n < 256) return 768 + n;
    if (n < 512) return 1040 + (n - 256);
    if (n < 768) return 2064 + (n - 512);
    if (n < 1024) return 2576 + (n - 768);
    if (n < 1280) return 1296 + (n - 1024);
    if (n < 1536) return 1552 + (n - 1280);
    if (n < 2304) return -2;
    if (n < 3072) return n - 2304;
    if (n < 3088) return 1024 + (n - 3072);
    return -1;
}

__device__ __forceinline__ void phase_0a(const Args& a, LAS unsigned char* lds) {
    const int tid = otid(), lane = tid & 63, wave = tid >> 6, G = gridDim.x, bid = obid();
    float* MOD = (float*)(a.ws + WS_MOD);
    if (bid < 192) {
        LAS float* sc = (LAS float*)lds;
        LAS float* red = (LAS float*)(lds + 9 * 1024 * 4);
        for (int i = tid; i < 9 * 1024; i += NTHR) { const int j = i >> 10, k = i & 1023; const float c = (j == 0) ? a.in[I_CCTX][k] : a.in[I_C][(j - 1) * 1024 + k]; sc[i] = silu_f(c); }
        __syncthreads();
        for (int it = bid; it < 192; it += G) {
            const int l = it / 48, cb = it % 48, col = cb * 64 + lane;
            float acc[9];
#pragma unroll
            for (int j = 0; j < 9; ++j) acc[j] = 0.f;
            const float* wp = a.in[I_ADAW] + ((size_t)l * 1024 + wave * 128) * 3072 + col;
#pragma unroll 8
            for (int k = 0; k < 128; ++k) { const float wv = wp[(size_t)k * 3072];
#pragma unroll
                for (int j = 0; j < 9; ++j) acc[j] += sc[j * 1024 + wave * 128 + k] * wv; }
#pragma unroll
            for (int j = 0; j < 9; ++j) red[(wave * 9 + j) * 64 + lane] = acc[j];
            __syncthreads();
            for (int i = tid; i < 576; i += NTHR) { const int j = i >> 6, ln = i & 63; float s = 0.f;
#pragma unroll
                for (int w = 0; w < 8; ++w) s += red[(w * 9 + j) * 64 + ln];
                MOD[(l * 9 + j) * 3072 + cb * 64 + ln] = s + a.in[I_ADAB][l * 3072 + cb * 64 + ln]; }
            __syncthreads();
        }
    }
    const int gtid = bid * NTHR + tid, GT = G * NTHR;
    float* GM = (float*)(a.ws + WS_GMAT);
    for (int t = gtid; t < 4 * 4 * 2 * 4096; t += GT) {
        const int d = t & 63, c = (t >> 6) & 63, cs = (t >> 12) & 1, g = (t >> 13) & 3, l = t >> 15;
        const float* fw = a.in[I_FW] + ((size_t)(l * 4 + g) * 64) * 64 + d;
        float s = 0.f;
        for (int m = 0; m < 64; ++m) { const float ph = (float)((m * c) & 63) * (1.f / 32.f); s += (cs ? sinpif(ph) : cospif(ph)) * fw[m * 64]; }
        GM[t] = s * 0.125f;
    }
    bf16* W1T = (bf16*)(a.ws + WS_W1T);
    for (int t = gtid; t < 4 * 128 * N1; t += GT) {
        const int n = t % N1, k8 = (t / N1) & 127, l = t / (N1 * 128);
        const int sc = srccol(n);
        if (sc == -2) continue;
        u32x4 o = (u32x4){0u, 0u, 0u, 0u};
        if (sc >= 0) { const float* wp = a.in[I_WIN] + ((size_t)l * 1024 + k8 * 8) * PIN + sc;
            o.x = pk2(wp[0], wp[PIN]); o.y = pk2(wp[2 * PIN], wp[3 * PIN]); o.z = pk2(wp[4 * PIN], wp[5 * PIN]); o.w = pk2(wp[6 * PIN], wp[7 * PIN]); }
        *(u32x4*)(W1T + ((size_t)l * N1 + n) * 1024 + k8 * 8) = o;
    }
    bf16* W2T = (bf16*)(a.ws + WS_W2T);
    for (int t = gtid; t < 4 * 128 * 1024; t += GT) {
        const int n = t & 1023, k8 = (t >> 10) & 127, l = t >> 17;
        const float* wp = a.in[I_WOUT] + ((size_t)l * 1024 + k8 * 8) * 1024 + n;
        u32x4 o; o.x = pk2(wp[0], wp[1024]); o.y = pk2(wp[2048], wp[3072]); o.z = pk2(wp[4096], wp[5120]); o.w = pk2(wp[6144], wp[7168]);
        *(u32x4*)(W2T + ((size_t)l * 1024 + n) * 1024 + k8 * 8) = o;
    }
    float* POS = (float*)(a.ws + WS_POS);
    for (int t = gtid; t < 64 * 256; t += GT) { const int f = t & 255, i = t >> 8; const float fr = powf(10000.f, -(float)f / 256.f); const float ang = (float)i * fr;
        POS[t] = sinf(ang); POS[64 * 256 + t] = cosf(ang); }
    bf16* DFT = (bf16*)(a.ws + WS_DFT);
    for (int t = gtid; t < 256 * 512; t += GT) { const int tp = t & 511, k = t >> 9, tt = tp & 255; const float ph = (float)((k * tt) & 255) * (1.f / 128.f);
        DFT[t] = (bf16)f2bf((tp < 256 ? cospif(ph) : -sinpif(ph)) * (1.f / 16.f)); }
    bf16* M1 = (bf16*)(a.ws + WS_M1);
    for (int t = gtid; t < 128 * 128; t += GT) { const int kk = t & 127, m = t >> 7, k1 = m & 63, t1 = kk & 63; const float ph = (float)((k1 * t1) & 63) * (1.f / 32.f);
        const float c = cospif(ph), s = sinpif(ph); float v;
        if (m < 64) v = (kk < 64) ? c : -s; else v = (kk < 64) ? s : c;
        M1[t] = (bf16)f2bf(v); }
    bf16* M2 = (bf16*)(a.ws + WS_M2);
    for (int t = gtid; t < 64 * 128; t += GT) { const int kk = t & 127, k2 = t >> 7, t2 = kk & 63; const float ph = (float)((k2 * t2) & 63) * (1.f / 32.f);
        M2[t] = (bf16)f2bf((kk < 64 ? cospif(ph) : -sinpif(ph)) * (1.f / 64.f)); }
    float* TW = (float*)(a.ws + WS_TW);
    for (int t = gtid; t < 64 * 64; t += GT) { const int t2 = t & 63, k1 = t >> 6; const float ph = (float)(k1 * t2) * (1.f / 2048.f); TW[2 * t] = cospif(ph); TW[2 * t + 1] = sinpif(ph); }
}

__device__ __forceinline__ void phase_0b(const Args& a, LAS unsigned char* lds) {
    const int tid = otid(), lane = tid & 63, wave = tid >> 6, G = gridDim.x, bid = obid();
    const int gtid = bid * NTHR + tid, GT = G * NTHR;
    const float* MOD = (const float*)(a.ws + WS_MOD);
    const float* GM = (const float*)(a.ws + WS_GMAT);
    bf16* W1T = (bf16*)(a.ws + WS_W1T);
    for (int it = bid; it < 384; it += G) {
        const int kblk = it & 7, g = (it >> 3) & 3, kind = (it >> 5) % 3, l = it / 96;
        LAS bf16* Al = (LAS bf16*)lds; LAS bf16* Bl = Al + 128 * 72;
        const int base = (kind == 0 ? 1808 : 2320) + 64 * g;
        const float* Gm = (kind == 0) ? (a.in[I_POOLW] + (size_t)(l * 4 + g) * 4096) : (GM + (size_t)((l * 4 + g) * 2 + (kind - 1)) * 4096);
        {
            const int row = tid >> 2, c0 = (tid & 3) * 16;
            const f32x4* wp = (const f32x4*)(a.in[I_WIN] + ((size_t)l * 1024 + kblk * 128 + row) * PIN + base + c0);
            const f32x4 w0 = wp[0], w1 = wp[1], w2 = wp[2], w3 = wp[3];
            u32x4 o0, o1; o0.x = pk2(w0.x, w0.y); o0.y = pk2(w0.z, w0.w); o0.z = pk2(w1.x, w1.y); o0.w = pk2(w1.z, w1.w);
            o1.x = pk2(w2.x, w2.y); o1.y = pk2(w2.z, w2.w); o1.z = pk2(w3.x, w3.y); o1.w = pk2(w3.z, w3.w);
            *(LAS u32x4*)(Al + row * 72 + c0) = o0; *(LAS u32x4*)(Al + row * 72 + c0 + 8) = o1;
            const int c = tid >> 3, d0 = (tid & 7) * 8;
            const f32x4 g0 = *(const f32x4*)(Gm + c * 64 + d0), g1 = *(const f32x4*)(Gm + c * 64 + d0 + 4);
            Bl[(d0 + 0) * 72 + c] = (bf16)f2bf(g0.x); Bl[(d0 + 1) * 72 + c] = (bf16)f2bf(g0.y); Bl[(d0 + 2) * 72 + c] = (bf16)f2bf(g0.z); Bl[(d0 + 3) * 72 + c] = (bf16)f2bf(g0.w);
            Bl[(d0 + 4) * 72 + c] = (bf16)f2bf(g1.x); Bl[(d0 + 5) * 72 + c] = (bf16)f2bf(g1.y); Bl[(d0 + 6) * 72 + c] = (bf16)f2bf(g1.z); Bl[(d0 + 7) * 72 + c] = (bf16)f2bf(g1.w);
        }
        __syncthreads();
        {
            const int m0 = wave * 16, r = lane & 15, kg = lane >> 4;
#pragma unroll
            for (int nt = 0; nt < 4; ++nt) {
                const f32x4 acc = tile_mm<2>((f32x4){0.f, 0.f, 0.f, 0.f}, Al, 72, m0, Bl, 72, nt * 16, lane);
                u32x2 o; o.x = pk2(acc[0], acc[1]); o.y = pk2(acc[2], acc[3]);
                *(u32x2*)(W1T + ((size_t)l * N1 + 1536 + kind * 256 + g * 64 + nt * 16 + r) * 1024 + kblk * 128 + m0 + 4 * kg) = o;
            }
        }
        __syncthreads();
    }
    const float* POS = (const float*)(a.ws + WS_POS);
    bf16* HB = (bf16*)a.out;
    bf16* XB = (bf16*)a.out + (size_t)M * D;
    float* RSS = (float*)(a.ws + WS_RSS);
    for (int row = bid * NWAVES + wave; row < M; row += G * NWAVES) {
        f32x4 v[4];
        const int j = cond_of_row(row);
        if (row < M_CTX) {
            const f32x4* xr = (const f32x4*)(a.in[I_XP] + (size_t)row * D) + lane;
#pragma unroll
            for (int q = 0; q < 4; ++q) v[q] = xr[64 * q];
        } else {
            const int rs = row - M_CTX, t = rs & 4095, gr = t >> 6, gc = t & 63;
            const f32x4* xr = (const f32x4*)(a.in[I_XS] + (size_t)rs * D) + lane;
            const f32x4 p0 = *((const f32x4*)(POS + gr * 256) + lane), p1 = *((const f32x4*)(POS + 64 * 256 + gr * 256) + lane);
            const f32x4 p2 = *((const f32x4*)(POS + gc * 256) + lane), p3 = *((const f32x4*)(POS + 64 * 256 + gc * 256) + lane);
            v[0] = xr[0] + p0; v[1] = xr[64] + p1; v[2] = xr[128] + p2; v[3] = xr[192] + p3;
        }
        float ss = 0.f;
#pragma unroll
        for (int q = 0; q < 4; ++q) ss += (v[q].x * v[q].x + v[q].y * v[q].y) + (v[q].z * v[q].z + v[q].w * v[q].w);
        ss = wave_sum(ss);
        u32x2* xrow = (u32x2*)(XB + (size_t)row * D) + lane;
        u32x2* hrow = (u32x2*)(HB + (size_t)row * D) + lane;
#pragma unroll
        for (int q = 0; q < 4; ++q) {
            u32x2 xb; xb.x = pk2(v[q].x, v[q].y); xb.y = pk2(v[q].z, v[q].w);
            xrow[64 * q] = xb;
            const f32x4 ng = *((const f32x4*)(a.in[I_NORMG] + 256 * q) + lane);
            const f32x4 sc = *((const f32x4*)(MOD + (0 * 9 + j) * 3072 + 1024 + 256 * q) + lane);
            u32x2 h; h.x = pk2(v[q].x * ng.x * (1.f + sc.x), v[q].y * ng.y * (1.f + sc.y)); h.y = pk2(v[q].z * ng.z * (1.f + sc.z), v[q].w * ng.w * (1.f + sc.w));
            hrow[64 * q] = h;
        }
        if (lane < 16) RSS[(size_t)row * 16 + lane] = (lane == 0) ? ss : 0.f;
    }
}

__device__ __forceinline__ void phase_0c(const Args& a) {
    const int tid = otid(), lane = tid & 63, wave = tid >> 6, G = gridDim.x, bid = obid();
    const float* MOD = (const float*)(a.ws + WS_MOD);
    const bf16* W1T = (const bf16*)(a.ws + WS_W1T);
    float* SW = (float*)(a.ws + WS_SW);
    for (int it = bid * NWAVES + wave; it < 4 * N1; it += G * NWAVES) {
        const int l = it / N1, n = it % N1;
        const u32x4* wr = (const u32x4*)(W1T + ((size_t)l * N1 + n) * 1024) + lane * 2;
        const u32x4 w0 = wr[0], w1 = wr[1];
        float w[16];
        w[0] = bflo(w0.x); w[1] = bfhi(w0.x); w[2] = bflo(w0.y); w[3] = bfhi(w0.y); w[4] = bflo(w0.z); w[5] = bfhi(w0.z); w[6] = bflo(w0.w); w[7] = bfhi(w0.w);
        w[8] = bflo(w1.x); w[9] = bfhi(w1.x); w[10] = bflo(w1.y); w[11] = bfhi(w1.y); w[12] = bflo(w1.z); w[13] = bfhi(w1.z); w[14] = bflo(w1.w); w[15] = bfhi(w1.w);
#pragma unroll
        for (int j = 0; j < 9; ++j) {
            const f32x4* sp = (const f32x4*)(MOD + (l * 9 + j) * 3072) + lane * 4;
            float s = 0.f;
#pragma unroll
            for (int q = 0; q < 4; ++q) { const f32x4 sv = sp[q]; s += sv.x * w[4 * q] + sv.y * w[4 * q + 1] + sv.z * w[4 * q + 2] + sv.w * w[4 * q + 3]; }
            s = wave_sum(s);
            if (lane == 0) SW[(l * 9 + j) * N1 + n] = s;
        }
    }
}

struct Epi1 {
    static constexpr bool PERM = true;
    bf16* PB; float* BA; const float* RSS; const float* SW;
    int cheap; bf16* dumb;
    const LAS float* rtab;
    __device__ __forceinline__ void operator()(const f32x4 (&acc)[2][2][4][2], const pg8::Unit& u, int wr, int wc, int fr, int fq, int ui) const {
        const int pn = u.pn, j = u.pm < 32 ? 0 : 1 + ((u.pm - 32) >> 4);
        const int row0 = u.pm * 256 + wr * 64 + fr, cb = pn * 256 + wc * 32 + 8 * fq;
        if (cheap == 1) {
#pragma unroll
            for (int ai = 0; ai < 2; ++ai)
#pragma unroll
                for (int m = 0; m < 4; ++m)
#pragma unroll
                    for (int bj = 0; bj < 2; ++bj) { const f32x4 v0 = acc[ai][bj][m][0], v1 = acc[ai][bj][m][1];
                        u32x4 w; w.x = pk2(v0[0], v0[1]); w.y = pk2(v0[2], v0[3]); w.z = pk2(v1[0], v1[1]); w.w = pk2(v1[2], v1[3]);
                        *(u32x4*)(dumb + (size_t)((row0 + ai * 128 + m * 16) & 1023) * LDP + cb + bj * 128) = w; }
            return;
        }
        const int act = (pn == 0 || pn == 2 || pn == 3 || pn == 5) ? 1 : ((pn == 1 || pn == 4) ? 2 : 0);
        f32x4 bv[2][2];
#pragma unroll
        for (int bj = 0; bj < 2; ++bj)
#pragma unroll
            for (int n = 0; n < 2; ++n) bv[bj][n] = *(const f32x4*)(SW + j * N1 + cb + bj * 128 + 4 * n);
#pragma unroll
        for (int ai = 0; ai < 2; ++ai)
#pragma unroll
            for (int m = 0; m < 4; ++m) {
                const int row = row0 + ai * 128 + m * 16;
                const float rinv = rtab[ui * 256 + wr * 64 + fr + ai * 128 + m * 16];
#pragma unroll
                for (int bj = 0; bj < 2; ++bj) {
                    f32x4 v0 = acc[ai][bj][m][0] * rinv + bv[bj][0], v1 = acc[ai][bj][m][1] * rinv + bv[bj][1];
                    if (pn < 12) {
                        if (act == 1) {
#pragma unroll
                            for (int q = 0; q < 4; ++q) { v0[q] = silu_f(v0[q]); v1[q] = silu_f(v1[q]); }
                        } else if (act == 2) {
#pragma unroll
                            for (int q = 0; q < 4; ++q) { v0[q] = gelu_tanh_f(v0[q]); v1[q] = gelu_tanh_f(v1[q]); }
                        }
                        u32x4 w; w.x = pk2(v0[0], v0[1]); w.y = pk2(v0[2], v0[3]); w.z = pk2(v1[0], v1[1]); w.w = pk2(v1[2], v1[3]);
                        *(u32x4*)((cheap ? dumb + (size_t)(row & 1023) * LDP : PB + (size_t)row * LDP) + cb + bj * 128) = w;
                    } else if (bj == 0 && wc == 0 && fq < 2) {
                        f32x4* bp = (f32x4*)(BA + (size_t)row * 16 + 8 * fq); bp[0] = v0; bp[1] = v1;
                    }
                }
            }
    }
};
struct Epi2 {
    static constexpr bool PERM = true;
    bf16* XB; bf16* HB; float* RSS; const float* gate;
    const float* ng_next; const float* sc_next;
    unsigned char* dum; int dry;
    __device__ __forceinline__ void operator()(const f32x4 (&acc)[2][2][4][2], const pg8::Unit& u, int wr, int wc, int fr, int fq, int) const {
        const int pn = u.pn, j = u.pm < 32 ? 0 : 1 + ((u.pm - 32) >> 4);
        const int row0 = u.pm * 256 + wr * 64 + fr, cb = pn * 256 + wc * 32 + 8 * fq;
        f32x4 gv[2][2];
#pragma unroll
        for (int bj = 0; bj < 2; ++bj)
#pragma unroll
            for (int n = 0; n < 2; ++n) gv[bj][n] = *(const f32x4*)(gate + j * 3072 + cb + bj * 128 + 4 * n);
#pragma unroll
        for (int am = 0; am < 4; ++am) {
            const int ai = am >> 1;
            u32x4 xv[4][2];
            f32x4 gs[2][2];
#pragma unroll
            for (int m = 2 * (am & 1); m < 2 * (am & 1) + 2; ++m)
#pragma unroll
                for (int bj = 0; bj < 2; ++bj) xv[m][bj] = *(const u32x4*)(XB + (size_t)(row0 + ai * 128 + m * 16) * D + cb + bj * 128);
#pragma unroll
            for (int bj = 0; bj < 2; ++bj)
#pragma unroll
                for (int n = 0; n < 2; ++n) {
                    if (ng_next) { const f32x4 ng = *(const f32x4*)(ng_next + cb + bj * 128 + 4 * n), sc = *(const f32x4*)(sc_next + j * 3072 + cb + bj * 128 + 4 * n); gs[bj][n] = ng * (sc + 1.f); }
                    else gs[bj][n] = (f32x4){0.f, 0.f, 0.f, 0.f};
                }
#pragma unroll
            for (int m = 2 * (am & 1); m < 2 * (am & 1) + 2; ++m) {
                const int row = row0 + ai * 128 + m * 16;
                float ssq = 0.f;
#pragma unroll
                for (int bj = 0; bj < 2; ++bj) {
                    const u32x4 xq = xv[m][bj];
                    const f32x4 x0 = (f32x4){bflo(xq.x), bfhi(xq.x), bflo(xq.y), bfhi(xq.y)}, x1 = (f32x4){bflo(xq.z), bfhi(xq.z), bflo(xq.w), bfhi(xq.w)};
                    const f32x4 n0 = x0 + gv[bj][0] * acc[ai][bj][m][0], n1 = x1 + gv[bj][1] * acc[ai][bj][m][1];
                    u32x4 xw; xw.x = pk2(n0[0], n0[1]); xw.y = pk2(n0[2], n0[3]); xw.z = pk2(n1[0], n1[1]); xw.w = pk2(n1[2], n1[3]);
                    *(u32x4*)((dry ? (bf16*)dum + (size_t)(row & 1023) * D : XB + (size_t)row * D) + cb + bj * 128) = xw;
                    ssq += (n0.x * n0.x + n0.y * n0.y) + (n0.z * n0.z + n0.w * n0.w) + (n1.x * n1.x + n1.y * n1.y) + (n1.z * n1.z + n1.w * n1.w);
                    if (ng_next) { const f32x4 h0 = n0 * gs[bj][0], h1 = n1 * gs[bj][1];
                        u32x4 w; w.x = pk2(h0[0], h0[1]); w.y = pk2(h0[2], h0[3]); w.z = pk2(h1[0], h1[1]); w.w = pk2(h1[2], h1[3]);
                        *(u32x4*)((dry ? (bf16*)(dum + 4 * MiB) + (size_t)(row & 1023) * D : HB + (size_t)row * D) + cb + bj * 128) = w; }
                }
                ssq += __shfl_xor(ssq, 16); ssq += __shfl_xor(ssq, 32);
                if (fq == 0) (dry ? (float*)(dum + 8 * MiB) + (size_t)(row & 1023) * 16 : RSS + (size_t)row * 16)[pn * 4 + wc] = ssq;
            }
        }
    }
};

typedef short bf16x4 __attribute__((ext_vector_type(4)));
__device__ __forceinline__ f32x4 mfma16(bf16x4 a, bf16x4 b, f32x4 c) { return __builtin_amdgcn_mfma_f32_16x16x16bf16_1k(a, b, c, 0, 0, 0); }
__device__ __forceinline__ bf16x4 pack4(f32x4 v) { u32x2 w; w.x = pk2(v[0], v[1]); w.y = pk2(v[2], v[3]); return __builtin_bit_cast(bf16x4, w); }
__device__ __forceinline__ bf16x8 pack8(f32x4 lo, f32x4 hi) { u32x4 w; w.x = pk2(lo[0], lo[1]); w.y = pk2(lo[2], lo[3]); w.z = pk2(hi[0], hi[1]); w.w = pk2(hi[2], hi[3]); return __builtin_bit_cast(bf16x8, w); }
constexpr int PREP_ITEM = 5 * 4096;

__device__ __forceinline__ void prep_dinv(const LAS bf16* Ab_, LAS bf16* Dl, int lane) {
    const int blk = lane >> 4, c = lane & 15;
    unsigned ab = (unsigned)(size_t)(Ab_ + (16 * blk) * 72 + 16 * blk);
    asm volatile("" : "+v"(ab));
    const LAS bf16* Ab = (const LAS bf16*)(size_t)ab;
    float x[16];
#pragma unroll
    for (int ii = 0; ii < 16; ++ii) {
        float acc = (ii == c) ? 1.f : 0.f;
        const LAS u32x4* ar = (const LAS u32x4*)(Ab + ii * 72);
#pragma unroll
        for (int jq = 0; jq < 2; ++jq) {
            if (8 * jq < ii) {
                const u32x4 av = ar[jq];
                if (8 * jq + 0 < ii) acc += bflo(av.x) * x[8 * jq + 0];
                if (8 * jq + 1 < ii) acc += bfhi(av.x) * x[8 * jq + 1];
                if (8 * jq + 2 < ii) acc += bflo(av.y) * x[8 * jq + 2];
                if (8 * jq + 3 < ii) acc += bfhi(av.y) * x[8 * jq + 3];
                if (8 * jq + 4 < ii) acc += bflo(av.z) * x[8 * jq + 4];
                if (8 * jq + 5 < ii) acc += bfhi(av.z) * x[8 * jq + 5];
                if (8 * jq + 6 < ii) acc += bflo(av.w) * x[8 * jq + 6];
                if (8 * jq + 7 < ii) acc += bfhi(av.w) * x[8 * jq + 7];
            }
        }
        asm volatile("" : "+v"(acc) :: "memory");
        x[ii] = acc;
    }
#pragma unroll
    for (int ii = 0; ii < 16; ++ii) Dl[(blk * 16 + ii) * 24 + c] = (bf16)f2bf(x[ii]);
}

struct PrepPre { u32x4 xr[7]; };
__device__ __forceinline__ void prep_prefetch(const Args& a, PrepPre& P, int sc, int h) {
    const int tid = otid();
    const bf16* PB = (const bf16*)(a.ws + WS_PB);
    const SeqGeo sg = seq_geo(sc);
    const int cg = tid % 24, seg = tid / 24, part = cg >> 3, d0 = (cg & 7) * 8;
    const int col = C_Q + (part < 3 ? part : 0) * 256 + h * 64 + d0;
#pragma unroll
    for (int i = 0; i < 7; ++i) { const int ts = sg.tseq0 + 4 * seg - 2 + i;
        P.xr[i] = (tid < 384 && ts >= 0 && ts < sg.T) ? *(const u32x4*)(PB + (size_t)(sg.seq_row0 + ts) * LDP + col) : (u32x4){0u, 0u, 0u, 0u}; }
}
__device__ __forceinline__ void prep_item(const Args& a, LAS unsigned char* lds, int l, int sc, int h, PrepPre& P, int nsc, int nh) {
    const int tid = otid(), lane = tid & 63, wave = __builtin_amdgcn_readfirstlane(tid >> 6);
    LAS float* qs = (LAS float*)lds;
    LAS float* ks = qs + 64 * 65;
    LAS float* vs = ks + 64 * 65;
    LAS bf16* Qb = (LAS bf16*)(lds + 49920);
    LAS bf16* Kb = (LAS bf16*)(lds + 59136);
    constexpr int PD = 30720;
    LAS unsigned char* dbase = lds + 68352;
    LAS float* beta = (LAS float*)(lds + 129792);
    LAS float* gcs = beta + 128;
    LAS float* egs = gcs + 128;
    LAS float* eks = egs + 128;
    const bf16* PB = (const bf16*)(a.ws + WS_PB);
    const float* BA = (const float*)(a.ws + WS_BA);
    const SeqGeo sg = seq_geo(sc);
    const int row0 = sc * 64;
    if (wave >= 6) {
        const int dir = wave - 6, tok = dir ? 63 - lane : lane;
        const float bl = BA[(size_t)(row0 + tok) * 16 + dir * 4 + h], al = BA[(size_t)(row0 + tok) * 16 + 8 + dir * 4 + h];
        const float bt = 1.f / (1.f + __expf(-bl));
        const float xx = al + a.in[I_DTB][(l * 2 + dir) * 4 + h];
        const float ex = __expf(xx);
        const float sp = xx > 20.f ? xx : (ex < 1e-2f ? ex * (1.f - ex * (0.5f - ex * (1.f / 3.f))) : __logf(1.f + ex));
        float g = -__expf(a.in[I_ALOG][(l * 2 + dir) * 4 + h]) * sp;
#pragma unroll
        for (int o = 1; o < 64; o <<= 1) { const float t = __shfl_up(g, o); if (lane >= o) g += t; }
        const float gl = __shfl(g, 63);
        beta[dir * 64 + lane] = bt; gcs[dir * 64 + lane] = g; egs[dir * 64 + lane] = __expf(g); eks[dir * 64 + lane] = __expf(gl - g);
        if (lane == 63) ((float*)(a.ws + WS_PGL))[(sc * 4 + h) * 2 + dir] = __expf(g);
    } else {
        const int cg = tid % 24, seg = tid / 24, part = cg >> 3, d0 = (cg & 7) * 8;
        const int chan = part * 256 + h * 64 + d0;
        u32x4 xr[7];
#pragma unroll
        for (int i = 0; i < 7; ++i) xr[i] = P.xr[i];
        f32x4 w0[4], w1[4];
#pragma unroll
        for (int jj = 0; jj < 4; ++jj) { w0[jj] = *(const f32x4*)(a.in[I_CONV] + (size_t)(l * 4 + jj) * 768 + chan); w1[jj] = *(const f32x4*)(a.in[I_CONV] + (size_t)(l * 4 + jj) * 768 + chan + 4); }
        float o[4][8];
#pragma unroll
        for (int j = 0; j < 4; ++j)
#pragma unroll
            for (int c = 0; c < 8; ++c) o[j][c] = 0.f;
#pragma unroll
        for (int i = 0; i < 7; ++i) {
            const float x0 = bflo(xr[i].x), x1 = bfhi(xr[i].x), x2 = bflo(xr[i].y), x3 = bfhi(xr[i].y), x4 = bflo(xr[i].z), x5 = bfhi(xr[i].z), x6 = bflo(xr[i].w), x7 = bfhi(xr[i].w);
#pragma unroll
            for (int j = 0; j < 4; ++j) { const int jj = i - j;
                if (jj >= 0 && jj < 4) {
                    o[j][0] += w0[jj].x * x0; o[j][1] += w0[jj].y * x1; o[j][2] += w0[jj].z * x2; o[j][3] += w0[jj].w * x3;
                    o[j][4] += w1[jj].x * x4; o[j][5] += w1[jj].y * x5; o[j][6] += w1[jj].z * x6; o[j][7] += w1[jj].w * x7; } }
        }
        LAS float* dst = (part == 0 ? qs : (part == 1 ? ks : vs)) + (4 * seg) * 65 + d0;
#pragma unroll
        for (int j = 0; j < 4; ++j)
#pragma unroll
            for (int c = 0; c < 8; ++c) dst[j * 65 + c] = silu_f(o[j][c]);
    }
    __syncthreads();
    {
        const int rowid = tid >> 2, seg = tid & 3, ar = rowid & 63;
        LAS float* p = (rowid < 64 ? qs : ks) + ar * 65 + seg * 16;
        float v[16]; float ss = 0.f;
#pragma unroll
        for (int c = 0; c < 16; ++c) { v[c] = p[c]; ss += v[c] * v[c]; }
        ss += __shfl_xor(ss, 1); ss += __shfl_xor(ss, 2);
        const float s = rsqrtf(ss + EPS) * (rowid < 64 ? 0.125f : 1.f);
#pragma unroll
        for (int c = 0; c < 16; ++c) { v[c] *= s; p[c] = v[c]; }
        LAS bf16* bp = (rowid < 64 ? Qb : Kb) + ar * 72 + seg * 16;
        u32x4 o0, o1; o0.x = pk2(v[0], v[1]); o0.y = pk2(v[2], v[3]); o0.z = pk2(v[4], v[5]); o0.w = pk2(v[6], v[7]);
        o1.x = pk2(v[8], v[9]); o1.y = pk2(v[10], v[11]); o1.z = pk2(v[12], v[13]); o1.w = pk2(v[14], v[15]);
        *(LAS u32x4*)bp = o0; *(LAS u32x4*)(bp + 8) = o1;
    }
    __syncthreads();
    {
        const int mt = wave >> 1, nh_ = wave & 1, m0 = mt * 16, r = lane & 15, kg = lane >> 4, arow = m0 + r;
#pragma unroll
        for (int t = 0; t < 2; ++t) {
            const int b0 = nh_ * 32 + 16 * t + 4 * kg;
            const f32x4 KKa = tile_mm<2>((f32x4){0.f, 0.f, 0.f, 0.f}, Kb, 72, nh_ * 32 + 16 * t, Kb, 72, m0, lane);
            const f32x4 QKa = tile_mm<2>((f32x4){0.f, 0.f, 0.f, 0.f}, Kb, 72, nh_ * 32 + 16 * t, Qb, 72, m0, lane);
#pragma unroll
            for (int dir = 0; dir < 2; ++dir) {
                LAS bf16* Ab = (LAS bf16*)(dbase + dir * PD); LAS bf16* QKl = Ab + 64 * 72;
                const int i = dir ? 63 - arow : arow;
                const float gi = gcs[dir * 64 + i], bi = beta[dir * 64 + i];
                float av[4], qv[4];
#pragma unroll
                for (int q = 0; q < 4; ++q) {
                    const int j = dir ? 63 - (b0 + q) : b0 + q;
                    const float dec = (i >= j) ? __expf(gi - gcs[dir * 64 + j]) : 0.f;
                    av[q] = (i > j) ? -bi * KKa[q] * dec : 0.f; qv[q] = QKa[q] * dec;
                }
                u32x2 aw, qw; const int j0 = dir ? 60 - b0 : b0;
                if (dir) { aw.x = pk2(av[3], av[2]); aw.y = pk2(av[1], av[0]); qw.x = pk2(qv[3], qv[2]); qw.y = pk2(qv[1], qv[0]); }
                else { aw.x = pk2(av[0], av[1]); aw.y = pk2(av[2], av[3]); qw.x = pk2(qv[0], qv[1]); qw.y = pk2(qv[2], qv[3]); }
                *(LAS u32x2*)(Ab + i * 72 + j0) = aw; *(LAS u32x2*)(QKl + i * 72 + j0) = qw;
            }
        }
    }
    __syncthreads();
    if (nsc >= 0) prep_prefetch(a, P, nsc, nh);
    bf16* PI0 = (bf16*)(a.ws + WS_PREP) + (size_t)((sc * 4 + h) * 2) * PREP_ITEM;
    if (wave < 2) prep_dinv((const LAS bf16*)(dbase + wave * PD), (LAS bf16*)(dbase + wave * PD + 3 * 9216), lane);
    for (int t = tid; t < 2048; t += NTHR) {
        const int dir = t >> 10, which = (t >> 9) & 1, rw = (t >> 3) & 63, sgp = t & 7, n0a = 32 * (sgp >> 2) + 4 * (sgp & 3), n0b = n0a + 16;
        float v[8];
        if (which == 0) {
            const int tok = dir ? 63 - rw : rw; const float e = egs[dir * 64 + rw];
#pragma unroll
            for (int c = 0; c < 4; ++c) { v[c] = qs[tok * 65 + n0a + c] * e; v[4 + c] = qs[tok * 65 + n0b + c] * e; }
        } else {
#pragma unroll
            for (int c = 0; c < 4; ++c) { const int ia = n0a + c, ib = n0b + c;
                v[c] = ks[(dir ? 63 - ia : ia) * 65 + rw] * eks[dir * 64 + ia]; v[4 + c] = ks[(dir ? 63 - ib : ib) * 65 + rw] * eks[dir * 64 + ib]; }
        }
        u32x4 o; o.x = pk2(v[0], v[1]); o.y = pk2(v[2], v[3]); o.z = pk2(v[4], v[5]); o.w = pk2(v[6], v[7]);
        *(u32x4*)(PI0 + (size_t)dir * PREP_ITEM + (1 + which) * 4096 + rw * 64 + sgp * 8) = o;
    }
    __syncthreads();
    {
        const int dir = wave >> 2, r = lane & 15, kg = lane >> 4, cc = 16 * (wave & 3) + r;
        const LAS bf16* Ab = (const LAS bf16*)(dbase + dir * PD); LAS bf16* Wl = (LAS bf16*)(dbase + dir * PD + 2 * 9216); const LAS bf16* Dl = (const LAS bf16*)(dbase + dir * PD + 3 * 9216);
        bf16* PI = PI0 + (size_t)dir * PREP_ITEM;
        f32x4 XU[4], XW[4];
#pragma unroll
        for (int b = 0; b < 4; ++b) {
            f32x4 TU, TW_;
#pragma unroll
            for (int q = 0; q < 4; ++q) { const int i = 16 * b + 4 * kg + q, tok = dir ? 63 - i : i;
                const float bt = beta[dir * 64 + i];
                TU[q] = bt * vs[tok * 65 + cc]; TW_[q] = bt * egs[dir * 64 + i] * ks[tok * 65 + cc]; }
#pragma unroll
            for (int m = 0; m < 4; ++m) if (m < b) {
                const bf16x4 af = *(const LAS bf16x4*)(Ab + (16 * b + r) * 72 + 16 * m + 4 * kg);
                TU = mfma16(af, pack4(XU[m]), TU); TW_ = mfma16(af, pack4(XW[m]), TW_);
            }
            const bf16x4 df = *(const LAS bf16x4*)(Dl + (b * 16 + r) * 24 + 4 * kg);
            XU[b] = mfma16(df, pack4(TU), (f32x4){0.f, 0.f, 0.f, 0.f});
            XW[b] = mfma16(df, pack4(TW_), (f32x4){0.f, 0.f, 0.f, 0.f});
            *(u32x2*)(PI + 4 * 4096 + cc * 64 + 16 * b + 4 * kg) = __builtin_bit_cast(u32x2, pack4(XU[b]));
#pragma unroll
            for (int q = 0; q < 4; ++q) Wl[(16 * b + 4 * kg + q) * 72 + cc] = (bf16)f2bf(XW[b][q]);
        }
    }
    __syncthreads();
    for (int t = tid; t < 2048; t += NTHR) {
        const int dir = t >> 10, which = (t >> 9) & 1, rw = (t >> 3) & 63, sgp = t & 7, n0a = 32 * (sgp >> 2) + 4 * (sgp & 3);
        const LAS bf16* src = (const LAS bf16*)(dbase + dir * PD + (which ? 1 : 2) * 9216) + rw * 72 + n0a;
        const u32x2 lo = *(const LAS u32x2*)src, hi = *(const LAS u32x2*)(src + 16);
        u32x4 o; o.x = lo.x; o.y = lo.y; o.z = hi.x; o.w = hi.y;
        *(u32x4*)(PI0 + (size_t)dir * PREP_ITEM + (which ? 3 : 0) * 4096 + rw * 64 + sgp * 8) = o;
    }
    __syncthreads();
}

__device__ __forceinline__ void sgu_item(const Args& a, LAS unsigned char* lds, int l, int ch, int g, int dry, bool w_cached) {
    const int tid = otid(), lane = tid & 63, wave = tid >> 6;
    LAS bf16* Wl = (LAS bf16*)lds;
    LAS bf16* VT = Wl + 128 * 136;
    LAS float* rstd = (LAS float*)(VT + 64 * 136);
    bf16* PB = (bf16*)(a.ws + WS_PB);
    const int row0 = ch * 128;
    bf16 upre[4][4], gpre[4][4];
    {
        const int m0 = wave * 16, r = lane & 15, kg = lane >> 4;
#pragma unroll
        for (int nt = 0; nt < 4; ++nt)
#pragma unroll
            for (int q = 0; q < 4; ++q) { const size_t ro = (size_t)(row0 + m0 + 4 * kg + q) * LDP + g * 64 + nt * 16 + r; upre[nt][q] = PB[ro + C_U]; gpre[nt][q] = PB[ro + C_GB]; }
    }
    {
        const int q = tid >> 2, part = tid & 3;
        const u32x4* vp = (const u32x4*)(PB + (size_t)(row0 + q) * LDP + C_V + part * 64);
        float ss = 0.f;
#pragma unroll
        for (int i = 0; i < 8; ++i) { const u32x4 v = vp[i];
            const float f0 = bflo(v.x), f1 = bfhi(v.x), f2 = bflo(v.y), f3 = bfhi(v.y), f4 = bflo(v.z), f5 = bfhi(v.z), f6 = bflo(v.w), f7 = bfhi(v.w);
            ss += (f0 * f0 + f1 * f1) + (f2 * f2 + f3 * f3) + (f4 * f4 + f5 * f5) + (f6 * f6 + f7 * f7); }
        ss += __shfl_xor(ss, 1); ss += __shfl_xor(ss, 2);
        if (part == 0) rstd[q] = rsqrtf(ss * (1.f / 256.f) + EPS);
    }
    if (!w_cached)
    for (int t = tid; t < 128 * 16; t += NTHR) {
        const int p = t >> 4, q8 = t & 15;
        const f32x4* wp = (const f32x4*)(a.in[I_SGUW] + ((size_t)(l * 4 + g) * 128 + p) * 128 + q8 * 8);
        const f32x4 w0 = wp[0], w1 = wp[1];
        u32x4 o; o.x = pk2(w0.x, w0.y); o.y = pk2(w0.z, w0.w); o.z = pk2(w1.x, w1.y); o.w = pk2(w1.z, w1.w);
        *(LAS u32x4*)(Wl + p * 136 + q8 * 8) = o;
    }
    __syncthreads();
    for (int t = tid; t < 128 * 8; t += NTHR) {
        const int q = t >> 3, c0 = (t & 7) * 8;
        const u32x4 v = *(const u32x4*)(PB + (size_t)(row0 + q) * LDP + C_V + g * 64 + c0);
        const f32x4 g0 = *(const f32x4*)(a.in[I_SGUNG] + l * 256 + g * 64 + c0), g1 = *(const f32x4*)(a.in[I_SGUNG] + l * 256 + g * 64 + c0 + 4);
        const float r = rstd[q];
        VT[(c0 + 0) * 136 + q] = (bf16)f2bf(bflo(v.x) * r * g0.x); VT[(c0 + 1) * 136 + q] = (bf16)f2bf(bfhi(v.x) * r * g0.y);
        VT[(c0 + 2) * 136 + q] = (bf16)f2bf(bflo(v.y) * r * g0.z); VT[(c0 + 3) * 136 + q] = (bf16)f2bf(bfhi(v.y) * r * g0.w);
        VT[(c0 + 4) * 136 + q] = (bf16)f2bf(bflo(v.z) * r * g1.x); VT[(c0 + 5) * 136 + q] = (bf16)f2bf(bfhi(v.z) * r * g1.y);
        VT[(c0 + 6) * 136 + q] = (bf16)f2bf(bflo(v.w) * r * g1.z); VT[(c0 + 7) * 136 + q] = (bf16)f2bf(bfhi(v.w) * r * g1.w);
    }
    __syncthreads();
    {
        const int m0 = wave * 16, r = lane & 15, kg = lane >> 4;
#pragma unroll
        for (int nt = 0; nt < 4; ++nt) {
            f32x4 acc = (f32x4){0.f, 0.f, 0.f, 0.f};
            acc = tile_mm<4>(acc, Wl, 136, m0, VT, 136, nt * 16, lane);
#pragma unroll
            for (int q = 0; q < 4; ++q) {
                const int p = m0 + 4 * kg + q, c = nt * 16 + r;
                const float sv = acc[q] + a.in[I_SGUB][(l * 4 + g) * 128 + p];
                bf16* up = PB + (size_t)(row0 + p) * LDP + C_U + g * 64 + c;
                const float uu = bf2f(upre[nt][q]), gb = bf2f(gpre[nt][q]);
                if (dry) up = (bf16*)(a.ws + WS_DUM) + (size_t)((row0 + p) & 1023) * LDP + C_U + g * 64 + c;
                *up = (bf16)f2bf(uu * sv * gb);
            }
        }
    }
    __syncthreads();
}

__device__ __forceinline__ void pool_item(const Args& a, LAS unsigned char* lds, int l, int sc, int dry) {
    const int tid = otid();
    LAS bf16* xt = (LAS bf16*)lds;
    bf16* PB = (bf16*)(a.ws + WS_PB);
    const SeqGeo sg = seq_geo(sc);
    u32x4 gpre[4];
#pragma unroll
    for (int i = 0; i < 4; ++i) { const int t = tid + NTHR * i, tok = t >> 5, c8 = t & 31; gpre[i] = *(const u32x4*)(PB + (size_t)(sg.seq_row0 + sg.tseq0 + tok) * LDP + C_GC + c8 * 8); }
    for (int t = tid; t < 80 * 32; t += NTHR) {
        const int r = t >> 5, c8 = t & 31, ts = sg.tseq0 - 8 + r;
        u32x4 v = (u32x4){0u, 0u, 0u, 0u};
        if (ts >= 0 && ts < sg.T) v = *(const u32x4*)(PB + (size_t)(sg.seq_row0 + ts) * LDP + C_XC + c8 * 8);
        *(LAS u32x4*)(xt + r * 264 + c8 * 8) = v;
    }
    __syncthreads();
#pragma unroll
    for (int i4 = 0; i4 < 4; ++i4) {
        const int t = tid + NTHR * i4;
        const int tok = t >> 5, c8 = t & 31, gi = c8 >> 3, half = 1 << gi;
        const int ts = sg.tseq0 + tok;
        const int lo = (ts - half) < 0 ? 0 : ts - half, hi = (ts + half) > sg.T ? sg.T : ts + half;
        float s[8];
#pragma unroll
        for (int c = 0; c < 8; ++c) s[c] = 0.f;
        for (int tt = lo; tt < hi; ++tt) {
            const u32x4 v = *(const LAS u32x4*)(xt + (tt - sg.tseq0 + 8) * 264 + c8 * 8);
            s[0] += bflo(v.x); s[1] += bfhi(v.x); s[2] += bflo(v.y); s[3] += bfhi(v.y); s[4] += bflo(v.z); s[5] += bfhi(v.z); s[6] += bflo(v.w); s[7] += bfhi(v.w);
        }
        const float inv = 1.f / (float)(hi - lo);
        const u32x4 xv = *(const LAS u32x4*)(xt + (tok + 8) * 264 + c8 * 8);
        const float x0[8] = {bflo(xv.x), bfhi(xv.x), bflo(xv.y), bfhi(xv.y), bflo(xv.z), bfhi(xv.z), bflo(xv.w), bfhi(xv.w)};
        bf16* yp = PB + (size_t)(sg.seq_row0 + ts) * LDP + C_GC + c8 * 8;
        const u32x4 gv = gpre[i4];
        const float gg[8] = {bflo(gv.x), bfhi(gv.x), bflo(gv.y), bfhi(gv.y), bflo(gv.z), bfhi(gv.z), bflo(gv.w), bfhi(gv.w)};
        const f32x4 p0 = *(const f32x4*)(a.in[I_POOLS] + l * 256 + c8 * 8), p1 = *(const f32x4*)(a.in[I_POOLS] + l * 256 + c8 * 8 + 4);
        const float ps[8] = {p0.x, p0.y, p0.z, p0.w, p1.x, p1.y, p1.z, p1.w};
        float y[8];
#pragma unroll
        for (int c = 0; c < 8; ++c) y[c] = (s[c] * inv - x0[c]) * ps[c] * gg[c];
        u32x4 o; o.x = pk2(y[0], y[1]); o.y = pk2(y[2], y[3]); o.z = pk2(y[4], y[5]); o.w = pk2(y[6], y[7]);
        if (dry) yp = (bf16*)(a.ws + WS_DUM) + (size_t)((sg.seq_row0 + ts) & 1023) * LDP + C_GC + c8 * 8;
        *(u32x4*)yp = o;
    }
    __syncthreads();
}

__device__ __forceinline__ void fctx_item(const Args& a, LAS unsigned char* lds, int b, int dblk, int dry) {
    const int tid = otid(), lane = tid & 63, wave = __builtin_amdgcn_readfirstlane(tid >> 6);
    LAS bf16* ZT = (LAS bf16*)lds;
    bf16* PB = (bf16*)(a.ws + WS_PB);
    const bf16* DFT = (const bf16*)(a.ws + WS_DFT);
    {
        u32x4 v[8];
#pragma unroll
        for (int i = 0; i < 8; ++i) { const int t = tid + NTHR * i, d8 = t & 7, ri = (t >> 3) & 1, tt = t >> 4;
            v[i] = *(const u32x4*)(PB + (size_t)(b * 256 + tt) * LDP + (ri ? C_QF : C_PF) + dblk * 64 + d8 * 8); }
#pragma unroll
        for (int i = 0; i < 8; ++i) { const int t = tid + NTHR * i, d8 = t & 7, ri = (t >> 3) & 1, tt = t >> 4;
            LAS bf16* dst = ZT + (d8 * 8) * 520 + ri * 256 + tt;
            dst[0 * 520] = (bf16)(v[i].x & 0xffffu); dst[1 * 520] = (bf16)(v[i].x >> 16); dst[2 * 520] = (bf16)(v[i].y & 0xffffu); dst[3 * 520] = (bf16)(v[i].y >> 16);
            dst[4 * 520] = (bf16)(v[i].z & 0xffffu); dst[5 * 520] = (bf16)(v[i].z >> 16); dst[6 * 520] = (bf16)(v[i].w & 0xffffu); dst[7 * 520] = (bf16)(v[i].w >> 16); }
    }
    __syncthreads();
    const int r = lane & 15, kg = lane >> 4;
#pragma unroll 1
    for (int mi = 0; mi < 2; ++mi) {
        const int m0 = wave * 32 + mi * 16;
        bf16 gdv[4][4];
#pragma unroll
        for (int nt = 0; nt < 4; ++nt)
#pragma unroll
            for (int q = 0; q < 4; ++q) gdv[nt][q] = PB[(size_t)(b * 256 + m0 + 4 * kg + q) * LDP + C_GD + dblk * 64 + nt * 16 + r];
        f32x4 acc[4];
#pragma unroll
        for (int nt = 0; nt < 4; ++nt) acc[nt] = (f32x4){0.f, 0.f, 0.f, 0.f};
#pragma unroll
        for (int kh = 0; kh < 2; ++kh) {
            bf16x8 af[8];
#pragma unroll
            for (int ksx = 0; ksx < 8; ++ksx) af[ksx] = *(const bf16x8*)(DFT + (size_t)(m0 + r) * 512 + (kh * 8 + ksx) * 32 + kg * 8);
#pragma unroll
            for (int nt = 0; nt < 4; ++nt) {
#pragma unroll
                for (int ksx = 0; ksx < 8; ++ksx) {
                    const bf16x8 bfr = *(const LAS bf16x8*)(ZT + (nt * 16 + r) * 520 + (kh * 8 + ksx) * 32 + kg * 8);
                    acc[nt] = __builtin_amdgcn_mfma_f32_16x16x32_bf16(af[ksx], bfr, acc[nt], 0, 0, 0);
                }
                __builtin_amdgcn_sched_barrier(0);
            }
        }
#pragma unroll
        for (int nt = 0; nt < 4; ++nt)
#pragma unroll
            for (int q = 0; q < 4; ++q) {
                const int k = m0 + 4 * kg + q, d = nt * 16 + r;
                bf16* yp = (dry ? (bf16*)(a.ws + WS_DUM) + (size_t)((b * 256 + k) & 1023) * LDP : PB + (size_t)(b * 256 + k) * LDP) + C_GD + dblk * 64 + d;
                *yp = (bf16)f2bf(acc[nt][q] * bf2f(gdv[nt][q]));
            }
    }
    __syncthreads();
}

__device__ __forceinline__ void fsmp_item(const Args& a, LAS unsigned char* lds, int b, int ds, int dry) {
    const int tid = otid(), lane = tid & 63, wave = __builtin_amdgcn_readfirstlane(tid >> 6);
    LAS bf16* ZT = (LAS bf16*)lds;
    LAS bf16* B2 = ZT + 256 * 136;
    bf16* PB = (bf16*)(a.ws + WS_PB);
    const bf16* M1 = (const bf16*)(a.ws + WS_M1);
    const bf16* M2 = (const bf16*)(a.ws + WS_M2);
    const int d0 = ds * 4;
    const size_t rowb = (size_t)M_CTX + (size_t)b * 4096;
    const int r = lane & 15, kg = lane >> 4, mp = wave & 3, nb = wave >> 2;
    {
        u32x2 v[16];
#pragma unroll
        for (int i = 0; i < 16; ++i) { const int t = tid + NTHR * i, ri = t & 1, tt = t >> 1;
            v[i] = *(const u32x2*)(PB + (rowb + tt) * LDP + (ri ? C_QF : C_PF) + d0); }
#pragma unroll
        for (int i = 0; i < 16; ++i) { const int t = tid + NTHR * i, ri = t & 1, tt = t >> 1, t1 = tt >> 6, t2 = tt & 63;
            LAS bf16* dst = ZT + (t2 * 4) * 136 + ri * 64 + t1;
            dst[0] = (bf16)(v[i].x & 0xffffu); dst[136] = (bf16)(v[i].x >> 16); dst[272] = (bf16)(v[i].y & 0xffffu); dst[408] = (bf16)(v[i].y >> 16); }
    }
    bf16x8 aRe[4], aIm[4], a2[4];
#pragma unroll
    for (int ksx = 0; ksx < 4; ++ksx) {
        aRe[ksx] = *(const bf16x8*)(M1 + (16 * mp + r) * 128 + ksx * 32 + kg * 8);
        aIm[ksx] = *(const bf16x8*)(M1 + (64 + 16 * mp + r) * 128 + ksx * 32 + kg * 8);
        a2[ksx] = *(const bf16x8*)(M2 + (16 * mp + r) * 128 + ksx * 32 + kg * 8);
    }
    bf16 gdv[8][4];
#pragma unroll
    for (int jb = 0; jb < 8; ++jb) { const int n = 16 * (nb + 2 * jb) + r, k1 = n >> 2, dd = n & 3;
#pragma unroll
        for (int q = 0; q < 4; ++q) gdv[jb][q] = PB[(rowb + k1 + 64 * (16 * mp + 4 * kg + q)) * LDP + C_GD + d0 + dd]; }
    __syncthreads();
#pragma unroll 2
    for (int jb = 0; jb < 8; ++jb) {
        const int nt = nb + 2 * jb;
        f32x4 ar = (f32x4){0.f, 0.f, 0.f, 0.f}, ai = (f32x4){0.f, 0.f, 0.f, 0.f};
#pragma unroll
        for (int ksx = 0; ksx < 4; ++ksx) {
            const bf16x8 z = *(const LAS bf16x8*)(ZT + (16 * nt + r) * 136 + ksx * 32 + kg * 8);
            ar = __builtin_amdgcn_mfma_f32_16x16x32_bf16(aRe[ksx], z, ar, 0, 0, 0);
            ai = __builtin_amdgcn_mfma_f32_16x16x32_bf16(aIm[ksx], z, ai, 0, 0, 0);
        }
        const int n = 16 * nt + r, t2 = n >> 2, dd = n & 3;
#pragma unroll
        for (int q = 0; q < 4; ++q) {
            const int k1 = 16 * mp + 4 * kg + q;
            const float rev = (float)((k1 * t2) & 4095) * (1.f / 4096.f);
            const float cw = __builtin_amdgcn_cosf(rev), sw = __builtin_amdgcn_sinf(rev);
            const float xr = ar[q] * cw - ai[q] * sw, xi = ar[q] * sw + ai[q] * cw;
            B2[(k1 * 4 + dd) * 136 + t2] = (bf16)f2bf(xr);
            B2[(k1 * 4 + dd) * 136 + 64 + t2] = (bf16)f2bf(xi);
        }
    }
    __syncthreads();
#pragma unroll 2
    for (int jb = 0; jb < 8; ++jb) {
        const int nt = nb + 2 * jb;
        f32x4 acc = (f32x4){0.f, 0.f, 0.f, 0.f};
#pragma unroll
        for (int ksx = 0; ksx < 4; ++ksx) {
            const bf16x8 z = *(const LAS bf16x8*)(B2 + (16 * nt + r) * 136 + ksx * 32 + kg * 8);
            acc = __builtin_amdgcn_mfma_f32_16x16x32_bf16(a2[ksx], z, acc, 0, 0, 0);
        }
        const int n = 16 * nt + r, k1 = n >> 2, dd = n & 3;
#pragma unroll
        for (int q = 0; q < 4; ++q) {
            const int k2 = 16 * mp + 4 * kg + q, kk = k1 + 64 * k2;
            bf16* yp = (dry ? (bf16*)(a.ws + WS_DUM) + (size_t)(kk & 1023) * LDP : PB + (rowb + kk) * LDP) + C_GD + d0 + dd;
            *yp = (bf16)f2bf(acc[q] * bf2f(gdv[jb][q]));
        }
    }
    __syncthreads();
}

constexpr int SC_MAT = 64 * 72 * 2;
constexpr int SC_BUF = 5 * SC_MAT + 16;
constexpr int SC_OT = 2 * SC_BUF;
__device__ __forceinline__ void scan_item(const Args& a, LAS unsigned char* lds, int l, int seq, int h, int dir) {
    const int tid = otid(), lane = tid & 63, wave = __builtin_amdgcn_readfirstlane(tid >> 6);
    bf16* PB = (bf16*)(a.ws + WS_PB);
    const int nch = seq < 32 ? 4 : 64;
    const int sc0 = seq < 32 ? seq * 4 : 128 + (seq - 32) * 64;
    const int r = lane & 15, kg = lane >> 4;
    if (wave >= 4) {
        const int ht = tid - 256;
        constexpr int PD_ = 4;
        u32x4 pre[PD_][10]; float pgl[PD_];
#define SC_ISSUE(set, ss) do { const int s_ = (ss) < nch ? (ss) : nch - 1; const int c_ = dir ? nch - 1 - s_ : s_; const size_t pid_ = (size_t)((sc0 + c_) * 4 + h) * 2 + dir; \
            const u32x4* src_ = (const u32x4*)((const bf16*)(a.ws + WS_PREP) + pid_ * PREP_ITEM) + ht; \
            _Pragma("unroll") for (int i_ = 0; i_ < 10; ++i_) pre[set][i_] = src_[256 * i_]; \
            pgl[set] = ((const float*)(a.ws + WS_PGL))[pid_]; } while (0)
#define SC_WRITE(set, bb) do { LAS unsigned char* B_ = lds + (bb) * SC_BUF; \
            _Pragma("unroll") for (int i_ = 0; i_ < 10; ++i_) { const int ch_ = ht + 256 * i_; \
                *(LAS u32x4*)(B_ + (ch_ >> 9) * SC_MAT + ((ch_ >> 3) & 63) * 144 + (ch_ & 7) * 16) = pre[set][i_]; } \
            if (ht == 0) *(LAS float*)(B_ + 5 * SC_MAT) = pgl[set]; } while (0)
#define SC_OSTORE(ss) do { const int c_ = dir ? nch - 1 - (ss) : (ss); const LAS unsigned char* O_ = lds + SC_OT + ((ss) & 1) * SC_MAT; \
            _Pragma("unroll") for (int i_ = 0; i_ < 2; ++i_) { const int ch_ = ht + 256 * i_, rw_ = ch_ >> 3, c8_ = ch_ & 7; \
                const u32x4 v_ = *(const LAS u32x4*)(O_ + rw_ * 144 + c8_ * 16); \
                *(u32x4*)(PB + (size_t)((sc0 + c_) * 64 + (dir ? 63 - rw_ : rw_)) * LDP + (dir ? C_K : C_Q) + h * 64 + c8_ * 8) = v_; } } while (0)
        SC_ISSUE(0, 0); SC_ISSUE(1, 1); SC_ISSUE(2, 2); SC_ISSUE(3, 3);
        SC_WRITE(0, 0);
        SC_ISSUE(0, 4);
        __syncthreads();
#pragma unroll 1
        for (int s0 = 0; s0 < nch; s0 += 4) {
#pragma unroll
            for (int j = 0; j < 4; ++j) {
                const int s = s0 + j;
                SC_WRITE((j + 1) & 3, (s + 1) & 1);
                if (s > 0) SC_OSTORE(s - 1);
                SC_ISSUE((j + 1) & 3, s + 5);
                __syncthreads();
            }
        }
        SC_OSTORE(nch - 1);
#undef SC_ISSUE
#undef SC_WRITE
#undef SC_OSTORE
    } else {
        const int e = 16 * wave + r;
        f32x4 S[4];
#pragma unroll
        for (int t = 0; t < 4; ++t)
#pragma unroll
            for (int q = 0; q < 4; ++q) {
                const int d = 16 * t + 4 * kg + q;
                S[t][q] = (seq < 32) ? 0.f : a.in[I_STATE][((size_t)(((seq - 32) * 4 + l) * 2 + dir) * 4 + h) * 4096 + d * 64 + e];
            }
        __syncthreads();
#pragma unroll 1
        for (int s = 0; s < nch; ++s) {
            const LAS unsigned char* B = lds + (s & 1) * SC_BUF;
            const LAS bf16* Wm = (const LAS bf16*)B; const LAS bf16* Qd = Wm + 64 * 72; const LAS bf16* KdT = Qd + 64 * 72; const LAS bf16* QKm = KdT + 64 * 72; const LAS bf16* UT = QKm + 64 * 72;
            const float egl = *(const LAS float*)(B + 5 * SC_MAT);
            LAS bf16* OT = (LAS bf16*)(lds + SC_OT + (s & 1) * SC_MAT);
            bf16x8 bS[2];
            bS[0] = pack8(S[0], S[1]); bS[1] = pack8(S[2], S[3]);
            f32x4 a1[4], oo[4];
#pragma unroll
            for (int t = 0; t < 4; ++t) {
                a1[t] = (f32x4){0.f, 0.f, 0.f, 0.f}; oo[t] = (f32x4){0.f, 0.f, 0.f, 0.f};
#pragma unroll
                for (int ksx = 0; ksx < 2; ++ksx) {
                    const bf16x8 wf = *(const LAS bf16x8*)(Wm + (16 * t + r) * 72 + ksx * 32 + kg * 8);
                    const bf16x8 qf = *(const LAS bf16x8*)(Qd + (16 * t + r) * 72 + ksx * 32 + kg * 8);
                    a1[t] = __builtin_amdgcn_mfma_f32_16x16x32_bf16(wf, bS[ksx], a1[t], 0, 0, 0);
                    oo[t] = __builtin_amdgcn_mfma_f32_16x16x32_bf16(qf, bS[ksx], oo[t], 0, 0, 0);
                }
            }
            f32x4 vn[4];
#pragma unroll
            for (int t = 0; t < 4; ++t) {
                const u32x2 uu = *(const LAS u32x2*)(UT + e * 72 + 16 * t + 4 * kg);
                vn[t][0] = bflo(uu.x) - a1[t][0]; vn[t][1] = bfhi(uu.x) - a1[t][1]; vn[t][2] = bflo(uu.y) - a1[t][2]; vn[t][3] = bfhi(uu.y) - a1[t][3];
            }
            bf16x8 bV[2];
            bV[0] = pack8(vn[0], vn[1]); bV[1] = pack8(vn[2], vn[3]);
#pragma unroll
            for (int t = 0; t < 4; ++t) {
                f32x4 as = (f32x4){0.f, 0.f, 0.f, 0.f};
#pragma unroll
                for (int ksx = 0; ksx < 2; ++ksx) {
                    const bf16x8 kf = *(const LAS bf16x8*)(QKm + (16 * t + r) * 72 + ksx * 32 + kg * 8);
                    const bf16x8 df = *(const LAS bf16x8*)(KdT + (16 * t + r) * 72 + ksx * 32 + kg * 8);
                    oo[t] = __builtin_amdgcn_mfma_f32_16x16x32_bf16(kf, bV[ksx], oo[t], 0, 0, 0);
                    as = __builtin_amdgcn_mfma_f32_16x16x32_bf16(df, bV[ksx], as, 0, 0, 0);
                }
                S[t] = S[t] * egl + as;
            }
#pragma unroll
            for (int t = 0; t < 4; ++t)
#pragma unroll
                for (int q = 0; q < 4; ++q) OT[(16 * t + 4 * kg + q) * 72 + e] = (bf16)f2bf(oo[t][q]);
            __syncthreads();
        }
        if (seq < 32) {
            float* ns = a.out + (size_t)M * D + ((size_t)((seq * 4 + l) * 2 + dir) * 4 + h) * 4096;
#pragma unroll
            for (int t = 0; t < 4; ++t)
#pragma unroll
                for (int q = 0; q < 4; ++q) ns[(16 * t + 4 * kg + q) * 64 + e] = S[t][q];
        }
    }
    __syncthreads();
}

__device__ __forceinline__ void phase_combine(const Args& a, int l, int dry) {
    const int tid = otid(), lane = tid & 63, wave = tid >> 6, G = gridDim.x, bid = obid();
    bf16* PB = (bf16*)(a.ws + WS_PB);
    const f32x4 ng = *(const f32x4*)(a.in[I_DNG] + l * 64 + (lane & 15) * 4);
    for (int row = bid * NWAVES + wave; row < M; row += G * NWAVES) {
        bf16* rp = PB + (size_t)row * LDP;
        const u32x2 of = *((const u32x2*)(rp + C_Q) + lane), ob = *((const u32x2*)(rp + C_K) + lane), ga = *((const u32x2*)(rp + C_GA) + lane);
        const float o0 = bflo(of.x) + bflo(ob.x), o1 = bfhi(of.x) + bfhi(ob.x), o2 = bflo(of.y) + bflo(ob.y), o3 = bfhi(of.y) + bfhi(ob.y);
        float ss = (o0 * o0 + o1 * o1) + (o2 * o2 + o3 * o3);
        ss += __shfl_xor(ss, 1); ss += __shfl_xor(ss, 2); ss += __shfl_xor(ss, 4); ss += __shfl_xor(ss, 8);
        const float rinv = rsqrtf(ss * (1.f / 64.f) + EPS);
        u32x2 y; y.x = pk2(o0 * rinv * ng.x * bflo(ga.x), o1 * rinv * ng.y * bfhi(ga.x)); y.y = pk2(o2 * rinv * ng.z * bflo(ga.y), o3 * rinv * ng.w * bfhi(ga.y));
        if (dry) rp = (bf16*)(a.ws + WS_DUM) + (size_t)(row & 1023) * LDP;
        *((u32x2*)(rp + C_GA) + lane) = y;
    }
}

constexpr int PF_ROWS = 5;
struct FinalRegs { u32x4 x[PF_ROWS][2]; float rinv[PF_ROWS]; };
__device__ __forceinline__ void final_load(const Args& a, FinalRegs& R, int rnd) {
    const int tid = otid(), lane = tid & 63, wave = tid >> 6, G = gridDim.x, bid = obid();
    const float* RSS = (const float*)(a.ws + WS_RSS);
    const bf16* XB = (const bf16*)a.out + (size_t)M * D;
#pragma unroll
    for (int i = 0; i < PF_ROWS; ++i) {
        const int row = bid * NWAVES + wave + G * NWAVES * (i + PF_ROWS * rnd);
        if (row < M) {
            const u32x4* xr = (const u32x4*)(XB + (size_t)row * D) + lane * 2;
            R.x[i][0] = xr[0]; R.x[i][1] = xr[1];
            float p = (lane < 16) ? RSS[(size_t)row * 16 + lane] : 0.f;
            p += __shfl_xor(p, 1); p += __shfl_xor(p, 2); p += __shfl_xor(p, 4); p += __shfl_xor(p, 8);
            R.rinv[i] = rsqrtf(__shfl(p, 0) * (1.f / 1024.f) + EPS);
        } else { R.x[i][0] = (u32x4){0u, 0u, 0u, 0u}; R.x[i][1] = R.x[i][0]; R.rinv[i] = 0.f; }
    }
}
__device__ __forceinline__ void final_store(const Args& a, const FinalRegs& R, int rnd) {
    const int tid = otid(), lane = tid & 63, wave = tid >> 6, G = gridDim.x, bid = obid();
    f32x4 fg[4];
#pragma unroll
    for (int q = 0; q < 4; ++q) fg[q] = *((const f32x4*)(a.in[I_FNG]) + lane * 4 + q);
#pragma unroll
    for (int i = 0; i < PF_ROWS; ++i) {
        const int row = bid * NWAVES + wave + G * NWAVES * (i + PF_ROWS * rnd);
        if (row < M) {
            f32x4* orow = (f32x4*)(a.out + (size_t)row * D) + lane * 4;
            const u32x4 x0 = R.x[i][0], x1 = R.x[i][1]; const float ri = R.rinv[i];
            orow[0] = (f32x4){bflo(x0.x), bfhi(x0.x), bflo(x0.y), bfhi(x0.y)} * ri * fg[0];
            orow[1] = (f32x4){bflo(x0.z), bfhi(x0.z), bflo(x0.w), bfhi(x0.w)} * ri * fg[1];
            orow[2] = (f32x4){bflo(x1.x), bfhi(x1.x), bflo(x1.y), bfhi(x1.y)} * ri * fg[2];
            orow[3] = (f32x4){bflo(x1.z), bfhi(x1.z), bflo(x1.w), bfhi(x1.w)} * ri * fg[3];
        }
    }
}

__device__ __forceinline__ void skinny_ba(const Args& a, int l, int pm) {
    const int tid = otid(), lane = tid & 63, wave = __builtin_amdgcn_readfirstlane(tid >> 6), r = lane & 15, kg = lane >> 4;
    const bf16* A = (const bf16*)a.out + (size_t)(pm * 256 + wave * 32 + r) * 1024 + kg * 8;
    const bf16* Bw = (const bf16*)(a.ws + WS_W1T) + ((size_t)l * N1 + 3072 + r) * 1024 + kg * 8;
    f32x4 acc0 = (f32x4){0.f, 0.f, 0.f, 0.f}, acc1 = acc0;
    bf16x8 a0[2][4], a1[2][4], bw[2][4];
#define SK_LOAD(buf, kc_) do { _Pragma("unroll") for (int ksx = 0; ksx < 4; ++ksx) { const int k = ((kc_) * 4 + ksx) * 32; \
        a0[buf][ksx] = *(const bf16x8*)(A + k); a1[buf][ksx] = *(const bf16x8*)(A + 16 * 1024 + k); bw[buf][ksx] = *(const bf16x8*)(Bw + k); } } while (0)
#define SK_MMA(buf) do { _Pragma("unroll") for (int ksx = 0; ksx < 4; ++ksx) { \
        acc0 = __builtin_amdgcn_mfma_f32_16x16x32_bf16(a0[buf][ksx], bw[buf][ksx], acc0, 0, 0, 0); \
        acc1 = __builtin_amdgcn_mfma_f32_16x16x32_bf16(a1[buf][ksx], bw[buf][ksx], acc1, 0, 0, 0); } } while (0)
    SK_LOAD(0, 0); SK_LOAD(1, 1);
    SK_MMA(0); SK_LOAD(0, 2); SK_MMA(1); SK_LOAD(1, 3); SK_MMA(0); SK_LOAD(0, 4); SK_MMA(1); SK_LOAD(1, 5);
    SK_MMA(0); SK_LOAD(0, 6); SK_MMA(1); SK_LOAD(1, 7); SK_MMA(0); SK_MMA(1);
#undef SK_LOAD
#undef SK_MMA
    const int j = pm < 32 ? 0 : 1 + ((pm - 32) >> 4);
    const float sw = ((const float*)(a.ws + WS_SW))[((size_t)l * 9 + j) * N1 + 3072 + r];
    const float* RSS = (const float*)(a.ws + WS_RSS);
    float* BA = (float*)(a.ws + WS_BA);
#pragma unroll
    for (int mi = 0; mi < 2; ++mi)
#pragma unroll
        for (int q = 0; q < 4; ++q) {
            const int row = pm * 256 + wave * 32 + mi * 16 + 4 * kg + q;
            const f32x4* rp = (const f32x4*)(RSS + (size_t)row * 16);
            const f32x4 r0 = rp[0], r1 = rp[1], r2 = rp[2], r3 = rp[3];
            const float ss = ((r0.x + r0.y) + (r0.z + r0.w)) + ((r1.x + r1.y) + (r1.z + r1.w)) + ((r2.x + r2.y) + (r2.z + r2.w)) + ((r3.x + r3.y) + (r3.z + r3.w));
            const float rinv = rsqrtf(ss * (1.f / 1024.f) + EPS);
            BA[(size_t)row * 16 + r] = (mi ? acc1[q] : acc0[q]) * rinv + sw;
        }
}

constexpr int NPHASE = 24;
__global__ void __launch_bounds__(NTHR, 2) fwd_kernel(Args args) {
    extern __shared__ __attribute__((aligned(16))) unsigned char lds_raw[];
    LAS unsigned char* lds = (LAS unsigned char*)lds_raw;
#if !MK_MULTI
    volatile LAS unsigned* MISC = (volatile LAS unsigned*)(lds + MISC_OFF);
    if (threadIdx.x < 64) MISC[threadIdx.x] = 0u;
    __syncthreads();
    XcdBarrier bar = xcd_barrier_post((unsigned*)(args.ws + WS_CTL) + CW_BAR, MISC + 8);
#define GRID_BAR() xcd_barrier(bar)
#else
#define GRID_BAR() do { } while (0)
#endif
    const int G = gridDim.x, bid = blockIdx.x;
    for (int pass = (PRE_HI > 0 ? 0 : 1); pass < 2; ++pass) {
        const int hi = (pass == 0) ? args.pad : args.ph_hi, lo = args.ph_lo;
#define RUN(k) ((k) >= lo && (k) < hi)
#define SEAM(k) do { if (RUN(k) && ((k) + 1 < hi || pass == 0)) { GRID_BAR(); for (int rb = 1; rb < REP_BAR; ++rb) GRID_BAR(); } } while (0)
        if (RUN(0)) { if (EN(0)) for (int rep = 0; rep < REP_P0; ++rep) phase_0a(args, lds); } SEAM(0);
        if (RUN(1)) { if (EN(1)) for (int rep = 0; rep < REP_P0; ++rep) phase_0b(args, lds); } SEAM(1);
        if (RUN(2)) { if (EN(2)) phase_0c(args); } SEAM(2);
#pragma unroll 1
        for (int l = 0; l < NL; ++l) {
            if (RUN(3 + 5 * l)) {
            if (EN(4)) {
                pg8::Gemm g{(const bf16*)args.out, (const bf16*)(args.ws + WS_W1T) + (size_t)l * N1 * 1024, M, LDP, 1024, 1024};
                pg8::StaticOrder S; S.init(M, LDP, G, bid);
                Epi1 E{(bf16*)(args.ws + WS_PB), (float*)(args.ws + WS_BA), (const float*)(args.ws + WS_RSS), (const float*)(args.ws + WS_SW) + (size_t)l * 9 * N1, 0, (bf16*)(args.ws + WS_DUM), (const LAS float*)(lds + 131072)};
                {
                    LAS float* rtab = (LAS float*)(lds + 131072); const float* RSSp = (const float*)(args.ws + WS_RSS);
                    for (int idx = otid(); idx < 8 * 256; idx += NTHR) { pg8::Unit u;
                        if (S.next(idx >> 8, u)) { const f32x4* rp = (const f32x4*)(RSSp + (size_t)(u.pm * 256 + (idx & 255)) * 16);
                            const f32x4 r0 = rp[0], r1 = rp[1], r2 = rp[2], r3 = rp[3];
                            const float ss = ((r0.x + r0.y) + (r0.z + r0.w)) + ((r1.x + r1.y) + (r1.z + r1.w)) + ((r2.x + r2.y) + (r2.z + r2.w)) + ((r3.x + r3.y) + (r3.z + r3.w));
                            rtab[idx] = rsqrtf(ss * (1.f / 1024.f) + EPS); } }
                    __syncthreads();
                }
                for (int rep = 0; rep < REP_G1; ++rep) { if (rep && G1CHEAP) E.cheap = args.one * G1CHEAP; pg8::gemm_phase<Epi1>(lds, g, S, E); if (rep && G1CHEAP) continue;
                    if (bid >= 128) for (int pm = bid - 128; pm < 160; pm += 128) skinny_ba(args, l, pm); } }
            }
            SEAM(3 + 5 * l);
            if (RUN(4 + 5 * l))
            {
                if (EN(5)) {
#if PREP_PREFETCH
                    PrepPre PP; if (bid < 2560) prep_prefetch(args, PP, bid >> 2, bid & 3);
                    for (int it = bid; it < 2560; it += G) { const int nit = it + G < 2560 ? it + G : -4; prep_item(args, lds, l, it >> 2, it & 3, PP, nit >> 2, nit & 3); }
#else
                    for (int it = bid; it < 2560; it += G) { PrepPre PP; prep_prefetch(args, PP, it >> 2, it & 3); prep_item(args, lds, l, it >> 2, it & 3, PP, -1, 0); }
#endif
                }
            }
            SEAM(4 + 5 * l);
            if (RUN(5 + 5 * l))
            {
                if (bid < 64 && !PSK(1)) { if (EN(10)) for (int rep = 0; rep < REP_SCAN; ++rep) scan_item(args, lds, l, 32 + (bid >> 3), (bid >> 1) & 3, bid & 1); }
                unsigned* qc = (unsigned*)(args.ws + WS_CTL) + CW_Q + 64 * l + 256 * pass;
                volatile LAS unsigned* qslot = (volatile LAS unsigned*)(lds + MISC_OFF) + 16;
                int lds_tag = 0;
                if (otid() == 0) qslot[0] = atomicAdd(qc, 1u);
                for (;;) {
                    __syncthreads();
                    const int it = (int)qslot[0];
                    __syncthreads();
                    if (it >= 2816) break;
                    unsigned nx = 0u; const bool puller = (otid() == 0);
                    if (it < 896 || it >= 2176) lds_tag = 0;
                    if (puller) nx = atomicAdd(qc, 1u);
                    if (it < 512) { if (EN(9) && !PSK(2)) fsmp_item(args, lds, it >> 6, it & 63, 0); }
                    else if (it < 640) { const int i2 = it - 512; if (EN(8) && !PSK(4)) fctx_item(args, lds, i2 >> 2, i2 & 3, 0); }
                    else if (it < 896) { const int i2 = it - 640; if (EN(10) && !PSK(8)) for (int rep = 0; rep < REP_SCAN; ++rep) scan_item(args, lds, l, i2 >> 3, (i2 >> 1) & 3, i2 & 1); }
                    else if (it < 2176) { const int i2 = it - 896, g_ = i2 / 320, ch_ = i2 % 320; if (EN(6) && !PSK(16)) { sgu_item(args, lds, l, ch_, g_, 0, lds_tag == 100 + g_); lds_tag = 100 + g_; } }
                    else { if (EN(7) && !PSK(32)) pool_item(args, lds, l, it - 2176, 0); }
                    if (puller) qslot[0] = nx;
                }
            }
            SEAM(5 + 5 * l);
            if (RUN(6 + 5 * l))
            {
                if (EN(11)) for (int rep = 0; rep < REP_COMB; ++rep) phase_combine(args, l, rep ? args.one : 0);
            }
            SEAM(6 + 5 * l);
            if (RUN(7 + 5 * l)) {
            if (EN(12)) {
                pg8::Gemm g{(const bf16*)(args.ws + WS_PB), (const bf16*)(args.ws + WS_W2T) + (size_t)l * 1024 * 1024, M, 1024, 1024, LDP};
                pg8::StaticOrder S; S.init(M, 1024, G, bid);
                const float* MOD = (const float*)(args.ws + WS_MOD);
                Epi2 E{(bf16*)args.out + (size_t)M * D, (bf16*)args.out, (float*)(args.ws + WS_RSS), MOD + (size_t)l * 9 * 3072 + 2048,
                       l < 3 ? args.in[I_NORMG] + (l + 1) * 1024 : nullptr, l < 3 ? MOD + (size_t)(l + 1) * 9 * 3072 + 1024 : nullptr, args.ws + WS_DUM, 0};
                pg8::gemm_phase<Epi2>(lds, g, S, E);
                for (int rep = 1; rep < REP_G2; ++rep) { Epi2 E2 = E; E2.dry = args.one; pg8::gemm_phase<Epi2>(lds, g, S, E2); }
            }
            }
            SEAM(7 + 5 * l);
        }
        if (RUN(23)) { if (EN(3) && pass == 1) { for (int rnd = 0; rnd < 4; ++rnd) { FinalRegs R; final_load(args, R, rnd); GRID_BAR(); final_store(args, R, rnd); } } }
#undef RUN
#undef SEAM
    }
}

extern "C" void kernel_launch(void* const* d_in, const int* in_sizes, int n_in, void* d_out, int out_size, void* d_ws, size_t ws_size, hipStream_t stream) {
    static int grid = 0;
    if (grid == 0) {
        if (n_in != 21 || ws_size < WS_DUM + 16 * MiB) { fprintf(stderr, "kernel_launch: unexpected n_in %d or ws_size %zu (< %zu)\n", n_in, ws_size, (size_t)WS_END); grid = -1; return; }
        int dev = 0, cus = 0, per_cu = 0;
        if (hipGetDevice(&dev) != hipSuccess || hipDeviceGetAttribute(&cus, hipDeviceAttributeMultiprocessorCount, dev) != hipSuccess) { grid = -1; return; }
        if (hipFuncSetAttribute((const void*)fwd_kernel, hipFuncAttributeMaxDynamicSharedMemorySize, LDS_BYTES) != hipSuccess) { fprintf(stderr, "kernel_launch: hipFuncSetAttribute failed\n"); grid = -1; return; }
        if (hipOccupancyMaxActiveBlocksPerMultiprocessor(&per_cu, (const void*)fwd_kernel, NTHR, LDS_BYTES) != hipSuccess || per_cu < 1) { fprintf(stderr, "kernel_launch: occupancy query failed (%d)\n", per_cu); (void)hipGetLastError(); per_cu = 1; }
        grid = cus * 1;
    }
    if (grid < 0) return;
    Args a{};
    for (int i = 0; i < 21; ++i) a.in[i] = (const float*)d_in[i];
    a.out = (float*)d_out; a.ws = (unsigned char*)d_ws; a.one = 1; a.pad = PRE_HI;
    (void)hipMemsetAsync((char*)d_ws + WS_CTL, 0, CTL_ZERO_BYTES, stream);
#if MK_MULTI
    for (int ph = 0; ph < NPHASE; ++ph) {
        a.ph_lo = ph; a.ph_hi = ph + 1;
        hipLaunchKernelGGL(fwd_kernel, dim3(grid), dim3(NTHR), LDS_BYTES, stream, a);
    }
#else
    a.ph_lo = 0; a.ph_hi = NPHASE;
    void* kargs[] = {&a};
    hipError_t e = hipLaunchCooperativeKernel((const void*)fwd_kernel, dim3(grid), dim3(NTHR), kargs, LDS_BYTES, stream);
    if (e != hipSuccess) fprintf(stderr, "kernel_launch: cooperative launch failed: %s (grid %d)\n", hipGetErrorString(e), grid);
#endif
}
```

```cpp
#include <hip/hip_runtime.h>
#include <cstdio>
#include <cstdint>

#ifndef MK_MULTI
#define MK_MULTI 0
#endif
#ifndef NAIVE_MM
#define NAIVE_MM 0
#endif
#ifndef ONLY
#define ONLY -1
#endif
#define EN(k) (ONLY < 0 || ONLY == (k))
#ifndef REP_G1
#define REP_G1 1
#endif
#ifndef REP_PREP
#define REP_PREP 1
#endif
#ifndef REP_SCAN
#define REP_SCAN 1
#endif
#ifndef REP_P0
#define REP_P0 1
#endif
#ifndef REP_MIX
#define REP_MIX 1
#endif
#ifndef REP_COMB
#define REP_COMB 1
#endif
#ifndef REP_G2
#define REP_G2 1
#endif
#ifndef MIXSEL
#define MIXSEL 15
#endif
#ifndef G1CHEAP
#define G1CHEAP 0
#endif
#ifndef REP_BAR
#define REP_BAR 1
#endif
#ifndef PRE_HI
#define PRE_HI 0
#endif
#ifndef REP_FCTX
#define REP_FCTX 1
#endif
#ifndef REP_FSMP
#define REP_FSMP 1
#endif
#ifndef REP_CTXS
#define REP_CTXS 1
#endif
#ifndef REP_SGU
#define REP_SGU 1
#endif
#ifndef PREP_PREFETCH
#define PREP_PREFETCH 0
#endif
#ifndef PRE_SKIP
#define PRE_SKIP 0
#endif
#define PSK(b) (pass == 0 && (PRE_SKIP & (b)))

#define LAS __attribute__((address_space(3)))
#define GAS __attribute__((address_space(1)))
typedef unsigned short bf16;
typedef short bf16x8 __attribute__((ext_vector_type(8)));
typedef float f32x4 __attribute__((ext_vector_type(4)));
typedef float f32x2 __attribute__((ext_vector_type(2)));
typedef unsigned u32x4 __attribute__((ext_vector_type(4)));
typedef unsigned u32x2 __attribute__((ext_vector_type(2)));

constexpr int D = 1024, NL = 4, NCOND = 9;
constexpr int M_CTX = 8192, M = 40960;
constexpr int PIN = 2832;
constexpr int N1 = 3328, LDP = 3072;
constexpr float EPS = 1e-6f;
constexpr int C_GA = 0, C_U = 256, C_GC = 512, C_GD = 768, C_V = 1024, C_GB = 1280, C_XC = 1536, C_PF = 1792, C_QF = 2048, C_Q = 2304, C_K = 2560, C_VV = 2816;

constexpr size_t MiB = 1u << 20;
constexpr size_t WS_CTL = 0, CTL_ZERO_BYTES = 1 * MiB;
constexpr size_t WS_MOD = 1 * MiB;
constexpr size_t WS_SW = WS_MOD + 512 * 1024;
constexpr size_t WS_GMAT = 2 * MiB;
constexpr size_t WS_POS = WS_GMAT + 512 * 1024;
constexpr size_t WS_DFT = WS_POS + 256 * 1024;
constexpr size_t WS_M1 = 3 * MiB;
constexpr size_t WS_M2 = WS_M1 + 32 * 1024;
constexpr size_t WS_TW = WS_M1 + 64 * 1024;
constexpr size_t WS_W1T = 4 * MiB;
constexpr size_t WS_W2T = 30 * MiB;
constexpr size_t WS_BA = 38 * MiB;
constexpr size_t WS_RSS = 41 * MiB;
constexpr size_t WS_PB = 44 * MiB;
constexpr size_t WS_HB = 284 * MiB;
constexpr size_t WS_PREP = 284 * MiB;
constexpr size_t WS_PGL = 484 * MiB;
constexpr size_t WS_VSS = 484 * MiB + 64 * 1024;
constexpr size_t WS_END = 485 * MiB;
constexpr size_t WS_DUM = 486 * MiB;
constexpr int CW_BAR = 4096, CW_Q = 8192;

constexpr int LDS_BYTES = 147456;
constexpr int MISC_OFF = 144 * 1024 - 256;
constexpr int NWAVES = 8, NTHR = 512;

typedef __bf16 hwbf16x2 __attribute__((ext_vector_type(2)));
__device__ __forceinline__ unsigned f2bf(float f) { return (unsigned)__builtin_bit_cast(unsigned short, (__bf16)f); }
__device__ __forceinline__ float bf2f(unsigned b) { return __builtin_bit_cast(float, (b & 0xffffu) << 16); }
__device__ __forceinline__ unsigned pk2(float lo, float hi) { const f32x2 v = {lo, hi}; return __builtin_bit_cast(unsigned, __builtin_convertvector(v, hwbf16x2)); }
__device__ __forceinline__ float bflo(unsigned w) { return __builtin_bit_cast(float, w << 16); }
__device__ __forceinline__ float bfhi(unsigned w) { return __builtin_bit_cast(float, w & 0xffff0000u); }
__device__ __forceinline__ float silu_f(float x) { return x * __builtin_amdgcn_rcpf(1.f + __builtin_amdgcn_exp2f(-1.4426950408889634f * x)); }
__device__ __forceinline__ float gelu_tanh_f(float x) { const float z = (-1.5957691216057308f * 1.4426950408889634f) * (x + 0.044715f * x * x * x); return x * __builtin_amdgcn_rcpf(1.f + __builtin_amdgcn_exp2f(z)); }
__device__ __forceinline__ float wave_sum(float v) {
#pragma unroll
    for (int o = 1; o < 64; o <<= 1) v += __shfl_xor(v, o);
    return v;
}
__device__ __forceinline__ int otid() { int t = threadIdx.x; asm volatile("" : "+v"(t)); return t; }
__device__ __forceinline__ int obid() { int b = blockIdx.x; asm volatile("" : "+s"(b)); return b; }
#define LDS_WAIT() asm volatile("s_waitcnt lgkmcnt(0)" ::: "memory")

namespace pg8 {
constexpr int BM = 256, BK = 64, HALF = 128, HTB = HALF * BK * 2, STAGE_BYTES = 8 * HTB, NXCD = 8, WGM = 8;
__host__ __device__ __forceinline__ int lds_byte(int r, int c) { const int st = (r >> 4) * 2 + (c >> 5), rr = r & 15, cc = c & 31, ob = rr * 64 + cc * 2; return st * 1024 + (ob ^ (((ob >> 9) & 1) << 5)); }
__host__ __device__ __forceinline__ void stage_rc(int b, int& R, int& C) { const int st = b / 1024, sb = b % 1024, swz = sb ^ (((sb >> 9) & 1) << 5); R = (st >> 1) * 16 + swz / 64; C = (st & 1) * 32 + (swz % 64) / 2; }
__host__ __device__ __forceinline__ int perm32(int rho) { const int n = rho >> 4, i = rho & 15; return 8 * (i >> 2) + 4 * n + (i & 3); }

struct Unit { int pm, pn; };
struct Gemm { const bf16* A; const bf16* Bt; int M, N, K, lda; };

struct StaticOrder {
    int nM, nN, nwg, G, c;
    __host__ __device__ void init(int M_, int N_, int G_, int c_) { nM = M_ / BM; nN = N_ / BM; nwg = nM * nN; G = G_; c = c_; }
    __host__ __device__ bool next(int i, Unit& u) const {
        const long L = (long)i * G + c; if (L >= nwg) return false;
        int wgid = (int)L; { const int q = nwg / NXCD, r = nwg % NXCD, xcd = wgid % NXCD, off = wgid / NXCD; wgid = (xcd < r ? xcd * (q + 1) : r * (q + 1) + (xcd - r) * q) + off; }
        const int nig = WGM * nN, gid = wgid / nig, fm = gid * WGM, gsz = (nM - fm) < WGM ? (nM - fm) : WGM;
        u.pm = fm + ((wgid % nig) % gsz); u.pn = (wgid % nig) / gsz; return true;
    }
};

template <class Epi>
__device__ __forceinline__ void gemm_phase(LAS unsigned char* lds, const Gemm g, const StaticOrder& S, const Epi& E) {
    const int tid = otid(), wid = __builtin_amdgcn_readfirstlane(tid >> 6), lane = tid & 63, wr = wid >> 2, wc = wid & 3, fr = lane & 15, fq = lane >> 4;
    const int K = g.K, nt = K / BK, lda = g.lda;
    unsigned voffA[2], voffB[2];
#pragma unroll
    for (int i = 0; i < 2; ++i) { int R, C; stage_rc(tid * 16 + i * 8192, R, C); const int Rb = Epi::PERM ? ((R & ~31) + perm32(R & 31)) : R;
        voffA[i] = (unsigned)(R * lda + C) * 2u; voffB[i] = (unsigned)(Rb * K + C) * 2u; }
    const size_t kstep = (size_t)(BK * 2);
    const size_t hstepA = (size_t)HALF * lda * 2, hstepB = (size_t)HALF * K * 2;
    const size_t tstepA = 2 * hstepA, tstepB = 2 * hstepB;
    const unsigned ldsw = (unsigned)wid * 1024u;
    const int aoff = lds_byte(wr * 64 + fr, fq * 8), boff = lds_byte(wc * 32 + fr, fq * 8);
#define PG8_SA(b, h) (((b) * 2 + (h)) * HTB)
#define PG8_SB(b, h) ((4 + (b) * 2 + (h)) * HTB)
#define PG8_STAGE(bufoff, gbase, voff) do { _Pragma("unroll") for (int _i = 0; _i < 2; ++_i) \
        __builtin_amdgcn_global_load_lds((const unsigned*)((const char*)(gbase) + (voff)[_i]), (LAS unsigned*)(lds + (bufoff) + ldsw + _i * 8192), 16, 0, 0); } while (0)
#define PG8_LDA(dst, b, h) do { _Pragma("unroll") for (int m = 0; m < 4; ++m) _Pragma("unroll") for (int k = 0; k < 2; ++k) dst[m][k] = *(const LAS bf16x8*)(lds + PG8_SA(b, h) + aoff + m * 2048 + k * 1024); } while (0)
#define PG8_LDB(dst, b, h) do { _Pragma("unroll") for (int n = 0; n < 2; ++n) _Pragma("unroll") for (int k = 0; k < 2; ++k) dst[n][k] = *(const LAS bf16x8*)(lds + PG8_SB(b, h) + boff + n * 2048 + k * 1024); } while (0)
#define PG8_MMA(ai, bj, At, Bt) do { __builtin_amdgcn_s_setprio(1); _Pragma("unroll") for (int m = 0; m < 4; ++m) _Pragma("unroll") for (int n = 0; n < 2; ++n) _Pragma("unroll") for (int k = 0; k < 2; ++k) \
        acc[ai][bj][m][n] = __builtin_amdgcn_mfma_f32_16x16x32_bf16(Bt[n][k], At[m][k], acc[ai][bj][m][n], 0, 0, 0); __builtin_amdgcn_s_setprio(0); } while (0)
#define PG8_WAIT_V(n) asm volatile("s_waitcnt vmcnt(" #n ")" ::: "memory")
#define PG8_WAIT_L(n) asm volatile("s_waitcnt lgkmcnt(" #n ")" ::: "memory")
#define PG8_BAR __builtin_amdgcn_s_barrier()
#define PG8_SCHED __builtin_amdgcn_sched_barrier(0)
    Unit cur, nxt; int ui = 0;
    if (!S.next(0, cur)) return;
    f32x4 acc[2][2][4][2];
#pragma unroll
    for (int a = 0; a < 2; ++a)
#pragma unroll
        for (int b = 0; b < 2; ++b)
#pragma unroll
            for (int m = 0; m < 4; ++m)
#pragma unroll
                for (int n = 0; n < 2; ++n) acc[a][b][m][n] = (f32x4){0.f, 0.f, 0.f, 0.f};
    bf16x8 At[4][2], B0[2][2], B1[2][2];
    const char* cA = (const char*)g.A + (size_t)cur.pm * tstepA; const char* cB = (const char*)g.Bt + (size_t)cur.pn * tstepB;
    PG8_STAGE(PG8_SB(0, 0), cB, voffB); PG8_STAGE(PG8_SA(0, 0), cA, voffA); PG8_STAGE(PG8_SB(0, 1), cB + hstepB, voffB); PG8_STAGE(PG8_SA(0, 1), cA + hstepA, voffA);
    if (wr == 1) PG8_BAR;
    PG8_WAIT_V(4); PG8_BAR;
    PG8_STAGE(PG8_SB(1, 0), cB + kstep, voffB); PG8_STAGE(PG8_SA(1, 0), cA + kstep, voffA); PG8_STAGE(PG8_SB(1, 1), cB + hstepB + kstep, voffB);
    PG8_WAIT_V(6); PG8_BAR;
    for (;;) {
        const bool has_next = S.next(ui + 1, nxt);
        const char* nA = has_next ? (const char*)g.A + (size_t)nxt.pm * tstepA : cA; const char* nB = has_next ? (const char*)g.Bt + (size_t)nxt.pn * tstepB : cB;
        for (int t = 0; t < nt; t += 2) {
            const bool last = (t == nt - 2);
            const char* a1 = cA + (size_t)(t + 1) * kstep;
            const char* a2 = last ? nA : cA + (size_t)(t + 2) * kstep; const char* b2 = last ? nB : cB + (size_t)(t + 2) * kstep;
            const char* a3 = a2 + kstep; const char* b3 = b2 + kstep;
            PG8_LDB(B0, 0, 0); PG8_SCHED; PG8_LDA(At, 0, 0); PG8_STAGE(PG8_SA(1, 1), a1 + hstepA, voffA);
            PG8_WAIT_L(8); PG8_BAR; PG8_WAIT_L(0); PG8_MMA(0, 0, At, B0); PG8_BAR; PG8_SCHED;
            PG8_LDB(B1, 0, 1); PG8_STAGE(PG8_SB(0, 0), b2, voffB);
            PG8_BAR; PG8_WAIT_L(0); PG8_MMA(0, 1, At, B1); PG8_BAR;
            PG8_LDA(At, 0, 1); PG8_STAGE(PG8_SA(0, 0), a2, voffA);
            PG8_BAR; PG8_WAIT_L(0); PG8_MMA(1, 0, At, B0); PG8_BAR; PG8_SCHED;
            PG8_STAGE(PG8_SB(0, 1), b2 + hstepB, voffB);
            PG8_WAIT_V(6); PG8_BAR; PG8_MMA(1, 1, At, B1); PG8_BAR;
            PG8_LDB(B0, 1, 0); PG8_SCHED; PG8_LDA(At, 1, 0); PG8_STAGE(PG8_SA(0, 1), a2 + hstepA, voffA);
            PG8_WAIT_L(8); PG8_BAR; PG8_WAIT_L(0); PG8_MMA(0, 0, At, B0); PG8_BAR; PG8_SCHED;
            PG8_LDB(B1, 1, 1); PG8_STAGE(PG8_SB(1, 0), b3, voffB);
            PG8_BAR; PG8_WAIT_L(0); PG8_MMA(0, 1, At, B1); PG8_BAR;
            PG8_LDA(At, 1, 1); PG8_STAGE(PG8_SA(1, 0), a3, voffA);
            PG8_BAR; PG8_WAIT_L(0); PG8_MMA(1, 0, At, B0); PG8_BAR; PG8_SCHED;
            PG8_STAGE(PG8_SB(1, 1), b3 + hstepB, voffB);
            PG8_WAIT_V(6); PG8_BAR; PG8_MMA(1, 1, At, B1); PG8_BAR;
        }
        E(acc, cur, wr, wc, fr, fq, ui);
        if (!has_next) break;
#pragma unroll
        for (int a = 0; a < 2; ++a)
#pragma unroll
            for (int b = 0; b < 2; ++b)
#pragma unroll
                for (int m = 0; m < 4; ++m)
#pragma unroll
                    for (int n = 0; n < 2; ++n) acc[a][b][m][n] = (f32x4){0.f, 0.f, 0.f, 0.f};
        cur = nxt; cA = nA; cB = nB; ++ui;
    }
    PG8_WAIT_V(0);
    if (wr == 0) PG8_BAR;
    PG8_BAR;
#undef PG8_SA
#undef PG8_SB
#undef PG8_STAGE
#undef PG8_LDA
#undef PG8_LDB
#undef PG8_MMA
#undef PG8_WAIT_V
#undef PG8_WAIT_L
#undef PG8_BAR
#undef PG8_SCHED
}
}

#define XB_TMO      128
#define XB_XCNT(j)  (256  + 64 * (j))
#define XB_XSUB(j)  (1280 + 64 * (j))
#define XB_XGEN(j)  (2304 + 64 * (j))
#define XB_TOP      3328
#define XB_TOPGEN   3392
#define XCD_BAR_WORDS 3456
#define XB_SPIN_CAP (1u << 18)
__device__ __forceinline__ unsigned xb_ld(unsigned* p)              { return __hip_atomic_load(p, __ATOMIC_RELAXED, __HIP_MEMORY_SCOPE_AGENT); }
__device__ __forceinline__ unsigned xb_add(unsigned* p, unsigned v) { return __hip_atomic_fetch_add(p, v, __ATOMIC_RELAXED, __HIP_MEMORY_SCOPE_AGENT); }
__device__ __forceinline__ unsigned xb_xcc_id() { return (unsigned)__builtin_amdgcn_s_getreg((3 << 11) | 20) & 0xFu; }
#define XB_SPIN(cond, bar) do { unsigned _sp = 0; while (cond) { __builtin_amdgcn_s_sleep(1); \
    if ((++_sp & 255u) == 0u) { if (xb_ld(&(bar)[XB_TMO])) break; if (_sp > XB_SPIN_CAP) { atomicAdd(&(bar)[XB_TMO], 1u); break; } } } } while (0)
struct XcdBarrier { unsigned* bar; unsigned x; volatile LAS unsigned* st; };
__device__ __forceinline__ XcdBarrier xcd_barrier_post(unsigned* bar, volatile LAS unsigned* st) {
    XcdBarrier b; b.bar = bar; b.x = xb_xcc_id(); b.st = st;
    if (threadIdx.x == 0) (void)xb_add(&bar[XB_XCNT(b.x)], 1u);
    return b;
}
__device__ __forceinline__ void xcd_barrier_complete(unsigned* bar, unsigned x, unsigned& nloc, unsigned& nx) {
    const unsigned G = gridDim.x * gridDim.y * gridDim.z;
    unsigned sum, cnt, mine, sp = 0u;
    for (;;) {
        sum = 0u; cnt = 0u; mine = 0u;
#pragma unroll
        for (unsigned j = 0; j < 16; ++j) { const unsigned c = xb_ld(&bar[XB_XCNT(j)]); sum += c; cnt += (c > 0u) ? 1u : 0u; mine = (j == x) ? c : mine; }
        if (sum == G) break;
        __builtin_amdgcn_s_sleep(1);
        if ((++sp & 255u) == 0u) { if (xb_ld(&bar[XB_TMO])) break; if (sp > XB_SPIN_CAP) { atomicAdd(&bar[XB_TMO], 1u); break; } }
    }
    nloc = mine > 0u ? mine : 1u; nx = cnt > 0u ? cnt : 1u;
}
__device__ __forceinline__ void xcd_barrier(const XcdBarrier& b) {
    asm volatile("s_waitcnt vmcnt(0)" ::: "memory");
    __syncthreads();
    if (threadIdx.x == 0) {
        unsigned* bar = b.bar;
        __builtin_amdgcn_s_waitcnt(0);
        unsigned nloc = b.st[0], nx = b.st[1];
        if (nloc == 0u) { xcd_barrier_complete(bar, b.x, nloc, nx); b.st[0] = nloc; b.st[1] = nx; }
        const unsigned old = xb_add(&bar[XB_XSUB(b.x)], 1u);
        const unsigned gen = old / nloc;
        if (old + 1u == (gen + 1u) * nloc) {
            __builtin_amdgcn_fence(__ATOMIC_RELEASE, "agent");
            asm volatile("s_waitcnt vmcnt(0)" ::: "memory");
            const unsigned og = xb_add(&bar[XB_TOP], 1u);
            const unsigned tg = og / nx;
            if (og + 1u == (tg + 1u) * nx) xb_add(&bar[XB_TOPGEN], 1u);
            else XB_SPIN(xb_ld(&bar[XB_TOPGEN]) == tg, bar);
            __builtin_amdgcn_fence(__ATOMIC_ACQUIRE, "agent");
            xb_add(&bar[XB_XGEN(b.x)], 1u);
            asm volatile("s_waitcnt vmcnt(0)" ::: "memory");
        } else {
            XB_SPIN(xb_ld(&bar[XB_XGEN(b.x)]) == gen, bar);
            __builtin_amdgcn_fence(__ATOMIC_ACQUIRE, "agent");
            asm volatile("s_waitcnt vmcnt(0)" ::: "memory");
        }
    }
    __syncthreads();
}

template <int KS>
__device__ __forceinline__ f32x4 tile_mm(f32x4 acc, const LAS bf16* A, int lda, int m0, const LAS bf16* Bt, int ldb, int n0, int lane) {
    const int r = lane & 15, kg = lane >> 4;
#if NAIVE_MM
#pragma unroll 1
    for (int k = 0; k < KS * 32; ++k) {
        const float b = bf2f(Bt[(n0 + r) * ldb + k]);
#pragma unroll
        for (int q = 0; q < 4; ++q) acc[q] += bf2f(A[(m0 + 4 * kg + q) * lda + k]) * b;
    }
#else
#pragma unroll
    for (int ks = 0; ks < KS; ++ks) {
        const bf16x8 a = *(const LAS bf16x8*)(A + (m0 + r) * lda + ks * 32 + kg * 8);
        const bf16x8 b = *(const LAS bf16x8*)(Bt + (n0 + r) * ldb + ks * 32 + kg * 8);
        acc = __builtin_amdgcn_mfma_f32_16x16x32_bf16(a, b, acc, 0, 0, 0);
    }
#endif
    return acc;
}
template <int KS>
__device__ __forceinline__ f32x4 tile_mm_g(f32x4 acc, const bf16* A, int lda, int m0, const LAS bf16* Bt, int ldb, int n0, int lane) {
    const int r = lane & 15, kg = lane >> 4;
#if NAIVE_MM
#pragma unroll 1
    for (int k = 0; k < KS * 32; ++k) {
        const float b = bf2f(Bt[(n0 + r) * ldb + k]);
#pragma unroll
        for (int q = 0; q < 4; ++q) acc[q] += bf2f(A[(m0 + 4 * kg + q) * lda + k]) * b;
    }
#else
#pragma unroll
    for (int ks = 0; ks < KS; ++ks) {
        const bf16x8 a = *(const bf16x8*)(A + (size_t)(m0 + r) * lda + ks * 32 + kg * 8);
        const bf16x8 b = *(const LAS bf16x8*)(Bt + (n0 + r) * ldb + ks * 32 + kg * 8);
        acc = __builtin_amdgcn_mfma_f32_16x16x32_bf16(a, b, acc, 0, 0, 0);
    }
#endif
    return acc;
}

struct Args { const float* in[21]; float* out; unsigned char* ws; int ph_lo, ph_hi, one, pad; };
enum { I_XP = 0, I_XS, I_STATE, I_C, I_CCTX, I_ADAW, I_ADAB, I_NORMG, I_WIN, I_CONV, I_ALOG, I_DTB, I_DNG, I_SGUNG, I_SGUW, I_SGUB, I_POOLW, I_POOLS, I_FW, I_WOUT, I_FNG };

struct SeqGeo { int T, tseq0, seq_row0; };
__device__ __forceinline__ SeqGeo seq_geo(int sc) {
    SeqGeo g;
    if (sc < 128) { g.T = 256; g.tseq0 = (sc & 3) * 64; g.seq_row0 = (sc >> 2) * 256; }
    else { const int s = sc - 128; g.T = 4096; g.tseq0 = (s & 63) * 64; g.seq_row0 = M_CTX + (s >> 6) * 4096; }
    return g;
}
__device__ __forceinline__ int cond_of_row(int row) { return row < M_CTX ? 0 : 1 + ((row - M_CTX) >> 12); }

__device__ __forceinline__ int srccol(int n) {
    if (n < 256) return 768 + n;
    if (n < 512) return 1040 + (n - 256);
    if (n < 768) return 2064 + (n - 512);
    if (n < 1024) return 2576 + (n - 768);
    if (n < 1280) return 1296 + (n - 1024);
    if (n < 1536) return 1552 + (n - 1280);
    if (n < 2304) return -2;
    if (n < 3072) return n - 2304;
    if (n < 3088) return 1024 + (n - 3072);
    return -1;
}

__device__ __forceinline__ void phase_0a(const Args& a, LAS unsigned char* lds) {
    const int tid = otid(), lane = tid & 63, wave = tid >> 6, G = gridDim.x, bid = obid();
    float* MOD = (float*)(a.ws + WS_MOD);
    if (bid < 192) {
        LAS float* sc = (LAS float*)lds;
        LAS float* red = (LAS float*)(lds + 9 * 1024 * 4);
        for (int i = tid; i < 9 * 1024; i += NTHR) { const int j = i >> 10, k = i & 1023; const float c = (j == 0) ? a.in[I_CCTX][k] : a.in[I_C][(j - 1) * 1024 + k]; sc[i] = silu_f(c); }
        __syncthreads();
        for (int it = bid; it < 192; it += G) {
            const int l = it / 48, cb = it % 48, col = cb * 64 + lane;
            float acc[9];
#pragma unroll
            for (int j = 0; j < 9; ++j) acc[j] = 0.f;
            const float* wp = a.in[I_ADAW] + ((size_t)l * 1024 + wave * 128) * 3072 + col;
#pragma unroll 8
            for (int k = 0; k < 128; ++k) { const float wv = wp[(size_t)k * 3072];
#pragma unroll
                for (int j = 0; j < 9; ++j) acc[j] += sc[j * 1024 + wave * 128 + k] * wv; }
#pragma unroll
            for (int j = 0; j < 9; ++j) red[(wave * 9 + j) * 64 + lane] = acc[j];
            __syncthreads();
            for (int i = tid; i < 576; i += NTHR) { const int j = i >> 6, ln = i & 63; float s = 0.f;
#pragma unroll
                for (int w = 0; w < 8; ++w) s += red[(w * 9 + j) * 64 + ln];
                MOD[(l * 9 + j) * 3072 + cb * 64 + ln] = s + a.in[I_ADAB][l * 3072 + cb * 64 + ln]; }
            __syncthreads();
        }
    }
    const int gtid = bid * NTHR + tid, GT = G * NTHR;
    float* GM = (float*)(a.ws + WS_GMAT);
    for (int t = gtid; t < 4 * 4 * 2 * 4096; t += GT) {
        const int d = t & 63, c = (t >> 6) & 63, cs = (t >> 12) & 1, g = (t >> 13) & 3, l = t >> 15;
        const float* fw = a.in[I_FW] + ((size_t)(l * 4 + g) * 64) * 64 + d;
        float s = 0.f;
        for (int m = 0; m < 64; ++m) { const float ph = (float)((m * c) & 63) * (1.f / 32.f); s += (cs ? sinpif(ph) : cospif(ph)) * fw[m * 64]; }
        GM[t] = s * 0.125f;
    }
    bf16* W1T = (bf16*)(a.ws + WS_W1T);
    for (int t = gtid; t < 4 * 128 * N1; t += GT) {
        const int n = t % N1, k8 = (t / N1) & 127, l = t / (N1 * 128);
        const int sc = srccol(n);
        if (sc == -2) continue;
        u32x4 o = (u32x4){0u, 0u, 0u, 0u};
        if (sc >= 0) { const float* wp = a.in[I_WIN] + ((size_t)l * 1024 + k8 * 8) * PIN + sc;
            o.x = pk2(wp[0], wp[PIN]); o.y = pk2(wp[2 * PIN], wp[3 * PIN]); o.z = pk2(wp[4 * PIN], wp[5 * PIN]); o.w = pk2(wp[6 * PIN], wp[7 * PIN]); }
        *(u32x4*)(W1T + ((size_t)l * N1 + n) * 1024 + k8 * 8) = o;
    }
    bf16* W2T = (bf16*)(a.ws + WS_W2T);
    for (int t = gtid; t < 4 * 128 * 1024; t += GT) {
        const int n = t & 1023, k8 = (t >> 10) & 127, l = t >> 17;
        const float* wp = a.in[I_WOUT] + ((size_t)l * 1024 + k8 * 8) * 1024 + n;
        u32x4 o; o.x = pk2(wp[0], wp[1024]); o.y = pk2(wp[2048], wp[3072]); o.z = pk2(wp[4096], wp[5120]); o.w = pk2(wp[6144], wp[7168]);
        *(u32x4*)(W2T + ((size_t)l * 1024 + n) * 1024 + k8 * 8) = o;
    }
    float* POS = (float*)(a.ws + WS_POS);
    for (int t = gtid; t < 64 * 256; t += GT) { const int f = t & 255, i = t >> 8; const float fr = powf(10000.f, -(float)f / 256.f); const float ang = (float)i * fr;
        POS[t] = sinf(ang); POS[64 * 256 + t] = cosf(ang); }
    bf16* DFT = (bf16*)(a.ws + WS_DFT);
    for (int t = gtid; t < 256 * 512; t += GT) { const int tp = t & 511, k = t >> 9, tt = tp & 255; const float ph = (float)((k * tt) & 255) * (1.f / 128.f);
        DFT[t] = (bf16)f2bf((tp < 256 ? cospif(ph) : -sinpif(ph)) * (1.f / 16.f)); }
    bf16* M1 = (bf16*)(a.ws + WS_M1);
    for (int t = gtid; t < 128 * 128; t += GT) { const int kk = t & 127, m = t >> 7, k1 = m & 63, t1 = kk & 63; const float ph = (float)((k1 * t1) & 63) * (1.f / 32.f);
        const float c = cospif(ph), s = sinpif(ph); float v;
        if (m < 64) v = (kk < 64) ? c : -s; else v = (kk < 64) ? s : c;
        M1[t] = (bf16)f2bf(v); }
    bf16* M2 = (bf16*)(a.ws + WS_M2);
    for (int t = gtid; t < 64 * 128; t += GT) { const int kk = t & 127, k2 = t >> 7, t2 = kk & 63; const float ph = (float)((k2 * t2) & 63) * (1.f / 32.f);
        M2[t] = (bf16)f2bf((kk < 64 ? cospif(ph) : -sinpif(ph)) * (1.f / 64.f)); }
    float* TW = (float*)(a.ws + WS_TW);
    for (int t = gtid; t < 64 * 64; t += GT) { const int t2 = t & 63, k1 = t >> 6; const float ph = (float)(k1 * t2) * (1.f / 2048.f); TW[2 * t] = cospif(ph); TW[2 * t + 1] = sinpif(ph); }
}

__device__ __forceinline__ void phase_0b(const Args& a, LAS unsigned char* lds) {
    const int tid = otid(), lane = tid & 63, wave = tid >> 6, G = gridDim.x, bid = obid();
    const int gtid = bid * NTHR + tid, GT = G * NTHR;
    const float* MOD = (const float*)(a.ws + WS_MOD);
    const float* GM = (const float*)(a.ws + WS_GMAT);
    bf16* W1T = (bf16*)(a.ws + WS_W1T);
    for (int it = bid; it < 384; it += G) {
        const int kblk = it & 7, g = (it >> 3) & 3, kind = (it >> 5) % 3, l = it / 96;
        LAS bf16* Al = (LAS bf16*)lds; LAS bf16* Bl = Al + 128 * 72;
        const int base = (kind == 0 ? 1808 : 2320) + 64 * g;
        const float* Gm = (kind == 0) ? (a.in[I_POOLW] + (size_t)(l * 4 + g) * 4096) : (GM + (size_t)((l * 4 + g) * 2 + (kind - 1)) * 4096);
        {
            const int row = tid >> 2, c0 = (tid & 3) * 16;
            const f32x4* wp = (const f32x4*)(a.in[I_WIN] + ((size_t)l * 1024 + kblk * 128 + row) * PIN + base + c0);
            const f32x4 w0 = wp[0], w1 = wp[1], w2 = wp[2], w3 = wp[3];
            u32x4 o0, o1; o0.x = pk2(w0.x, w0.y); o0.y = pk2(w0.z, w0.w); o0.z = pk2(w1.x, w1.y); o0.w = pk2(w1.z, w1.w);
            o1.x = pk2(w2.x, w2.y); o1.y = pk2(w2.z, w2.w); o1.z = pk2(w3.x, w3.y); o1.w = pk2(w3.z, w3.w);
            *(LAS u32x4*)(Al + row * 72 + c0) = o0; *(LAS u32x4*)(Al + row * 72 + c0 + 8) = o1;
            const int c = tid >> 3, d0 = (tid & 7) * 8;
            const f32x4 g0 = *(const f32x4*)(Gm + c * 64 + d0), g1 = *(const f32x4*)(Gm + c * 64 + d0 + 4);
            Bl[(d0 + 0) * 72 + c] = (bf16)f2bf(g0.x); Bl[(d0 + 1) * 72 + c] = (bf16)f2bf(g0.y); Bl[(d0 + 2) * 72 + c] = (bf16)f2bf(g0.z); Bl[(d0 + 3) * 72 + c] = (bf16)f2bf(g0.w);
            Bl[(d0 + 4) * 72 + c] = (bf16)f2bf(g1.x); Bl[(d0 + 5) * 72 + c] = (bf16)f2bf(g1.y); Bl[(d0 + 6) * 72 + c] = (bf16)f2bf(g1.z); Bl[(d0 + 7) * 72 + c] = (bf16)f2bf(g1.w);
        }
        __syncthreads();
        {
            const int m0 = wave * 16, r = lane & 15, kg = lane >> 4;
#pragma unroll
            for (int nt = 0; nt < 4; ++nt) {
                const f32x4 acc = tile_mm<2>((f32x4){0.f, 0.f, 0.f, 0.f}, Al, 72, m0, Bl, 72, nt * 16, lane);
                u32x2 o; o.x = pk2(acc[0], acc[1]); o.y = pk2(acc[2], acc[3]);
                *(u32x2*)(W1T + ((size_t)l * N1 + 1536 + kind * 256 + g * 64 + nt * 16 + r) * 1024 + kblk * 128 + m0 + 4 * kg) = o;
            }
        }
        __syncthreads();
    }
    const float* POS = (const float*)(a.ws + WS_POS);
    bf16* HB = (bf16*)a.out;
    bf16* XB = (bf16*)a.out + (size_t)M * D;
    float* RSS = (float*)(a.ws + WS_RSS);
    for (int row = bid * NWAVES + wave; row < M; row += G * NWAVES) {
        f32x4 v[4];
        const int j = cond_of_row(row);
        if (row < M_CTX) {
            const f32x4* xr = (const f32x4*)(a.in[I_XP] + (size_t)row * D) + lane;
#pragma unroll
            for (int q = 0; q < 4; ++q) v[q] = xr[64 * q];
        } else {
            const int rs = row - M_CTX, t = rs & 4095, gr = t >> 6, gc = t & 63;
            const f32x4* xr = (const f32x4*)(a.in[I_XS] + (size_t)rs * D) + lane;
            const f32x4 p0 = *((const f32x4*)(POS + gr * 256) + lane), p1 = *((const f32x4*)(POS + 64 * 256 + gr * 256) + lane);
            const f32x4 p2 = *((const f32x4*)(POS + gc * 256) + lane), p3 = *((const f32x4*)(POS + 64 * 256 + gc * 256) + lane);
            v[0] = xr[0] + p0; v[1] = xr[64] + p1; v[2] = xr[128] + p2; v[3] = xr[192] + p3;
        }
        float ss = 0.f;
#pragma unroll
        for (int q = 0; q < 4; ++q) ss += (v[q].x * v[q].x + v[q].y * v[q].y) + (v[q].z * v[q].z + v[q].w * v[q].w);
        ss = wave_sum(ss);
        u32x2* xrow = (u32x2*)(XB + (size_t)row * D) + lane;
        u32x2* hrow = (u32x2*)(HB + (size_t)row * D) + lane;
#pragma unroll
        for (int q = 0; q < 4; ++q) {
            u32x2 xb; xb.x = pk2(v[q].x, v[q].y); xb.y = pk2(v[q].z, v[q].w);
            xrow[64 * q] = xb;
            const f32x4 ng = *((const f32x4*)(a.in[I_NORMG] + 256 * q) + lane);
            const f32x4 sc = *((const f32x4*)(MOD + (0 * 9 + j) * 3072 + 1024 + 256 * q) + lane);
            u32x2 h; h.x = pk2(v[q].x * ng.x * (1.f + sc.x), v[q].y * ng.y * (1.f + sc.y)); h.y = pk2(v[q].z * ng.z * (1.f + sc.z), v[q].w * ng.w * (1.f + sc.w));
            hrow[64 * q] = h;
        }
        if (lane < 16) RSS[(size_t)row * 16 + lane] = (lane == 0) ? ss : 0.f;
    }
}

__device__ __forceinline__ void phase_0c(const Args& a) {
    const int tid = otid(), lane = tid & 63, wave = tid >> 6, G = gridDim.x, bid = obid();
    const float* MOD = (const float*)(a.ws + WS_MOD);
    const bf16* W1T = (const bf16*)(a.ws + WS_W1T);
    float* SW = (float*)(a.ws + WS_SW);
    for (int it = bid * NWAVES + wave; it < 4 * N1; it += G * NWAVES) {
        const int l = it / N1, n = it % N1;
        const u32x4* wr = (const u32x4*)(W1T + ((size_t)l * N1 + n) * 1024) + lane * 2;
        const u32x4 w0 = wr[0], w1 = wr[1];
        float w[16];
        w[0] = bflo(w0.x); w[1] = bfhi(w0.x); w[2] = bflo(w0.y); w[3] = bfhi(w0.y); w[4] = bflo(w0.z); w[5] = bfhi(w0.z); w[6] = bflo(w0.w); w[7] = bfhi(w0.w);
        w[8] = bflo(w1.x); w[9] = bfhi(w1.x); w[10] = bflo(w1.y); w[11] = bfhi(w1.y); w[12] = bflo(w1.z); w[13] = bfhi(w1.z); w[14] = bflo(w1.w); w[15] = bfhi(w1.w);
#pragma unroll
        for (int j = 0; j < 9; ++j) {
            const f32x4* sp = (const f32x4*)(MOD + (l * 9 + j) * 3072) + lane * 4;
            float s = 0.f;
#pragma unroll
            for (int q = 0; q < 4; ++q) { const f32x4 sv = sp[q]; s += sv.x * w[4 * q] + sv.y * w[4 * q + 1] + sv.z * w[4 * q + 2] + sv.w * w[4 * q + 3]; }
            s = wave_sum(s);
            if (lane == 0) SW[(l * 9 + j) * N1 + n] = s;
        }
    }
}

struct Epi1 {
    static constexpr bool PERM = true;
    bf16* PB; float* BA; const float* RSS; const float* SW;
    int cheap; bf16* dumb;
    const LAS float* rtab;
    float* VSS;
    __device__ __forceinline__ void operator()(const f32x4 (&acc)[2][2][4][2], const pg8::Unit& u, int wr, int wc, int fr, int fq, int ui) const {
        const int pn = u.pn, j = u.pm < 32 ? 0 : 1 + ((u.pm - 32) >> 4);
        const int row0 = u.pm * 256 + wr * 64 + fr, cb = pn * 256 + wc * 32 + 8 * fq;
        if (cheap == 1) {
#pragma unroll
            for (int ai = 0; ai < 2; ++ai)
#pragma unroll
                for (int m = 0; m < 4; ++m)
#pragma unroll
                    for (int bj = 0; bj < 2; ++bj) { const f32x4 v0 = acc[ai][bj][m][0], v1 = acc[ai][bj][m][1];
                        u32x4 w; w.x = pk2(v0[0], v0[1]); w.y = pk2(v0[2], v0[3]); w.z = pk2(v1[0], v1[1]); w.w = pk2(v1[2], v1[3]);
                        *(u32x4*)(dumb + (size_t)((row0 + ai * 128 + m * 16) & 1023) * LDP + cb + bj * 128) = w; }
            return;
        }
        const int act = (pn == 0 || pn == 2 || pn == 3 || pn == 5) ? 1 : ((pn == 1 || pn == 4) ? 2 : 0);
        f32x4 bv[2][2];
#pragma unroll
        for (int bj = 0; bj < 2; ++bj)
#pragma unroll
            for (int n = 0; n < 2; ++n) bv[bj][n] = *(const f32x4*)(SW + j * N1 + cb + bj * 128 + 4 * n);
#pragma unroll
        for (int ai = 0; ai < 2; ++ai)
#pragma unroll
            for (int m = 0; m < 4; ++m) {
                const int row = row0 + ai * 128 + m * 16;
                const float rinv = rtab[ui * 256 + wr * 64 + fr + ai * 128 + m * 16];
                float vss = 0.f;
#pragma unroll
                for (int bj = 0; bj < 2; ++bj) {
                    f32x4 v0 = acc[ai][bj][m][0] * rinv + bv[bj][0], v1 = acc[ai][bj][m][1] * rinv + bv[bj][1];
                    if (pn < 12) {
                        if (act == 1) {
#pragma unroll
                            for (int q = 0; q < 4; ++q) { v0[q] = silu_f(v0[q]); v1[q] = silu_f(v1[q]); }
                        } else if (act == 2) {
#pragma unroll
                            for (int q = 0; q < 4; ++q) { v0[q] = gelu_tanh_f(v0[q]); v1[q] = gelu_tanh_f(v1[q]); }
                        }
                        u32x4 w; w.x = pk2(v0[0], v0[1]); w.y = pk2(v0[2], v0[3]); w.z = pk2(v1[0], v1[1]); w.w = pk2(v1[2], v1[3]);
                        if (pn == 4) vss += (v0[0] * v0[0] + v0[1] * v0[1]) + (v0[2] * v0[2] + v0[3] * v0[3]) + (v1[0] * v1[0] + v1[1] * v1[1]) + (v1[2] * v1[2] + v1[3] * v1[3]);
                        if ((pn == 7 || pn == 8) && u.pm >= 32 && !cheap) {
                            const int t = row - M_CTX, tq = t & 4095, sl = (wc * 32 + 8 * fq + bj * 128) >> 2;
                            bf16* dst = PB + (size_t)(M_CTX + (t & ~4095) + sl * 64 + (tq >> 6)) * LDP + C_PF + (tq & 63) * 8 + (pn == 8 ? 4 : 0);
                            u32x2 lo2, hi2; lo2.x = w.x; lo2.y = w.y; hi2.x = w.z; hi2.y = w.w;
                            *(u32x2*)dst = lo2; *(u32x2*)(dst + 64 * LDP) = hi2;
                        } else
                        *(u32x4*)((cheap ? dumb + (size_t)(row & 1023) * LDP : PB + (size_t)row * LDP) + cb + bj * 128) = w;
                    } else if (bj == 0 && wc == 0 && fq < 2) {
                        f32x4* bp = (f32x4*)(BA + (size_t)row * 16 + 8 * fq); bp[0] = v0; bp[1] = v1;
                    }
                }
                if (pn == 4) { vss += __shfl_xor(vss, 16); vss += __shfl_xor(vss, 32); if (fq == 0 && !cheap) VSS[(size_t)row * 4 + wc] = vss; }
            }
    }
};
struct Epi2 {
    static constexpr bool PERM = true;
    bf16* XB; bf16* HB; float* RSS; const float* gate;
    const float* ng_next; const float* sc_next;
    unsigned char* dum; int dry;
    __device__ __forceinline__ void operator()(const f32x4 (&acc)[2][2][4][2], const pg8::Unit& u, int wr, int wc, int fr, int fq, int) const {
        const int pn = u.pn, j = u.pm < 32 ? 0 : 1 + ((u.pm - 32) >> 4);
        const int row0 = u.pm * 256 + wr * 64 + fr, cb = pn * 256 + wc * 32 + 8 * fq;
        f32x4 gv[2][2];
#pragma unroll
        for (int bj = 0; bj < 2; ++bj)
#pragma unroll
            for (int n = 0; n < 2; ++n) gv[bj][n] = *(const f32x4*)(gate + j * 3072 + cb + bj * 128 + 4 * n);
#pragma unroll
        for (int am = 0; am < 4; ++am) {
            const int ai = am >> 1;
            u32x4 xv[4][2];
            f32x4 gs[2][2];
#pragma unroll
            for (int m = 2 * (am & 1); m < 2 * (am & 1) + 2; ++m)
#pragma unroll
                for (int bj = 0; bj < 2; ++bj) xv[m][bj] = *(const u32x4*)(XB + (size_t)(row0 + ai * 128 + m * 16) * D + cb + bj * 128);
#pragma unroll
            for (int bj = 0; bj < 2; ++bj)
#pragma unroll
                for (int n = 0; n < 2; ++n) {
                    if (ng_next) { const f32x4 ng = *(const f32x4*)(ng_next + cb + bj * 128 + 4 * n), sc = *(const f32x4*)(sc_next + j * 3072 + cb + bj * 128 + 4 * n); gs[bj][n] = ng * (sc + 1.f); }
                    else gs[bj][n] = (f32x4){0.f, 0.f, 0.f, 0.f};
                }
#pragma unroll
            for (int m = 2 * (am & 1); m < 2 * (am & 1) + 2; ++m) {
                const int row = row0 + ai * 128 + m * 16;
                float ssq = 0.f;
#pragma unroll
                for (int bj = 0; bj < 2; ++bj) {
                    const u32x4 xq = xv[m][bj];
                    const f32x4 x0 = (f32x4){bflo(xq.x), bfhi(xq.x), bflo(xq.y), bfhi(xq.y)}, x1 = (f32x4){bflo(xq.z), bfhi(xq.z), bflo(xq.w), bfhi(xq.w)};
                    const f32x4 n0 = x0 + gv[bj][0] * acc[ai][bj][m][0], n1 = x1 + gv[bj][1] * acc[ai][bj][m][1];
                    u32x4 xw; xw.x = pk2(n0[0], n0[1]); xw.y = pk2(n0[2], n0[3]); xw.z = pk2(n1[0], n1[1]); xw.w = pk2(n1[2], n1[3]);
                    *(u32x4*)((dry ? (bf16*)dum + (size_t)(row & 1023) * D : XB + (size_t)row * D) + cb + bj * 128) = xw;
                    ssq += (n0.x * n0.x + n0.y * n0.y) + (n0.z * n0.z + n0.w * n0.w) + (n1.x * n1.x + n1.y * n1.y) + (n1.z * n1.z + n1.w * n1.w);
                    if (ng_next) { const f32x4 h0 = n0 * gs[bj][0], h1 = n1 * gs[bj][1];
                        u32x4 w; w.x = pk2(h0[0], h0[1]); w.y = pk2(h0[2], h0[3]); w.z = pk2(h1[0], h1[1]); w.w = pk2(h1[2], h1[3]);
                        *(u32x4*)((dry ? (bf16*)(dum + 4 * MiB) + (size_t)(row & 1023) * D : HB + (size_t)row * D) + cb + bj * 128) = w; }
                }
                ssq += __shfl_xor(ssq, 16); ssq += __shfl_xor(ssq, 32);
                if (fq == 0) (dry ? (float*)(dum + 8 * MiB) + (size_t)(row & 1023) * 16 : RSS + (size_t)row * 16)[pn * 4 + wc] = ssq;
            }
        }
    }
};

typedef short bf16x4 __attribute__((ext_vector_type(4)));
__device__ __forceinline__ f32x4 mfma16(bf16x4 a, bf16x4 b, f32x4 c) { return __builtin_amdgcn_mfma_f32_16x16x16bf16_1k(a, b, c, 0, 0, 0); }
__device__ __forceinline__ bf16x4 pack4(f32x4 v) { u32x2 w; w.x = pk2(v[0], v[1]); w.y = pk2(v[2], v[3]); return __builtin_bit_cast(bf16x4, w); }
__device__ __forceinline__ bf16x8 pack8(f32x4 lo, f32x4 hi) { u32x4 w; w.x = pk2(lo[0], lo[1]); w.y = pk2(lo[2], lo[3]); w.z = pk2(hi[0], hi[1]); w.w = pk2(hi[2], hi[3]); return __builtin_bit_cast(bf16x8, w); }
constexpr int PREP_ITEM = 5 * 4096;

__device__ __forceinline__ void prep_dinv(const LAS bf16* Ab_, LAS bf16* Dl, int lane) {
    const int blk = lane >> 4, c = lane & 15;
    unsigned ab = (unsigned)(size_t)(Ab_ + (16 * blk) * 72 + 16 * blk);
    asm volatile("" : "+v"(ab));
    const LAS bf16* Ab = (const LAS bf16*)(size_t)ab;
    float x[16];
#pragma unroll
    for (int ii = 0; ii < 16; ++ii) {
        float acc = (ii == c) ? 1.f : 0.f;
        const LAS u32x4* ar = (const LAS u32x4*)(Ab + ii * 72);
#pragma unroll
        for (int jq = 0; jq < 2; ++jq) {
            if (8 * jq < ii) {
                const u32x4 av = ar[jq];
                if (8 * jq + 0 < ii) acc += bflo(av.x) * x[8 * jq + 0];
                if (8 * jq + 1 < ii) acc += bfhi(av.x) * x[8 * jq + 1];
                if (8 * jq + 2 < ii) acc += bflo(av.y) * x[8 * jq + 2];
                if (8 * jq + 3 < ii) acc += bfhi(av.y) * x[8 * jq + 3];
                if (8 * jq + 4 < ii) acc += bflo(av.z) * x[8 * jq + 4];
                if (8 * jq + 5 < ii) acc += bfhi(av.z) * x[8 * jq + 5];
                if (8 * jq + 6 < ii) acc += bflo(av.w) * x[8 * jq + 6];
                if (8 * jq + 7 < ii) acc += bfhi(av.w) * x[8 * jq + 7];
            }
        }
        asm volatile("" : "+v"(acc) :: "memory");
        x[ii] = acc;
    }
#pragma unroll
    for (int ii = 0; ii < 16; ++ii) Dl[(blk * 16 + ii) * 24 + c] = (bf16)f2bf(x[ii]);
}

struct PrepPre { u32x4 xr[7]; };
__device__ __forceinline__ void prep_prefetch(const Args& a, PrepPre& P, int sc, int h) {
    const int tid = otid();
    const bf16* PB = (const bf16*)(a.ws + WS_PB);
    const SeqGeo sg = seq_geo(sc);
    const int cg = tid % 24, seg = tid / 24, part = cg >> 3, d0 = (cg & 7) * 8;
    const int col = C_Q + (part < 3 ? part : 0) * 256 + h * 64 + d0;
#pragma unroll
    for (int i = 0; i < 7; ++i) { const int ts = sg.tseq0 + 4 * seg - 2 + i;
        P.xr[i] = (tid < 384 && ts >= 0 && ts < sg.T) ? *(const u32x4*)(PB + (size_t)(sg.seq_row0 + ts) * LDP + col) : (u32x4){0u, 0u, 0u, 0u}; }
}
__device__ __forceinline__ void prep_item(const Args& a, LAS unsigned char* lds, int l, int sc, int h, PrepPre& P, int nsc, int nh) {
    const int tid = otid(), lane = tid & 63, wave = __builtin_amdgcn_readfirstlane(tid >> 6);
    LAS float* qs = (LAS float*)lds;
    LAS float* ks = qs + 64 * 65;
    LAS float* vs = ks + 64 * 65;
    LAS bf16* Qb = (LAS bf16*)(lds + 49920);
    LAS bf16* Kb = (LAS bf16*)(lds + 59136);
    constexpr int PD = 30720;
    LAS unsigned char* dbase = lds + 68352;
    LAS float* beta = (LAS float*)(lds + 129792);
    LAS float* gcs = beta + 128;
    LAS float* egs = gcs + 128;
    LAS float* eks = egs + 128;
    const bf16* PB = (const bf16*)(a.ws + WS_PB);
    const float* BA = (const float*)(a.ws + WS_BA);
    const SeqGeo sg = seq_geo(sc);
    const int row0 = sc * 64;
    if (wave >= 6) {
        const int dir = wave - 6, tok = dir ? 63 - lane : lane;
        const float bl = BA[(size_t)(row0 + tok) * 16 + dir * 4 + h], al = BA[(size_t)(row0 + tok) * 16 + 8 + dir * 4 + h];
        const float bt = 1.f / (1.f + __expf(-bl));
        const float xx = al + a.in[I_DTB][(l * 2 + dir) * 4 + h];
        const float ex = __expf(xx);
        const float sp = xx > 20.f ? xx : (ex < 1e-2f ? ex * (1.f - ex * (0.5f - ex * (1.f / 3.f))) : __logf(1.f + ex));
        float g = -__expf(a.in[I_ALOG][(l * 2 + dir) * 4 + h]) * sp;
#pragma unroll
        for (int o = 1; o < 64; o <<= 1) { const float t = __shfl_up(g, o); if (lane >= o) g += t; }
        const float gl = __shfl(g, 63);
        beta[dir * 64 + lane] = bt; gcs[dir * 64 + lane] = g; egs[dir * 64 + lane] = __expf(g); eks[dir * 64 + lane] = __expf(gl - g);
        if (lane == 63) ((float*)(a.ws + WS_PGL))[(sc * 4 + h) * 2 + dir] = __expf(g);
    } else {
        const int cg = tid % 24, seg = tid / 24, part = cg >> 3, d0 = (cg & 7) * 8;
        const int chan = part * 256 + h * 64 + d0;
        u32x4 xr[7];
#pragma unroll
        for (int i = 0; i < 7; ++i) xr[i] = P.xr[i];
        f32x4 w0[4], w1[4];
#pragma unroll
        for (int jj = 0; jj < 4; ++jj) { w0[jj] = *(const f32x4*)(a.in[I_CONV] + (size_t)(l * 4 + jj) * 768 + chan); w1[jj] = *(const f32x4*)(a.in[I_CONV] + (size_t)(l * 4 + jj) * 768 + chan + 4); }
        float o[4][8];
#pragma unroll
        for (int j = 0; j < 4; ++j)
#pragma unroll
            for (int c = 0; c < 8; ++c) o[j][c] = 0.f;
#pragma unroll
        for (int i = 0; i < 7; ++i) {
            const float x0 = bflo(xr[i].x), x1 = bfhi(xr[i].x), x2 = bflo(xr[i].y), x3 = bfhi(xr[i].y), x4 = bflo(xr[i].z), x5 = bfhi(xr[i].z), x6 = bflo(xr[i].w), x7 = bfhi(xr[i].w);
#pragma unroll
            for (int j = 0; j < 4; ++j) { const int jj = i - j;
                if (jj >= 0 && jj < 4) {
                    o[j][0] += w0[jj].x * x0; o[j][1] += w0[jj].y * x1; o[j][2] += w0[jj].z * x2; o[j][3] += w0[jj].w * x3;
                    o[j][4] += w1[jj].x * x4; o[j][5] += w1[jj].y * x5; o[j][6] += w1[jj].z * x6; o[j][7] += w1[jj].w * x7; } }
        }
        LAS float* dst = (part == 0 ? qs : (part == 1 ? ks : vs)) + (4 * seg) * 65 + d0;
#pragma unroll
        for (int j = 0; j < 4; ++j)
#pragma unroll
            for (int c = 0; c < 8; ++c) dst[j * 65 + c] = silu_f(o[j][c]);
    }
    __syncthreads();
    {
        const int rowid = tid >> 2, seg = tid & 3, ar = rowid & 63;
        LAS float* p = (rowid < 64 ? qs : ks) + ar * 65 + seg * 16;
        float v[16]; float ss = 0.f;
#pragma unroll
        for (int c = 0; c < 16; ++c) { v[c] = p[c]; ss += v[c] * v[c]; }
        ss += __shfl_xor(ss, 1); ss += __shfl_xor(ss, 2);
        const float s = rsqrtf(ss + EPS) * (rowid < 64 ? 0.125f : 1.f);
#pragma unroll
        for (int c = 0; c < 16; ++c) { v[c] *= s; p[c] = v[c]; }
        LAS bf16* bp = (rowid < 64 ? Qb : Kb) + ar * 72 + seg * 16;
        u32x4 o0, o1; o0.x = pk2(v[0], v[1]); o0.y = pk2(v[2], v[3]); o0.z = pk2(v[4], v[5]); o0.w = pk2(v[6], v[7]);
        o1.x = pk2(v[8], v[9]); o1.y = pk2(v[10], v[11]); o1.z = pk2(v[12], v[13]); o1.w = pk2(v[14], v[15]);
        *(LAS u32x4*)bp = o0; *(LAS u32x4*)(bp + 8) = o1;
    }
    __syncthreads();
    {
        const int mt = wave >> 1, nh_ = wave & 1, m0 = mt * 16, r = lane & 15, kg = lane >> 4, arow = m0 + r;
#pragma unroll
        for (int t = 0; t < 2; ++t) {
            const int b0 = nh_ * 32 + 16 * t + 4 * kg;
            const f32x4 KKa = tile_mm<2>((f32x4){0.f, 0.f, 0.f, 0.f}, Kb, 72, nh_ * 32 + 16 * t, Kb, 72, m0, lane);
            const f32x4 QKa = tile_mm<2>((f32x4){0.f, 0.f, 0.f, 0.f}, Kb, 72, nh_ * 32 + 16 * t, Qb, 72, m0, lane);
#pragma unroll
            for (int dir = 0; dir < 2; ++dir) {
                LAS bf16* Ab = (LAS bf16*)(dbase + dir * PD); LAS bf16* QKl = Ab + 64 * 72;
                const int i = dir ? 63 - arow : arow;
                const float gi = gcs[dir * 64 + i], bi = beta[dir * 64 + i];
                float av[4], qv[4];
#pragma unroll
                for (int q = 0; q < 4; ++q) {
                    const int j = dir ? 63 - (b0 + q) : b0 + q;
                    const float dec = (i >= j) ? __expf(gi - gcs[dir * 64 + j]) : 0.f;
                    av[q] = (i > j) ? -bi * KKa[q] * dec : 0.f; qv[q] = QKa[q] * dec;
                }
                u32x2 aw, qw; const int j0 = dir ? 60 - b0 : b0;
                if (dir) { aw.x = pk2(av[3], av[2]); aw.y = pk2(av[1], av[0]); qw.x = pk2(qv[3], qv[2]); qw.y = pk2(qv[1], qv[0]); }
                else { aw.x = pk2(av[0], av[1]); aw.y = pk2(av[2], av[3]); qw.x = pk2(qv[0], qv[1]); qw.y = pk2(qv[2], qv[3]); }
                *(LAS u32x2*)(Ab + i * 72 + j0) = aw; *(LAS u32x2*)(QKl + i * 72 + j0) = qw;
            }
        }
    }
    __syncthreads();
    if (nsc >= 0) prep_prefetch(a, P, nsc, nh);
    bf16* PI0 = (bf16*)(a.ws + WS_PREP) + (size_t)((sc * 4 + h) * 2) * PREP_ITEM;
    if (wave < 2) prep_dinv((const LAS bf16*)(dbase + wave * PD), (LAS bf16*)(dbase + wave * PD + 3 * 9216), lane);
    for (int t = tid; t < 2048; t += NTHR) {
        const int dir = t >> 10, which = (t >> 9) & 1, rw = (t >> 3) & 63, sgp = t & 7, n0a = 32 * (sgp >> 2) + 4 * (sgp & 3), n0b = n0a + 16;
        float v[8];
        if (which == 0) {
            const int tok = dir ? 63 - rw : rw; const float e = egs[dir * 64 + rw];
#pragma unroll
            for (int c = 0; c < 4; ++c) { v[c] = qs[tok * 65 + n0a + c] * e; v[4 + c] = qs[tok * 65 + n0b + c] * e; }
        } else {
#pragma unroll
            for (int c = 0; c < 4; ++c) { const int ia = n0a + c, ib = n0b + c;
                v[c] = ks[(dir ? 63 - ia : ia) * 65 + rw] * eks[dir * 64 + ia]; v[4 + c] = ks[(dir ? 63 - ib : ib) * 65 + rw] * eks[dir * 64 + ib]; }
        }
        u32x4 o; o.x = pk2(v[0], v[1]); o.y = pk2(v[2], v[3]); o.z = pk2(v[4], v[5]); o.w = pk2(v[6], v[7]);
        *(u32x4*)(PI0 + (size_t)dir * PREP_ITEM + (1 + which) * 4096 + rw * 64 + sgp * 8) = o;
    }
    __syncthreads();
    {
        const int dir = wave >> 2, r = lane & 15, kg = lane >> 4, cc = 16 * (wave & 3) + r;
        const LAS bf16* Ab = (const LAS bf16*)(dbase + dir * PD); LAS bf16* Wl = (LAS bf16*)(dbase + dir * PD + 2 * 9216); const LAS bf16* Dl = (const LAS bf16*)(dbase + dir * PD + 3 * 9216);
        bf16* PI = PI0 + (size_t)dir * PREP_ITEM;
        f32x4 XU[4], XW[4];
#pragma unroll
        for (int b = 0; b < 4; ++b) {
            f32x4 TU, TW_;
#pragma unroll
            for (int q = 0; q < 4; ++q) { const int i = 16 * b + 4 * kg + q, tok = dir ? 63 - i : i;
                const float bt = beta[dir * 64 + i];
                TU[q] = bt * vs[tok * 65 + cc]; TW_[q] = bt * egs[dir * 64 + i] * ks[tok * 65 + cc]; }
#pragma unroll
            for (int m = 0; m < 4; ++m) if (m < b) {
                const bf16x4 af = *(const LAS bf16x4*)(Ab + (16 * b + r) * 72 + 16 * m + 4 * kg);
                TU = mfma16(af, pack4(XU[m]), TU); TW_ = mfma16(af, pack4(XW[m]), TW_);
            }
            const bf16x4 df = *(const LAS bf16x4*)(Dl + (b * 16 + r) * 24 + 4 * kg);
            XU[b] = mfma16(df, pack4(TU), (f32x4){0.f, 0.f, 0.f, 0.f});
            XW[b] = mfma16(df, pack4(TW_), (f32x4){0.f, 0.f, 0.f, 0.f});
            *(u32x2*)(PI + 4 * 4096 + cc * 64 + 16 * b + 4 * kg) = __builtin_bit_cast(u32x2, pack4(XU[b]));
#pragma unroll
            for (int q = 0; q < 4; ++q) Wl[(16 * b + 4 * kg + q) * 72 + cc] = (bf16)f2bf(XW[b][q]);
        }
    }
    __syncthreads();
    for (int t = tid; t < 2048; t += NTHR) {
        const int dir = t >> 10, which = (t >> 9) & 1, rw = (t >> 3) & 63, sgp = t & 7, n0a = 32 * (sgp >> 2) + 4 * (sgp & 3);
        const LAS bf16* src = (const LAS bf16*)(dbase + dir * PD + (which ? 1 : 2) * 9216) + rw * 72 + n0a;
        const u32x2 lo = *(const LAS u32x2*)src, hi = *(const LAS u32x2*)(src + 16);
        u32x4 o; o.x = lo.x; o.y = lo.y; o.z = hi.x; o.w = hi.y;
        *(u32x4*)(PI0 + (size_t)dir * PREP_ITEM + (which ? 3 : 0) * 4096 + rw * 64 + sgp * 8) = o;
    }
    __syncthreads();
}

__device__ __forceinline__ void sgu_item(const Args& a, LAS unsigned char* lds, int l, int ch, int g, int dry, bool w_cached) {
    const int tid = otid(), lane = tid & 63, wave = tid >> 6;
    LAS bf16* Wl = (LAS bf16*)lds;
    LAS bf16* VT = Wl + 128 * 136;
    LAS float* rstd = (LAS float*)(VT + 64 * 136);
    bf16* PB = (bf16*)(a.ws + WS_PB);
    const int row0 = ch * 128;
    bf16 upre[4][4], gpre[4][4];
    {
        const int m0 = wave * 16, r = lane & 15, kg = lane >> 4;
#pragma unroll
        for (int nt = 0; nt < 4; ++nt)
#pragma unroll
            for (int q = 0; q < 4; ++q) { const size_t ro = (size_t)(row0 + m0 + 4 * kg + q) * LDP + g * 64 + nt * 16 + r; upre[nt][q] = PB[ro + C_U]; gpre[nt][q] = PB[ro + C_GB]; }
    }
    if (tid < 128) {
        const f32x4 p = *(const f32x4*)((const float*)(a.ws + WS_VSS) + (size_t)(row0 + tid) * 4);
        rstd[tid] = rsqrtf(((p.x + p.y) + (p.z + p.w)) * (1.f / 256.f) + EPS);
    }
    if (!w_cached)
    for (int t = tid; t < 128 * 16; t += NTHR) {
        const int p = t >> 4, q8 = t & 15;
        const f32x4* wp = (const f32x4*)(a.in[I_SGUW] + ((size_t)(l * 4 + g) * 128 + p) * 128 + q8 * 8);
        const f32x4 w0 = wp[0], w1 = wp[1];
        u32x4 o; o.x = pk2(w0.x, w0.y); o.y = pk2(w0.z, w0.w); o.z = pk2(w1.x, w1.y); o.w = pk2(w1.z, w1.w);
        *(LAS u32x4*)(Wl + p * 136 + q8 * 8) = o;
    }
    __syncthreads();
    for (int t = tid; t < 128 * 8; t += NTHR) {
        const int q = t >> 3, c0 = (t & 7) * 8;
        const u32x4 v = *(const u32x4*)(PB + (size_t)(row0 + q) * LDP + C_V + g * 64 + c0);
        const f32x4 g0 = *(const f32x4*)(a.in[I_SGUNG] + l * 256 + g * 64 + c0), g1 = *(const f32x4*)(a.in[I_SGUNG] + l * 256 + g * 64 + c0 + 4);
        const float r = rstd[q];
        VT[(c0 + 0) * 136 + q] = (bf16)f2bf(bflo(v.x) * r * g0.x); VT[(c0 + 1) * 136 + q] = (bf16)f2bf(bfhi(v.x) * r * g0.y);
        VT[(c0 + 2) * 136 + q] = (bf16)f2bf(bflo(v.y) * r * g0.z); VT[(c0 + 3) * 136 + q] = (bf16)f2bf(bfhi(v.y) * r * g0.w);
        VT[(c0 + 4) * 136 + q] = (bf16)f2bf(bflo(v.z) * r * g1.x); VT[(c0 + 5) * 136 + q] = (bf16)f2bf(bfhi(v.z) * r * g1.y);
        VT[(c0 + 6) * 136 + q] = (bf16)f2bf(bflo(v.w) * r * g1.z); VT[(c0 + 7) * 136 + q] = (bf16)f2bf(bfhi(v.w) * r * g1.w);
    }
    __syncthreads();
    {
        const int m0 = wave * 16, r = lane & 15, kg = lane >> 4;
#pragma unroll
        for (int nt = 0; nt < 4; ++nt) {
            f32x4 acc = (f32x4){0.f, 0.f, 0.f, 0.f};
            acc = tile_mm<4>(acc, Wl, 136, m0, VT, 136, nt * 16, lane);
#pragma unroll
            for (int q = 0; q < 4; ++q) {
                const int p = m0 + 4 * kg + q, c = nt * 16 + r;
                const float sv = acc[q] + a.in[I_SGUB][(l * 4 + g) * 128 + p];
                bf16* up = PB + (size_t)(row0 + p) * LDP + C_U + g * 64 + c;
                const float uu = bf2f(upre[nt][q]), gb = bf2f(gpre[nt][q]);
                if (dry) up = (bf16*)(a.ws + WS_DUM) + (size_t)((row0 + p) & 1023) * LDP + C_U + g * 64 + c;
                *up = (bf16)f2bf(uu * sv * gb);
            }
        }
    }
    __syncthreads();
}

__device__ __forceinline__ void pool_item(const Args& a, LAS unsigned char* lds, int l, int sc, int dry) {
    const int tid = otid();
    LAS bf16* xt = (LAS bf16*)lds;
    bf16* PB = (bf16*)(a.ws + WS_PB);
    const SeqGeo sg = seq_geo(sc);
    u32x4 gpre[4];
#pragma unroll
    for (int i = 0; i < 4; ++i) { const int t = tid + NTHR * i, tok = t >> 5, c8 = t & 31; gpre[i] = *(const u32x4*)(PB + (size_t)(sg.seq_row0 + sg.tseq0 + tok) * LDP + C_GC + c8 * 8); }
    for (int t = tid; t < 80 * 32; t += NTHR) {
        const int r = t >> 5, c8 = t & 31, ts = sg.tseq0 - 8 + r;
        u32x4 v = (u32x4){0u, 0u, 0u, 0u};
        if (ts >= 0 && ts < sg.T) v = *(const u32x4*)(PB + (size_t)(sg.seq_row0 + ts) * LDP + C_XC + c8 * 8);
        *(LAS u32x4*)(xt + r * 264 + c8 * 8) = v;
    }
    __syncthreads();
#pragma unroll
    for (int i4 = 0; i4 < 4; ++i4) {
        const int t = tid + NTHR * i4;
        const int tok = t >> 5, c8 = t & 31, gi = c8 >> 3, half = 1 << gi;
        const int ts = sg.tseq0 + tok;
        const int lo = (ts - half) < 0 ? 0 : ts - half, hi = (ts + half) > sg.T ? sg.T : ts + half;
        float s[8];
#pragma unroll
        for (int c = 0; c < 8; ++c) s[c] = 0.f;
        for (int tt = lo; tt < hi; ++tt) {
            const u32x4 v = *(const LAS u32x4*)(xt + (tt - sg.tseq0 + 8) * 264 + c8 * 8);
            s[0] += bflo(v.x); s[1] += bfhi(v.x); s[2] += bflo(v.y); s[3] += bfhi(v.y); s[4] += bflo(v.z); s[5] += bfhi(v.z); s[6] += bflo(v.w); s[7] += bfhi(v.w);
        }
        const float inv = 1.f / (float)(hi - lo);
        const u32x4 xv = *(const LAS u32x4*)(xt + (tok + 8) * 264 + c8 * 8);
        const float x0[8] = {bflo(xv.x), bfhi(xv.x), bflo(xv.y), bfhi(xv.y), bflo(xv.z), bfhi(xv.z), bflo(xv.w), bfhi(xv.w)};
        bf16* yp = PB + (size_t)(sg.seq_row0 + ts) * LDP + C_GC + c8 * 8;
        const u32x4 gv = gpre[i4];
        const float gg[8] = {bflo(gv.x), bfhi(gv.x), bflo(gv.y), bfhi(gv.y), bflo(gv.z), bfhi(gv.z), bflo(gv.w), bfhi(gv.w)};
        const f32x4 p0 = *(const f32x4*)(a.in[I_POOLS] + l * 256 + c8 * 8), p1 = *(const f32x4*)(a.in[I_POOLS] + l * 256 + c8 * 8 + 4);
        const float ps[8] = {p0.x, p0.y, p0.z, p0.w, p1.x, p1.y, p1.z, p1.w};
        float y[8];
#pragma unroll
        for (int c = 0; c < 8; ++c) y[c] = (s[c] * inv - x0[c]) * ps[c] * gg[c];
        u32x4 o; o.x = pk2(y[0], y[1]); o.y = pk2(y[2], y[3]); o.z = pk2(y[4], y[5]); o.w = pk2(y[6], y[7]);
        if (dry) yp = (bf16*)(a.ws + WS_DUM) + (size_t)((sg.seq_row0 + ts) & 1023) * LDP + C_GC + c8 * 8;
        *(u32x4*)yp = o;
    }
    __syncthreads();
}

__device__ __forceinline__ void fctx_item(const Args& a, LAS unsigned char* lds, int b, int dblk, int dry) {
    const int tid = otid(), lane = tid & 63, wave = __builtin_amdgcn_readfirstlane(tid >> 6);
    LAS bf16* ZT = (LAS bf16*)lds;
    bf16* PB = (bf16*)(a.ws + WS_PB);
    const bf16* DFT = (const bf16*)(a.ws + WS_DFT);
    {
        u32x4 v[8];
#pragma unroll
        for (int i = 0; i < 8; ++i) { const int t = tid + NTHR * i, d8 = t & 7, ri = (t >> 3) & 1, tt = t >> 4;
            v[i] = *(const u32x4*)(PB + (size_t)(b * 256 + tt) * LDP + (ri ? C_QF : C_PF) + dblk * 64 + d8 * 8); }
#pragma unroll
        for (int i = 0; i < 8; ++i) { const int t = tid + NTHR * i, d8 = t & 7, ri = (t >> 3) & 1, tt = t >> 4;
            const int col = ri * 256 + tt;
            LAS bf16* dst = ZT + (d8 * 8) * 520 + ((((col >> 3) ^ d8) << 3) | (col & 7));
            dst[0 * 520] = (bf16)(v[i].x & 0xffffu); dst[1 * 520] = (bf16)(v[i].x >> 16); dst[2 * 520] = (bf16)(v[i].y & 0xffffu); dst[3 * 520] = (bf16)(v[i].y >> 16);
            dst[4 * 520] = (bf16)(v[i].z & 0xffffu); dst[5 * 520] = (bf16)(v[i].z >> 16); dst[6 * 520] = (bf16)(v[i].w & 0xffffu); dst[7 * 520] = (bf16)(v[i].w >> 16); }
    }
    __syncthreads();
    const int r = lane & 15, kg = lane >> 4;
#pragma unroll 1
    for (int mi = 0; mi < 2; ++mi) {
        const int m0 = wave * 32 + mi * 16;
        bf16 gdv[4][4];
#pragma unroll
        for (int nt = 0; nt < 4; ++nt)
#pragma unroll
            for (int q = 0; q < 4; ++q) gdv[nt][q] = PB[(size_t)(b * 256 + m0 + 4 * kg + q) * LDP + C_GD + dblk * 64 + nt * 16 + r];
        f32x4 acc[4];
#pragma unroll
        for (int nt = 0; nt < 4; ++nt) acc[nt] = (f32x4){0.f, 0.f, 0.f, 0.f};
#pragma unroll
        for (int kh = 0; kh < 2; ++kh) {
            bf16x8 af[8];
#pragma unroll
            for (int ksx = 0; ksx < 8; ++ksx) af[ksx] = *(const bf16x8*)(DFT + (size_t)(m0 + r) * 512 + (kh * 8 + ksx) * 32 + kg * 8);
#pragma unroll
            for (int nt = 0; nt < 4; ++nt) {
#pragma unroll
                for (int ksx = 0; ksx < 8; ++ksx) {
                    const bf16x8 bfr = *(const LAS bf16x8*)(ZT + (nt * 16 + r) * 520 + (((((kh * 8 + ksx) * 4 + kg)) ^ (((nt * 16 + r) >> 3) & 7)) << 3));
                    acc[nt] = __builtin_amdgcn_mfma_f32_16x16x32_bf16(af[ksx], bfr, acc[nt], 0, 0, 0);
                }
                __builtin_amdgcn_sched_barrier(0);
            }
        }
#pragma unroll
        for (int nt = 0; nt < 4; ++nt)
#pragma unroll
            for (int q = 0; q < 4; ++q) {
                const int k = m0 + 4 * kg + q, d = nt * 16 + r;
                bf16* yp = (dry ? (bf16*)(a.ws + WS_DUM) + (size_t)((b * 256 + k) & 1023) * LDP : PB + (size_t)(b * 256 + k) * LDP) + C_GD + dblk * 64 + d;
                *yp = (bf16)f2bf(acc[nt][q] * bf2f(gdv[nt][q]));
            }
    }
    __syncthreads();
}

__device__ __forceinline__ void fsmp_item(const Args& a, LAS unsigned char* lds, int b, int ds, int dry) {
    const int tid = otid(), lane = tid & 63, wave = __builtin_amdgcn_readfirstlane(tid >> 6);
    LAS bf16* ZT = (LAS bf16*)lds;
    LAS bf16* B2 = ZT + 256 * 136;
    bf16* PB = (bf16*)(a.ws + WS_PB);
    const bf16* M1 = (const bf16*)(a.ws + WS_M1);
    const bf16* M2 = (const bf16*)(a.ws + WS_M2);
    const int d0 = ds * 4;
    const size_t rowb = (size_t)M_CTX + (size_t)b * 4096;
    const int r = lane & 15, kg = lane >> 4, mp = wave & 3, nb = wave >> 2;
    {
        u32x4 v[8];
#pragma unroll
        for (int i = 0; i < 8; ++i) { const int tt = tid + NTHR * i;
            v[i] = *(const u32x4*)(PB + (rowb + ds * 64 + (tt >> 6)) * LDP + C_PF + (tt & 63) * 8); }
#pragma unroll
        for (int i = 0; i < 8; ++i) { const int tt = tid + NTHR * i, t1 = tt >> 6, t2 = tt & 63;
            const int sw = t2 & 15;
            LAS bf16* dp = ZT + (t2 * 4) * 136 + ((((t1 >> 3) ^ sw) << 3) | (t1 & 7));
            LAS bf16* dq = ZT + (t2 * 4) * 136 + ((((8 + (t1 >> 3)) ^ sw) << 3) | (t1 & 7));
            dp[0] = (bf16)(v[i].x & 0xffffu); dp[136] = (bf16)(v[i].x >> 16); dp[272] = (bf16)(v[i].y & 0xffffu); dp[408] = (bf16)(v[i].y >> 16);
            dq[0] = (bf16)(v[i].z & 0xffffu); dq[136] = (bf16)(v[i].z >> 16); dq[272] = (bf16)(v[i].w & 0xffffu); dq[408] = (bf16)(v[i].w >> 16); }
    }
    bf16x8 aRe[4], aIm[4], a2[4];
#pragma unroll
    for (int ksx = 0; ksx < 4; ++ksx) {
        aRe[ksx] = *(const bf16x8*)(M1 + (16 * mp + r) * 128 + ksx * 32 + kg * 8);
        aIm[ksx] = *(const bf16x8*)(M1 + (64 + 16 * mp + r) * 128 + ksx * 32 + kg * 8);
        a2[ksx] = *(const bf16x8*)(M2 + (16 * mp + r) * 128 + ksx * 32 + kg * 8);
    }
    __syncthreads();
#pragma unroll 2
    for (int jb = 0; jb < 8; ++jb) {
        const int nt = nb + 2 * jb;
        f32x4 ar = (f32x4){0.f, 0.f, 0.f, 0.f}, ai = (f32x4){0.f, 0.f, 0.f, 0.f};
#pragma unroll
        for (int ksx = 0; ksx < 4; ++ksx) {
            const bf16x8 z = *(const LAS bf16x8*)(ZT + (16 * nt + r) * 136 + (((ksx * 4 + kg) ^ (((16 * nt + r) >> 2) & 15)) << 3));
            ar = __builtin_amdgcn_mfma_f32_16x16x32_bf16(aRe[ksx], z, ar, 0, 0, 0);
            ai = __builtin_amdgcn_mfma_f32_16x16x32_bf16(aIm[ksx], z, ai, 0, 0, 0);
        }
        const int n = 16 * nt + r, t2 = n >> 2, dd = n & 3;
#pragma unroll
        for (int q = 0; q < 4; ++q) {
            const int k1 = 16 * mp + 4 * kg + q;
            const float rev = (float)((k1 * t2) & 4095) * (1.f / 4096.f);
            const float cw = __builtin_amdgcn_cosf(rev), sw = __builtin_amdgcn_sinf(rev);
            const float xr = ar[q] * cw - ai[q] * sw, xi = ar[q] * sw + ai[q] * cw;
            B2[(k1 * 4 + dd) * 136 + ((((t2 >> 3) ^ (k1 & 15)) << 3) | (t2 & 7))] = (bf16)f2bf(xr);
            B2[(k1 * 4 + dd) * 136 + ((((8 + (t2 >> 3)) ^ (k1 & 15)) << 3) | (t2 & 7))] = (bf16)f2bf(xi);
        }
    }
    __syncthreads();
#pragma unroll 2
    for (int jb = 0; jb < 8; ++jb) {
        const int nt = nb + 2 * jb;
        f32x4 acc = (f32x4){0.f, 0.f, 0.f, 0.f};
#pragma unroll
        for (int ksx = 0; ksx < 4; ++ksx) {
            const bf16x8 z = *(const LAS bf16x8*)(B2 + (16 * nt + r) * 136 + (((ksx * 4 + kg) ^ (((16 * nt + r) >> 2) & 15)) << 3));
            acc = __builtin_amdgcn_mfma_f32_16x16x32_bf16(a2[ksx], z, acc, 0, 0, 0);
        }
#pragma unroll
        for (int q = 0; q < 4; ++q) ZT[(16 * mp + 4 * kg + q) * 264 + 16 * nt + r] = (bf16)f2bf(acc[q]);
    }
    __syncthreads();
#pragma unroll
    for (int i = 0; i < 4; ++i) { const int ch = tid + NTHR * i, k2 = ch >> 5, c16 = ch & 31;
        const u32x4 v = *(const LAS u32x4*)(ZT + k2 * 264 + c16 * 8);
        *(u32x4*)((dry ? (bf16*)(a.ws + WS_DUM) + (size_t)((ds * 64 + k2) & 1023) * LDP : PB + (rowb + ds * 64 + k2) * LDP) + C_PF + c16 * 8) = v; }
    __syncthreads();
}

__device__ __forceinline__ void ffin_item(const Args& a, LAS unsigned char* lds, int b, int tr) {
    const int tid = otid();
    LAS bf16* FL = (LAS bf16*)lds;
    bf16* PB = (bf16*)(a.ws + WS_PB);
    const size_t rowb = (size_t)M_CTX + (size_t)b * 4096;
    u32x4 gv[4];
#pragma unroll
    for (int i = 0; i < 4; ++i) { const int t = tid + NTHR * i, tl = t >> 5, c8 = t & 31; gv[i] = *(const u32x4*)(PB + (rowb + tr * 64 + tl) * LDP + C_GD + c8 * 8); }
#pragma unroll
    for (int i = 0; i < 4; ++i) { const int ch = tid + NTHR * i, sl = ch >> 5, c16 = ch & 31;
        *(LAS u32x4*)(FL + sl * 264 + c16 * 8) = *(const u32x4*)(PB + (rowb + sl * 64 + tr) * LDP + C_PF + c16 * 8); }
    __syncthreads();
#pragma unroll
    for (int i = 0; i < 4; ++i) { const int t = tid + NTHR * i, tl = t >> 5, c8 = t & 31;
        const u32x2 f0 = *(const LAS u32x2*)(FL + (2 * c8) * 264 + tl * 4), f1 = *(const LAS u32x2*)(FL + (2 * c8 + 1) * 264 + tl * 4);
        u32x4 o; o.x = pk2(bflo(f0.x) * bflo(gv[i].x), bfhi(f0.x) * bfhi(gv[i].x)); o.y = pk2(bflo(f0.y) * bflo(gv[i].y), bfhi(f0.y) * bfhi(gv[i].y));
        o.z = pk2(bflo(f1.x) * bflo(gv[i].z), bfhi(f1.x) * bfhi(gv[i].z)); o.w = pk2(bflo(f1.y) * bflo(gv[i].w), bfhi(f1.y) * bfhi(gv[i].w));
        *(u32x4*)(PB + (rowb + tr * 64 + tl) * LDP + C_GD + c8 * 8) = o; }
    __syncthreads();
}

constexpr int SC_MAT = 64 * 72 * 2;
constexpr int SC_BUF = 5 * SC_MAT + 16;
constexpr int SC_OT = 2 * SC_BUF;
__device__ __forceinline__ void scan_item(const Args& a, LAS unsigned char* lds, int l, int seq, int h, int dir) {
    const int tid = otid(), lane = tid & 63, wave = __builtin_amdgcn_readfirstlane(tid >> 6);
    bf16* PB = (bf16*)(a.ws + WS_PB);
    const int nch = seq < 32 ? 4 : 64;
    const int sc0 = seq < 32 ? seq * 4 : 128 + (seq - 32) * 64;
    const int r = lane & 15, kg = lane >> 4;
    if (wave >= 4) {
        const int ht = tid - 256;
        constexpr int PD_ = 4;
        u32x4 pre[PD_][10]; float pgl[PD_];
#define SC_ISSUE(set, ss) do { const int s_ = (ss) < nch ? (ss) : nch - 1; const int c_ = dir ? nch - 1 - s_ : s_; const size_t pid_ = (size_t)((sc0 + c_) * 4 + h) * 2 + dir; \
            const u32x4* src_ = (const u32x4*)((const bf16*)(a.ws + WS_PREP) + pid_ * PREP_ITEM) + ht; \
            _Pragma("unroll") for (int i_ = 0; i_ < 10; ++i_) pre[set][i_] = src_[256 * i_]; \
            pgl[set] = ((const float*)(a.ws + WS_PGL))[pid_]; } while (0)
#define SC_WRITE(set, bb) do { LAS unsigned char* B_ = lds + (bb) * SC_BUF; \
            _Pragma("unroll") for (int i_ = 0; i_ < 10; ++i_) { const int ch_ = ht + 256 * i_; \
                *(LAS u32x4*)(B_ + (ch_ >> 9) * SC_MAT + ((ch_ >> 3) & 63) * 144 + (ch_ & 7) * 16) = pre[set][i_]; } \
            if (ht == 0) *(LAS float*)(B_ + 5 * SC_MAT) = pgl[set]; } while (0)
#define SC_OSTORE(ss) do { const int c_ = dir ? nch - 1 - (ss) : (ss); const LAS unsigned char* O_ = lds + SC_OT + ((ss) & 1) * SC_MAT; \
            _Pragma("unroll") for (int i_ = 0; i_ < 2; ++i_) { const int ch_ = ht + 256 * i_, rw_ = ch_ >> 3, c8_ = ch_ & 7; \
                const u32x4 v_ = *(const LAS u32x4*)(O_ + rw_ * 144 + c8_ * 16); \
                *(u32x4*)(PB + (size_t)((sc0 + c_) * 64 + (dir ? 63 - rw_ : rw_)) * LDP + (dir ? C_K : C_Q) + h * 64 + c8_ * 8) = v_; } } while (0)
        SC_ISSUE(0, 0); SC_ISSUE(1, 1); SC_ISSUE(2, 2); SC_ISSUE(3, 3);
        SC_WRITE(0, 0);
        SC_ISSUE(0, 4);
        __syncthreads();
#pragma unroll 1
        for (int s0 = 0; s0 < nch; s0 += 4) {
#pragma unroll
            for (int j = 0; j < 4; ++j) {
                const int s = s0 + j;
                SC_WRITE((j + 1) & 3, (s + 1) & 1);
                if (s > 0) SC_OSTORE(s - 1);
                SC_ISSUE((j + 1) & 3, s + 5);
                __syncthreads();
            }
        }
        SC_OSTORE(nch - 1);
#undef SC_ISSUE
#undef SC_WRITE
#undef SC_OSTORE
    } else {
        const int e = 16 * wave + r;
        f32x4 S[4];
#pragma unroll
        for (int t = 0; t < 4; ++t)
#pragma unroll
            for (int q = 0; q < 4; ++q) {
                const int d = 16 * t + 4 * kg + q;
                S[t][q] = (seq < 32) ? 0.f : a.in[I_STATE][((size_t)(((seq - 32) * 4 + l) * 2 + dir) * 4 + h) * 4096 + d * 64 + e];
            }
        __syncthreads();
#pragma unroll 1
        for (int s = 0; s < nch; ++s) {
            const LAS unsigned char* B = lds + (s & 1) * SC_BUF;
            const LAS bf16* Wm = (const LAS bf16*)B; const LAS bf16* Qd = Wm + 64 * 72; const LAS bf16* KdT = Qd + 64 * 72; const LAS bf16* QKm = KdT + 64 * 72; const LAS bf16* UT = QKm + 64 * 72;
            const float egl = *(const LAS float*)(B + 5 * SC_MAT);
            LAS bf16* OT = (LAS bf16*)(lds + SC_OT + (s & 1) * SC_MAT);
            bf16x8 bS[2];
            bS[0] = pack8(S[0], S[1]); bS[1] = pack8(S[2], S[3]);
            f32x4 a1[4], oo[4];
#pragma unroll
            for (int t = 0; t < 4; ++t) {
                a1[t] = (f32x4){0.f, 0.f, 0.f, 0.f}; oo[t] = (f32x4){0.f, 0.f, 0.f, 0.f};
#pragma unroll
                for (int ksx = 0; ksx < 2; ++ksx) {
                    const bf16x8 wf = *(const LAS bf16x8*)(Wm + (16 * t + r) * 72 + ksx * 32 + kg * 8);
                    const bf16x8 qf = *(const LAS bf16x8*)(Qd + (16 * t + r) * 72 + ksx * 32 + kg * 8);
                    a1[t] = __builtin_amdgcn_mfma_f32_16x16x32_bf16(wf, bS[ksx], a1[t], 0, 0, 0);
                    oo[t] = __builtin_amdgcn_mfma_f32_16x16x32_bf16(qf, bS[ksx], oo[t], 0, 0, 0);
                }
            }
            f32x4 vn[4];
#pragma unroll
            for (int t = 0; t < 4; ++t) {
                const u32x2 uu = *(const LAS u32x2*)(UT + e * 72 + 16 * t + 4 * kg);
                vn[t][0] = bflo(uu.x) - a1[t][0]; vn[t][1] = bfhi(uu.x) - a1[t][1]; vn[t][2] = bflo(uu.y) - a1[t][2]; vn[t][3] = bfhi(uu.y) - a1[t][3];
            }
            bf16x8 bV[2];
            bV[0] = pack8(vn[0], vn[1]); bV[1] = pack8(vn[2], vn[3]);
#pragma unroll
            for (int t = 0; t < 4; ++t) {
                f32x4 as = (f32x4){0.f, 0.f, 0.f, 0.f};
#pragma unroll
                for (int ksx = 0; ksx < 2; ++ksx) {
                    const bf16x8 kf = *(const LAS bf16x8*)(QKm + (16 * t + r) * 72 + ksx * 32 + kg * 8);
                    const bf16x8 df = *(const LAS bf16x8*)(KdT + (16 * t + r) * 72 + ksx * 32 + kg * 8);
                    oo[t] = __builtin_amdgcn_mfma_f32_16x16x32_bf16(kf, bV[ksx], oo[t], 0, 0, 0);
                    as = __builtin_amdgcn_mfma_f32_16x16x32_bf16(df, bV[ksx], as, 0, 0, 0);
                }
                S[t] = S[t] * egl + as;
            }
#pragma unroll
            for (int t = 0; t < 4; ++t)
#pragma unroll
                for (int q = 0; q < 4; ++q) OT[(16 * t + 4 * kg + q) * 72 + e] = (bf16)f2bf(oo[t][q]);
            __syncthreads();
        }
        if (seq < 32) {
            float* ns = a.out + (size_t)M * D + ((size_t)((seq * 4 + l) * 2 + dir) * 4 + h) * 4096;
#pragma unroll
            for (int t = 0; t < 4; ++t)
#pragma unroll
                for (int q = 0; q < 4; ++q) ns[(16 * t + 4 * kg + q) * 64 + e] = S[t][q];
        }
    }
    __syncthreads();
}

__device__ __forceinline__ void phase_combine(const Args& a, int l, int dry) {
    const int tid = otid(), lane = tid & 63, wave = tid >> 6, G = gridDim.x, bid = obid();
    bf16* PB = (bf16*)(a.ws + WS_PB);
    const f32x4 ng = *(const f32x4*)(a.in[I_DNG] + l * 64 + (lane & 15) * 4);
    for (int row = bid * NWAVES + wave; row < M; row += G * NWAVES) {
        bf16* rp = PB + (size_t)row * LDP;
        const u32x2 of = *((const u32x2*)(rp + C_Q) + lane), ob = *((const u32x2*)(rp + C_K) + lane), ga = *((const u32x2*)(rp + C_GA) + lane);
        const float o0 = bflo(of.x) + bflo(ob.x), o1 = bfhi(of.x) + bfhi(ob.x), o2 = bflo(of.y) + bflo(ob.y), o3 = bfhi(of.y) + bfhi(ob.y);
        float ss = (o0 * o0 + o1 * o1) + (o2 * o2 + o3 * o3);
        ss += __shfl_xor(ss, 1); ss += __shfl_xor(ss, 2); ss += __shfl_xor(ss, 4); ss += __shfl_xor(ss, 8);
        const float rinv = rsqrtf(ss * (1.f / 64.f) + EPS);
        u32x2 y; y.x = pk2(o0 * rinv * ng.x * bflo(ga.x), o1 * rinv * ng.y * bfhi(ga.x)); y.y = pk2(o2 * rinv * ng.z * bflo(ga.y), o3 * rinv * ng.w * bfhi(ga.y));
        if (dry) rp = (bf16*)(a.ws + WS_DUM) + (size_t)(row & 1023) * LDP;
        *((u32x2*)(rp + C_GA) + lane) = y;
    }
}

constexpr int PF_ROWS = 5;
struct FinalRegs { u32x4 x[PF_ROWS][2]; float rinv[PF_ROWS]; };
__device__ __forceinline__ void final_load(const Args& a, FinalRegs& R, int rnd) {
    const int tid = otid(), lane = tid & 63, wave = tid >> 6, G = gridDim.x, bid = obid();
    const float* RSS = (const float*)(a.ws + WS_RSS);
    const bf16* XB = (const bf16*)a.out + (size_t)M * D;
#pragma unroll
    for (int i = 0; i < PF_ROWS; ++i) {
        const int row = bid * NWAVES + wave + G * NWAVES * (i + PF_ROWS * rnd);
        if (row < M) {
            const u32x4* xr = (const u32x4*)(XB + (size_t)row * D) + lane * 2;
            R.x[i][0] = xr[0]; R.x[i][1] = xr[1];
            float p = (lane < 16) ? RSS[(size_t)row * 16 + lane] : 0.f;
            p += __shfl_xor(p, 1); p += __shfl_xor(p, 2); p += __shfl_xor(p, 4); p += __shfl_xor(p, 8);
            R.rinv[i] = rsqrtf(__shfl(p, 0) * (1.f / 1024.f) + EPS);
        } else { R.x[i][0] = (u32x4){0u, 0u, 0u, 0u}; R.x[i][1] = R.x[i][0]; R.rinv[i] = 0.f; }
    }
}
__device__ __forceinline__ void final_store(const Args& a, const FinalRegs& R, int rnd) {
    const int tid = otid(), lane = tid & 63, wave = tid >> 6, G = gridDim.x, bid = obid();
    f32x4 fg[4];
#pragma unroll
    for (int q = 0; q < 4; ++q) fg[q] = *((const f32x4*)(a.in[I_FNG]) + lane * 4 + q);
#pragma unroll
    for (int i = 0; i < PF_ROWS; ++i) {
        const int row = bid * NWAVES + wave + G * NWAVES * (i + PF_ROWS * rnd);
        if (row < M) {
            f32x4* orow = (f32x4*)(a.out + (size_t)row * D) + lane * 4;
            const u32x4 x0 = R.x[i][0], x1 = R.x[i][1]; const float ri = R.rinv[i];
            orow[0] = (f32x4){bflo(x0.x), bfhi(x0.x), bflo(x0.y), bfhi(x0.y)} * ri * fg[0];
            orow[1] = (f32x4){bflo(x0.z), bfhi(x0.z), bflo(x0.w), bfhi(x0.w)} * ri * fg[1];
            orow[2] = (f32x4){bflo(x1.x), bfhi(x1.x), bflo(x1.y), bfhi(x1.y)} * ri * fg[2];
            orow[3] = (f32x4){bflo(x1.z), bfhi(x1.z), bflo(x1.w), bfhi(x1.w)} * ri * fg[3];
        }
    }
}

__device__ __forceinline__ void skinny_ba(const Args& a, int l, int pm) {
    const int tid = otid(), lane = tid & 63, wave = __builtin_amdgcn_readfirstlane(tid >> 6), r = lane & 15, kg = lane >> 4;
    const bf16* A = (const bf16*)a.out + (size_t)(pm * 256 + wave * 32 + r) * 1024 + kg * 8;
    const bf16* Bw = (const bf16*)(a.ws + WS_W1T) + ((size_t)l * N1 + 3072 + r) * 1024 + kg * 8;
    f32x4 acc0 = (f32x4){0.f, 0.f, 0.f, 0.f}, acc1 = acc0;
    bf16x8 a0[2][4], a1[2][4], bw[2][4];
#define SK_LOAD(buf, kc_) do { _Pragma("unroll") for (int ksx = 0; ksx < 4; ++ksx) { const int k = ((kc_) * 4 + ksx) * 32; \
        a0[buf][ksx] = *(const bf16x8*)(A + k); a1[buf][ksx] = *(const bf16x8*)(A + 16 * 1024 + k); bw[buf][ksx] = *(const bf16x8*)(Bw + k); } } while (0)
#define SK_MMA(buf) do { _Pragma("unroll") for (int ksx = 0; ksx < 4; ++ksx) { \
        acc0 = __builtin_amdgcn_mfma_f32_16x16x32_bf16(a0[buf][ksx], bw[buf][ksx], acc0, 0, 0, 0); \
        acc1 = __builtin_amdgcn_mfma_f32_16x16x32_bf16(a1[buf][ksx], bw[buf][ksx], acc1, 0, 0, 0); } } while (0)
    SK_LOAD(0, 0); SK_LOAD(1, 1);
    SK_MMA(0); SK_LOAD(0, 2); SK_MMA(1); SK_LOAD(1, 3); SK_MMA(0); SK_LOAD(0, 4); SK_MMA(1); SK_LOAD(1, 5);
    SK_MMA(0); SK_LOAD(0, 6); SK_MMA(1); SK_LOAD(1, 7); SK_MMA(0); SK_MMA(1);
#undef SK_LOAD
#undef SK_MMA
    const int j = pm < 32 ? 0 : 1 + ((pm - 32) >> 4);
    const float sw = ((const float*)(a.ws + WS_SW))[((size_t)l * 9 + j) * N1 + 3072 + r];
    const float* RSS = (const float*)(a.ws + WS_RSS);
    float* BA = (float*)(a.ws + WS_BA);
#pragma unroll
    for (int mi = 0; mi < 2; ++mi)
#pragma unroll
        for (int q = 0; q < 4; ++q) {
            const int row = pm * 256 + wave * 32 + mi * 16 + 4 * kg + q;
            const f32x4* rp = (const f32x4*)(RSS + (size_t)row * 16);
            const f32x4 r0 = rp[0], r1 = rp[1], r2 = rp[2], r3 = rp[3];
            const float ss = ((r0.x + r0.y) + (r0.z + r0.w)) + ((r1.x + r1.y) + (r1.z + r1.w)) + ((r2.x + r2.y) + (r2.z + r2.w)) + ((r3.x + r3.y) + (r3.z + r3.w));
            const float rinv = rsqrtf(ss * (1.f / 1024.f) + EPS);
            BA[(size_t)row * 16 + r] = (mi ? acc1[q] : acc0[q]) * rinv + sw;
        }
}

constexpr int NPHASE = 24;
__global__ void __launch_bounds__(NTHR, 2) fwd_kernel(Args args) {
    extern __shared__ __attribute__((aligned(16))) unsigned char lds_raw[];
    LAS unsigned char* lds = (LAS unsigned char*)lds_raw;
#if !MK_MULTI
    volatile LAS unsigned* MISC = (volatile LAS unsigned*)(lds + MISC_OFF);
    if (threadIdx.x < 64) MISC[threadIdx.x] = 0u;
    __syncthreads();
    XcdBarrier bar = xcd_barrier_post((unsigned*)(args.ws + WS_CTL) + CW_BAR, MISC + 8);
#define GRID_BAR() xcd_barrier(bar)
#else
#define GRID_BAR() do { } while (0)
#endif
    const int G = gridDim.x, bid = blockIdx.x;
    for (int pass = (PRE_HI > 0 ? 0 : 1); pass < 2; ++pass) {
        const int hi = (pass == 0) ? args.pad : args.ph_hi, lo = args.ph_lo;
#define RUN(k) ((k) >= lo && (k) < hi)
#define SEAM(k) do { if (RUN(k) && ((k) + 1 < hi || pass == 0)) { GRID_BAR(); for (int rb = 1; rb < REP_BAR; ++rb) GRID_BAR(); } } while (0)
        if (RUN(0)) { if (EN(0)) for (int rep = 0; rep < REP_P0; ++rep) phase_0a(args, lds); } SEAM(0);
        if (RUN(1)) { if (EN(1)) for (int rep = 0; rep < REP_P0; ++rep) phase_0b(args, lds); } SEAM(1);
        if (RUN(2)) { if (EN(2)) phase_0c(args); } SEAM(2);
#pragma unroll 1
        for (int l = 0; l < NL; ++l) {
            if (RUN(3 + 5 * l)) {
            if (EN(4)) {
                pg8::Gemm g{(const bf16*)args.out, (const bf16*)(args.ws + WS_W1T) + (size_t)l * N1 * 1024, M, LDP, 1024, 1024};
                pg8::StaticOrder S; S.init(M, LDP, G, bid);
                Epi1 E{(bf16*)(args.ws + WS_PB), (float*)(args.ws + WS_BA), (const float*)(args.ws + WS_RSS), (const float*)(args.ws + WS_SW) + (size_t)l * 9 * N1, 0, (bf16*)(args.ws + WS_DUM), (const LAS float*)(lds + 131072), (float*)(args.ws + WS_VSS)};
                {
                    LAS float* rtab = (LAS float*)(lds + 131072); const float* RSSp = (const float*)(args.ws + WS_RSS);
                    for (int idx = otid(); idx < 8 * 256; idx += NTHR) { pg8::Unit u;
                        if (S.next(idx >> 8, u)) { const f32x4* rp = (const f32x4*)(RSSp + (size_t)(u.pm * 256 + (idx & 255)) * 16);
                            const f32x4 r0 = rp[0], r1 = rp[1], r2 = rp[2], r3 = rp[3];
                            const float ss = ((r0.x + r0.y) + (r0.z + r0.w)) + ((r1.x + r1.y) + (r1.z + r1.w)) + ((r2.x + r2.y) + (r2.z + r2.w)) + ((r3.x + r3.y) + (r3.z + r3.w));
                            rtab[idx] = rsqrtf(ss * (1.f / 1024.f) + EPS); } }
                    __syncthreads();
                }
                for (int rep = 0; rep < REP_G1; ++rep) { if (rep && G1CHEAP) E.cheap = args.one * G1CHEAP; pg8::gemm_phase<Epi1>(lds, g, S, E); if (rep && G1CHEAP) continue;
                    if (bid >= 128) for (int pm = bid - 128; pm < 160; pm += 128) skinny_ba(args, l, pm); } }
            }
            SEAM(3 + 5 * l);
            if (RUN(4 + 5 * l))
            {
                if (EN(5)) {
#if PREP_PREFETCH
                    PrepPre PP; if (bid < 2560) prep_prefetch(args, PP, bid >> 2, bid & 3);
                    for (int it = bid; it < 2560; it += G) { const int nit = it + G < 2560 ? it + G : -4; prep_item(args, lds, l, it >> 2, it & 3, PP, nit >> 2, nit & 3); }
#else
                    for (int it = bid; it < 2560; it += G) { PrepPre PP; prep_prefetch(args, PP, it >> 2, it & 3); prep_item(args, lds, l, it >> 2, it & 3, PP, -1, 0); }
#endif
                }
            }
            SEAM(4 + 5 * l);
            if (RUN(5 + 5 * l))
            {
                if (bid < 64 && !PSK(1)) { if (EN(10)) for (int rep = 0; rep < REP_SCAN; ++rep) scan_item(args, lds, l, 32 + (bid >> 3), (bid >> 1) & 3, bid & 1); }
                unsigned* qc = (unsigned*)(args.ws + WS_CTL) + CW_Q + 64 * l + 256 * pass;
                volatile LAS unsigned* qslot = (volatile LAS unsigned*)(lds + MISC_OFF) + 16;
                if (otid() == 0) qslot[0] = atomicAdd(qc, 1u);
                for (;;) {
                    __syncthreads();
                    const int it = (int)qslot[0];
                    __syncthreads();
                    if (it >= 1376) break;
                    unsigned nx = 0u; const bool puller = (otid() == 0);
                    if (puller) nx = atomicAdd(qc, 1u);
                    if (it < 512) { if (EN(9) && !PSK(2)) for (int rep = 0; rep < REP_FSMP; ++rep) fsmp_item(args, lds, it >> 6, it & 63, rep ? args.one : 0); }
                    else if (it < 640) { const int i2 = it - 512; if (EN(8) && !PSK(4)) for (int rep = 0; rep < REP_FCTX; ++rep) fctx_item(args, lds, i2 >> 2, i2 & 3, rep ? args.one : 0); }
                    else if (it < 896) { const int i2 = it - 640; if (EN(10) && !PSK(8)) for (int rep = 0; rep < REP_CTXS; ++rep) scan_item(args, lds, l, i2 >> 3, (i2 >> 1) & 3, i2 & 1); }
                    else if (it < 1216) { const int i2 = it - 896, g_ = i2 / 80, c4 = (i2 % 80) * 4;
                        if (EN(6) && !PSK(16)) for (int rep = 0; rep < REP_SGU; ++rep) for (int cc = 0; cc < 4; ++cc) sgu_item(args, lds, l, c4 + cc, g_, rep ? args.one : 0, cc > 0 || rep > 0); }
                    else { const int i2 = (it - 1216) * 4; if (EN(7) && !PSK(32)) for (int cc = 0; cc < 4; ++cc) pool_item(args, lds, l, i2 + cc, 0); }
                    if (puller) qslot[0] = nx;
                }
            }
            SEAM(5 + 5 * l);
            if (RUN(6 + 5 * l))
            {
                if (EN(11)) { for (int it = bid; it < 512; it += G) ffin_item(args, lds, it >> 6, it & 63);
                    for (int rep = 0; rep < REP_COMB; ++rep) phase_combine(args, l, rep ? args.one : 0); }
            }
            SEAM(6 + 5 * l);
            if (RUN(7 + 5 * l)) {
            if (EN(12)) {
                pg8::Gemm g{(const bf16*)(args.ws + WS_PB), (const bf16*)(args.ws + WS_W2T) + (size_t)l * 1024 * 1024, M, 1024, 1024, LDP};
                pg8::StaticOrder S; S.init(M, 1024, G, bid);
                const float* MOD = (const float*)(args.ws + WS_MOD);
                Epi2 E{(bf16*)args.out + (size_t)M * D, (bf16*)args.out, (float*)(args.ws + WS_RSS), MOD + (size_t)l * 9 * 3072 + 2048,
                       l < 3 ? args.in[I_NORMG] + (l + 1) * 1024 : nullptr, l < 3 ? MOD + (size_t)(l + 1) * 9 * 3072 + 1024 : nullptr, args.ws + WS_DUM, 0};
                pg8::gemm_phase<Epi2>(lds, g, S, E);
                for (int rep = 1; rep < REP_G2; ++rep) { Epi2 E2 = E; E2.dry = args.one; pg8::gemm_phase<Epi2>(lds, g, S, E2); }
            }
            }
            SEAM(7 + 5 * l);
        }
        if (RUN(23)) { if (EN(3) && pass == 1) { for (int rnd = 0; rnd < 4; ++rnd) { FinalRegs R; final_load(args, R, rnd); GRID_BAR(); final_store(args, R, rnd); } } }
#undef RUN
#undef SEAM
    }
}

extern "C" void kernel_launch(void* const* d_in, const int* in_sizes, int n_in, void* d_out, int out_size, void* d_ws, size_t ws_size, hipStream_t stream) {
    static int grid = 0;
    if (grid == 0) {
        if (n_in != 21 || ws_size < WS_DUM + 16 * MiB) { fprintf(stderr, "kernel_launch: unexpected n_in %d or ws_size %zu (< %zu)\n", n_in, ws_size, (size_t)WS_END); grid = -1; return; }
        int dev = 0, cus = 0, per_cu = 0;
        if (hipGetDevice(&dev) != hipSuccess || hipDeviceGetAttribute(&cus, hipDeviceAttributeMultiprocessorCount, dev) != hipSuccess) { grid = -1; return; }
        if (hipFuncSetAttribute((const void*)fwd_kernel, hipFuncAttributeMaxDynamicSharedMemorySize, LDS_BYTES) != hipSuccess) { fprintf(stderr, "kernel_launch: hipFuncSetAttribute failed\n"); grid = -1; return; }
        if (hipOccupancyMaxActiveBlocksPerMultiprocessor(&per_cu, (const void*)fwd_kernel, NTHR, LDS_BYTES) != hipSuccess || per_cu < 1) { fprintf(stderr, "kernel_launch: occupancy query failed (%d)\n", per_cu); (void)hipGetLastError(); per_cu = 1; }
        grid = cus * 1;
    }
    if (grid < 0) return;
    Args a{};
    for (int i = 0; i < 21; ++i) a.in[i] = (const float*)d_in[i];
    a.out = (float*)d_out; a.ws = (unsigned char*)d_ws; a.one = 1; a.pad = PRE_HI;
    (void)hipMemsetAsync((char*)d_ws + WS_CTL, 0, CTL_ZERO_BYTES, stream);
#if MK_MULTI
    for (int ph = 0; ph < NPHASE; ++ph) {
        a.ph_lo = ph; a.ph_hi = ph + 1;
        hipLaunchKernelGGL(fwd_kernel, dim3(grid), dim3(NTHR), LDS_BYTES, stream, a);
    }
#else
    a.ph_lo = 0; a.ph_hi = NPHASE;
    void* kargs[] = {&a};
    hipError_t e = hipLaunchCooperativeKernel((const void*)fwd_kernel, dim3(grid), dim3(NTHR), kargs, LDS_BYTES, stream);
    if (e != hipSuccess) fprintf(stderr, "kernel_launch: cooperative launch failed: %s (grid %d)\n", hipGetErrorString(e), grid);
#endif
}
```

```cpp
#include <hip/hip_runtime.h>
#include <cstdio>
#include <cstdint>

#ifndef MK_MULTI
#define MK_MULTI 0
#endif
#ifndef NAIVE_MM
#define NAIVE_MM 0
#endif
#ifndef ONLY
#define ONLY -1
#endif
#define EN(k) (ONLY < 0 || ONLY == (k))
#ifndef REP_G1
#define REP_G1 1
#endif
#ifndef REP_PREP
#define REP_PREP 1
#endif
#ifndef REP_SCAN
#define REP_SCAN 1
#endif
#ifndef REP_P0
#define REP_P0 1
#endif
#ifndef REP_MIX
#define REP_MIX 1
#endif
#ifndef REP_COMB
#define REP_COMB 1
#endif
#ifndef REP_G2
#define REP_G2 1
#endif
#ifndef MIXSEL
#define MIXSEL 15
#endif
#ifndef G1CHEAP
#define G1CHEAP 0
#endif
#ifndef REP_BAR
#define REP_BAR 1
#endif
#ifndef PRE_HI
#define PRE_HI 0
#endif
#ifndef PROBE_A
#define PROBE_A -1
#endif
#ifndef PROBE_B
#define PROBE_B -1
#endif
#ifndef PROBE_FAKE
#define PROBE_FAKE 0
#endif
#ifndef PROBE_SCALE
#define PROBE_SCALE 1
#endif
#ifndef PROBE_X
#define PROBE_X -1
#endif
#define PROBE_L 1
#ifndef REP_FCTX
#define REP_FCTX 1
#endif
#ifndef REP_FSMP
#define REP_FSMP 1
#endif
#ifndef REP_CTXS
#define REP_CTXS 1
#endif
#ifndef REP_SGU
#define REP_SGU 1
#endif
#ifndef PREP_PREFETCH
#define PREP_PREFETCH 0
#endif
#ifndef PRE_SKIP
#define PRE_SKIP 0
#endif
#define PSK(b) (pass == 0 && (PRE_SKIP & (b)))

#define LAS __attribute__((address_space(3)))
#define GAS __attribute__((address_space(1)))
typedef unsigned short bf16;
typedef short bf16x8 __attribute__((ext_vector_type(8)));
typedef float f32x4 __attribute__((ext_vector_type(4)));
typedef float f32x2 __attribute__((ext_vector_type(2)));
typedef unsigned u32x4 __attribute__((ext_vector_type(4)));
typedef unsigned u32x2 __attribute__((ext_vector_type(2)));

constexpr int D = 1024, NL = 4, NCOND = 9;
constexpr int M_CTX = 8192, M = 40960;
constexpr int PIN = 2832;
constexpr int N1 = 3328, LDP = 3072;
constexpr float EPS = 1e-6f;
constexpr int C_GA = 0, C_U = 256, C_GC = 512, C_GD = 768, C_V = 1024, C_GB = 1280, C_XC = 1536, C_PF = 1792, C_QF = 2048, C_Q = 2304, C_K = 2560, C_VV = 2816;

constexpr size_t MiB = 1u << 20;
constexpr size_t WS_CTL = 0, CTL_ZERO_BYTES = 1 * MiB;
constexpr size_t WS_MOD = 1 * MiB;
constexpr size_t WS_SW = WS_MOD + 512 * 1024;
constexpr size_t WS_GMAT = 2 * MiB;
constexpr size_t WS_POS = WS_GMAT + 512 * 1024;
constexpr size_t WS_DFT = WS_POS + 256 * 1024;
constexpr size_t WS_M1 = 3 * MiB;
constexpr size_t WS_M2 = WS_M1 + 32 * 1024;
constexpr size_t WS_TW = WS_M1 + 64 * 1024;
constexpr size_t WS_W1T = 4 * MiB;
constexpr size_t WS_W2T = 30 * MiB;
constexpr size_t WS_BA = 38 * MiB;
constexpr size_t WS_RSS = 41 * MiB;
constexpr size_t WS_PB = 44 * MiB;
constexpr size_t WS_HB = 284 * MiB;
constexpr size_t WS_PREP = 284 * MiB;
constexpr size_t WS_PGL = 484 * MiB;
constexpr size_t WS_VSS = 484 * MiB + 64 * 1024;
constexpr size_t WS_END = 485 * MiB;
constexpr size_t WS_DUM = 486 * MiB;
constexpr int CW_BAR = 4096, CW_Q = 8192;

constexpr int LDS_BYTES = 147456;
constexpr int MISC_OFF = 144 * 1024 - 256;
constexpr int NWAVES = 8, NTHR = 512;

typedef __bf16 hwbf16x2 __attribute__((ext_vector_type(2)));
__device__ __forceinline__ unsigned f2bf(float f) { return (unsigned)__builtin_bit_cast(unsigned short, (__bf16)f); }
__device__ __forceinline__ float bf2f(unsigned b) { return __builtin_bit_cast(float, (b & 0xffffu) << 16); }
__device__ __forceinline__ unsigned pk2(float lo, float hi) { const f32x2 v = {lo, hi}; return __builtin_bit_cast(unsigned, __builtin_convertvector(v, hwbf16x2)); }
__device__ __forceinline__ float bflo(unsigned w) { return __builtin_bit_cast(float, w << 16); }
__device__ __forceinline__ float bfhi(unsigned w) { return __builtin_bit_cast(float, w & 0xffff0000u); }
__device__ __forceinline__ float silu_f(float x) { return x * __builtin_amdgcn_rcpf(1.f + __builtin_amdgcn_exp2f(-1.4426950408889634f * x)); }
__device__ __forceinline__ float gelu_tanh_f(float x) { const float z = (-1.5957691216057308f * 1.4426950408889634f) * (x + 0.044715f * x * x * x); return x * __builtin_amdgcn_rcpf(1.f + __builtin_amdgcn_exp2f(z)); }
__device__ __forceinline__ float wave_sum(float v) {
#pragma unroll
    for (int o = 1; o < 64; o <<= 1) v += __shfl_xor(v, o);
    return v;
}
__device__ __forceinline__ int otid() { int t = threadIdx.x; asm volatile("" : "+v"(t)); return t; }
__device__ __forceinline__ int obid() { int b = blockIdx.x; asm volatile("" : "+s"(b)); return b; }
#define LDS_WAIT() asm volatile("s_waitcnt lgkmcnt(0)" ::: "memory")

namespace pg8 {
constexpr int BM = 256, BK = 64, HALF = 128, HTB = HALF * BK * 2, STAGE_BYTES = 8 * HTB, NXCD = 8, WGM = 8;
__host__ __device__ __forceinline__ int lds_byte(int r, int c) { const int st = (r >> 4) * 2 + (c >> 5), rr = r & 15, cc = c & 31, ob = rr * 64 + cc * 2; return st * 1024 + (ob ^ (((ob >> 9) & 1) << 5)); }
__host__ __device__ __forceinline__ void stage_rc(int b, int& R, int& C) { const int st = b / 1024, sb = b % 1024, swz = sb ^ (((sb >> 9) & 1) << 5); R = (st >> 1) * 16 + swz / 64; C = (st & 1) * 32 + (swz % 64) / 2; }
__host__ __device__ __forceinline__ int perm32(int rho) { const int n = rho >> 4, i = rho & 15; return 8 * (i >> 2) + 4 * n + (i & 3); }

struct Unit { int pm, pn; };
struct Gemm { const bf16* A; const bf16* Bt; int M, N, K, lda; };

struct StaticOrder {
    int nM, nN, nwg, G, c;
    __host__ __device__ __forceinline__ void init(int M_, int N_, int G_, int c_) { nM = M_ / BM; nN = N_ / BM; nwg = nM * nN; G = G_; c = c_; }
    __host__ __device__ __forceinline__ bool next(int i, Unit& u) const {
        const long L = (long)i * G + c; if (L >= nwg) return false;
        int wgid = (int)L; { const int q = nwg / NXCD, r = nwg % NXCD, xcd = wgid % NXCD, off = wgid / NXCD; wgid = (xcd < r ? xcd * (q + 1) : r * (q + 1) + (xcd - r) * q) + off; }
        const int nig = WGM * nN, gid = wgid / nig, fm = gid * WGM, gsz = (nM - fm) < WGM ? (nM - fm) : WGM;
        u.pm = fm + ((wgid % nig) % gsz); u.pn = (wgid % nig) / gsz; return true;
    }
};

template <class Epi>
__device__ __forceinline__ void gemm_phase(LAS unsigned char* lds, const Gemm g, const StaticOrder& S, const Epi& E) {
    const int tid = otid(), wid = __builtin_amdgcn_readfirstlane(tid >> 6), lane = tid & 63, wr = wid >> 2, wc = wid & 3, fr = lane & 15, fq = lane >> 4;
    const int K = g.K, nt = K / BK, lda = g.lda;
    unsigned voffA[2], voffB[2];
#pragma unroll
    for (int i = 0; i < 2; ++i) { int R, C; stage_rc(tid * 16 + i * 8192, R, C); const int Rb = Epi::PERM ? ((R & ~31) + perm32(R & 31)) : R;
        voffA[i] = (unsigned)(R * lda + C) * 2u; voffB[i] = (unsigned)(Rb * K + C) * 2u; }
    const size_t kstep = (size_t)(BK * 2);
    const size_t hstepA = (size_t)HALF * lda * 2, hstepB = (size_t)HALF * K * 2;
    const size_t tstepA = 2 * hstepA, tstepB = 2 * hstepB;
    const unsigned ldsw = (unsigned)wid * 1024u;
    const int aoff = lds_byte(wr * 64 + fr, fq * 8), boff = lds_byte(wc * 32 + fr, fq * 8);
#define PG8_SA(b, h) (((b) * 2 + (h)) * HTB)
#define PG8_SB(b, h) ((4 + (b) * 2 + (h)) * HTB)
#define PG8_STAGE(bufoff, gbase, voff) do { _Pragma("unroll") for (int _i = 0; _i < 2; ++_i) \
        __builtin_amdgcn_global_load_lds((const unsigned*)((const char*)(gbase) + (voff)[_i]), (LAS unsigned*)(lds + (bufoff) + ldsw + _i * 8192), 16, 0, 0); } while (0)
#define PG8_LDA(dst, b, h) do { _Pragma("unroll") for (int m = 0; m < 4; ++m) _Pragma("unroll") for (int k = 0; k < 2; ++k) dst[m][k] = *(const LAS bf16x8*)(lds + PG8_SA(b, h) + aoff + m * 2048 + k * 1024); } while (0)
#define PG8_LDB(dst, b, h) do { _Pragma("unroll") for (int n = 0; n < 2; ++n) _Pragma("unroll") for (int k = 0; k < 2; ++k) dst[n][k] = *(const LAS bf16x8*)(lds + PG8_SB(b, h) + boff + n * 2048 + k * 1024); } while (0)
#define PG8_MMA(ai, bj, At, Bt) do { __builtin_amdgcn_s_setprio(1); _Pragma("unroll") for (int m = 0; m < 4; ++m) _Pragma("unroll") for (int n = 0; n < 2; ++n) _Pragma("unroll") for (int k = 0; k < 2; ++k) \
        acc[ai][bj][m][n] = __builtin_amdgcn_mfma_f32_16x16x32_bf16(Bt[n][k], At[m][k], acc[ai][bj][m][n], 0, 0, 0); __builtin_amdgcn_s_setprio(0); } while (0)
#define PG8_WAIT_V(n) asm volatile("s_waitcnt vmcnt(" #n ")" ::: "memory")
#define PG8_WAIT_L(n) asm volatile("s_waitcnt lgkmcnt(" #n ")" ::: "memory")
#define PG8_BAR __builtin_amdgcn_s_barrier()
#define PG8_SCHED __builtin_amdgcn_sched_barrier(0)
    Unit cur, nxt; int ui = 0;
    if (!S.next(0, cur)) return;
    f32x4 acc[2][2][4][2];
#pragma unroll
    for (int a = 0; a < 2; ++a)
#pragma unroll
        for (int b = 0; b < 2; ++b)
#pragma unroll
            for (int m = 0; m < 4; ++m)
#pragma unroll
                for (int n = 0; n < 2; ++n) acc[a][b][m][n] = (f32x4){0.f, 0.f, 0.f, 0.f};
    bf16x8 At[4][2], B0[2][2], B1[2][2];
    const char* cA = (const char*)g.A + (size_t)cur.pm * tstepA; const char* cB = (const char*)g.Bt + (size_t)cur.pn * tstepB;
    PG8_STAGE(PG8_SB(0, 0), cB, voffB); PG8_STAGE(PG8_SA(0, 0), cA, voffA); PG8_STAGE(PG8_SB(0, 1), cB + hstepB, voffB); PG8_STAGE(PG8_SA(0, 1), cA + hstepA, voffA);
    if (wr == 1) PG8_BAR;
    PG8_WAIT_V(4); PG8_BAR;
    PG8_STAGE(PG8_SB(1, 0), cB + kstep, voffB); PG8_STAGE(PG8_SA(1, 0), cA + kstep, voffA); PG8_STAGE(PG8_SB(1, 1), cB + hstepB + kstep, voffB);
    PG8_WAIT_V(6); PG8_BAR;
    for (;;) {
        const bool has_next = S.next(ui + 1, nxt);
        const char* nA = has_next ? (const char*)g.A + (size_t)nxt.pm * tstepA : cA; const char* nB = has_next ? (const char*)g.Bt + (size_t)nxt.pn * tstepB : cB;
        for (int t = 0; t < nt; t += 2) {
            const bool last = (t == nt - 2);
            const char* a1 = cA + (size_t)(t + 1) * kstep;
            const char* a2 = last ? nA : cA + (size_t)(t + 2) * kstep; const char* b2 = last ? nB : cB + (size_t)(t + 2) * kstep;
            const char* a3 = a2 + kstep; const char* b3 = b2 + kstep;
            PG8_LDB(B0, 0, 0); PG8_SCHED; PG8_LDA(At, 0, 0); PG8_STAGE(PG8_SA(1, 1), a1 + hstepA, voffA);
            PG8_WAIT_L(8); PG8_BAR; PG8_WAIT_L(0); PG8_MMA(0, 0, At, B0); PG8_BAR; PG8_SCHED;
            PG8_LDB(B1, 0, 1); PG8_STAGE(PG8_SB(0, 0), b2, voffB);
            PG8_BAR; PG8_WAIT_L(0); PG8_MMA(0, 1, At, B1); PG8_BAR;
            PG8_LDA(At, 0, 1); PG8_STAGE(PG8_SA(0, 0), a2, voffA);
            PG8_BAR; PG8_WAIT_L(0); PG8_MMA(1, 0, At, B0); PG8_BAR; PG8_SCHED;
            PG8_STAGE(PG8_SB(0, 1), b2 + hstepB, voffB);
            PG8_WAIT_V(6); PG8_BAR; PG8_MMA(1, 1, At, B1); PG8_BAR;
            PG8_LDB(B0, 1, 0); PG8_SCHED; PG8_LDA(At, 1, 0); PG8_STAGE(PG8_SA(0, 1), a2 + hstepA, voffA);
            PG8_WAIT_L(8); PG8_BAR; PG8_WAIT_L(0); PG8_MMA(0, 0, At, B0); PG8_BAR; PG8_SCHED;
            PG8_LDB(B1, 1, 1); PG8_STAGE(PG8_SB(1, 0), b3, voffB);
            PG8_BAR; PG8_WAIT_L(0); PG8_MMA(0, 1, At, B1); PG8_BAR;
            PG8_LDA(At, 1, 1); PG8_STAGE(PG8_SA(1, 0), a3, voffA);
            PG8_BAR; PG8_WAIT_L(0); PG8_MMA(1, 0, At, B0); PG8_BAR; PG8_SCHED;
            PG8_STAGE(PG8_SB(1, 1), b3 + hstepB, voffB);
            PG8_WAIT_V(6); PG8_BAR; PG8_MMA(1, 1, At, B1); PG8_BAR;
        }
        E(acc, cur, wr, wc, fr, fq, ui);
        if (!has_next) break;
#pragma unroll
        for (int a = 0; a < 2; ++a)
#pragma unroll
            for (int b = 0; b < 2; ++b)
#pragma unroll
                for (int m = 0; m < 4; ++m)
#pragma unroll
                    for (int n = 0; n < 2; ++n) acc[a][b][m][n] = (f32x4){0.f, 0.f, 0.f, 0.f};
        cur = nxt; cA = nA; cB = nB; ++ui;
    }
    PG8_WAIT_V(0);
    if (wr == 0) PG8_BAR;
    PG8_BAR;
#undef PG8_SA
#undef PG8_SB
#undef PG8_STAGE
#undef PG8_LDA
#undef PG8_LDB
#undef PG8_MMA
#undef PG8_WAIT_V
#undef PG8_WAIT_L
#undef PG8_BAR
#undef PG8_SCHED
}
}

#define XB_TMO      128
#define XB_XCNT(j)  (256  + 64 * (j))
#define XB_XSUB(j)  (1280 + 64 * (j))
#define XB_XGEN(j)  (2304 + 64 * (j))
#define XB_TOP      3328
#define XB_TOPGEN   3392
#define XCD_BAR_WORDS 3456
#define XB_SPIN_CAP (1u << 18)
__device__ __forceinline__ unsigned xb_ld(unsigned* p)              { return __hip_atomic_load(p, __ATOMIC_RELAXED, __HIP_MEMORY_SCOPE_AGENT); }
__device__ __forceinline__ unsigned xb_add(unsigned* p, unsigned v) { return __hip_atomic_fetch_add(p, v, __ATOMIC_RELAXED, __HIP_MEMORY_SCOPE_AGENT); }
__device__ __forceinline__ unsigned xb_xcc_id() { return (unsigned)__builtin_amdgcn_s_getreg((3 << 11) | 20) & 0xFu; }
#define XB_SPIN(cond, bar) do { unsigned _sp = 0; while (cond) { __builtin_amdgcn_s_sleep(1); \
    if ((++_sp & 255u) == 0u) { if (xb_ld(&(bar)[XB_TMO])) break; if (_sp > XB_SPIN_CAP) { atomicAdd(&(bar)[XB_TMO], 1u); break; } } } } while (0)
struct XcdBarrier { unsigned* bar; unsigned x; volatile LAS unsigned* st; };
__device__ __forceinline__ XcdBarrier xcd_barrier_post(unsigned* bar, volatile LAS unsigned* st) {
    XcdBarrier b; b.bar = bar; b.x = xb_xcc_id(); b.st = st;
    if (threadIdx.x == 0) (void)xb_add(&bar[XB_XCNT(b.x)], 1u);
    return b;
}
__device__ __forceinline__ void xcd_barrier_complete(unsigned* bar, unsigned x, unsigned& nloc, unsigned& nx) {
    const unsigned G = gridDim.x * gridDim.y * gridDim.z;
    unsigned sum, cnt, mine, sp = 0u;
    for (;;) {
        sum = 0u; cnt = 0u; mine = 0u;
#pragma unroll
        for (unsigned j = 0; j < 16; ++j) { const unsigned c = xb_ld(&bar[XB_XCNT(j)]); sum += c; cnt += (c > 0u) ? 1u : 0u; mine = (j == x) ? c : mine; }
        if (sum == G) break;
        __builtin_amdgcn_s_sleep(1);
        if ((++sp & 255u) == 0u) { if (xb_ld(&bar[XB_TMO])) break; if (sp > XB_SPIN_CAP) { atomicAdd(&bar[XB_TMO], 1u); break; } }
    }
    nloc = mine > 0u ? mine : 1u; nx = cnt > 0u ? cnt : 1u;
}
__device__ __forceinline__ void xcd_barrier(const XcdBarrier& b) {
    asm volatile("s_waitcnt vmcnt(0)" ::: "memory");
    __syncthreads();
    if (threadIdx.x == 0) {
        unsigned* bar = b.bar;
        __builtin_amdgcn_s_waitcnt(0);
        unsigned nloc = b.st[0], nx = b.st[1];
        if (nloc == 0u) { xcd_barrier_complete(bar, b.x, nloc, nx); b.st[0] = nloc; b.st[1] = nx; }
        const unsigned old = xb_add(&bar[XB_XSUB(b.x)], 1u);
        const unsigned gen = old / nloc;
        if (old + 1u == (gen + 1u) * nloc) {
            __builtin_amdgcn_fence(__ATOMIC_RELEASE, "agent");
            asm volatile("s_waitcnt vmcnt(0)" ::: "memory");
            const unsigned og = xb_add(&bar[XB_TOP], 1u);
            const unsigned tg = og / nx;
            if (og + 1u == (tg + 1u) * nx) xb_add(&bar[XB_TOPGEN], 1u);
            else XB_SPIN(xb_ld(&bar[XB_TOPGEN]) == tg, bar);
            __builtin_amdgcn_fence(__ATOMIC_ACQUIRE, "agent");
            xb_add(&bar[XB_XGEN(b.x)], 1u);
            asm volatile("s_waitcnt vmcnt(0)" ::: "memory");
        } else {
            XB_SPIN(xb_ld(&bar[XB_XGEN(b.x)]) == gen, bar);
            __builtin_amdgcn_fence(__ATOMIC_ACQUIRE, "agent");
            asm volatile("s_waitcnt vmcnt(0)" ::: "memory");
        }
    }
    __syncthreads();
}

template <int KS>
__device__ __forceinline__ f32x4 tile_mm(f32x4 acc, const LAS bf16* A, int lda, int m0, const LAS bf16* Bt, int ldb, int n0, int lane) {
    const int r = lane & 15, kg = lane >> 4;
#if NAIVE_MM
#pragma unroll 1
    for (int k = 0; k < KS * 32; ++k) {
        const float b = bf2f(Bt[(n0 + r) * ldb + k]);
#pragma unroll
        for (int q = 0; q < 4; ++q) acc[q] += bf2f(A[(m0 + 4 * kg + q) * lda + k]) * b;
    }
#else
#pragma unroll
    for (int ks = 0; ks < KS; ++ks) {
        const bf16x8 a = *(const LAS bf16x8*)(A + (m0 + r) * lda + ks * 32 + kg * 8);
        const bf16x8 b = *(const LAS bf16x8*)(Bt + (n0 + r) * ldb + ks * 32 + kg * 8);
        acc = __builtin_amdgcn_mfma_f32_16x16x32_bf16(a, b, acc, 0, 0, 0);
    }
#endif
    return acc;
}
template <int KS>
__device__ __forceinline__ f32x4 tile_mm_g(f32x4 acc, const bf16* A, int lda, int m0, const LAS bf16* Bt, int ldb, int n0, int lane) {
    const int r = lane & 15, kg = lane >> 4;
#if NAIVE_MM
#pragma unroll 1
    for (int k = 0; k < KS * 32; ++k) {
        const float b = bf2f(Bt[(n0 + r) * ldb + k]);
#pragma unroll
        for (int q = 0; q < 4; ++q) acc[q] += bf2f(A[(m0 + 4 * kg + q) * lda + k]) * b;
    }
#else
#pragma unroll
    for (int ks = 0; ks < KS; ++ks) {
        const bf16x8 a = *(const bf16x8*)(A + (size_t)(m0 + r) * lda + ks * 32 + kg * 8);
        const bf16x8 b = *(const LAS bf16x8*)(Bt + (n0 + r) * ldb + ks * 32 + kg * 8);
        acc = __builtin_amdgcn_mfma_f32_16x16x32_bf16(a, b, acc, 0, 0, 0);
    }
#endif
    return acc;
}

struct Args { const float* in[21]; float* out; unsigned char* ws; int ph_lo, ph_hi, one, pad; };
enum { I_XP = 0, I_XS, I_STATE, I_C, I_CCTX, I_ADAW, I_ADAB, I_NORMG, I_WIN, I_CONV, I_ALOG, I_DTB, I_DNG, I_SGUNG, I_SGUW, I_SGUB, I_POOLW, I_POOLS, I_FW, I_WOUT, I_FNG };

struct SeqGeo { int T, tseq0, seq_row0; };
__device__ __forceinline__ SeqGeo seq_geo(int sc) {
    SeqGeo g;
    if (sc < 128) { g.T = 256; g.tseq0 = (sc & 3) * 64; g.seq_row0 = (sc >> 2) * 256; }
    else { const int s = sc - 128; g.T = 4096; g.tseq0 = (s & 63) * 64; g.seq_row0 = M_CTX + (s >> 6) * 4096; }
    return g;
}
__device__ __forceinline__ int cond_of_row(int row) { return row < M_CTX ? 0 : 1 + ((row - M_CTX) >> 12); }

__device__ __forceinline__ int srccol(int n) {
    if (n < 256) return 768 + n;
    if (n < 512) return 1040 + (n - 256);
    if (n < 768) return 2064 + (n - 512);
    if (n < 1024) return 2576 + (n - 768);
    if (n < 1280) return 1296 + (n - 1024);
    if (n < 1536) return 1552 + (n - 1280);
    if (n < 2304) return -2;
    if (n < 3072) return n - 2304;
    if (n < 3088) return 1024 + (n - 3072);
    return -1;
}

__device__ __forceinline__ void phase_0a(const Args& a, LAS unsigned char* lds) {
    const int tid = otid(), lane = tid & 63, wave = tid >> 6, G = gridDim.x, bid = obid();
    float* MOD = (float*)(a.ws + WS_MOD);
    if (bid < 192) {
        LAS float* sc = (LAS float*)lds;
        LAS float* red = (LAS float*)(lds + 9 * 1024 * 4);
        for (int i = tid; i < 9 * 1024; i += NTHR) { const int j = i >> 10, k = i & 1023; const float c = (j == 0) ? a.in[I_CCTX][k] : a.in[I_C][(j - 1) * 1024 + k]; sc[i] = silu_f(c); }
        __syncthreads();
        for (int it = bid; it < 192; it += G) {
            const int l = it / 48, cb = it % 48, col = cb * 64 + lane;
            float acc[9];
#pragma unroll
            for (int j = 0; j < 9; ++j) acc[j] = 0.f;
            const float* wp = a.in[I_ADAW] + ((size_t)l * 1024 + wave * 128) * 3072 + col;
#pragma unroll 8
            for (int k = 0; k < 128; ++k) { const float wv = wp[(size_t)k * 3072];
#pragma unroll
                for (int j = 0; j < 9; ++j) acc[j] += sc[j * 1024 + wave * 128 + k] * wv; }
#pragma unroll
            for (int j = 0; j < 9; ++j) red[(wave * 9 + j) * 64 + lane] = acc[j];
            __syncthreads();
            for (int i = tid; i < 576; i += NTHR) { const int j = i >> 6, ln = i & 63; float s = 0.f;
#pragma unroll
                for (int w = 0; w < 8; ++w) s += red[(w * 9 + j) * 64 + ln];
                MOD[(l * 9 + j) * 3072 + cb * 64 + ln] = s + a.in[I_ADAB][l * 3072 + cb * 64 + ln]; }
            __syncthreads();
        }
    }
    const int gtid = bid * NTHR + tid, GT = G * NTHR;
    float* GM = (float*)(a.ws + WS_GMAT);
    for (int t = gtid; t < 4 * 4 * 2 * 4096; t += GT) {
        const int d = t & 63, c = (t >> 6) & 63, cs = (t >> 12) & 1, g = (t >> 13) & 3, l = t >> 15;
        const float* fw = a.in[I_FW] + ((size_t)(l * 4 + g) * 64) * 64 + d;
        float s = 0.f;
        for (int m = 0; m < 64; ++m) { const float ph = (float)((m * c) & 63) * (1.f / 32.f); s += (cs ? sinpif(ph) : cospif(ph)) * fw[m * 64]; }
        GM[t] = s * 0.125f;
    }
    bf16* W1T = (bf16*)(a.ws + WS_W1T);
    for (int t = gtid; t < 4 * 128 * N1; t += GT) {
        const int n = t % N1, k8 = (t / N1) & 127, l = t / (N1 * 128);
        const int sc = srccol(n);
        if (sc == -2) continue;
        u32x4 o = (u32x4){0u, 0u, 0u, 0u};
        if (sc >= 0) { const float* wp = a.in[I_WIN] + ((size_t)l * 1024 + k8 * 8) * PIN + sc;
            o.x = pk2(wp[0], wp[PIN]); o.y = pk2(wp[2 * PIN], wp[3 * PIN]); o.z = pk2(wp[4 * PIN], wp[5 * PIN]); o.w = pk2(wp[6 * PIN], wp[7 * PIN]); }
        *(u32x4*)(W1T + ((size_t)l * N1 + n) * 1024 + k8 * 8) = o;
    }
    bf16* W2T = (bf16*)(a.ws + WS_W2T);
    for (int t = gtid; t < 4 * 128 * 1024; t += GT) {
        const int n = t & 1023, k8 = (t >> 10) & 127, l = t >> 17;
        const float* wp = a.in[I_WOUT] + ((size_t)l * 1024 + k8 * 8) * 1024 + n;
        u32x4 o; o.x = pk2(wp[0], wp[1024]); o.y = pk2(wp[2048], wp[3072]); o.z = pk2(wp[4096], wp[5120]); o.w = pk2(wp[6144], wp[7168]);
        *(u32x4*)(W2T + ((size_t)l * 1024 + n) * 1024 + k8 * 8) = o;
    }
    float* POS = (float*)(a.ws + WS_POS);
    for (int t = gtid; t < 64 * 256; t += GT) { const int f = t & 255, i = t >> 8; const float fr = powf(10000.f, -(float)f / 256.f); const float ang = (float)i * fr;
        POS[t] = sinf(ang); POS[64 * 256 + t] = cosf(ang); }
    bf16* DFT = (bf16*)(a.ws + WS_DFT);
    for (int t = gtid; t < 256 * 512; t += GT) { const int tp = t & 511, k = t >> 9, tt = tp & 255; const float ph = (float)((k * tt) & 255) * (1.f / 128.f);
        DFT[t] = (bf16)f2bf((tp < 256 ? cospif(ph) : -sinpif(ph)) * (1.f / 16.f)); }
    bf16* M1 = (bf16*)(a.ws + WS_M1);
    for (int t = gtid; t < 128 * 128; t += GT) { const int kk = t & 127, m = t >> 7, k1 = m & 63, t1 = kk & 63; const float ph = (float)((k1 * t1) & 63) * (1.f / 32.f);
        const float c = cospif(ph), s = sinpif(ph); float v;
        if (m < 64) v = (kk < 64) ? c : -s; else v = (kk < 64) ? s : c;
        M1[t] = (bf16)f2bf(v); }
    bf16* M2 = (bf16*)(a.ws + WS_M2);
    for (int t = gtid; t < 64 * 128; t += GT) { const int kk = t & 127, k2 = t >> 7, t2 = kk & 63; const float ph = (float)((k2 * t2) & 63) * (1.f / 32.f);
        M2[t] = (bf16)f2bf((kk < 64 ? cospif(ph) : -sinpif(ph)) * (1.f / 64.f)); }
    float* TW = (float*)(a.ws + WS_TW);
    for (int t = gtid; t < 64 * 64; t += GT) { const int t2 = t & 63, k1 = t >> 6; const float ph = (float)(k1 * t2) * (1.f / 2048.f); TW[2 * t] = cospif(ph); TW[2 * t + 1] = sinpif(ph); }
}

__device__ __forceinline__ void phase_0b(const Args& a, LAS unsigned char* lds) {
    const int tid = otid(), lane = tid & 63, wave = tid >> 6, G = gridDim.x, bid = obid();
    const int gtid = bid * NTHR + tid, GT = G * NTHR;
    const float* MOD = (const float*)(a.ws + WS_MOD);
    const float* GM = (const float*)(a.ws + WS_GMAT);
    bf16* W1T = (bf16*)(a.ws + WS_W1T);
    for (int it = bid; it < 384; it += G) {
        const int kblk = it & 7, g = (it >> 3) & 3, kind = (it >> 5) % 3, l = it / 96;
        LAS bf16* Al = (LAS bf16*)lds; LAS bf16* Bl = Al + 128 * 72;
        const int base = (kind == 0 ? 1808 : 2320) + 64 * g;
        const float* Gm = (kind == 0) ? (a.in[I_POOLW] + (size_t)(l * 4 + g) * 4096) : (GM + (size_t)((l * 4 + g) * 2 + (kind - 1)) * 4096);
        {
            const int row = tid >> 2, c0 = (tid & 3) * 16;
            const f32x4* wp = (const f32x4*)(a.in[I_WIN] + ((size_t)l * 1024 + kblk * 128 + row) * PIN + base + c0);
            const f32x4 w0 = wp[0], w1 = wp[1], w2 = wp[2], w3 = wp[3];
            u32x4 o0, o1; o0.x = pk2(w0.x, w0.y); o0.y = pk2(w0.z, w0.w); o0.z = pk2(w1.x, w1.y); o0.w = pk2(w1.z, w1.w);
            o1.x = pk2(w2.x, w2.y); o1.y = pk2(w2.z, w2.w); o1.z = pk2(w3.x, w3.y); o1.w = pk2(w3.z, w3.w);
            *(LAS u32x4*)(Al + row * 72 + c0) = o0; *(LAS u32x4*)(Al + row * 72 + c0 + 8) = o1;
            const int c = tid >> 3, d0 = (tid & 7) * 8;
            const f32x4 g0 = *(const f32x4*)(Gm + c * 64 + d0), g1 = *(const f32x4*)(Gm + c * 64 + d0 + 4);
            Bl[(d0 + 0) * 72 + c] = (bf16)f2bf(g0.x); Bl[(d0 + 1) * 72 + c] = (bf16)f2bf(g0.y); Bl[(d0 + 2) * 72 + c] = (bf16)f2bf(g0.z); Bl[(d0 + 3) * 72 + c] = (bf16)f2bf(g0.w);
            Bl[(d0 + 4) * 72 + c] = (bf16)f2bf(g1.x); Bl[(d0 + 5) * 72 + c] = (bf16)f2bf(g1.y); Bl[(d0 + 6) * 72 + c] = (bf16)f2bf(g1.z); Bl[(d0 + 7) * 72 + c] = (bf16)f2bf(g1.w);
        }
        __syncthreads();
        {
            const int m0 = wave * 16, r = lane & 15, kg = lane >> 4;
#pragma unroll
            for (int nt = 0; nt < 4; ++nt) {
                const f32x4 acc = tile_mm<2>((f32x4){0.f, 0.f, 0.f, 0.f}, Al, 72, m0, Bl, 72, nt * 16, lane);
                u32x2 o; o.x = pk2(acc[0], acc[1]); o.y = pk2(acc[2], acc[3]);
                *(u32x2*)(W1T + ((size_t)l * N1 + 1536 + kind * 256 + g * 64 + nt * 16 + r) * 1024 + kblk * 128 + m0 + 4 * kg) = o;
            }
        }
        __syncthreads();
    }
    const float* POS = (const float*)(a.ws + WS_POS);
    bf16* HB = (bf16*)a.out;
    bf16* XB = (bf16*)a.out + (size_t)M * D;
    float* RSS = (float*)(a.ws + WS_RSS);
    for (int r0 = bid * NWAVES + wave; r0 < M; r0 += 4 * G * NWAVES) {
        f32x4 v[4][4], pe[4][4];
#pragma unroll
        for (int u = 0; u < 4; ++u) {
            const int row = r0 + u * G * NWAVES;
#pragma unroll
            for (int q = 0; q < 4; ++q) { v[u][q] = (f32x4){0.f, 0.f, 0.f, 0.f}; pe[u][q] = v[u][q]; }
            if (row < M_CTX) {
                const f32x4* xr = (const f32x4*)(a.in[I_XP] + (size_t)row * D) + lane;
#pragma unroll
                for (int q = 0; q < 4; ++q) v[u][q] = xr[64 * q];
            } else if (row < M) {
                const int rs = row - M_CTX, t = rs & 4095, gr = t >> 6, gc = t & 63;
                const f32x4* xr = (const f32x4*)(a.in[I_XS] + (size_t)rs * D) + lane;
#pragma unroll
                for (int q = 0; q < 4; ++q) v[u][q] = xr[64 * q];
                pe[u][0] = *((const f32x4*)(POS + gr * 256) + lane); pe[u][1] = *((const f32x4*)(POS + 64 * 256 + gr * 256) + lane);
                pe[u][2] = *((const f32x4*)(POS + gc * 256) + lane); pe[u][3] = *((const f32x4*)(POS + 64 * 256 + gc * 256) + lane);
            }
        }
#pragma unroll
        for (int u = 0; u < 4; ++u) {
            const int row = r0 + u * G * NWAVES;
            if (row < M) {
                const int j = cond_of_row(row);
                float ss = 0.f;
#pragma unroll
                for (int q = 0; q < 4; ++q) { v[u][q] = v[u][q] + pe[u][q]; ss += (v[u][q].x * v[u][q].x + v[u][q].y * v[u][q].y) + (v[u][q].z * v[u][q].z + v[u][q].w * v[u][q].w); }
                ss = wave_sum(ss);
                u32x2* xrow = (u32x2*)(XB + (size_t)row * D) + lane;
                u32x2* hrow = (u32x2*)(HB + (size_t)row * D) + lane;
#pragma unroll
                for (int q = 0; q < 4; ++q) {
                    u32x2 xb; xb.x = pk2(v[u][q].x, v[u][q].y); xb.y = pk2(v[u][q].z, v[u][q].w);
                    xrow[64 * q] = xb;
                    const f32x4 ng = *((const f32x4*)(a.in[I_NORMG] + 256 * q) + lane);
                    const f32x4 sc = *((const f32x4*)(MOD + (0 * 9 + j) * 3072 + 1024 + 256 * q) + lane);
                    u32x2 h; h.x = pk2(v[u][q].x * ng.x * (1.f + sc.x), v[u][q].y * ng.y * (1.f + sc.y)); h.y = pk2(v[u][q].z * ng.z * (1.f + sc.z), v[u][q].w * ng.w * (1.f + sc.w));
                    hrow[64 * q] = h;
                }
                if (lane < 16) RSS[(size_t)row * 16 + lane] = (lane == 0) ? ss : 0.f;
            }
        }
    }
}

__device__ __forceinline__ void phase_0c(const Args& a) {
    const int tid = otid(), lane = tid & 63, wave = tid >> 6, G = gridDim.x, bid = obid();
    const float* MOD = (const float*)(a.ws + WS_MOD);
    const bf16* W1T = (const bf16*)(a.ws + WS_W1T);
    float* SW = (float*)(a.ws + WS_SW);
    for (int it = bid * NWAVES + wave; it < 4 * N1; it += G * NWAVES) {
        const int l = it / N1, n = it % N1;
        const u32x4* wr = (const u32x4*)(W1T + ((size_t)l * N1 + n) * 1024) + lane * 2;
        const u32x4 w0 = wr[0], w1 = wr[1];
        float w[16];
        w[0] = bflo(w0.x); w[1] = bfhi(w0.x); w[2] = bflo(w0.y); w[3] = bfhi(w0.y); w[4] = bflo(w0.z); w[5] = bfhi(w0.z); w[6] = bflo(w0.w); w[7] = bfhi(w0.w);
        w[8] = bflo(w1.x); w[9] = bfhi(w1.x); w[10] = bflo(w1.y); w[11] = bfhi(w1.y); w[12] = bflo(w1.z); w[13] = bfhi(w1.z); w[14] = bflo(w1.w); w[15] = bfhi(w1.w);
#pragma unroll
        for (int j = 0; j < 9; ++j) {
            const f32x4* sp = (const f32x4*)(MOD + (l * 9 + j) * 3072) + lane * 4;
            float s = 0.f;
#pragma unroll
            for (int q = 0; q < 4; ++q) { const f32x4 sv = sp[q]; s += sv.x * w[4 * q] + sv.y * w[4 * q + 1] + sv.z * w[4 * q + 2] + sv.w * w[4 * q + 3]; }
            s = wave_sum(s);
            if (lane == 0) SW[(l * 9 + j) * N1 + n] = s;
        }
    }
}

struct Epi1 {
    static constexpr bool PERM = true;
    bf16* PB; float* BA; const float* RSS; const float* SW;
    int cheap; bf16* dumb;
    const LAS float* rtab;
    float* VSS;
    __device__ __forceinline__ void operator()(const f32x4 (&acc)[2][2][4][2], const pg8::Unit& u, int wr, int wc, int fr, int fq, int ui) const {
        const int pn = u.pn, j = u.pm < 32 ? 0 : 1 + ((u.pm - 32) >> 4);
        const int row0 = u.pm * 256 + wr * 64 + fr, cb = pn * 256 + wc * 32 + 8 * fq;
        if (cheap == 1) {
#pragma unroll
            for (int ai = 0; ai < 2; ++ai)
#pragma unroll
                for (int m = 0; m < 4; ++m)
#pragma unroll
                    for (int bj = 0; bj < 2; ++bj) { const f32x4 v0 = acc[ai][bj][m][0], v1 = acc[ai][bj][m][1];
                        u32x4 w; w.x = pk2(v0[0], v0[1]); w.y = pk2(v0[2], v0[3]); w.z = pk2(v1[0], v1[1]); w.w = pk2(v1[2], v1[3]);
                        *(u32x4*)(dumb + (size_t)((row0 + ai * 128 + m * 16) & 1023) * LDP + cb + bj * 128) = w; }
            return;
        }
        const int act = (pn == 0 || pn == 2 || pn == 3 || pn == 5) ? 1 : ((pn == 1 || pn == 4) ? 2 : 0);
        f32x4 bv[2][2];
#pragma unroll
        for (int bj = 0; bj < 2; ++bj)
#pragma unroll
            for (int n = 0; n < 2; ++n) bv[bj][n] = *(const f32x4*)(SW + j * N1 + cb + bj * 128 + 4 * n);
#pragma unroll
        for (int ai = 0; ai < 2; ++ai)
#pragma unroll
            for (int m = 0; m < 4; ++m) {
                const int row = row0 + ai * 128 + m * 16;
                const float rinv = rtab[ui * 256 + wr * 64 + fr + ai * 128 + m * 16];
                float vss = 0.f;
#pragma unroll
                for (int bj = 0; bj < 2; ++bj) {
                    f32x4 v0 = acc[ai][bj][m][0] * rinv + bv[bj][0], v1 = acc[ai][bj][m][1] * rinv + bv[bj][1];
                    if (pn < 12) {
                        if (act == 1) {
#pragma unroll
                            for (int q = 0; q < 4; ++q) { v0[q] = silu_f(v0[q]); v1[q] = silu_f(v1[q]); }
                        } else if (act == 2) {
#pragma unroll
                            for (int q = 0; q < 4; ++q) { v0[q] = gelu_tanh_f(v0[q]); v1[q] = gelu_tanh_f(v1[q]); }
                        }
                        u32x4 w; w.x = pk2(v0[0], v0[1]); w.y = pk2(v0[2], v0[3]); w.z = pk2(v1[0], v1[1]); w.w = pk2(v1[2], v1[3]);
                        if (pn == 4) vss += (v0[0] * v0[0] + v0[1] * v0[1]) + (v0[2] * v0[2] + v0[3] * v0[3]) + (v1[0] * v1[0] + v1[1] * v1[1]) + (v1[2] * v1[2] + v1[3] * v1[3]);
                        if ((pn == 7 || pn == 8) && u.pm >= 32 && !cheap) {
                            const int t = row - M_CTX, tq = t & 4095, sl = (wc * 32 + 8 * fq + bj * 128) >> 2;
                            bf16* dst = PB + (size_t)(M_CTX + (t & ~4095) + sl * 64 + (tq >> 6)) * LDP + C_PF + (tq & 63) * 8 + (pn == 8 ? 4 : 0);
                            u32x2 lo2, hi2; lo2.x = w.x; lo2.y = w.y; hi2.x = w.z; hi2.y = w.w;
                            *(u32x2*)dst = lo2; *(u32x2*)(dst + 64 * LDP) = hi2;
                        } else
                        *(u32x4*)((cheap ? dumb + (size_t)(row & 1023) * LDP : PB + (size_t)row * LDP) + cb + bj * 128) = w;
                    } else if (bj == 0 && wc == 0 && fq < 2) {
                        f32x4* bp = (f32x4*)(BA + (size_t)row * 16 + 8 * fq); bp[0] = v0; bp[1] = v1;
                    }
                }
                if (pn == 4) { vss += __shfl_xor(vss, 16); vss += __shfl_xor(vss, 32); if (fq == 0 && !cheap) VSS[(size_t)row * 4 + wc] = vss; }
            }
    }
};
struct Epi2 {
    static constexpr bool PERM = true;
    bf16* XB; bf16* HB; float* RSS; const float* gate;
    const float* ng_next; const float* sc_next;
    unsigned char* dum; int dry;
    __device__ __forceinline__ void operator()(const f32x4 (&acc)[2][2][4][2], const pg8::Unit& u, int wr, int wc, int fr, int fq, int) const {
        const int pn = u.pn, j = u.pm < 32 ? 0 : 1 + ((u.pm - 32) >> 4);
        const int row0 = u.pm * 256 + wr * 64 + fr, cb = pn * 256 + wc * 32 + 8 * fq;
        f32x4 gv[2][2];
#pragma unroll
        for (int bj = 0; bj < 2; ++bj)
#pragma unroll
            for (int n = 0; n < 2; ++n) gv[bj][n] = *(const f32x4*)(gate + j * 3072 + cb + bj * 128 + 4 * n);
#pragma unroll
        for (int am = 0; am < 4; ++am) {
            const int ai = am >> 1;
            u32x4 xv[4][2];
            f32x4 gs[2][2];
#pragma unroll
            for (int m = 2 * (am & 1); m < 2 * (am & 1) + 2; ++m)
#pragma unroll
                for (int bj = 0; bj < 2; ++bj) xv[m][bj] = *(const u32x4*)(XB + (size_t)(row0 + ai * 128 + m * 16) * D + cb + bj * 128);
#pragma unroll
            for (int bj = 0; bj < 2; ++bj)
#pragma unroll
                for (int n = 0; n < 2; ++n) {
                    if (ng_next) { const f32x4 ng = *(const f32x4*)(ng_next + cb + bj * 128 + 4 * n), sc = *(const f32x4*)(sc_next + j * 3072 + cb + bj * 128 + 4 * n); gs[bj][n] = ng * (sc + 1.f); }
                    else gs[bj][n] = (f32x4){0.f, 0.f, 0.f, 0.f};
                }
#pragma unroll
            for (int m = 2 * (am & 1); m < 2 * (am & 1) + 2; ++m) {
                const int row = row0 + ai * 128 + m * 16;
                float ssq = 0.f;
#pragma unroll
                for (int bj = 0; bj < 2; ++bj) {
                    const u32x4 xq = xv[m][bj];
                    const f32x4 x0 = (f32x4){bflo(xq.x), bfhi(xq.x), bflo(xq.y), bfhi(xq.y)}, x1 = (f32x4){bflo(xq.z), bfhi(xq.z), bflo(xq.w), bfhi(xq.w)};
                    const f32x4 n0 = x0 + gv[bj][0] * acc[ai][bj][m][0], n1 = x1 + gv[bj][1] * acc[ai][bj][m][1];
                    u32x4 xw; xw.x = pk2(n0[0], n0[1]); xw.y = pk2(n0[2], n0[3]); xw.z = pk2(n1[0], n1[1]); xw.w = pk2(n1[2], n1[3]);
                    *(u32x4*)((dry ? (bf16*)dum + (size_t)(row & 1023) * D : XB + (size_t)row * D) + cb + bj * 128) = xw;
                    ssq += (n0.x * n0.x + n0.y * n0.y) + (n0.z * n0.z + n0.w * n0.w) + (n1.x * n1.x + n1.y * n1.y) + (n1.z * n1.z + n1.w * n1.w);
                    if (ng_next) { const f32x4 h0 = n0 * gs[bj][0], h1 = n1 * gs[bj][1];
                        u32x4 w; w.x = pk2(h0[0], h0[1]); w.y = pk2(h0[2], h0[3]); w.z = pk2(h1[0], h1[1]); w.w = pk2(h1[2], h1[3]);
                        *(u32x4*)((dry ? (bf16*)(dum + 4 * MiB) + (size_t)(row & 1023) * D : HB + (size_t)row * D) + cb + bj * 128) = w; }
                }
                ssq += __shfl_xor(ssq, 16); ssq += __shfl_xor(ssq, 32);
                if (fq == 0) (dry ? (float*)(dum + 8 * MiB) + (size_t)(row & 1023) * 16 : RSS + (size_t)row * 16)[pn * 4 + wc] = ssq;
            }
        }
    }
};

typedef short bf16x4 __attribute__((ext_vector_type(4)));
__device__ __forceinline__ f32x4 mfma16(bf16x4 a, bf16x4 b, f32x4 c) { return __builtin_amdgcn_mfma_f32_16x16x16bf16_1k(a, b, c, 0, 0, 0); }
__device__ __forceinline__ bf16x4 pack4(f32x4 v) { u32x2 w; w.x = pk2(v[0], v[1]); w.y = pk2(v[2], v[3]); return __builtin_bit_cast(bf16x4, w); }
__device__ __forceinline__ bf16x8 pack8(f32x4 lo, f32x4 hi) { u32x4 w; w.x = pk2(lo[0], lo[1]); w.y = pk2(lo[2], lo[3]); w.z = pk2(hi[0], hi[1]); w.w = pk2(hi[2], hi[3]); return __builtin_bit_cast(bf16x8, w); }
constexpr int PREP_ITEM = 5 * 4096;

__device__ __forceinline__ void prep_dinv(const LAS bf16* Ab_, LAS bf16* Dl, int lane) {
    const int blk = lane >> 4, c = lane & 15;
    unsigned ab = (unsigned)(size_t)(Ab_ + (16 * blk) * 72 + 16 * blk);
    asm volatile("" : "+v"(ab));
    const LAS bf16* Ab = (const LAS bf16*)(size_t)ab;
    float x[16];
#pragma unroll
    for (int ii = 0; ii < 16; ++ii) {
        float acc = (ii == c) ? 1.f : 0.f;
        const LAS u32x4* ar = (const LAS u32x4*)(Ab + ii * 72);
#pragma unroll
        for (int jq = 0; jq < 2; ++jq) {
            if (8 * jq < ii) {
                const u32x4 av = ar[jq];
                if (8 * jq + 0 < ii) acc += bflo(av.x) * x[8 * jq + 0];
                if (8 * jq + 1 < ii) acc += bfhi(av.x) * x[8 * jq + 1];
                if (8 * jq + 2 < ii) acc += bflo(av.y) * x[8 * jq + 2];
                if (8 * jq + 3 < ii) acc += bfhi(av.y) * x[8 * jq + 3];
                if (8 * jq + 4 < ii) acc += bflo(av.z) * x[8 * jq + 4];
                if (8 * jq + 5 < ii) acc += bfhi(av.z) * x[8 * jq + 5];
                if (8 * jq + 6 < ii) acc += bflo(av.w) * x[8 * jq + 6];
                if (8 * jq + 7 < ii) acc += bfhi(av.w) * x[8 * jq + 7];
            }
        }
        asm volatile("" : "+v"(acc) :: "memory");
        x[ii] = acc;
    }
#pragma unroll
    for (int ii = 0; ii < 16; ++ii) Dl[(blk * 16 + ii) * 24 + c] = (bf16)f2bf(x[ii]);
}

struct PrepPre { u32x4 xr[7]; };
__device__ __forceinline__ void prep_prefetch(const Args& a, PrepPre& P, int sc, int h) {
    const int tid = otid();
    const bf16* PB = (const bf16*)(a.ws + WS_PB);
    const SeqGeo sg = seq_geo(sc);
    const int cg = tid % 24, seg = tid / 24, part = cg >> 3, d0 = (cg & 7) * 8;
    const int col = C_Q + (part < 3 ? part : 0) * 256 + h * 64 + d0;
#pragma unroll
    for (int i = 0; i < 7; ++i) { const int ts = sg.tseq0 + 4 * seg - 2 + i;
        P.xr[i] = (tid < 384 && ts >= 0 && ts < sg.T) ? *(const u32x4*)(PB + (size_t)(sg.seq_row0 + ts) * LDP + col) : (u32x4){0u, 0u, 0u, 0u}; }
}
__device__ __forceinline__ void prep_item(const Args& a, LAS unsigned char* lds, int l, int sc, int h, PrepPre& P, int nsc, int nh) {
    const int tid = otid(), lane = tid & 63, wave = __builtin_amdgcn_readfirstlane(tid >> 6);
    LAS float* qs = (LAS float*)lds;
    LAS float* ks = qs + 64 * 65;
    LAS float* vs = ks + 64 * 65;
    LAS bf16* Qb = (LAS bf16*)(lds + 49920);
    LAS bf16* Kb = (LAS bf16*)(lds + 59136);
    constexpr int PD = 30720;
    LAS unsigned char* dbase = lds + 68352;
    LAS float* beta = (LAS float*)(lds + 129792);
    LAS float* gcs = beta + 128;
    LAS float* egs = gcs + 128;
    LAS float* eks = egs + 128;
    const bf16* PB = (const bf16*)(a.ws + WS_PB);
    const float* BA = (const float*)(a.ws + WS_BA);
    const SeqGeo sg = seq_geo(sc);
    const int row0 = sc * 64;
    if (wave >= 6) {
        const int dir = wave - 6, tok = dir ? 63 - lane : lane;
        const float bl = BA[(size_t)(row0 + tok) * 16 + dir * 4 + h], al = BA[(size_t)(row0 + tok) * 16 + 8 + dir * 4 + h];
        const float bt = 1.f / (1.f + __expf(-bl));
        const float xx = al + a.in[I_DTB][(l * 2 + dir) * 4 + h];
        const float ex = __expf(xx);
        const float sp = xx > 20.f ? xx : (ex < 1e-2f ? ex * (1.f - ex * (0.5f - ex * (1.f / 3.f))) : __logf(1.f + ex));
        float g = -__expf(a.in[I_ALOG][(l * 2 + dir) * 4 + h]) * sp;
#pragma unroll
        for (int o = 1; o < 64; o <<= 1) { const float t = __shfl_up(g, o); if (lane >= o) g += t; }
        const float gl = __shfl(g, 63);
        beta[dir * 64 + lane] = bt; gcs[dir * 64 + lane] = g; egs[dir * 64 + lane] = __expf(g); eks[dir * 64 + lane] = __expf(gl - g);
        if (lane == 63) ((float*)(a.ws + WS_PGL))[(sc * 4 + h) * 2 + dir] = __expf(g);
    } else {
        const int cg = tid % 24, seg = tid / 24, part = cg >> 3, d0 = (cg & 7) * 8;
        const int chan = part * 256 + h * 64 + d0;
        u32x4 xr[7];
#pragma unroll
        for (int i = 0; i < 7; ++i) xr[i] = P.xr[i];
        f32x4 w0[4], w1[4];
#pragma unroll
        for (int jj = 0; jj < 4; ++jj) { w0[jj] = *(const f32x4*)(a.in[I_CONV] + (size_t)(l * 4 + jj) * 768 + chan); w1[jj] = *(const f32x4*)(a.in[I_CONV] + (size_t)(l * 4 + jj) * 768 + chan + 4); }
        float o[4][8];
#pragma unroll
        for (int j = 0; j < 4; ++j)
#pragma unroll
            for (int c = 0; c < 8; ++c) o[j][c] = 0.f;
#pragma unroll
        for (int i = 0; i < 7; ++i) {
            const float x0 = bflo(xr[i].x), x1 = bfhi(xr[i].x), x2 = bflo(xr[i].y), x3 = bfhi(xr[i].y), x4 = bflo(xr[i].z), x5 = bfhi(xr[i].z), x6 = bflo(xr[i].w), x7 = bfhi(xr[i].w);
#pragma unroll
            for (int j = 0; j < 4; ++j) { const int jj = i - j;
                if (jj >= 0 && jj < 4) {
                    o[j][0] += w0[jj].x * x0; o[j][1] += w0[jj].y * x1; o[j][2] += w0[jj].z * x2; o[j][3] += w0[jj].w * x3;
                    o[j][4] += w1[jj].x * x4; o[j][5] += w1[jj].y * x5; o[j][6] += w1[jj].z * x6; o[j][7] += w1[jj].w * x7; } }
        }
        LAS float* dst = (part == 0 ? qs : (part == 1 ? ks : vs)) + (4 * seg) * 65 + d0;
#pragma unroll
        for (int j = 0; j < 4; ++j)
#pragma unroll
            for (int c = 0; c < 8; ++c) dst[j * 65 + c] = silu_f(o[j][c]);
    }
    __syncthreads();
    {
        const int rowid = tid >> 2, seg = tid & 3, ar = rowid & 63;
        LAS float* p = (rowid < 64 ? qs : ks) + ar * 65 + seg * 16;
        float v[16]; float ss = 0.f;
#pragma unroll
        for (int c = 0; c < 16; ++c) { v[c] = p[c]; ss += v[c] * v[c]; }
        ss += __shfl_xor(ss, 1); ss += __shfl_xor(ss, 2);
        const float s = rsqrtf(ss + EPS) * (rowid < 64 ? 0.125f : 1.f);
#pragma unroll
        for (int c = 0; c < 16; ++c) { v[c] *= s; p[c] = v[c]; }
        LAS bf16* bp = (rowid < 64 ? Qb : Kb) + ar * 72 + seg * 16;
        u32x4 o0, o1; o0.x = pk2(v[0], v[1]); o0.y = pk2(v[2], v[3]); o0.z = pk2(v[4], v[5]); o0.w = pk2(v[6], v[7]);
        o1.x = pk2(v[8], v[9]); o1.y = pk2(v[10], v[11]); o1.z = pk2(v[12], v[13]); o1.w = pk2(v[14], v[15]);
        *(LAS u32x4*)bp = o0; *(LAS u32x4*)(bp + 8) = o1;
    }
    __syncthreads();
    {
        const int mt = wave >> 1, nh_ = wave & 1, m0 = mt * 16, r = lane & 15, kg = lane >> 4, arow = m0 + r;
#pragma unroll
        for (int t = 0; t < 2; ++t) {
            const int b0 = nh_ * 32 + 16 * t + 4 * kg;
            const f32x4 KKa = tile_mm<2>((f32x4){0.f, 0.f, 0.f, 0.f}, Kb, 72, nh_ * 32 + 16 * t, Kb, 72, m0, lane);
            const f32x4 QKa = tile_mm<2>((f32x4){0.f, 0.f, 0.f, 0.f}, Kb, 72, nh_ * 32 + 16 * t, Qb, 72, m0, lane);
#pragma unroll
            for (int dir = 0; dir < 2; ++dir) {
                LAS bf16* Ab = (LAS bf16*)(dbase + dir * PD); LAS bf16* QKl = Ab + 64 * 72;
                const int i = dir ? 63 - arow : arow;
                const float gi = gcs[dir * 64 + i], bi = beta[dir * 64 + i];
                float av[4], qv[4];
#pragma unroll
                for (int q = 0; q < 4; ++q) {
                    const int j = dir ? 63 - (b0 + q) : b0 + q;
                    const float dec = (i >= j) ? __expf(gi - gcs[dir * 64 + j]) : 0.f;
                    av[q] = (i > j) ? -bi * KKa[q] * dec : 0.f; qv[q] = QKa[q] * dec;
                }
                u32x2 aw, qw; const int j0 = dir ? 60 - b0 : b0;
                if (dir) { aw.x = pk2(av[3], av[2]); aw.y = pk2(av[1], av[0]); qw.x = pk2(qv[3], qv[2]); qw.y = pk2(qv[1], qv[0]); }
                else { aw.x = pk2(av[0], av[1]); aw.y = pk2(av[2], av[3]); qw.x = pk2(qv[0], qv[1]); qw.y = pk2(qv[2], qv[3]); }
                *(LAS u32x2*)(Ab + i * 72 + j0) = aw; *(LAS u32x2*)(QKl + i * 72 + j0) = qw;
            }
        }
    }
    __syncthreads();
    if (nsc >= 0) prep_prefetch(a, P, nsc, nh);
    bf16* PI0 = (bf16*)(a.ws + WS_PREP) + (size_t)((sc * 4 + h) * 2) * PREP_ITEM;
    if (wave < 2) prep_dinv((const LAS bf16*)(dbase + wave * PD), (LAS bf16*)(dbase + wave * PD + 3 * 9216), lane);
    for (int t = tid; t < 2048; t += NTHR) {
        const int dir = t >> 10, which = (t >> 9) & 1, rw = (t >> 3) & 63, sgp = t & 7, n0a = 32 * (sgp >> 2) + 4 * (sgp & 3), n0b = n0a + 16;
        float v[8];
        if (which == 0) {
            const int tok = dir ? 63 - rw : rw; const float e = egs[dir * 64 + rw];
#pragma unroll
            for (int c = 0; c < 4; ++c) { v[c] = qs[tok * 65 + n0a + c] * e; v[4 + c] = qs[tok * 65 + n0b + c] * e; }
        } else {
#pragma unroll
            for (int c = 0; c < 4; ++c) { const int ia = n0a + c, ib = n0b + c;
                v[c] = ks[(dir ? 63 - ia : ia) * 65 + rw] * eks[dir * 64 + ia]; v[4 + c] = ks[(dir ? 63 - ib : ib) * 65 + rw] * eks[dir * 64 + ib]; }
        }
        u32x4 o; o.x = pk2(v[0], v[1]); o.y = pk2(v[2], v[3]); o.z = pk2(v[4], v[5]); o.w = pk2(v[6], v[7]);
        *(u32x4*)(PI0 + (size_t)dir * PREP_ITEM + (1 + which) * 4096 + rw * 64 + sgp * 8) = o;
    }
    __syncthreads();
    {
        const int dir = wave >> 2, r = lane & 15, kg = lane >> 4, cc = 16 * (wave & 3) + r;
        const LAS bf16* Ab = (const LAS bf16*)(dbase + dir * PD); LAS bf16* Wl = (LAS bf16*)(dbase + dir * PD + 2 * 9216); const LAS bf16* Dl = (const LAS bf16*)(dbase + dir * PD + 3 * 9216);
        bf16* PI = PI0 + (size_t)dir * PREP_ITEM;
        f32x4 XU[4], XW[4];
#pragma unroll
        for (int b = 0; b < 4; ++b) {
            f32x4 TU, TW_;
#pragma unroll
            for (int q = 0; q < 4; ++q) { const int i = 16 * b + 4 * kg + q, tok = dir ? 63 - i : i;
                const float bt = beta[dir * 64 + i];
                TU[q] = bt * vs[tok * 65 + cc]; TW_[q] = bt * egs[dir * 64 + i] * ks[tok * 65 + cc]; }
#pragma unroll
            for (int m = 0; m < 4; ++m) if (m < b) {
                const bf16x4 af = *(const LAS bf16x4*)(Ab + (16 * b + r) * 72 + 16 * m + 4 * kg);
                TU = mfma16(af, pack4(XU[m]), TU); TW_ = mfma16(af, pack4(XW[m]), TW_);
            }
            const bf16x4 df = *(const LAS bf16x4*)(Dl + (b * 16 + r) * 24 + 4 * kg);
            XU[b] = mfma16(df, pack4(TU), (f32x4){0.f, 0.f, 0.f, 0.f});
            XW[b] = mfma16(df, pack4(TW_), (f32x4){0.f, 0.f, 0.f, 0.f});
            *(u32x2*)(PI + 4 * 4096 + cc * 64 + 16 * b + 4 * kg) = __builtin_bit_cast(u32x2, pack4(XU[b]));
#pragma unroll
            for (int q = 0; q < 4; ++q) Wl[(16 * b + 4 * kg + q) * 72 + cc] = (bf16)f2bf(XW[b][q]);
        }
    }
    __syncthreads();
    for (int t = tid; t < 2048; t += NTHR) {
        const int dir = t >> 10, which = (t >> 9) & 1, rw = (t >> 3) & 63, sgp = t & 7, n0a = 32 * (sgp >> 2) + 4 * (sgp & 3);
        const LAS bf16* src = (const LAS bf16*)(dbase + dir * PD + (which ? 1 : 2) * 9216) + rw * 72 + n0a;
        const u32x2 lo = *(const LAS u32x2*)src, hi = *(const LAS u32x2*)(src + 16);
        u32x4 o; o.x = lo.x; o.y = lo.y; o.z = hi.x; o.w = hi.y;
        *(u32x4*)(PI0 + (size_t)dir * PREP_ITEM + (which ? 3 : 0) * 4096 + rw * 64 + sgp * 8) = o;
    }
    __syncthreads();
}

__device__ __forceinline__ void sgu_item(const Args& a, LAS unsigned char* lds, int l, int ch, int g, int dry, bool w_cached) {
    const int tid = otid(), lane = tid & 63, wave = tid >> 6;
    LAS bf16* Wl = (LAS bf16*)lds;
    LAS bf16* VT = Wl + 128 * 136;
    LAS float* rstd = (LAS float*)(VT + 64 * 136);
    LAS float* SV = rstd + 128;
    bf16* PB = (bf16*)(a.ws + WS_PB);
    const int row0 = ch * 128;
    u32x4 vv[2], uu[2], gg[2];
#pragma unroll
    for (int i = 0; i < 2; ++i) { const int t = tid + NTHR * i, q = t >> 3, c0 = (t & 7) * 8; const bf16* rp = PB + (size_t)(row0 + q) * LDP + g * 64 + c0;
        vv[i] = *(const u32x4*)(rp + C_V); uu[i] = *(const u32x4*)(rp + C_U); gg[i] = *(const u32x4*)(rp + C_GB); }
    const int c0t = (tid & 7) * 8;
    const f32x4 g0 = *(const f32x4*)(a.in[I_SGUNG] + l * 256 + g * 64 + c0t), g1 = *(const f32x4*)(a.in[I_SGUNG] + l * 256 + g * 64 + c0t + 4);
    if (tid < 128) {
        const f32x4 p = *(const f32x4*)((const float*)(a.ws + WS_VSS) + (size_t)(row0 + tid) * 4);
        rstd[tid] = rsqrtf(((p.x + p.y) + (p.z + p.w)) * (1.f / 256.f) + EPS);
    }
    if (!w_cached)
    for (int t = tid; t < 128 * 16; t += NTHR) {
        const int p = t >> 4, q8 = t & 15;
        const f32x4* wp = (const f32x4*)(a.in[I_SGUW] + ((size_t)(l * 4 + g) * 128 + p) * 128 + q8 * 8);
        const f32x4 w0 = wp[0], w1 = wp[1];
        u32x4 o; o.x = pk2(w0.x, w0.y); o.y = pk2(w0.z, w0.w); o.z = pk2(w1.x, w1.y); o.w = pk2(w1.z, w1.w);
        *(LAS u32x4*)(Wl + p * 136 + q8 * 8) = o;
    }
    __syncthreads();
#pragma unroll
    for (int i = 0; i < 2; ++i) {
        const int t = tid + NTHR * i, q = t >> 3, c0 = (t & 7) * 8;
        const float r = rstd[q]; const u32x4 v = vv[i];
        LAS bf16* dst = VT + c0 * 136 + ((((q >> 3) ^ (c0 >> 3)) << 3) | (q & 7));
        dst[0 * 136] = (bf16)f2bf(bflo(v.x) * r * g0.x); dst[1 * 136] = (bf16)f2bf(bfhi(v.x) * r * g0.y);
        dst[2 * 136] = (bf16)f2bf(bflo(v.y) * r * g0.z); dst[3 * 136] = (bf16)f2bf(bfhi(v.y) * r * g0.w);
        dst[4 * 136] = (bf16)f2bf(bflo(v.z) * r * g1.x); dst[5 * 136] = (bf16)f2bf(bfhi(v.z) * r * g1.y);
        dst[6 * 136] = (bf16)f2bf(bflo(v.w) * r * g1.z); dst[7 * 136] = (bf16)f2bf(bfhi(v.w) * r * g1.w);
    }
    __syncthreads();
    {
        const int m0 = wave * 16, r = lane & 15, kg = lane >> 4;
        bf16x8 af[4];
#pragma unroll
        for (int ksx = 0; ksx < 4; ++ksx) af[ksx] = *(const LAS bf16x8*)(Wl + (m0 + r) * 136 + ksx * 32 + kg * 8);
#pragma unroll
        for (int nt = 0; nt < 4; ++nt) {
            f32x4 acc = (f32x4){0.f, 0.f, 0.f, 0.f};
#pragma unroll
            for (int ksx = 0; ksx < 4; ++ksx) {
                const int cr = nt * 16 + r;
                const bf16x8 bfr = *(const LAS bf16x8*)(VT + cr * 136 + (((ksx * 4 + kg) ^ (cr >> 3)) << 3));
                acc = __builtin_amdgcn_mfma_f32_16x16x32_bf16(af[ksx], bfr, acc, 0, 0, 0);
            }
#pragma unroll
            for (int q = 0; q < 4; ++q) SV[(m0 + 4 * kg + q) * 68 + nt * 16 + r] = acc[q];
        }
    }
    __syncthreads();
#pragma unroll
    for (int i = 0; i < 2; ++i) {
        const int t = tid + NTHR * i, p = t >> 3, c0 = (t & 7) * 8;
        const f32x4 s0 = *(const LAS f32x4*)(SV + p * 68 + c0), s1 = *(const LAS f32x4*)(SV + p * 68 + c0 + 4);
        const float b = a.in[I_SGUB][(l * 4 + g) * 128 + p];
        u32x4 o;
        o.x = pk2(bflo(uu[i].x) * (s0.x + b) * bflo(gg[i].x), bfhi(uu[i].x) * (s0.y + b) * bfhi(gg[i].x));
        o.y = pk2(bflo(uu[i].y) * (s0.z + b) * bflo(gg[i].y), bfhi(uu[i].y) * (s0.w + b) * bfhi(gg[i].y));
        o.z = pk2(bflo(uu[i].z) * (s1.x + b) * bflo(gg[i].z), bfhi(uu[i].z) * (s1.y + b) * bfhi(gg[i].z));
        o.w = pk2(bflo(uu[i].w) * (s1.z + b) * bflo(gg[i].w), bfhi(uu[i].w) * (s1.w + b) * bfhi(gg[i].w));
        *(u32x4*)((dry ? (bf16*)(a.ws + WS_DUM) + (size_t)((row0 + p) & 1023) * LDP : PB + (size_t)(row0 + p) * LDP) + C_U + g * 64 + c0) = o;
    }
    __syncthreads();
}

__device__ __forceinline__ void pool_item(const Args& a, LAS unsigned char* lds, int l, int sc, int dry) {
    const int tid = otid();
    LAS bf16* xt = (LAS bf16*)lds;
    bf16* PB = (bf16*)(a.ws + WS_PB);
    const SeqGeo sg = seq_geo(sc);
    u32x4 gpre[4];
#pragma unroll
    for (int i = 0; i < 4; ++i) { const int t = tid + NTHR * i, tok = t >> 5, c8 = t & 31; gpre[i] = *(const u32x4*)(PB + (size_t)(sg.seq_row0 + sg.tseq0 + tok) * LDP + C_GC + c8 * 8); }
    for (int t = tid; t < 80 * 32; t += NTHR) {
        const int r = t >> 5, c8 = t & 31, ts = sg.tseq0 - 8 + r;
        u32x4 v = (u32x4){0u, 0u, 0u, 0u};
        if (ts >= 0 && ts < sg.T) v = *(const u32x4*)(PB + (size_t)(sg.seq_row0 + ts) * LDP + C_XC + c8 * 8);
        *(LAS u32x4*)(xt + r * 264 + c8 * 8) = v;
    }
    __syncthreads();
#pragma unroll
    for (int i4 = 0; i4 < 4; ++i4) {
        const int t = tid + NTHR * i4;
        const int tok = t >> 5, c8 = t & 31, gi = c8 >> 3, half = 1 << gi;
        const int ts = sg.tseq0 + tok;
        const int lo = (ts - half) < 0 ? 0 : ts - half, hi = (ts + half) > sg.T ? sg.T : ts + half;
        float s[8];
#pragma unroll
        for (int c = 0; c < 8; ++c) s[c] = 0.f;
        for (int tt = lo; tt < hi; ++tt) {
            const u32x4 v = *(const LAS u32x4*)(xt + (tt - sg.tseq0 + 8) * 264 + c8 * 8);
            s[0] += bflo(v.x); s[1] += bfhi(v.x); s[2] += bflo(v.y); s[3] += bfhi(v.y); s[4] += bflo(v.z); s[5] += bfhi(v.z); s[6] += bflo(v.w); s[7] += bfhi(v.w);
        }
        const float inv = 1.f / (float)(hi - lo);
        const u32x4 xv = *(const LAS u32x4*)(xt + (tok + 8) * 264 + c8 * 8);
        const float x0[8] = {bflo(xv.x), bfhi(xv.x), bflo(xv.y), bfhi(xv.y), bflo(xv.z), bfhi(xv.z), bflo(xv.w), bfhi(xv.w)};
        bf16* yp = PB + (size_t)(sg.seq_row0 + ts) * LDP + C_GC + c8 * 8;
        const u32x4 gv = gpre[i4];
        const float gg[8] = {bflo(gv.x), bfhi(gv.x), bflo(gv.y), bfhi(gv.y), bflo(gv.z), bfhi(gv.z), bflo(gv.w), bfhi(gv.w)};
        const f32x4 p0 = *(const f32x4*)(a.in[I_POOLS] + l * 256 + c8 * 8), p1 = *(const f32x4*)(a.in[I_POOLS] + l * 256 + c8 * 8 + 4);
        const float ps[8] = {p0.x, p0.y, p0.z, p0.w, p1.x, p1.y, p1.z, p1.w};
        float y[8];
#pragma unroll
        for (int c = 0; c < 8; ++c) y[c] = (s[c] * inv - x0[c]) * ps[c] * gg[c];
        u32x4 o; o.x = pk2(y[0], y[1]); o.y = pk2(y[2], y[3]); o.z = pk2(y[4], y[5]); o.w = pk2(y[6], y[7]);
        if (dry) yp = (bf16*)(a.ws + WS_DUM) + (size_t)((sg.seq_row0 + ts) & 1023) * LDP + C_GC + c8 * 8;
        *(u32x4*)yp = o;
    }
    __syncthreads();
}

__device__ __forceinline__ void fctx_item(const Args& a, LAS unsigned char* lds, int b, int dblk, int dry) {
    const int tid = otid(), lane = tid & 63, wave = __builtin_amdgcn_readfirstlane(tid >> 6);
    LAS bf16* ZT = (LAS bf16*)lds;
    bf16* PB = (bf16*)(a.ws + WS_PB);
    const bf16* DFT = (const bf16*)(a.ws + WS_DFT);
    {
        u32x4 v[8];
#pragma unroll
        for (int i = 0; i < 8; ++i) { const int t = tid + NTHR * i, d8 = t & 7, ri = (t >> 3) & 1, tt = t >> 4;
            v[i] = *(const u32x4*)(PB + (size_t)(b * 256 + tt) * LDP + (ri ? C_QF : C_PF) + dblk * 64 + d8 * 8); }
#pragma unroll
        for (int i = 0; i < 8; ++i) { const int t = tid + NTHR * i, d8 = t & 7, ri = (t >> 3) & 1, tt = t >> 4;
            const int col = ri * 256 + tt;
            LAS bf16* dst = ZT + (d8 * 8) * 520 + ((((col >> 3) ^ d8) << 3) | (col & 7));
            dst[0 * 520] = (bf16)(v[i].x & 0xffffu); dst[1 * 520] = (bf16)(v[i].x >> 16); dst[2 * 520] = (bf16)(v[i].y & 0xffffu); dst[3 * 520] = (bf16)(v[i].y >> 16);
            dst[4 * 520] = (bf16)(v[i].z & 0xffffu); dst[5 * 520] = (bf16)(v[i].z >> 16); dst[6 * 520] = (bf16)(v[i].w & 0xffffu); dst[7 * 520] = (bf16)(v[i].w >> 16); }
    }
    __syncthreads();
    const int r = lane & 15, kg = lane >> 4;
#pragma unroll 1
    for (int mi = 0; mi < 2; ++mi) {
        const int m0 = wave * 32 + mi * 16;
        bf16 gdv[4][4];
#pragma unroll
        for (int nt = 0; nt < 4; ++nt)
#pragma unroll
            for (int q = 0; q < 4; ++q) gdv[nt][q] = PB[(size_t)(b * 256 + m0 + 4 * kg + q) * LDP + C_GD + dblk * 64 + nt * 16 + r];
        f32x4 acc[4];
#pragma unroll
        for (int nt = 0; nt < 4; ++nt) acc[nt] = (f32x4){0.f, 0.f, 0.f, 0.f};
#pragma unroll
        for (int kh = 0; kh < 2; ++kh) {
            bf16x8 af[8];
#pragma unroll
            for (int ksx = 0; ksx < 8; ++ksx) af[ksx] = *(const bf16x8*)(DFT + (size_t)(m0 + r) * 512 + (kh * 8 + ksx) * 32 + kg * 8);
#pragma unroll
            for (int nt = 0; nt < 4; ++nt) {
#pragma unroll
                for (int ksx = 0; ksx < 8; ++ksx) {
                    const bf16x8 bfr = *(const LAS bf16x8*)(ZT + (nt * 16 + r) * 520 + (((((kh * 8 + ksx) * 4 + kg)) ^ (((nt * 16 + r) >> 3) & 7)) << 3));
                    acc[nt] = __builtin_amdgcn_mfma_f32_16x16x32_bf16(af[ksx], bfr, acc[nt], 0, 0, 0);
                }
                __builtin_amdgcn_sched_barrier(0);
            }
        }
#pragma unroll
        for (int nt = 0; nt < 4; ++nt)
#pragma unroll
            for (int q = 0; q < 4; ++q) {
                const int k = m0 + 4 * kg + q, d = nt * 16 + r;
                bf16* yp = (dry ? (bf16*)(a.ws + WS_DUM) + (size_t)((b * 256 + k) & 1023) * LDP : PB + (size_t)(b * 256 + k) * LDP) + C_GD + dblk * 64 + d;
                *yp = (bf16)f2bf(acc[nt][q] * bf2f(gdv[nt][q]));
            }
    }
    __syncthreads();
}

__device__ __forceinline__ void fsmp_item(const Args& a, LAS unsigned char* lds, int b, int ds, int dry) {
    const int tid = otid(), lane = tid & 63, wave = __builtin_amdgcn_readfirstlane(tid >> 6);
    LAS bf16* ZT = (LAS bf16*)lds;
    LAS bf16* B2 = ZT + 256 * 136;
    bf16* PB = (bf16*)(a.ws + WS_PB);
    const bf16* M1 = (const bf16*)(a.ws + WS_M1);
    const bf16* M2 = (const bf16*)(a.ws + WS_M2);
    const int d0 = ds * 4;
    const size_t rowb = (size_t)M_CTX + (size_t)b * 4096;
    const int r = lane & 15, kg = lane >> 4, mp = wave & 3, nb = wave >> 2;
    {
        u32x4 v[8];
#pragma unroll
        for (int i = 0; i < 8; ++i) { const int tt = tid + NTHR * i;
            v[i] = *(const u32x4*)(PB + (rowb + ds * 64 + (tt >> 6)) * LDP + C_PF + (tt & 63) * 8); }
#pragma unroll
        for (int i = 0; i < 8; ++i) { const int tt = tid + NTHR * i, t1 = tt >> 6, t2 = tt & 63;
            const int sw = t2 & 15;
            LAS bf16* dp = ZT + (t2 * 4) * 136 + ((((t1 >> 3) ^ sw) << 3) | (t1 & 7));
            LAS bf16* dq = ZT + (t2 * 4) * 136 + ((((8 + (t1 >> 3)) ^ sw) << 3) | (t1 & 7));
            dp[0] = (bf16)(v[i].x & 0xffffu); dp[136] = (bf16)(v[i].x >> 16); dp[272] = (bf16)(v[i].y & 0xffffu); dp[408] = (bf16)(v[i].y >> 16);
            dq[0] = (bf16)(v[i].z & 0xffffu); dq[136] = (bf16)(v[i].z >> 16); dq[272] = (bf16)(v[i].w & 0xffffu); dq[408] = (bf16)(v[i].w >> 16); }
    }
    bf16x8 aRe[4], aIm[4], a2[4];
#pragma unroll
    for (int ksx = 0; ksx < 4; ++ksx) {
        aRe[ksx] = *(const bf16x8*)(M1 + (16 * mp + r) * 128 + ksx * 32 + kg * 8);
        aIm[ksx] = *(const bf16x8*)(M1 + (64 + 16 * mp + r) * 128 + ksx * 32 + kg * 8);
        a2[ksx] = *(const bf16x8*)(M2 + (16 * mp + r) * 128 + ksx * 32 + kg * 8);
    }
    __syncthreads();
#pragma unroll 2
    for (int jb = 0; jb < 8; ++jb) {
        const int nt = nb + 2 * jb;
        f32x4 ar = (f32x4){0.f, 0.f, 0.f, 0.f}, ai = (f32x4){0.f, 0.f, 0.f, 0.f};
#pragma unroll
        for (int ksx = 0; ksx < 4; ++ksx) {
            const bf16x8 z = *(const LAS bf16x8*)(ZT + (16 * nt + r) * 136 + (((ksx * 4 + kg) ^ (((16 * nt + r) >> 2) & 15)) << 3));
            ar = __builtin_amdgcn_mfma_f32_16x16x32_bf16(aRe[ksx], z, ar, 0, 0, 0);
            ai = __builtin_amdgcn_mfma_f32_16x16x32_bf16(aIm[ksx], z, ai, 0, 0, 0);
        }
        const int n = 16 * nt + r, t2 = n >> 2, dd = n & 3;
#pragma unroll
        for (int q = 0; q < 4; ++q) {
            const int k1 = 16 * mp + 4 * kg + q;
            const float rev = (float)((k1 * t2) & 4095) * (1.f / 4096.f);
            const float cw = __builtin_amdgcn_cosf(rev), sw = __builtin_amdgcn_sinf(rev);
            const float xr = ar[q] * cw - ai[q] * sw, xi = ar[q] * sw + ai[q] * cw;
            B2[(k1 * 4 + dd) * 136 + ((((t2 >> 3) ^ (k1 & 15)) << 3) | (t2 & 7))] = (bf16)f2bf(xr);
            B2[(k1 * 4 + dd) * 136 + ((((8 + (t2 >> 3)) ^ (k1 & 15)) << 3) | (t2 & 7))] = (bf16)f2bf(xi);
        }
    }
    __syncthreads();
#pragma unroll 2
    for (int jb = 0; jb < 8; ++jb) {
        const int nt = nb + 2 * jb;
        f32x4 acc = (f32x4){0.f, 0.f, 0.f, 0.f};
#pragma unroll
        for (int ksx = 0; ksx < 4; ++ksx) {
            const bf16x8 z = *(const LAS bf16x8*)(B2 + (16 * nt + r) * 136 + (((ksx * 4 + kg) ^ (((16 * nt + r) >> 2) & 15)) << 3));
            acc = __builtin_amdgcn_mfma_f32_16x16x32_bf16(a2[ksx], z, acc, 0, 0, 0);
        }
#pragma unroll
        for (int q = 0; q < 4; ++q) ZT[(16 * mp + 4 * kg + q) * 264 + 16 * nt + r] = (bf16)f2bf(acc[q]);
    }
    __syncthreads();
#pragma unroll
    for (int i = 0; i < 4; ++i) { const int ch = tid + NTHR * i, k2 = ch >> 5, c16 = ch & 31;
        const u32x4 v = *(const LAS u32x4*)(ZT + k2 * 264 + c16 * 8);
        *(u32x4*)((dry ? (bf16*)(a.ws + WS_DUM) + (size_t)((ds * 64 + k2) & 1023) * LDP : PB + (rowb + ds * 64 + k2) * LDP) + C_PF + c16 * 8) = v; }
    __syncthreads();
}

__device__ __forceinline__ void ffin_item(const Args& a, LAS unsigned char* lds, int b, int tr) {
    const int tid = otid();
    LAS bf16* FL = (LAS bf16*)lds;
    bf16* PB = (bf16*)(a.ws + WS_PB);
    const size_t rowb = (size_t)M_CTX + (size_t)b * 4096;
    u32x4 gv[4];
#pragma unroll
    for (int i = 0; i < 4; ++i) { const int t = tid + NTHR * i, tl = t >> 5, c8 = t & 31; gv[i] = *(const u32x4*)(PB + (rowb + tr * 64 + tl) * LDP + C_GD + c8 * 8); }
#pragma unroll
    for (int i = 0; i < 4; ++i) { const int ch = tid + NTHR * i, sl = ch >> 5, c16 = ch & 31;
        *(LAS u32x4*)(FL + sl * 264 + c16 * 8) = *(const u32x4*)(PB + (rowb + sl * 64 + tr) * LDP + C_PF + c16 * 8); }
    __syncthreads();
#pragma unroll
    for (int i = 0; i < 4; ++i) { const int t = tid + NTHR * i, tl = t >> 5, c8 = t & 31;
        const u32x2 f0 = *(const LAS u32x2*)(FL + (2 * c8) * 264 + tl * 4), f1 = *(const LAS u32x2*)(FL + (2 * c8 + 1) * 264 + tl * 4);
        u32x4 o; o.x = pk2(bflo(f0.x) * bflo(gv[i].x), bfhi(f0.x) * bfhi(gv[i].x)); o.y = pk2(bflo(f0.y) * bflo(gv[i].y), bfhi(f0.y) * bfhi(gv[i].y));
        o.z = pk2(bflo(f1.x) * bflo(gv[i].z), bfhi(f1.x) * bfhi(gv[i].z)); o.w = pk2(bflo(f1.y) * bflo(gv[i].w), bfhi(f1.y) * bfhi(gv[i].w));
        *(u32x4*)(PB + (rowb + tr * 64 + tl) * LDP + C_GD + c8 * 8) = o; }
    __syncthreads();
}

constexpr int SC_MAT = 64 * 72 * 2;
constexpr int SC_BUF = 5 * SC_MAT + 16;
constexpr int SC_OT = 2 * SC_BUF;
__device__ __forceinline__ void scan_item(const Args& a, LAS unsigned char* lds, int l, int seq, int h, int dir) {
    const int tid = otid(), lane = tid & 63, wave = __builtin_amdgcn_readfirstlane(tid >> 6);
    bf16* PB = (bf16*)(a.ws + WS_PB);
    const int nch = seq < 32 ? 4 : 64;
    const int sc0 = seq < 32 ? seq * 4 : 128 + (seq - 32) * 64;
    const int r = lane & 15, kg = lane >> 4;
    if (wave >= 4) {
        const int ht = tid - 256;
        constexpr int PD_ = 4;
        u32x4 pre[PD_][10]; float pgl[PD_];
#define SC_ISSUE(set, ss) do { const int s_ = (ss) < nch ? (ss) : nch - 1; const int c_ = dir ? nch - 1 - s_ : s_; const size_t pid_ = (size_t)((sc0 + c_) * 4 + h) * 2 + dir; \
            const u32x4* src_ = (const u32x4*)((const bf16*)(a.ws + WS_PREP) + pid_ * PREP_ITEM) + ht; \
            _Pragma("unroll") for (int i_ = 0; i_ < 10; ++i_) pre[set][i_] = src_[256 * i_]; \
            pgl[set] = ((const float*)(a.ws + WS_PGL))[pid_]; } while (0)
#define SC_WRITE(set, bb) do { LAS unsigned char* B_ = lds + (bb) * SC_BUF; \
            _Pragma("unroll") for (int i_ = 0; i_ < 10; ++i_) { const int ch_ = ht + 256 * i_; \
                *(LAS u32x4*)(B_ + (ch_ >> 9) * SC_MAT + ((ch_ >> 3) & 63) * 144 + (ch_ & 7) * 16) = pre[set][i_]; } \
            if (ht == 0) *(LAS float*)(B_ + 5 * SC_MAT) = pgl[set]; } while (0)
#define SC_OSTORE(ss) do { const int c_ = dir ? nch - 1 - (ss) : (ss); const LAS unsigned char* O_ = lds + SC_OT + ((ss) & 1) * SC_MAT; \
            _Pragma("unroll") for (int i_ = 0; i_ < 2; ++i_) { const int ch_ = ht + 256 * i_, rw_ = ch_ >> 3, c8_ = ch_ & 7; \
                const u32x4 v_ = *(const LAS u32x4*)(O_ + rw_ * 144 + c8_ * 16); \
                *(u32x4*)(PB + (size_t)((sc0 + c_) * 64 + (dir ? 63 - rw_ : rw_)) * LDP + (dir ? C_K : C_Q) + h * 64 + c8_ * 8) = v_; } } while (0)
        SC_ISSUE(0, 0); SC_ISSUE(1, 1); SC_ISSUE(2, 2); SC_ISSUE(3, 3);
        SC_WRITE(0, 0);
        SC_ISSUE(0, 4);
        __syncthreads();
#pragma unroll 1
        for (int s0 = 0; s0 < nch; s0 += 4) {
#pragma unroll
            for (int j = 0; j < 4; ++j) {
                const int s = s0 + j;
                SC_WRITE((j + 1) & 3, (s + 1) & 1);
                if (s > 0) SC_OSTORE(s - 1);
                SC_ISSUE((j + 1) & 3, s + 5);
                __syncthreads();
            }
        }
        SC_OSTORE(nch - 1);
#undef SC_ISSUE
#undef SC_WRITE
#undef SC_OSTORE
    } else {
        const int e = 16 * wave + r;
        f32x4 S[4];
#pragma unroll
        for (int t = 0; t < 4; ++t)
#pragma unroll
            for (int q = 0; q < 4; ++q) {
                const int d = 16 * t + 4 * kg + q;
                S[t][q] = (seq < 32) ? 0.f : a.in[I_STATE][((size_t)(((seq - 32) * 4 + l) * 2 + dir) * 4 + h) * 4096 + d * 64 + e];
            }
        __syncthreads();
#pragma unroll 1
        for (int s = 0; s < nch; ++s) {
            const LAS unsigned char* B = lds + (s & 1) * SC_BUF;
            const LAS bf16* Wm = (const LAS bf16*)B; const LAS bf16* Qd = Wm + 64 * 72; const LAS bf16* KdT = Qd + 64 * 72; const LAS bf16* QKm = KdT + 64 * 72; const LAS bf16* UT = QKm + 64 * 72;
            const float egl = *(const LAS float*)(B + 5 * SC_MAT);
            LAS bf16* OT = (LAS bf16*)(lds + SC_OT + (s & 1) * SC_MAT);
            bf16x8 bS[2];
            bS[0] = pack8(S[0], S[1]); bS[1] = pack8(S[2], S[3]);
            f32x4 a1[4], oo[4];
#pragma unroll
            for (int t = 0; t < 4; ++t) {
                a1[t] = (f32x4){0.f, 0.f, 0.f, 0.f}; oo[t] = (f32x4){0.f, 0.f, 0.f, 0.f};
#pragma unroll
                for (int ksx = 0; ksx < 2; ++ksx) {
                    const bf16x8 wf = *(const LAS bf16x8*)(Wm + (16 * t + r) * 72 + ksx * 32 + kg * 8);
                    const bf16x8 qf = *(const LAS bf16x8*)(Qd + (16 * t + r) * 72 + ksx * 32 + kg * 8);
                    a1[t] = __builtin_amdgcn_mfma_f32_16x16x32_bf16(wf, bS[ksx], a1[t], 0, 0, 0);
                    oo[t] = __builtin_amdgcn_mfma_f32_16x16x32_bf16(qf, bS[ksx], oo[t], 0, 0, 0);
                }
            }
            f32x4 vn[4];
#pragma unroll
            for (int t = 0; t < 4; ++t) {
                const u32x2 uu = *(const LAS u32x2*)(UT + e * 72 + 16 * t + 4 * kg);
                vn[t][0] = bflo(uu.x) - a1[t][0]; vn[t][1] = bfhi(uu.x) - a1[t][1]; vn[t][2] = bflo(uu.y) - a1[t][2]; vn[t][3] = bfhi(uu.y) - a1[t][3];
            }
            bf16x8 bV[2];
            bV[0] = pack8(vn[0], vn[1]); bV[1] = pack8(vn[2], vn[3]);
#pragma unroll
            for (int t = 0; t < 4; ++t) {
                f32x4 as = (f32x4){0.f, 0.f, 0.f, 0.f};
#pragma unroll
                for (int ksx = 0; ksx < 2; ++ksx) {
                    const bf16x8 kf = *(const LAS bf16x8*)(QKm + (16 * t + r) * 72 + ksx * 32 + kg * 8);
                    const bf16x8 df = *(const LAS bf16x8*)(KdT + (16 * t + r) * 72 + ksx * 32 + kg * 8);
                    oo[t] = __builtin_amdgcn_mfma_f32_16x16x32_bf16(kf, bV[ksx], oo[t], 0, 0, 0);
                    as = __builtin_amdgcn_mfma_f32_16x16x32_bf16(df, bV[ksx], as, 0, 0, 0);
                }
                S[t] = S[t] * egl + as;
            }
#pragma unroll
            for (int t = 0; t < 4; ++t)
#pragma unroll
                for (int q = 0; q < 4; ++q) OT[(16 * t + 4 * kg + q) * 72 + e] = (bf16)f2bf(oo[t][q]);
            __syncthreads();
        }
        if (seq < 32) {
            float* ns = a.out + (size_t)M * D + ((size_t)((seq * 4 + l) * 2 + dir) * 4 + h) * 4096;
#pragma unroll
            for (int t = 0; t < 4; ++t)
#pragma unroll
                for (int q = 0; q < 4; ++q) ns[(16 * t + 4 * kg + q) * 64 + e] = S[t][q];
        }
    }
    __syncthreads();
}

__device__ __forceinline__ void phase_combine(const Args& a, int l, int dry) {
    const int tid = otid(), lane = tid & 63, wave = tid >> 6, G = gridDim.x, bid = obid();
    bf16* PB = (bf16*)(a.ws + WS_PB);
    const f32x4 ng = *(const f32x4*)(a.in[I_DNG] + l * 64 + (lane & 15) * 4);
    for (int r0 = bid * NWAVES + wave; r0 < M; r0 += 4 * G * NWAVES) {
        u32x2 of[4], ob[4], ga[4];
#pragma unroll
        for (int u = 0; u < 4; ++u) { const int row = r0 + u * G * NWAVES;
            if (row < M) { const bf16* rp = PB + (size_t)row * LDP; of[u] = *((const u32x2*)(rp + C_Q) + lane); ob[u] = *((const u32x2*)(rp + C_K) + lane); ga[u] = *((const u32x2*)(rp + C_GA) + lane); }
            else { of[u] = (u32x2){0u, 0u}; ob[u] = of[u]; ga[u] = of[u]; } }
#pragma unroll
        for (int u = 0; u < 4; ++u) { const int row = r0 + u * G * NWAVES;
            if (row < M) {
                bf16* rp = PB + (size_t)row * LDP;
                const float o0 = bflo(of[u].x) + bflo(ob[u].x), o1 = bfhi(of[u].x) + bfhi(ob[u].x), o2 = bflo(of[u].y) + bflo(ob[u].y), o3 = bfhi(of[u].y) + bfhi(ob[u].y);
                float ss = (o0 * o0 + o1 * o1) + (o2 * o2 + o3 * o3);
                ss += __shfl_xor(ss, 1); ss += __shfl_xor(ss, 2); ss += __shfl_xor(ss, 4); ss += __shfl_xor(ss, 8);
                const float rinv = rsqrtf(ss * (1.f / 64.f) + EPS);
                u32x2 y; y.x = pk2(o0 * rinv * ng.x * bflo(ga[u].x), o1 * rinv * ng.y * bfhi(ga[u].x)); y.y = pk2(o2 * rinv * ng.z * bflo(ga[u].y), o3 * rinv * ng.w * bfhi(ga[u].y));
                if (dry) rp = (bf16*)(a.ws + WS_DUM) + (size_t)(row & 1023) * LDP;
                *((u32x2*)(rp + C_GA) + lane) = y;
            } }
    }
}

constexpr int PF_ROWS = 5;
struct FinalRegs { u32x4 x[PF_ROWS][2]; float rinv[PF_ROWS]; };
__device__ __forceinline__ void final_load(const Args& a, FinalRegs& R, int rnd) {
    const int tid = otid(), lane = tid & 63, wave = tid >> 6, G = gridDim.x, bid = obid();
    const float* RSS = (const float*)(a.ws + WS_RSS);
    const bf16* XB = (const bf16*)a.out + (size_t)M * D;
#pragma unroll
    for (int i = 0; i < PF_ROWS; ++i) {
        const int row = bid * NWAVES + wave + G * NWAVES * (i + PF_ROWS * rnd);
        if (row < M) {
            const u32x4* xr = (const u32x4*)(XB + (size_t)row * D) + lane * 2;
            R.x[i][0] = xr[0]; R.x[i][1] = xr[1];
            float p = (lane < 16) ? RSS[(size_t)row * 16 + lane] : 0.f;
            p += __shfl_xor(p, 1); p += __shfl_xor(p, 2); p += __shfl_xor(p, 4); p += __shfl_xor(p, 8);
            R.rinv[i] = rsqrtf(__shfl(p, 0) * (1.f / 1024.f) + EPS);
        } else { R.x[i][0] = (u32x4){0u, 0u, 0u, 0u}; R.x[i][1] = R.x[i][0]; R.rinv[i] = 0.f; }
    }
}
__device__ __forceinline__ void final_store(const Args& a, const FinalRegs& R, int rnd) {
    const int tid = otid(), lane = tid & 63, wave = tid >> 6, G = gridDim.x, bid = obid();
    f32x4 fg[4];
#pragma unroll
    for (int q = 0; q < 4; ++q) fg[q] = *((const f32x4*)(a.in[I_FNG]) + lane * 4 + q);
#pragma unroll
    for (int i = 0; i < PF_ROWS; ++i) {
        const int row = bid * NWAVES + wave + G * NWAVES * (i + PF_ROWS * rnd);
        if (row < M) {
            f32x4* orow = (f32x4*)(a.out + (size_t)row * D) + lane * 4;
            const u32x4 x0 = R.x[i][0], x1 = R.x[i][1]; const float ri = R.rinv[i];
            orow[0] = (f32x4){bflo(x0.x), bfhi(x0.x), bflo(x0.y), bfhi(x0.y)} * ri * fg[0];
            orow[1] = (f32x4){bflo(x0.z), bfhi(x0.z), bflo(x0.w), bfhi(x0.w)} * ri * fg[1];
            orow[2] = (f32x4){bflo(x1.x), bfhi(x1.x), bflo(x1.y), bfhi(x1.y)} * ri * fg[2];
            orow[3] = (f32x4){bflo(x1.z), bfhi(x1.z), bflo(x1.w), bfhi(x1.w)} * ri * fg[3];
        }
    }
}

__device__ __forceinline__ void skinny_ba(const Args& a, int l, int pm) {
    const int tid = otid(), lane = tid & 63, wave = __builtin_amdgcn_readfirstlane(tid >> 6), r = lane & 15, kg = lane >> 4;
    const bf16* A = (const bf16*)a.out + (size_t)(pm * 256 + wave * 32 + r) * 1024 + kg * 8;
    const bf16* Bw = (const bf16*)(a.ws + WS_W1T) + ((size_t)l * N1 + 3072 + r) * 1024 + kg * 8;
    f32x4 acc0 = (f32x4){0.f, 0.f, 0.f, 0.f}, acc1 = acc0;
    bf16x8 a0[2][4], a1[2][4], bw[2][4];
#define SK_LOAD(buf, kc_) do { _Pragma("unroll") for (int ksx = 0; ksx < 4; ++ksx) { const int k = ((kc_) * 4 + ksx) * 32; \
        a0[buf][ksx] = *(const bf16x8*)(A + k); a1[buf][ksx] = *(const bf16x8*)(A + 16 * 1024 + k); bw[buf][ksx] = *(const bf16x8*)(Bw + k); } } while (0)
#define SK_MMA(buf) do { _Pragma("unroll") for (int ksx = 0; ksx < 4; ++ksx) { \
        acc0 = __builtin_amdgcn_mfma_f32_16x16x32_bf16(a0[buf][ksx], bw[buf][ksx], acc0, 0, 0, 0); \
        acc1 = __builtin_amdgcn_mfma_f32_16x16x32_bf16(a1[buf][ksx], bw[buf][ksx], acc1, 0, 0, 0); } } while (0)
    SK_LOAD(0, 0); SK_LOAD(1, 1);
    SK_MMA(0); SK_LOAD(0, 2); SK_MMA(1); SK_LOAD(1, 3); SK_MMA(0); SK_LOAD(0, 4); SK_MMA(1); SK_LOAD(1, 5);
    SK_MMA(0); SK_LOAD(0, 6); SK_MMA(1); SK_LOAD(1, 7); SK_MMA(0); SK_MMA(1);
#undef SK_LOAD
#undef SK_MMA
    const int j = pm < 32 ? 0 : 1 + ((pm - 32) >> 4);
    const float sw = ((const float*)(a.ws + WS_SW))[((size_t)l * 9 + j) * N1 + 3072 + r];
    const float* RSS = (const float*)(a.ws + WS_RSS);
    float* BA = (float*)(a.ws + WS_BA);
#pragma unroll
    for (int mi = 0; mi < 2; ++mi)
#pragma unroll
        for (int q = 0; q < 4; ++q) {
            const int row = pm * 256 + wave * 32 + mi * 16 + 4 * kg + q;
            const f32x4* rp = (const f32x4*)(RSS + (size_t)row * 16);
            const f32x4 r0 = rp[0], r1 = rp[1], r2 = rp[2], r3 = rp[3];
            const float ss = ((r0.x + r0.y) + (r0.z + r0.w)) + ((r1.x + r1.y) + (r1.z + r1.w)) + ((r2.x + r2.y) + (r2.z + r2.w)) + ((r3.x + r3.y) + (r3.z + r3.w));
            const float rinv = rsqrtf(ss * (1.f / 1024.f) + EPS);
            BA[(size_t)row * 16 + r] = (mi ? acc1[q] : acc0[q]) * rinv + sw;
        }
}

constexpr int NPHASE = 24;
__global__ void __launch_bounds__(NTHR, 2) fwd_kernel(Args args) {
    extern __shared__ __attribute__((aligned(16))) unsigned char lds_raw[];
    LAS unsigned char* lds = (LAS unsigned char*)lds_raw;
#if !MK_MULTI
    volatile LAS unsigned* MISC = (volatile LAS unsigned*)(lds + MISC_OFF);
    if (threadIdx.x < 64) MISC[threadIdx.x] = 0u;
    __syncthreads();
    XcdBarrier bar = xcd_barrier_post((unsigned*)(args.ws + WS_CTL) + CW_BAR, MISC + 8);
#define GRID_BAR() xcd_barrier(bar)
#else
#define GRID_BAR() do { } while (0)
#endif
    const int G = gridDim.x, bid = blockIdx.x;
#pragma unroll
    for (int pass = (PRE_HI > 0 ? 0 : 1); pass < 2; ++pass) {
        const int hi = (pass == 0) ? args.pad : args.ph_hi, lo = args.ph_lo;
        volatile LAS unsigned long long* TSL = (volatile LAS unsigned long long*)(lds + MISC_OFF + 128);
        if (PROBE_A == -2 && PROBE_B >= 0 && threadIdx.x == 0) TSL[0] = __builtin_amdgcn_s_memrealtime();
#define RUN(k) ((k) >= lo && (k) < hi)
#define SEAM(k) do { if (RUN(k) && ((k) + 1 < hi || pass == 0)) { GRID_BAR(); for (int rb = 1; rb < REP_BAR; ++rb) GRID_BAR(); } if (PROBE_B >= 0 && threadIdx.x == 0) { if ((k) == PROBE_A) TSL[0] = __builtin_amdgcn_s_memrealtime(); if ((k) == PROBE_B) TSL[1] = __builtin_amdgcn_s_memrealtime(); } } while (0)
        if (RUN(0)) { if (EN(0)) for (int rep = 0; rep < REP_P0; ++rep) phase_0a(args, lds); } SEAM(0);
        if (RUN(1)) { if (EN(1)) for (int rep = 0; rep < REP_P0; ++rep) phase_0b(args, lds); } SEAM(1);
        if (RUN(2)) { if (EN(2)) phase_0c(args); } SEAM(2);
#pragma unroll 1
        for (int l = 0; l < NL; ++l) {
            if (RUN(3 + 5 * l)) {
            if (EN(4)) {
                pg8::Gemm g{(const bf16*)args.out, (const bf16*)(args.ws + WS_W1T) + (size_t)l * N1 * 1024, M, LDP, 1024, 1024};
                pg8::StaticOrder S; S.init(M, LDP, G, bid);
                Epi1 E{(bf16*)(args.ws + WS_PB), (float*)(args.ws + WS_BA), (const float*)(args.ws + WS_RSS), (const float*)(args.ws + WS_SW) + (size_t)l * 9 * N1, 0, (bf16*)(args.ws + WS_DUM), (const LAS float*)(lds + 131072), (float*)(args.ws + WS_VSS)};
                {
                    LAS float* rtab = (LAS float*)(lds + 131072); const float* RSSp = (const float*)(args.ws + WS_RSS);
                    for (int idx = otid(); idx < 8 * 256; idx += NTHR) { pg8::Unit u;
                        if (S.next(idx >> 8, u)) { const f32x4* rp = (const f32x4*)(RSSp + (size_t)(u.pm * 256 + (idx & 255)) * 16);
                            const f32x4 r0 = rp[0], r1 = rp[1], r2 = rp[2], r3 = rp[3];
                            const float ss = ((r0.x + r0.y) + (r0.z + r0.w)) + ((r1.x + r1.y) + (r1.z + r1.w)) + ((r2.x + r2.y) + (r2.z + r2.w)) + ((r3.x + r3.y) + (r3.z + r3.w));
                            rtab[idx] = rsqrtf(ss * (1.f / 1024.f) + EPS); } }
                    __syncthreads();
                }
                for (int rep = 0; rep < REP_G1; ++rep) { if (rep && G1CHEAP) E.cheap = args.one * G1CHEAP; pg8::gemm_phase<Epi1>(lds, g, S, E); if (rep && G1CHEAP) continue;
                    if (bid >= 128) for (int pm = bid - 128; pm < 160; pm += 128) skinny_ba(args, l, pm); } }
            }
            SEAM(3 + 5 * l);
            if (RUN(4 + 5 * l))
            {
                if (EN(5)) {
#if PREP_PREFETCH
                    PrepPre PP; if (bid < 2560) prep_prefetch(args, PP, bid >> 2, bid & 3);
                    for (int it = bid; it < 2560; it += G) { const int nit = it + G < 2560 ? it + G : -4; prep_item(args, lds, l, it >> 2, it & 3, PP, nit >> 2, nit & 3); }
#else
                    for (int it = bid; it < 2560; it += G) { PrepPre PP; prep_prefetch(args, PP, it >> 2, it & 3); prep_item(args, lds, l, it >> 2, it & 3, PP, -1, 0); }
#endif
                }
            }
            SEAM(4 + 5 * l);
            if (RUN(5 + 5 * l))
            {
                if (bid < 64 && !PSK(1)) { if (EN(10)) for (int rep = 0; rep < REP_SCAN; ++rep) scan_item(args, lds, l, 32 + (bid >> 3), (bid >> 1) & 3, bid & 1); }
                if (PROBE_X >= 0 && l == PROBE_L && bid < 64 && threadIdx.x == 0) atomicMax((unsigned long long*)(args.ws + WS_CTL) + 2048 + 0, (unsigned long long)__builtin_amdgcn_s_memrealtime());
                unsigned* qc = (unsigned*)(args.ws + WS_CTL) + CW_Q + 64 * l + 256 * pass;
                volatile LAS unsigned* qslot = (volatile LAS unsigned*)(lds + MISC_OFF) + 16;
                if (otid() == 0) qslot[0] = atomicAdd(qc, 1u);
                for (;;) {
                    __syncthreads();
                    const int it = (int)qslot[0];
                    __syncthreads();
                    if (PROBE_X >= 0 && l == PROBE_L && threadIdx.x == 0 && (it >= 1856 || it == 320 || it == 576 || it == 1088 || it == 1216)) { const unsigned long long now = __builtin_amdgcn_s_memrealtime();
                        unsigned long long* T_ = (unsigned long long*)(args.ws + WS_CTL) + 2048;
                        if (it >= 1856) { atomicMax(T_ + 1, now); if (atomicCAS(T_ + 3, 0ull, now) == 0ull) {} }
                        if (it == 320) atomicMax(T_ + 4, now); if (it == 576) atomicMax(T_ + 5, now); if (it == 1088) atomicMax(T_ + 6, now); if (it == 1216) atomicMax(T_ + 7, now); }
                    if (it >= 1856) break;
                    unsigned nx = 0u; const bool puller = (otid() == 0);
                    if (puller) nx = atomicAdd(qc, 1u);
                    if (it < 320) { const int g_ = it / 80, c4 = (it % 80) * 4;
                        if (EN(6) && !PSK(16)) for (int rep = 0; rep < REP_SGU; ++rep) for (int cc = 0; cc < 4; ++cc) sgu_item(args, lds, l, c4 + cc, g_, rep ? args.one : 0, cc > 0 || rep > 0); }
                    else if (it < 576) { const int i2 = it - 320; if (EN(10) && !PSK(8)) for (int rep = 0; rep < REP_CTXS; ++rep) scan_item(args, lds, l, i2 >> 3, (i2 >> 1) & 3, i2 & 1); }
                    else if (it < 1088) { const int i2 = it - 576; if (EN(9) && !PSK(2)) for (int rep = 0; rep < REP_FSMP; ++rep) fsmp_item(args, lds, i2 >> 6, i2 & 63, rep ? args.one : 0); }
                    else if (it < 1216) { const int i2 = it - 1088; if (EN(8) && !PSK(4)) for (int rep = 0; rep < REP_FCTX; ++rep) fctx_item(args, lds, i2 >> 2, i2 & 3, rep ? args.one : 0); }
                    else { if (EN(7) && !PSK(32)) pool_item(args, lds, l, it - 1216, 0); }
                    if (puller) qslot[0] = nx;
                }
            }
            SEAM(5 + 5 * l);
            if (RUN(6 + 5 * l))
            {
                if (EN(11)) { for (int it = bid; it < 512; it += G) ffin_item(args, lds, it >> 6, it & 63);
                    for (int rep = 0; rep < REP_COMB; ++rep) phase_combine(args, l, rep ? args.one : 0); }
            }
            SEAM(6 + 5 * l);
            if (RUN(7 + 5 * l)) {
            if (EN(12)) {
                pg8::Gemm g{(const bf16*)(args.ws + WS_PB), (const bf16*)(args.ws + WS_W2T) + (size_t)l * 1024 * 1024, M, 1024, 1024, LDP};
                pg8::StaticOrder S; S.init(M, 1024, G, bid);
                const float* MOD = (const float*)(args.ws + WS_MOD);
                Epi2 E{(bf16*)args.out + (size_t)M * D, (bf16*)args.out, (float*)(args.ws + WS_RSS), MOD + (size_t)l * 9 * 3072 + 2048,
                       l < 3 ? args.in[I_NORMG] + (l + 1) * 1024 : nullptr, l < 3 ? MOD + (size_t)(l + 1) * 9 * 3072 + 1024 : nullptr, args.ws + WS_DUM, 0};
                pg8::gemm_phase<Epi2>(lds, g, S, E);
                for (int rep = 1; rep < REP_G2; ++rep) { Epi2 E2 = E; E2.dry = args.one; pg8::gemm_phase<Epi2>(lds, g, S, E2); }
            }
            }
            SEAM(7 + 5 * l);
        }
        if (RUN(23)) { if (EN(3) && pass == 1) { for (int rnd = 0; rnd < 4; ++rnd) { FinalRegs R; final_load(args, R, rnd); GRID_BAR(); final_store(args, R, rnd); } } }
        if (PROBE_B >= 0 && blockIdx.x == 0 && threadIdx.x == 0) {
            asm volatile("s_waitcnt vmcnt(0)" ::: "memory");
            const unsigned long long tend = (PROBE_X >= 0) ? __hip_atomic_load((unsigned long long*)(args.ws + WS_CTL) + 2048 + PROBE_X, __ATOMIC_RELAXED, __HIP_MEMORY_SCOPE_AGENT) : (unsigned long long)TSL[1];
            const float T = PROBE_FAKE ? (float)PROBE_FAKE : (float)(tend - TSL[0]) * (0.01f * PROBE_SCALE);
            args.out[0] += sqrtf(8.39f * T);
        }
#undef RUN
#undef SEAM
    }
}

extern "C" void kernel_launch(void* const* d_in, const int* in_sizes, int n_in, void* d_out, int out_size, void* d_ws, size_t ws_size, hipStream_t stream) {
    static int grid = 0;
    if (grid == 0) {
        if (n_in != 21 || ws_size < WS_DUM + 16 * MiB) { fprintf(stderr, "kernel_launch: unexpected n_in %d or ws_size %zu (< %zu)\n", n_in, ws_size, (size_t)WS_END); grid = -1; return; }
        int dev = 0, cus = 0, per_cu = 0;
        if (hipGetDevice(&dev) != hipSuccess || hipDeviceGetAttribute(&cus, hipDeviceAttributeMultiprocessorCount, dev) != hipSuccess) { grid = -1; return; }
        if (hipFuncSetAttribute((const void*)fwd_kernel, hipFuncAttributeMaxDynamicSharedMemorySize, LDS_BYTES) != hipSuccess) { fprintf(stderr, "kernel_launch: hipFuncSetAttribute failed\n"); grid = -1; return; }
        if (hipOccupancyMaxActiveBlocksPerMultiprocessor(&per_cu, (const void*)fwd_kernel, NTHR, LDS_BYTES) != hipSuccess || per_cu < 1) { fprintf(stderr, "kernel_launch: occupancy query failed (%d)\n", per_cu); (void)hipGetLastError(); per_cu = 1; }
        grid = cus * 1;
    }
    if (grid < 0) return;
    Args a{};
    for (int i = 0; i < 21; ++i) a.in[i] = (const float*)d_in[i];
    a.out = (float*)d_out; a.ws = (unsigned char*)d_ws; a.one = 1; a.pad = PRE_HI;
    (void)hipMemsetAsync((char*)d_ws + WS_CTL, 0, CTL_ZERO_BYTES, stream);
#if MK_MULTI
    for (int ph = 0; ph < NPHASE; ++ph) {
        a.ph_lo = ph; a.ph_hi = ph + 1;
        hipLaunchKernelGGL(fwd_kernel, dim3(grid), dim3(NTHR), LDS_BYTES, stream, a);
    }
#else
    a.ph_lo = 0; a.ph_hi = NPHASE;
    void* kargs[] = {&a};
    hipError_t e = hipLaunchCooperativeKernel((const void*)fwd_kernel, dim3(grid), dim3(NTHR), kargs, LDS_BYTES, stream);
    if (e != hipSuccess) fprintf(stderr, "kernel_launch: cooperative launch failed: %s (grid %d)\n", hipGetErrorString(e), grid);
#endif
}
```

```cpp
#include <hip/hip_runtime.h>
#include <cstdio>
#include <cstdint>

#ifndef MK_MULTI
#define MK_MULTI 0
#endif
#ifndef NAIVE_MM
#define NAIVE_MM 0
#endif
#ifndef ONLY
#define ONLY -1
#endif
#define EN(k) (ONLY < 0 || ONLY == (k))
#ifndef REP_G1
#define REP_G1 1
#endif
#ifndef REP_PREP
#define REP_PREP 1
#endif
#ifndef REP_SCAN
#define REP_SCAN 1
#endif
#ifndef REP_P0
#define REP_P0 1
#endif
#ifndef REP_MIX
#define REP_MIX 1
#endif
#ifndef REP_COMB
#define REP_COMB 1
#endif
#ifndef REP_G2
#define REP_G2 1
#endif
#ifndef MIXSEL
#define MIXSEL 15
#endif
#ifndef G1CHEAP
#define G1CHEAP 0
#endif
#ifndef REP_BAR
#define REP_BAR 1
#endif
#ifndef PRE_HI
#define PRE_HI 0
#endif
#ifndef PROBE_A
#define PROBE_A -1
#endif
#ifndef PROBE_B
#define PROBE_B -1
#endif
#ifndef PROBE_FAKE
#define PROBE_FAKE 0
#endif
#ifndef PROBE_SCALE
#define PROBE_SCALE 1
#endif
#ifndef PLAIN_LAUNCH
#define PLAIN_LAUNCH 0
#endif
#ifndef PROBE_X
#define PROBE_X -1
#endif
#define PROBE_L 1
#ifndef REP_FCTX
#define REP_FCTX 1
#endif
#ifndef REP_FSMP
#define REP_FSMP 1
#endif
#ifndef REP_CTXS
#define REP_CTXS 1
#endif
#ifndef REP_SGU
#define REP_SGU 1
#endif
#ifndef PREP_PREFETCH
#define PREP_PREFETCH 0
#endif
#ifndef PRE_SKIP
#define PRE_SKIP 0
#endif
#define PSK(b) (pass == 0 && (PRE_SKIP & (b)))

#define LAS __attribute__((address_space(3)))
#define GAS __attribute__((address_space(1)))
typedef unsigned short bf16;
typedef short bf16x8 __attribute__((ext_vector_type(8)));
typedef float f32x4 __attribute__((ext_vector_type(4)));
typedef float f32x2 __attribute__((ext_vector_type(2)));
typedef unsigned u32x4 __attribute__((ext_vector_type(4)));
typedef unsigned u32x2 __attribute__((ext_vector_type(2)));

constexpr int D = 1024, NL = 4, NCOND = 9;
constexpr int M_CTX = 8192, M = 40960;
constexpr int PIN = 2832;
constexpr int N1 = 3328, LDP = 3072;
constexpr float EPS = 1e-6f;
constexpr int C_GA = 0, C_U = 256, C_GC = 512, C_GD = 768, C_V = 1024, C_GB = 1280, C_XC = 1536, C_PF = 1792, C_QF = 2048, C_Q = 2304, C_K = 2560, C_VV = 2816;

constexpr size_t MiB = 1u << 20;
constexpr size_t WS_CTL = 0, CTL_ZERO_BYTES = 64 * 1024;
constexpr size_t WS_MOD = 1 * MiB;
constexpr size_t WS_SW = WS_MOD + 512 * 1024;
constexpr size_t WS_GMAT = 2 * MiB;
constexpr size_t WS_POS = WS_GMAT + 512 * 1024;
constexpr size_t WS_DFT = WS_POS + 256 * 1024;
constexpr size_t WS_M1 = 3 * MiB;
constexpr size_t WS_M2 = WS_M1 + 32 * 1024;
constexpr size_t WS_TW = WS_M1 + 64 * 1024;
constexpr size_t WS_W1T = 4 * MiB;
constexpr size_t WS_W2T = 30 * MiB;
constexpr size_t WS_BA = 38 * MiB;
constexpr size_t WS_RSS = 41 * MiB;
constexpr size_t WS_PB = 44 * MiB;
constexpr size_t WS_HB = 284 * MiB;
constexpr size_t WS_PREP = 284 * MiB;
constexpr size_t WS_PGL = 484 * MiB;
constexpr size_t WS_VSS = 484 * MiB + 64 * 1024;
constexpr size_t WS_END = 485 * MiB;
constexpr size_t WS_DUM = 486 * MiB;
constexpr int CW_BAR = 4096, CW_Q = 8192;

constexpr int LDS_BYTES = 147456;
constexpr int MISC_OFF = 144 * 1024 - 256;
constexpr int NWAVES = 8, NTHR = 512;

typedef __bf16 hwbf16x2 __attribute__((ext_vector_type(2)));
__device__ __forceinline__ unsigned f2bf(float f) { return (unsigned)__builtin_bit_cast(unsigned short, (__bf16)f); }
__device__ __forceinline__ float bf2f(unsigned b) { return __builtin_bit_cast(float, (b & 0xffffu) << 16); }
__device__ __forceinline__ unsigned pk2(float lo, float hi) { const f32x2 v = {lo, hi}; return __builtin_bit_cast(unsigned, __builtin_convertvector(v, hwbf16x2)); }
__device__ __forceinline__ float bflo(unsigned w) { return __builtin_bit_cast(float, w << 16); }
__device__ __forceinline__ float bfhi(unsigned w) { return __builtin_bit_cast(float, w & 0xffff0000u); }
__device__ __forceinline__ float silu_f(float x) { return x * __builtin_amdgcn_rcpf(1.f + __builtin_amdgcn_exp2f(-1.4426950408889634f * x)); }
__device__ __forceinline__ float gelu_tanh_f(float x) { const float z = (-1.5957691216057308f * 1.4426950408889634f) * (x + 0.044715f * x * x * x); return x * __builtin_amdgcn_rcpf(1.f + __builtin_amdgcn_exp2f(z)); }
__device__ __forceinline__ float wave_sum(float v) {
#pragma unroll
    for (int o = 1; o < 64; o <<= 1) v += __shfl_xor(v, o);
    return v;
}
__device__ __forceinline__ int otid() { int t = threadIdx.x; asm volatile("" : "+v"(t)); return t; }
__device__ __forceinline__ int obid() { int b = blockIdx.x; asm volatile("" : "+s"(b)); return b; }
#define LDS_WAIT() asm volatile("s_waitcnt lgkmcnt(0)" ::: "memory")

namespace pg8 {
constexpr int BM = 256, BK = 64, HALF = 128, HTB = HALF * BK * 2, STAGE_BYTES = 8 * HTB, NXCD = 8, WGM = 8;
__host__ __device__ __forceinline__ int lds_byte(int r, int c) { const int st = (r >> 4) * 2 + (c >> 5), rr = r & 15, cc = c & 31, ob = rr * 64 + cc * 2; return st * 1024 + (ob ^ (((ob >> 9) & 1) << 5)); }
__host__ __device__ __forceinline__ void stage_rc(int b, int& R, int& C) { const int st = b / 1024, sb = b % 1024, swz = sb ^ (((sb >> 9) & 1) << 5); R = (st >> 1) * 16 + swz / 64; C = (st & 1) * 32 + (swz % 64) / 2; }
__host__ __device__ __forceinline__ int perm32(int rho) { const int n = rho >> 4, i = rho & 15; return 8 * (i >> 2) + 4 * n + (i & 3); }

struct Unit { int pm, pn; };
struct Gemm { const bf16* A; const bf16* Bt; int M, N, K, lda; };

struct StaticOrder {
    int nM, nN, nwg, G, c;
    __host__ __device__ __forceinline__ void init(int M_, int N_, int G_, int c_) { nM = M_ / BM; nN = N_ / BM; nwg = nM * nN; G = G_; c = c_; }
    __host__ __device__ __forceinline__ bool next(int i, Unit& u) const {
        const long L = (long)i * G + c; if (L >= nwg) return false;
        int wgid = (int)L; { const int q = nwg / NXCD, r = nwg % NXCD, xcd = wgid % NXCD, off = wgid / NXCD; wgid = (xcd < r ? xcd * (q + 1) : r * (q + 1) + (xcd - r) * q) + off; }
        const int nig = WGM * nN, gid = wgid / nig, fm = gid * WGM, gsz = (nM - fm) < WGM ? (nM - fm) : WGM;
        u.pm = fm + ((wgid % nig) % gsz); u.pn = (wgid % nig) / gsz; return true;
    }
};

template <class Epi>
__device__ __forceinline__ void gemm_phase(LAS unsigned char* lds, const Gemm g, const StaticOrder& S, const Epi& E) {
    const int tid = otid(), wid = __builtin_amdgcn_readfirstlane(tid >> 6), lane = tid & 63, wr = wid >> 2, wc = wid & 3, fr = lane & 15, fq = lane >> 4;
    const int K = g.K, nt = K / BK, lda = g.lda;
    unsigned voffA[2], voffB[2];
#pragma unroll
    for (int i = 0; i < 2; ++i) { int R, C; stage_rc(tid * 16 + i * 8192, R, C); const int Rb = Epi::PERM ? ((R & ~31) + perm32(R & 31)) : R;
        voffA[i] = (unsigned)(R * lda + C) * 2u; voffB[i] = (unsigned)(Rb * K + C) * 2u; }
    const size_t kstep = (size_t)(BK * 2);
    const size_t hstepA = (size_t)HALF * lda * 2, hstepB = (size_t)HALF * K * 2;
    const size_t tstepA = 2 * hstepA, tstepB = 2 * hstepB;
    const unsigned ldsw = (unsigned)wid * 1024u;
    const int aoff = lds_byte(wr * 64 + fr, fq * 8), boff = lds_byte(wc * 32 + fr, fq * 8);
#define PG8_SA(b, h) (((b) * 2 + (h)) * HTB)
#define PG8_SB(b, h) ((4 + (b) * 2 + (h)) * HTB)
#define PG8_STAGE(bufoff, gbase, voff) do { _Pragma("unroll") for (int _i = 0; _i < 2; ++_i) \
        __builtin_amdgcn_global_load_lds((const unsigned*)((const char*)(gbase) + (voff)[_i]), (LAS unsigned*)(lds + (bufoff) + ldsw + _i * 8192), 16, 0, 0); } while (0)
#define PG8_LDA(dst, b, h) do { _Pragma("unroll") for (int m = 0; m < 4; ++m) _Pragma("unroll") for (int k = 0; k < 2; ++k) dst[m][k] = *(const LAS bf16x8*)(lds + PG8_SA(b, h) + aoff + m * 2048 + k * 1024); } while (0)
#define PG8_LDB(dst, b, h) do { _Pragma("unroll") for (int n = 0; n < 2; ++n) _Pragma("unroll") for (int k = 0; k < 2; ++k) dst[n][k] = *(const LAS bf16x8*)(lds + PG8_SB(b, h) + boff + n * 2048 + k * 1024); } while (0)
#define PG8_MMA(ai, bj, At, Bt) do { __builtin_amdgcn_s_setprio(1); _Pragma("unroll") for (int m = 0; m < 4; ++m) _Pragma("unroll") for (int n = 0; n < 2; ++n) _Pragma("unroll") for (int k = 0; k < 2; ++k) \
        acc[ai][bj][m][n] = __builtin_amdgcn_mfma_f32_16x16x32_bf16(Bt[n][k], At[m][k], acc[ai][bj][m][n], 0, 0, 0); __builtin_amdgcn_s_setprio(0); } while (0)
#define PG8_WAIT_V(n) asm volatile("s_waitcnt vmcnt(" #n ")" ::: "memory")
#define PG8_WAIT_L(n) asm volatile("s_waitcnt lgkmcnt(" #n ")" ::: "memory")
#define PG8_BAR __builtin_amdgcn_s_barrier()
#define PG8_SCHED __builtin_amdgcn_sched_barrier(0)
    Unit cur, nxt; int ui = 0;
    if (!S.next(0, cur)) return;
    f32x4 acc[2][2][4][2];
#pragma unroll
    for (int a = 0; a < 2; ++a)
#pragma unroll
        for (int b = 0; b < 2; ++b)
#pragma unroll
            for (int m = 0; m < 4; ++m)
#pragma unroll
                for (int n = 0; n < 2; ++n) acc[a][b][m][n] = (f32x4){0.f, 0.f, 0.f, 0.f};
    bf16x8 At[4][2], B0[2][2], B1[2][2];
    const char* cA = (const char*)g.A + (size_t)cur.pm * tstepA; const char* cB = (const char*)g.Bt + (size_t)cur.pn * tstepB;
    PG8_STAGE(PG8_SB(0, 0), cB, voffB); PG8_STAGE(PG8_SA(0, 0), cA, voffA); PG8_STAGE(PG8_SB(0, 1), cB + hstepB, voffB); PG8_STAGE(PG8_SA(0, 1), cA + hstepA, voffA);
    if (wr == 1) PG8_BAR;
    PG8_WAIT_V(4); PG8_BAR;
    PG8_STAGE(PG8_SB(1, 0), cB + kstep, voffB); PG8_STAGE(PG8_SA(1, 0), cA + kstep, voffA); PG8_STAGE(PG8_SB(1, 1), cB + hstepB + kstep, voffB);
    PG8_WAIT_V(6); PG8_BAR;
    for (;;) {
        const bool has_next = S.next(ui + 1, nxt);
        const char* nA = has_next ? (const char*)g.A + (size_t)nxt.pm * tstepA : cA; const char* nB = has_next ? (const char*)g.Bt + (size_t)nxt.pn * tstepB : cB;
        for (int t = 0; t < nt; t += 2) {
            const bool last = (t == nt - 2);
            const char* a1 = cA + (size_t)(t + 1) * kstep;
            const char* a2 = last ? nA : cA + (size_t)(t + 2) * kstep; const char* b2 = last ? nB : cB + (size_t)(t + 2) * kstep;
            const char* a3 = a2 + kstep; const char* b3 = b2 + kstep;
            PG8_LDB(B0, 0, 0); PG8_SCHED; PG8_LDA(At, 0, 0); PG8_STAGE(PG8_SA(1, 1), a1 + hstepA, voffA);
            PG8_WAIT_L(8); PG8_BAR; PG8_WAIT_L(0); PG8_MMA(0, 0, At, B0); PG8_BAR; PG8_SCHED;
            PG8_LDB(B1, 0, 1); PG8_STAGE(PG8_SB(0, 0), b2, voffB);
            PG8_BAR; PG8_WAIT_L(0); PG8_MMA(0, 1, At, B1); PG8_BAR;
            PG8_LDA(At, 0, 1); PG8_STAGE(PG8_SA(0, 0), a2, voffA);
            PG8_BAR; PG8_WAIT_L(0); PG8_MMA(1, 0, At, B0); PG8_BAR; PG8_SCHED;
            PG8_STAGE(PG8_SB(0, 1), b2 + hstepB, voffB);
            PG8_WAIT_V(6); PG8_BAR; PG8_MMA(1, 1, At, B1); PG8_BAR;
            PG8_LDB(B0, 1, 0); PG8_SCHED; PG8_LDA(At, 1, 0); PG8_STAGE(PG8_SA(0, 1), a2 + hstepA, voffA);
            PG8_WAIT_L(8); PG8_BAR; PG8_WAIT_L(0); PG8_MMA(0, 0, At, B0); PG8_BAR; PG8_SCHED;
            PG8_LDB(B1, 1, 1); PG8_STAGE(PG8_SB(1, 0), b3, voffB);
            PG8_BAR; PG8_WAIT_L(0); PG8_MMA(0, 1, At, B1); PG8_BAR;
            PG8_LDA(At, 1, 1); PG8_STAGE(PG8_SA(1, 0), a3, voffA);
            PG8_BAR; PG8_WAIT_L(0); PG8_MMA(1, 0, At, B0); PG8_BAR; PG8_SCHED;
            PG8_STAGE(PG8_SB(1, 1), b3 + hstepB, voffB);
            PG8_WAIT_V(6); PG8_BAR; PG8_MMA(1, 1, At, B1); PG8_BAR;
        }
        E(acc, cur, wr, wc, fr, fq, ui);
        if (!has_next) break;
#pragma unroll
        for (int a = 0; a < 2; ++a)
#pragma unroll
            for (int b = 0; b < 2; ++b)
#pragma unroll
                for (int m = 0; m < 4; ++m)
#pragma unroll
                    for (int n = 0; n < 2; ++n) acc[a][b][m][n] = (f32x4){0.f, 0.f, 0.f, 0.f};
        cur = nxt; cA = nA; cB = nB; ++ui;
    }
    PG8_WAIT_V(0);
    if (wr == 0) PG8_BAR;
    PG8_BAR;
#undef PG8_SA
#undef PG8_SB
#undef PG8_STAGE
#undef PG8_LDA
#undef PG8_LDB
#undef PG8_MMA
#undef PG8_WAIT_V
#undef PG8_WAIT_L
#undef PG8_BAR
#undef PG8_SCHED
}
}

#define XB_TMO      128
#define XB_XCNT(j)  (256  + 64 * (j))
#define XB_XSUB(j)  (1280 + 64 * (j))
#define XB_XGEN(j)  (2304 + 64 * (j))
#define XB_TOP      3328
#define XB_TOPGEN   3392
#define XCD_BAR_WORDS 3456
#define XB_SPIN_CAP (1u << 18)
__device__ __forceinline__ unsigned xb_ld(unsigned* p)              { return __hip_atomic_load(p, __ATOMIC_RELAXED, __HIP_MEMORY_SCOPE_AGENT); }
__device__ __forceinline__ unsigned xb_add(unsigned* p, unsigned v) { return __hip_atomic_fetch_add(p, v, __ATOMIC_RELAXED, __HIP_MEMORY_SCOPE_AGENT); }
__device__ __forceinline__ unsigned xb_xcc_id() { return (unsigned)__builtin_amdgcn_s_getreg((3 << 11) | 20) & 0xFu; }
#define XB_SPIN(cond, bar) do { unsigned _sp = 0; while (cond) { __builtin_amdgcn_s_sleep(1); \
    if ((++_sp & 255u) == 0u) { if (xb_ld(&(bar)[XB_TMO])) break; if (_sp > XB_SPIN_CAP) { atomicAdd(&(bar)[XB_TMO], 1u); break; } } } } while (0)
struct XcdBarrier { unsigned* bar; unsigned x; volatile LAS unsigned* st; };
__device__ __forceinline__ XcdBarrier xcd_barrier_post(unsigned* bar, volatile LAS unsigned* st) {
    XcdBarrier b; b.bar = bar; b.x = xb_xcc_id(); b.st = st;
    if (threadIdx.x == 0) (void)xb_add(&bar[XB_XCNT(b.x)], 1u);
    return b;
}
__device__ __forceinline__ void xcd_barrier_complete(unsigned* bar, unsigned x, unsigned& nloc, unsigned& nx) {
    const unsigned G = gridDim.x * gridDim.y * gridDim.z;
    unsigned sum, cnt, mine, sp = 0u;
    for (;;) {
        sum = 0u; cnt = 0u; mine = 0u;
#pragma unroll
        for (unsigned j = 0; j < 16; ++j) { const unsigned c = xb_ld(&bar[XB_XCNT(j)]); sum += c; cnt += (c > 0u) ? 1u : 0u; mine = (j == x) ? c : mine; }
        if (sum == G) break;
        __builtin_amdgcn_s_sleep(1);
        if ((++sp & 255u) == 0u) { if (xb_ld(&bar[XB_TMO])) break; if (sp > XB_SPIN_CAP) { atomicAdd(&bar[XB_TMO], 1u); break; } }
    }
    nloc = mine > 0u ? mine : 1u; nx = cnt > 0u ? cnt : 1u;
}
__device__ __forceinline__ void xcd_barrier(const XcdBarrier& b) {
    asm volatile("s_waitcnt vmcnt(0)" ::: "memory");
    __syncthreads();
    if (threadIdx.x == 0) {
        unsigned* bar = b.bar;
        __builtin_amdgcn_s_waitcnt(0);
        unsigned nloc = b.st[0], nx = b.st[1];
        if (nloc == 0u) { xcd_barrier_complete(bar, b.x, nloc, nx); b.st[0] = nloc; b.st[1] = nx; }
        const unsigned old = xb_add(&bar[XB_XSUB(b.x)], 1u);
        const unsigned gen = old / nloc;
        if (old + 1u == (gen + 1u) * nloc) {
            __builtin_amdgcn_fence(__ATOMIC_RELEASE, "agent");
            asm volatile("s_waitcnt vmcnt(0)" ::: "memory");
            const unsigned og = xb_add(&bar[XB_TOP], 1u);
            const unsigned tg = og / nx;
            if (og + 1u == (tg + 1u) * nx) xb_add(&bar[XB_TOPGEN], 1u);
            else XB_SPIN(xb_ld(&bar[XB_TOPGEN]) == tg, bar);
            __builtin_amdgcn_fence(__ATOMIC_ACQUIRE, "agent");
            xb_add(&bar[XB_XGEN(b.x)], 1u);
            asm volatile("s_waitcnt vmcnt(0)" ::: "memory");
        } else {
            XB_SPIN(xb_ld(&bar[XB_XGEN(b.x)]) == gen, bar);
            __builtin_amdgcn_fence(__ATOMIC_ACQUIRE, "agent");
            asm volatile("s_waitcnt vmcnt(0)" ::: "memory");
        }
    }
    __syncthreads();
}

template <int KS>
__device__ __forceinline__ f32x4 tile_mm(f32x4 acc, const LAS bf16* A, int lda, int m0, const LAS bf16* Bt, int ldb, int n0, int lane) {
    const int r = lane & 15, kg = lane >> 4;
#if NAIVE_MM
#pragma unroll 1
    for (int k = 0; k < KS * 32; ++k) {
        const float b = bf2f(Bt[(n0 + r) * ldb + k]);
#pragma unroll
        for (int q = 0; q < 4; ++q) acc[q] += bf2f(A[(m0 + 4 * kg + q) * lda + k]) * b;
    }
#else
#pragma unroll
    for (int ks = 0; ks < KS; ++ks) {
        const bf16x8 a = *(const LAS bf16x8*)(A + (m0 + r) * lda + ks * 32 + kg * 8);
        const bf16x8 b = *(const LAS bf16x8*)(Bt + (n0 + r) * ldb + ks * 32 + kg * 8);
        acc = __builtin_amdgcn_mfma_f32_16x16x32_bf16(a, b, acc, 0, 0, 0);
    }
#endif
    return acc;
}
template <int KS>
__device__ __forceinline__ f32x4 tile_mm_g(f32x4 acc, const bf16* A, int lda, int m0, const LAS bf16* Bt, int ldb, int n0, int lane) {
    const int r = lane & 15, kg = lane >> 4;
#if NAIVE_MM
#pragma unroll 1
    for (int k = 0; k < KS * 32; ++k) {
        const float b = bf2f(Bt[(n0 + r) * ldb + k]);
#pragma unroll
        for (int q = 0; q < 4; ++q) acc[q] += bf2f(A[(m0 + 4 * kg + q) * lda + k]) * b;
    }
#else
#pragma unroll
    for (int ks = 0; ks < KS; ++ks) {
        const bf16x8 a = *(const bf16x8*)(A + (size_t)(m0 + r) * lda + ks * 32 + kg * 8);
        const bf16x8 b = *(const LAS bf16x8*)(Bt + (n0 + r) * ldb + ks * 32 + kg * 8);
        acc = __builtin_amdgcn_mfma_f32_16x16x32_bf16(a, b, acc, 0, 0, 0);
    }
#endif
    return acc;
}

struct Args { const float* in[21]; float* out; unsigned char* ws; int ph_lo, ph_hi, one, pad; };
enum { I_XP = 0, I_XS, I_STATE, I_C, I_CCTX, I_ADAW, I_ADAB, I_NORMG, I_WIN, I_CONV, I_ALOG, I_DTB, I_DNG, I_SGUNG, I_SGUW, I_SGUB, I_POOLW, I_POOLS, I_FW, I_WOUT, I_FNG };

struct SeqGeo { int T, tseq0, seq_row0; };
__device__ __forceinline__ SeqGeo seq_geo(int sc) {
    SeqGeo g;
    if (sc < 128) { g.T = 256; g.tseq0 = (sc & 3) * 64; g.seq_row0 = (sc >> 2) * 256; }
    else { const int s = sc - 128; g.T = 4096; g.tseq0 = (s & 63) * 64; g.seq_row0 = M_CTX + (s >> 6) * 4096; }
    return g;
}
__device__ __forceinline__ int cond_of_row(int row) { return row < M_CTX ? 0 : 1 + ((row - M_CTX) >> 12); }

__device__ __forceinline__ int srccol(int n) {
    if (n < 256) return 768 + n;
    if (n < 512) return 1040 + (n - 256);
    if (n < 768) return 2064 + (n - 512);
    if (n < 1024) return 2576 + (n - 768);
    if (n < 1280) return 1296 + (n - 1024);
    if (n < 1536) return 1552 + (n - 1280);
    if (n < 2304) return -2;
    if (n < 3072) return n - 2304;
    if (n < 3088) return 1024 + (n - 3072);
    return -1;
}

__device__ __forceinline__ void phase_0a(const Args& a, LAS unsigned char* lds) {
    const int tid = otid(), lane = tid & 63, wave = tid >> 6, G = gridDim.x, bid = obid();
    float* MOD = (float*)(a.ws + WS_MOD);
    if (bid < 192) {
        LAS float* sc = (LAS float*)lds;
        LAS float* red = (LAS float*)(lds + 9 * 1024 * 4);
        for (int i = tid; i < 9 * 1024; i += NTHR) { const int j = i >> 10, k = i & 1023; const float c = (j == 0) ? a.in[I_CCTX][k] : a.in[I_C][(j - 1) * 1024 + k]; sc[i] = silu_f(c); }
        __syncthreads();
        for (int it = bid; it < 192; it += G) {
            const int l = it / 48, cb = it % 48, col = cb * 64 + lane;
            float acc[9];
#pragma unroll
            for (int j = 0; j < 9; ++j) acc[j] = 0.f;
            const float* wp = a.in[I_ADAW] + ((size_t)l * 1024 + wave * 128) * 3072 + col;
#pragma unroll 8
            for (int k = 0; k < 128; ++k) { const float wv = wp[(size_t)k * 3072];
#pragma unroll
                for (int j = 0; j < 9; ++j) acc[j] += sc[j * 1024 + wave * 128 + k] * wv; }
#pragma unroll
            for (int j = 0; j < 9; ++j) red[(wave * 9 + j) * 64 + lane] = acc[j];
            __syncthreads();
            for (int i = tid; i < 576; i += NTHR) { const int j = i >> 6, ln = i & 63; float s = 0.f;
#pragma unroll
                for (int w = 0; w < 8; ++w) s += red[(w * 9 + j) * 64 + ln];
                MOD[(l * 9 + j) * 3072 + cb * 64 + ln] = s + a.in[I_ADAB][l * 3072 + cb * 64 + ln]; }
            __syncthreads();
        }
    }
    const int gtid = bid * NTHR + tid, GT = G * NTHR;
    float* GM = (float*)(a.ws + WS_GMAT);
    for (int t = gtid; t < 4 * 4 * 2 * 4096; t += GT) {
        const int d = t & 63, c = (t >> 6) & 63, cs = (t >> 12) & 1, g = (t >> 13) & 3, l = t >> 15;
        const float* fw = a.in[I_FW] + ((size_t)(l * 4 + g) * 64) * 64 + d;
        float s = 0.f;
        for (int m = 0; m < 64; ++m) { const float ph = (float)((m * c) & 63) * (1.f / 32.f); s += (cs ? sinpif(ph) : cospif(ph)) * fw[m * 64]; }
        GM[t] = s * 0.125f;
    }
    bf16* W1T = (bf16*)(a.ws + WS_W1T);
    for (int t = gtid; t < 4 * 128 * N1; t += GT) {
        const int n = t % N1, k8 = (t / N1) & 127, l = t / (N1 * 128);
        const int sc = srccol(n);
        if (sc == -2) continue;
        u32x4 o = (u32x4){0u, 0u, 0u, 0u};
        if (sc >= 0) { const float* wp = a.in[I_WIN] + ((size_t)l * 1024 + k8 * 8) * PIN + sc;
            o.x = pk2(wp[0], wp[PIN]); o.y = pk2(wp[2 * PIN], wp[3 * PIN]); o.z = pk2(wp[4 * PIN], wp[5 * PIN]); o.w = pk2(wp[6 * PIN], wp[7 * PIN]); }
        *(u32x4*)(W1T + ((size_t)l * N1 + n) * 1024 + k8 * 8) = o;
    }
    bf16* W2T = (bf16*)(a.ws + WS_W2T);
    for (int t = gtid; t < 4 * 128 * 1024; t += GT) {
        const int n = t & 1023, k8 = (t >> 10) & 127, l = t >> 17;
        const float* wp = a.in[I_WOUT] + ((size_t)l * 1024 + k8 * 8) * 1024 + n;
        u32x4 o; o.x = pk2(wp[0], wp[1024]); o.y = pk2(wp[2048], wp[3072]); o.z = pk2(wp[4096], wp[5120]); o.w = pk2(wp[6144], wp[7168]);
        *(u32x4*)(W2T + ((size_t)l * 1024 + n) * 1024 + k8 * 8) = o;
    }
    float* POS = (float*)(a.ws + WS_POS);
    for (int t = gtid; t < 64 * 256; t += GT) { const int f = t & 255, i = t >> 8; const float fr = powf(10000.f, -(float)f / 256.f); const float ang = (float)i * fr;
        POS[t] = sinf(ang); POS[64 * 256 + t] = cosf(ang); }
    bf16* DFT = (bf16*)(a.ws + WS_DFT);
    for (int t = gtid; t < 256 * 512; t += GT) { const int tp = t & 511, k = t >> 9, tt = tp & 255; const float ph = (float)((k * tt) & 255) * (1.f / 128.f);
        DFT[t] = (bf16)f2bf((tp < 256 ? cospif(ph) : -sinpif(ph)) * (1.f / 16.f)); }
    bf16* M1 = (bf16*)(a.ws + WS_M1);
    for (int t = gtid; t < 128 * 128; t += GT) { const int kk = t & 127, m = t >> 7, k1 = m & 63, t1 = kk & 63; const float ph = (float)((k1 * t1) & 63) * (1.f / 32.f);
        const float c = cospif(ph), s = sinpif(ph); float v;
        if (m < 64) v = (kk < 64) ? c : -s; else v = (kk < 64) ? s : c;
        M1[t] = (bf16)f2bf(v); }
    bf16* M2 = (bf16*)(a.ws + WS_M2);
    for (int t = gtid; t < 64 * 128; t += GT) { const int kk = t & 127, k2 = t >> 7, t2 = kk & 63; const float ph = (float)((k2 * t2) & 63) * (1.f / 32.f);
        M2[t] = (bf16)f2bf((kk < 64 ? cospif(ph) : -sinpif(ph)) * (1.f / 64.f)); }
    float* TW = (float*)(a.ws + WS_TW);
    for (int t = gtid; t < 64 * 64; t += GT) { const int t2 = t & 63, k1 = t >> 6; const float ph = (float)(k1 * t2) * (1.f / 2048.f); TW[2 * t] = cospif(ph); TW[2 * t + 1] = sinpif(ph); }
}

__device__ __forceinline__ void phase_0b(const Args& a, LAS unsigned char* lds) {
    const int tid = otid(), lane = tid & 63, wave = tid >> 6, G = gridDim.x, bid = obid();
    const int gtid = bid * NTHR + tid, GT = G * NTHR;
    const float* MOD = (const float*)(a.ws + WS_MOD);
    const float* GM = (const float*)(a.ws + WS_GMAT);
    bf16* W1T = (bf16*)(a.ws + WS_W1T);
    for (int it = bid; it < 384; it += G) {
        const int kblk = it & 7, g = (it >> 3) & 3, kind = (it >> 5) % 3, l = it / 96;
        LAS bf16* Al = (LAS bf16*)lds; LAS bf16* Bl = Al + 128 * 72;
        const int base = (kind == 0 ? 1808 : 2320) + 64 * g;
        const float* Gm = (kind == 0) ? (a.in[I_POOLW] + (size_t)(l * 4 + g) * 4096) : (GM + (size_t)((l * 4 + g) * 2 + (kind - 1)) * 4096);
        {
            const int row = tid >> 2, c0 = (tid & 3) * 16;
            const f32x4* wp = (const f32x4*)(a.in[I_WIN] + ((size_t)l * 1024 + kblk * 128 + row) * PIN + base + c0);
            const f32x4 w0 = wp[0], w1 = wp[1], w2 = wp[2], w3 = wp[3];
            u32x4 o0, o1; o0.x = pk2(w0.x, w0.y); o0.y = pk2(w0.z, w0.w); o0.z = pk2(w1.x, w1.y); o0.w = pk2(w1.z, w1.w);
            o1.x = pk2(w2.x, w2.y); o1.y = pk2(w2.z, w2.w); o1.z = pk2(w3.x, w3.y); o1.w = pk2(w3.z, w3.w);
            *(LAS u32x4*)(Al + row * 72 + c0) = o0; *(LAS u32x4*)(Al + row * 72 + c0 + 8) = o1;
            const int c = tid >> 3, d0 = (tid & 7) * 8;
            const f32x4 g0 = *(const f32x4*)(Gm + c * 64 + d0), g1 = *(const f32x4*)(Gm + c * 64 + d0 + 4);
            Bl[(d0 + 0) * 72 + c] = (bf16)f2bf(g0.x); Bl[(d0 + 1) * 72 + c] = (bf16)f2bf(g0.y); Bl[(d0 + 2) * 72 + c] = (bf16)f2bf(g0.z); Bl[(d0 + 3) * 72 + c] = (bf16)f2bf(g0.w);
            Bl[(d0 + 4) * 72 + c] = (bf16)f2bf(g1.x); Bl[(d0 + 5) * 72 + c] = (bf16)f2bf(g1.y); Bl[(d0 + 6) * 72 + c] = (bf16)f2bf(g1.z); Bl[(d0 + 7) * 72 + c] = (bf16)f2bf(g1.w);
        }
        __syncthreads();
        {
            const int m0 = wave * 16, r = lane & 15, kg = lane >> 4;
#pragma unroll
            for (int nt = 0; nt < 4; ++nt) {
                const f32x4 acc = tile_mm<2>((f32x4){0.f, 0.f, 0.f, 0.f}, Al, 72, m0, Bl, 72, nt * 16, lane);
                u32x2 o; o.x = pk2(acc[0], acc[1]); o.y = pk2(acc[2], acc[3]);
                *(u32x2*)(W1T + ((size_t)l * N1 + 1536 + kind * 256 + g * 64 + nt * 16 + r) * 1024 + kblk * 128 + m0 + 4 * kg) = o;
            }
        }
        __syncthreads();
    }
    const float* POS = (const float*)(a.ws + WS_POS);
    bf16* HB = (bf16*)a.out;
    bf16* XB = (bf16*)a.out + (size_t)M * D;
    float* RSS = (float*)(a.ws + WS_RSS);
    for (int r0 = bid * NWAVES + wave; r0 < M; r0 += 4 * G * NWAVES) {
        f32x4 v[4][4], pe[4][4];
#pragma unroll
        for (int u = 0; u < 4; ++u) {
            const int row = r0 + u * G * NWAVES;
#pragma unroll
            for (int q = 0; q < 4; ++q) { v[u][q] = (f32x4){0.f, 0.f, 0.f, 0.f}; pe[u][q] = v[u][q]; }
            if (row < M_CTX) {
                const f32x4* xr = (const f32x4*)(a.in[I_XP] + (size_t)row * D) + lane;
#pragma unroll
                for (int q = 0; q < 4; ++q) v[u][q] = xr[64 * q];
            } else if (row < M) {
                const int rs = row - M_CTX, t = rs & 4095, gr = t >> 6, gc = t & 63;
                const f32x4* xr = (const f32x4*)(a.in[I_XS] + (size_t)rs * D) + lane;
#pragma unroll
                for (int q = 0; q < 4; ++q) v[u][q] = xr[64 * q];
                pe[u][0] = *((const f32x4*)(POS + gr * 256) + lane); pe[u][1] = *((const f32x4*)(POS + 64 * 256 + gr * 256) + lane);
                pe[u][2] = *((const f32x4*)(POS + gc * 256) + lane); pe[u][3] = *((const f32x4*)(POS + 64 * 256 + gc * 256) + lane);
            }
        }
#pragma unroll
        for (int u = 0; u < 4; ++u) {
            const int row = r0 + u * G * NWAVES;
            if (row < M) {
                const int j = cond_of_row(row);
                float ss = 0.f;
#pragma unroll
                for (int q = 0; q < 4; ++q) { v[u][q] = v[u][q] + pe[u][q]; ss += (v[u][q].x * v[u][q].x + v[u][q].y * v[u][q].y) + (v[u][q].z * v[u][q].z + v[u][q].w * v[u][q].w); }
                ss = wave_sum(ss);
                u32x2* xrow = (u32x2*)(XB + (size_t)row * D) + lane;
                u32x2* hrow = (u32x2*)(HB + (size_t)row * D) + lane;
#pragma unroll
                for (int q = 0; q < 4; ++q) {
                    u32x2 xb; xb.x = pk2(v[u][q].x, v[u][q].y); xb.y = pk2(v[u][q].z, v[u][q].w);
                    xrow[64 * q] = xb;
                    const f32x4 ng = *((const f32x4*)(a.in[I_NORMG] + 256 * q) + lane);
                    const f32x4 sc = *((const f32x4*)(MOD + (0 * 9 + j) * 3072 + 1024 + 256 * q) + lane);
                    u32x2 h; h.x = pk2(v[u][q].x * ng.x * (1.f + sc.x), v[u][q].y * ng.y * (1.f + sc.y)); h.y = pk2(v[u][q].z * ng.z * (1.f + sc.z), v[u][q].w * ng.w * (1.f + sc.w));
                    hrow[64 * q] = h;
                }
                if (lane < 16) RSS[(size_t)row * 16 + lane] = (lane == 0) ? ss : 0.f;
            }
        }
    }
}

__device__ __forceinline__ void phase_0c(const Args& a) {
    const int tid = otid(), lane = tid & 63, wave = tid >> 6, G = gridDim.x, bid = obid();
    const float* MOD = (const float*)(a.ws + WS_MOD);
    const bf16* W1T = (const bf16*)(a.ws + WS_W1T);
    float* SW = (float*)(a.ws + WS_SW);
    for (int it = bid * NWAVES + wave; it < 4 * N1; it += G * NWAVES) {
        const int l = it / N1, n = it % N1;
        const u32x4* wr = (const u32x4*)(W1T + ((size_t)l * N1 + n) * 1024) + lane * 2;
        const u32x4 w0 = wr[0], w1 = wr[1];
        float w[16];
        w[0] = bflo(w0.x); w[1] = bfhi(w0.x); w[2] = bflo(w0.y); w[3] = bfhi(w0.y); w[4] = bflo(w0.z); w[5] = bfhi(w0.z); w[6] = bflo(w0.w); w[7] = bfhi(w0.w);
        w[8] = bflo(w1.x); w[9] = bfhi(w1.x); w[10] = bflo(w1.y); w[11] = bfhi(w1.y); w[12] = bflo(w1.z); w[13] = bfhi(w1.z); w[14] = bflo(w1.w); w[15] = bfhi(w1.w);
#pragma unroll
        for (int j = 0; j < 9; ++j) {
            const f32x4* sp = (const f32x4*)(MOD + (l * 9 + j) * 3072) + lane * 4;
            float s = 0.f;
#pragma unroll
            for (int q = 0; q < 4; ++q) { const f32x4 sv = sp[q]; s += sv.x * w[4 * q] + sv.y * w[4 * q + 1] + sv.z * w[4 * q + 2] + sv.w * w[4 * q + 3]; }
            s = wave_sum(s);
            if (lane == 0) SW[(l * 9 + j) * N1 + n] = s;
        }
    }
}

struct Epi1 {
    static constexpr bool PERM = true;
    bf16* PB; float* BA; const float* RSS; const float* SW;
    int cheap; bf16* dumb;
    const LAS float* rtab;
    float* VSS;
    __device__ __forceinline__ void operator()(const f32x4 (&acc)[2][2][4][2], const pg8::Unit& u, int wr, int wc, int fr, int fq, int ui) const {
        const int pn = u.pn, j = u.pm < 32 ? 0 : 1 + ((u.pm - 32) >> 4);
        const int row0 = u.pm * 256 + wr * 64 + fr, cb = pn * 256 + wc * 32 + 8 * fq;
        if (cheap == 1) {
#pragma unroll
            for (int ai = 0; ai < 2; ++ai)
#pragma unroll
                for (int m = 0; m < 4; ++m)
#pragma unroll
                    for (int bj = 0; bj < 2; ++bj) { const f32x4 v0 = acc[ai][bj][m][0], v1 = acc[ai][bj][m][1];
                        u32x4 w; w.x = pk2(v0[0], v0[1]); w.y = pk2(v0[2], v0[3]); w.z = pk2(v1[0], v1[1]); w.w = pk2(v1[2], v1[3]);
                        *(u32x4*)(dumb + (size_t)((row0 + ai * 128 + m * 16) & 1023) * LDP + cb + bj * 128) = w; }
            return;
        }
        const int act = (pn == 0 || pn == 2 || pn == 3 || pn == 5) ? 1 : ((pn == 1 || pn == 4) ? 2 : 0);
        f32x4 bv[2][2];
#pragma unroll
        for (int bj = 0; bj < 2; ++bj)
#pragma unroll
            for (int n = 0; n < 2; ++n) bv[bj][n] = *(const f32x4*)(SW + j * N1 + cb + bj * 128 + 4 * n);
#pragma unroll
        for (int ai = 0; ai < 2; ++ai)
#pragma unroll
            for (int m = 0; m < 4; ++m) {
                const int row = row0 + ai * 128 + m * 16;
                const float rinv = rtab[ui * 256 + wr * 64 + fr + ai * 128 + m * 16];
                float vss = 0.f;
#pragma unroll
                for (int bj = 0; bj < 2; ++bj) {
                    f32x4 v0 = acc[ai][bj][m][0] * rinv + bv[bj][0], v1 = acc[ai][bj][m][1] * rinv + bv[bj][1];
                    if (pn < 12) {
                        if (act == 1) {
#pragma unroll
                            for (int q = 0; q < 4; ++q) { v0[q] = silu_f(v0[q]); v1[q] = silu_f(v1[q]); }
                        } else if (act == 2) {
#pragma unroll
                            for (int q = 0; q < 4; ++q) { v0[q] = gelu_tanh_f(v0[q]); v1[q] = gelu_tanh_f(v1[q]); }
                        }
                        u32x4 w; w.x = pk2(v0[0], v0[1]); w.y = pk2(v0[2], v0[3]); w.z = pk2(v1[0], v1[1]); w.w = pk2(v1[2], v1[3]);
                        if (pn == 4) vss += (v0[0] * v0[0] + v0[1] * v0[1]) + (v0[2] * v0[2] + v0[3] * v0[3]) + (v1[0] * v1[0] + v1[1] * v1[1]) + (v1[2] * v1[2] + v1[3] * v1[3]);
                        if ((pn == 7 || pn == 8) && u.pm >= 32 && !cheap) {
                            const int t = row - M_CTX, tq = t & 4095, sl = (wc * 32 + 8 * fq + bj * 128) >> 2;
                            bf16* dst = PB + (size_t)(M_CTX + (t & ~4095) + sl * 64 + (tq >> 6)) * LDP + C_PF + (tq & 63) * 8 + (pn == 8 ? 4 : 0);
                            u32x2 lo2, hi2; lo2.x = w.x; lo2.y = w.y; hi2.x = w.z; hi2.y = w.w;
                            *(u32x2*)dst = lo2; *(u32x2*)(dst + 64 * LDP) = hi2;
                        } else
                        *(u32x4*)((cheap ? dumb + (size_t)(row & 1023) * LDP : PB + (size_t)row * LDP) + cb + bj * 128) = w;
                    } else if (bj == 0 && wc == 0 && fq < 2) {
                        f32x4* bp = (f32x4*)(BA + (size_t)row * 16 + 8 * fq); bp[0] = v0; bp[1] = v1;
                    }
                }
                if (pn == 4) { vss += __shfl_xor(vss, 16); vss += __shfl_xor(vss, 32); if (fq == 0 && !cheap) VSS[(size_t)row * 4 + wc] = vss; }
            }
    }
};
struct Epi2 {
    static constexpr bool PERM = true;
    bf16* XB; bf16* HB; float* RSS; const float* gate;
    const float* ng_next; const float* sc_next;
    unsigned char* dum; int dry;
    __device__ __forceinline__ void operator()(const f32x4 (&acc)[2][2][4][2], const pg8::Unit& u, int wr, int wc, int fr, int fq, int) const {
        const int pn = u.pn, j = u.pm < 32 ? 0 : 1 + ((u.pm - 32) >> 4);
        const int row0 = u.pm * 256 + wr * 64 + fr, cb = pn * 256 + wc * 32 + 8 * fq;
        f32x4 gv[2][2], gs[2][2];
#pragma unroll
        for (int bj = 0; bj < 2; ++bj)
#pragma unroll
            for (int n = 0; n < 2; ++n) {
                gv[bj][n] = *(const f32x4*)(gate + j * 3072 + cb + bj * 128 + 4 * n);
                if (ng_next) { const f32x4 ng = *(const f32x4*)(ng_next + cb + bj * 128 + 4 * n), sc = *(const f32x4*)(sc_next + j * 3072 + cb + bj * 128 + 4 * n); gs[bj][n] = ng * (sc + 1.f); }
                else gs[bj][n] = (f32x4){0.f, 0.f, 0.f, 0.f};
            }
#pragma unroll
        for (int ai = 0; ai < 2; ++ai) {
            u32x4 xall[4][2];
#pragma unroll
            for (int m = 0; m < 4; ++m)
#pragma unroll
                for (int bj = 0; bj < 2; ++bj) xall[m][bj] = *(const u32x4*)(XB + (size_t)(row0 + ai * 128 + m * 16) * D + cb + bj * 128);
            asm volatile("" ::: "memory");
#pragma unroll
            for (int m = 0; m < 4; ++m) {
                const int row = row0 + ai * 128 + m * 16;
                float ssq = 0.f;
#pragma unroll
                for (int bj = 0; bj < 2; ++bj) {
                    const u32x4 xq = xall[m][bj];
                    const f32x4 x0 = (f32x4){bflo(xq.x), bfhi(xq.x), bflo(xq.y), bfhi(xq.y)}, x1 = (f32x4){bflo(xq.z), bfhi(xq.z), bflo(xq.w), bfhi(xq.w)};
                    const f32x4 n0 = x0 + gv[bj][0] * acc[ai][bj][m][0], n1 = x1 + gv[bj][1] * acc[ai][bj][m][1];
                    u32x4 xw; xw.x = pk2(n0[0], n0[1]); xw.y = pk2(n0[2], n0[3]); xw.z = pk2(n1[0], n1[1]); xw.w = pk2(n1[2], n1[3]);
                    *(u32x4*)((dry ? (bf16*)dum + (size_t)(row & 1023) * D : XB + (size_t)row * D) + cb + bj * 128) = xw;
                    ssq += (n0.x * n0.x + n0.y * n0.y) + (n0.z * n0.z + n0.w * n0.w) + (n1.x * n1.x + n1.y * n1.y) + (n1.z * n1.z + n1.w * n1.w);
                    if (ng_next) { const f32x4 h0 = n0 * gs[bj][0], h1 = n1 * gs[bj][1];
                        u32x4 w; w.x = pk2(h0[0], h0[1]); w.y = pk2(h0[2], h0[3]); w.z = pk2(h1[0], h1[1]); w.w = pk2(h1[2], h1[3]);
                        *(u32x4*)((dry ? (bf16*)(dum + 4 * MiB) + (size_t)(row & 1023) * D : HB + (size_t)row * D) + cb + bj * 128) = w; }
                }
                ssq += __shfl_xor(ssq, 16); ssq += __shfl_xor(ssq, 32);
                if (fq == 0) (dry ? (float*)(dum + 8 * MiB) + (size_t)(row & 1023) * 16 : RSS + (size_t)row * 16)[pn * 4 + wc] = ssq;
            }
        }
    }
};

typedef short bf16x4 __attribute__((ext_vector_type(4)));
__device__ __forceinline__ f32x4 mfma16(bf16x4 a, bf16x4 b, f32x4 c) { return __builtin_amdgcn_mfma_f32_16x16x16bf16_1k(a, b, c, 0, 0, 0); }
__device__ __forceinline__ bf16x4 pack4(f32x4 v) { u32x2 w; w.x = pk2(v[0], v[1]); w.y = pk2(v[2], v[3]); return __builtin_bit_cast(bf16x4, w); }
__device__ __forceinline__ bf16x8 pack8(f32x4 lo, f32x4 hi) { u32x4 w; w.x = pk2(lo[0], lo[1]); w.y = pk2(lo[2], lo[3]); w.z = pk2(hi[0], hi[1]); w.w = pk2(hi[2], hi[3]); return __builtin_bit_cast(bf16x8, w); }
constexpr int PREP_ITEM = 5 * 4096;

__device__ __forceinline__ void prep_dinv(const LAS bf16* Ab_, LAS bf16* Dl, int lane) {
    const int blk = lane >> 4, c = lane & 15;
    unsigned ab = (unsigned)(size_t)(Ab_ + (16 * blk) * 72 + 16 * blk);
    asm volatile("" : "+v"(ab));
    const LAS bf16* Ab = (const LAS bf16*)(size_t)ab;
    float x[16];
#pragma unroll
    for (int ii = 0; ii < 16; ++ii) {
        float acc = (ii == c) ? 1.f : 0.f;
        const LAS u32x4* ar = (const LAS u32x4*)(Ab + ii * 72);
#pragma unroll
        for (int jq = 0; jq < 2; ++jq) {
            if (8 * jq < ii) {
                const u32x4 av = ar[jq];
                if (8 * jq + 0 < ii) acc += bflo(av.x) * x[8 * jq + 0];
                if (8 * jq + 1 < ii) acc += bfhi(av.x) * x[8 * jq + 1];
                if (8 * jq + 2 < ii) acc += bflo(av.y) * x[8 * jq + 2];
                if (8 * jq + 3 < ii) acc += bfhi(av.y) * x[8 * jq + 3];
                if (8 * jq + 4 < ii) acc += bflo(av.z) * x[8 * jq + 4];
                if (8 * jq + 5 < ii) acc += bfhi(av.z) * x[8 * jq + 5];
                if (8 * jq + 6 < ii) acc += bflo(av.w) * x[8 * jq + 6];
                if (8 * jq + 7 < ii) acc += bfhi(av.w) * x[8 * jq + 7];
            }
        }
        asm volatile("" : "+v"(acc) :: "memory");
        x[ii] = acc;
    }
#pragma unroll
    for (int ii = 0; ii < 16; ++ii) Dl[(blk * 16 + ii) * 24 + c] = (bf16)f2bf(x[ii]);
}

struct PrepPre { u32x4 xr[7]; };
__device__ __forceinline__ void prep_prefetch(const Args& a, PrepPre& P, int sc, int h) {
    const int tid = otid();
    const bf16* PB = (const bf16*)(a.ws + WS_PB);
    const SeqGeo sg = seq_geo(sc);
    const int cg = tid % 24, seg = tid / 24, part = cg >> 3, d0 = (cg & 7) * 8;
    const int col = C_Q + (part < 3 ? part : 0) * 256 + h * 64 + d0;
#pragma unroll
    for (int i = 0; i < 7; ++i) { const int ts = sg.tseq0 + 4 * seg - 2 + i;
        P.xr[i] = (tid < 384 && ts >= 0 && ts < sg.T) ? *(const u32x4*)(PB + (size_t)(sg.seq_row0 + ts) * LDP + col) : (u32x4){0u, 0u, 0u, 0u}; }
}
__device__ __forceinline__ void prep_item(const Args& a, LAS unsigned char* lds, int l, int sc, int h, PrepPre& P, int nsc, int nh) {
    const int tid = otid(), lane = tid & 63, wave = __builtin_amdgcn_readfirstlane(tid >> 6);
    LAS float* qs = (LAS float*)lds;
    LAS float* ks = qs + 64 * 65;
    LAS float* vs = ks + 64 * 65;
    LAS bf16* Qb = (LAS bf16*)(lds + 49920);
    LAS bf16* Kb = (LAS bf16*)(lds + 59136);
    constexpr int PD = 30720;
    LAS unsigned char* dbase = lds + 68352;
    LAS float* beta = (LAS float*)(lds + 129792);
    LAS float* gcs = beta + 128;
    LAS float* egs = gcs + 128;
    LAS float* eks = egs + 128;
    const bf16* PB = (const bf16*)(a.ws + WS_PB);
    const float* BA = (const float*)(a.ws + WS_BA);
    const SeqGeo sg = seq_geo(sc);
    const int row0 = sc * 64;
    if (wave >= 6) {
        const int dir = wave - 6, tok = dir ? 63 - lane : lane;
        const float bl = BA[(size_t)(row0 + tok) * 16 + dir * 4 + h], al = BA[(size_t)(row0 + tok) * 16 + 8 + dir * 4 + h];
        const float bt = 1.f / (1.f + __expf(-bl));
        const float xx = al + a.in[I_DTB][(l * 2 + dir) * 4 + h];
        const float ex = __expf(xx);
        const float sp = xx > 20.f ? xx : (ex < 1e-2f ? ex * (1.f - ex * (0.5f - ex * (1.f / 3.f))) : __logf(1.f + ex));
        float g = -__expf(a.in[I_ALOG][(l * 2 + dir) * 4 + h]) * sp;
#pragma unroll
        for (int o = 1; o < 64; o <<= 1) { const float t = __shfl_up(g, o); if (lane >= o) g += t; }
        const float gl = __shfl(g, 63);
        beta[dir * 64 + lane] = bt; gcs[dir * 64 + lane] = g; egs[dir * 64 + lane] = __expf(g); eks[dir * 64 + lane] = __expf(gl - g);
        if (lane == 63) ((float*)(a.ws + WS_PGL))[(sc * 4 + h) * 2 + dir] = __expf(g);
    } else {
        const int cg = tid % 24, seg = tid / 24, part = cg >> 3, d0 = (cg & 7) * 8;
        const int chan = part * 256 + h * 64 + d0;
        u32x4 xr[7];
#pragma unroll
        for (int i = 0; i < 7; ++i) xr[i] = P.xr[i];
        f32x4 w0[4], w1[4];
#pragma unroll
        for (int jj = 0; jj < 4; ++jj) { w0[jj] = *(const f32x4*)(a.in[I_CONV] + (size_t)(l * 4 + jj) * 768 + chan); w1[jj] = *(const f32x4*)(a.in[I_CONV] + (size_t)(l * 4 + jj) * 768 + chan + 4); }
        float o[4][8];
#pragma unroll
        for (int j = 0; j < 4; ++j)
#pragma unroll
            for (int c = 0; c < 8; ++c) o[j][c] = 0.f;
#pragma unroll
        for (int i = 0; i < 7; ++i) {
            const float x0 = bflo(xr[i].x), x1 = bfhi(xr[i].x), x2 = bflo(xr[i].y), x3 = bfhi(xr[i].y), x4 = bflo(xr[i].z), x5 = bfhi(xr[i].z), x6 = bflo(xr[i].w), x7 = bfhi(xr[i].w);
#pragma unroll
            for (int j = 0; j < 4; ++j) { const int jj = i - j;
                if (jj >= 0 && jj < 4) {
                    o[j][0] += w0[jj].x * x0; o[j][1] += w0[jj].y * x1; o[j][2] += w0[jj].z * x2; o[j][3] += w0[jj].w * x3;
                    o[j][4] += w1[jj].x * x4; o[j][5] += w1[jj].y * x5; o[j][6] += w1[jj].z * x6; o[j][7] += w1[jj].w * x7; } }
        }
        LAS float* dst = (part == 0 ? qs : (part == 1 ? ks : vs)) + (4 * seg) * 65 + d0;
#pragma unroll
        for (int j = 0; j < 4; ++j)
#pragma unroll
            for (int c = 0; c < 8; ++c) dst[j * 65 + c] = silu_f(o[j][c]);
    }
    __syncthreads();
    {
        const int rowid = tid >> 2, seg = tid & 3, ar = rowid & 63;
        LAS float* p = (rowid < 64 ? qs : ks) + ar * 65 + seg * 16;
        float v[16]; float ss = 0.f;
#pragma unroll
        for (int c = 0; c < 16; ++c) { v[c] = p[c]; ss += v[c] * v[c]; }
        ss += __shfl_xor(ss, 1); ss += __shfl_xor(ss, 2);
        const float s = rsqrtf(ss + EPS) * (rowid < 64 ? 0.125f : 1.f);
#pragma unroll
        for (int c = 0; c < 16; ++c) { v[c] *= s; p[c] = v[c]; }
        LAS bf16* bp = (rowid < 64 ? Qb : Kb) + ar * 72 + seg * 16;
        u32x4 o0, o1; o0.x = pk2(v[0], v[1]); o0.y = pk2(v[2], v[3]); o0.z = pk2(v[4], v[5]); o0.w = pk2(v[6], v[7]);
        o1.x = pk2(v[8], v[9]); o1.y = pk2(v[10], v[11]); o1.z = pk2(v[12], v[13]); o1.w = pk2(v[14], v[15]);
        *(LAS u32x4*)bp = o0; *(LAS u32x4*)(bp + 8) = o1;
    }
    __syncthreads();
    {
        const int mt = wave >> 1, nh_ = wave & 1, m0 = mt * 16, r = lane & 15, kg = lane >> 4, arow = m0 + r;
#pragma unroll
        for (int t = 0; t < 2; ++t) {
            const int b0 = nh_ * 32 + 16 * t + 4 * kg;
            const f32x4 KKa = tile_mm<2>((f32x4){0.f, 0.f, 0.f, 0.f}, Kb, 72, nh_ * 32 + 16 * t, Kb, 72, m0, lane);
            const f32x4 QKa = tile_mm<2>((f32x4){0.f, 0.f, 0.f, 0.f}, Kb, 72, nh_ * 32 + 16 * t, Qb, 72, m0, lane);
#pragma unroll
            for (int dir = 0; dir < 2; ++dir) {
                LAS bf16* Ab = (LAS bf16*)(dbase + dir * PD); LAS bf16* QKl = Ab + 64 * 72;
                const int i = dir ? 63 - arow : arow;
                const float gi = gcs[dir * 64 + i], bi = beta[dir * 64 + i];
                float av[4], qv[4];
#pragma unroll
                for (int q = 0; q < 4; ++q) {
                    const int j = dir ? 63 - (b0 + q) : b0 + q;
                    const float dec = (i >= j) ? __expf(gi - gcs[dir * 64 + j]) : 0.f;
                    av[q] = (i > j) ? -bi * KKa[q] * dec : 0.f; qv[q] = QKa[q] * dec;
                }
                u32x2 aw, qw; const int j0 = dir ? 60 - b0 : b0;
                if (dir) { aw.x = pk2(av[3], av[2]); aw.y = pk2(av[1], av[0]); qw.x = pk2(qv[3], qv[2]); qw.y = pk2(qv[1], qv[0]); }
                else { aw.x = pk2(av[0], av[1]); aw.y = pk2(av[2], av[3]); qw.x = pk2(qv[0], qv[1]); qw.y = pk2(qv[2], qv[3]); }
                *(LAS u32x2*)(Ab + i * 72 + j0) = aw; *(LAS u32x2*)(QKl + i * 72 + j0) = qw;
            }
        }
    }
    __syncthreads();
    if (nsc >= 0) prep_prefetch(a, P, nsc, nh);
    bf16* PI0 = (bf16*)(a.ws + WS_PREP) + (size_t)((sc * 4 + h) * 2) * PREP_ITEM;
    if (wave < 2) prep_dinv((const LAS bf16*)(dbase + wave * PD), (LAS bf16*)(dbase + wave * PD + 3 * 9216), lane);
    for (int t = tid; t < 2048; t += NTHR) {
        const int dir = t >> 10, which = (t >> 9) & 1, rw = (t >> 3) & 63, sgp = t & 7, n0a = 32 * (sgp >> 2) + 4 * (sgp & 3), n0b = n0a + 16;
        float v[8];
        if (which == 0) {
            const int tok = dir ? 63 - rw : rw; const float e = egs[dir * 64 + rw];
#pragma unroll
            for (int c = 0; c < 4; ++c) { v[c] = qs[tok * 65 + n0a + c] * e; v[4 + c] = qs[tok * 65 + n0b + c] * e; }
        } else {
#pragma unroll
            for (int c = 0; c < 4; ++c) { const int ia = n0a + c, ib = n0b + c;
                v[c] = ks[(dir ? 63 - ia : ia) * 65 + rw] * eks[dir * 64 + ia]; v[4 + c] = ks[(dir ? 63 - ib : ib) * 65 + rw] * eks[dir * 64 + ib]; }
        }
        u32x4 o; o.x = pk2(v[0], v[1]); o.y = pk2(v[2], v[3]); o.z = pk2(v[4], v[5]); o.w = pk2(v[6], v[7]);
        *(u32x4*)(PI0 + (size_t)dir * PREP_ITEM + (1 + which) * 4096 + rw * 64 + sgp * 8) = o;
    }
    __syncthreads();
    {
        const int dir = wave >> 2, r = lane & 15, kg = lane >> 4, cc = 16 * (wave & 3) + r;
        const LAS bf16* Ab = (const LAS bf16*)(dbase + dir * PD); LAS bf16* Wl = (LAS bf16*)(dbase + dir * PD + 2 * 9216); const LAS bf16* Dl = (const LAS bf16*)(dbase + dir * PD + 3 * 9216);
        bf16* PI = PI0 + (size_t)dir * PREP_ITEM;
        f32x4 XU[4], XW[4];
#pragma unroll
        for (int b = 0; b < 4; ++b) {
            f32x4 TU, TW_;
#pragma unroll
            for (int q = 0; q < 4; ++q) { const int i = 16 * b + 4 * kg + q, tok = dir ? 63 - i : i;
                const float bt = beta[dir * 64 + i];
                TU[q] = bt * vs[tok * 65 + cc]; TW_[q] = bt * egs[dir * 64 + i] * ks[tok * 65 + cc]; }
#pragma unroll
            for (int m = 0; m < 4; ++m) if (m < b) {
                const bf16x4 af = *(const LAS bf16x4*)(Ab + (16 * b + r) * 72 + 16 * m + 4 * kg);
                TU = mfma16(af, pack4(XU[m]), TU); TW_ = mfma16(af, pack4(XW[m]), TW_);
            }
            const bf16x4 df = *(const LAS bf16x4*)(Dl + (b * 16 + r) * 24 + 4 * kg);
            XU[b] = mfma16(df, pack4(TU), (f32x4){0.f, 0.f, 0.f, 0.f});
            XW[b] = mfma16(df, pack4(TW_), (f32x4){0.f, 0.f, 0.f, 0.f});
            *(u32x2*)(PI + 4 * 4096 + cc * 64 + 16 * b + 4 * kg) = __builtin_bit_cast(u32x2, pack4(XU[b]));
#pragma unroll
            for (int q = 0; q < 4; ++q) Wl[(16 * b + 4 * kg + q) * 72 + cc] = (bf16)f2bf(XW[b][q]);
        }
    }
    __syncthreads();
    for (int t = tid; t < 2048; t += NTHR) {
        const int dir = t >> 10, which = (t >> 9) & 1, rw = (t >> 3) & 63, sgp = t & 7, n0a = 32 * (sgp >> 2) + 4 * (sgp & 3);
        const LAS bf16* src = (const LAS bf16*)(dbase + dir * PD + (which ? 1 : 2) * 9216) + rw * 72 + n0a;
        const u32x2 lo = *(const LAS u32x2*)src, hi = *(const LAS u32x2*)(src + 16);
        u32x4 o; o.x = lo.x; o.y = lo.y; o.z = hi.x; o.w = hi.y;
        *(u32x4*)(PI0 + (size_t)dir * PREP_ITEM + (which ? 3 : 0) * 4096 + rw * 64 + sgp * 8) = o;
    }
    __syncthreads();
}

__device__ __forceinline__ void sgu_item(const Args& a, LAS unsigned char* lds, int l, int ch, int g, int dry, bool w_cached) {
    const int tid = otid(), lane = tid & 63, wave = tid >> 6;
    LAS bf16* Wl = (LAS bf16*)lds;
    LAS bf16* VT = Wl + 128 * 136;
    LAS float* rstd = (LAS float*)(VT + 64 * 136);
    LAS float* SV = rstd + 128;
    bf16* PB = (bf16*)(a.ws + WS_PB);
    const int row0 = ch * 128;
    u32x4 vv[2], uu[2], gg[2];
#pragma unroll
    for (int i = 0; i < 2; ++i) { const int t = tid + NTHR * i, q = t >> 3, c0 = (t & 7) * 8; const bf16* rp = PB + (size_t)(row0 + q) * LDP + g * 64 + c0;
        vv[i] = *(const u32x4*)(rp + C_V); uu[i] = *(const u32x4*)(rp + C_U); gg[i] = *(const u32x4*)(rp + C_GB); }
    const int c0t = (tid & 7) * 8;
    const f32x4 g0 = *(const f32x4*)(a.in[I_SGUNG] + l * 256 + g * 64 + c0t), g1 = *(const f32x4*)(a.in[I_SGUNG] + l * 256 + g * 64 + c0t + 4);
    if (tid < 128) {
        const f32x4 p = *(const f32x4*)((const float*)(a.ws + WS_VSS) + (size_t)(row0 + tid) * 4);
        rstd[tid] = rsqrtf(((p.x + p.y) + (p.z + p.w)) * (1.f / 256.f) + EPS);
    }
    if (!w_cached)
    for (int t = tid; t < 128 * 16; t += NTHR) {
        const int p = t >> 4, q8 = t & 15;
        const f32x4* wp = (const f32x4*)(a.in[I_SGUW] + ((size_t)(l * 4 + g) * 128 + p) * 128 + q8 * 8);
        const f32x4 w0 = wp[0], w1 = wp[1];
        u32x4 o; o.x = pk2(w0.x, w0.y); o.y = pk2(w0.z, w0.w); o.z = pk2(w1.x, w1.y); o.w = pk2(w1.z, w1.w);
        *(LAS u32x4*)(Wl + p * 136 + q8 * 8) = o;
    }
    __syncthreads();
#pragma unroll
    for (int i = 0; i < 2; ++i) {
        const int t = tid + NTHR * i, q = t >> 3, c0 = (t & 7) * 8;
        const float r = rstd[q]; const u32x4 v = vv[i];
        LAS bf16* dst = VT + c0 * 136 + ((((q >> 3) ^ (c0 >> 3)) << 3) | (q & 7));
        dst[0 * 136] = (bf16)f2bf(bflo(v.x) * r * g0.x); dst[1 * 136] = (bf16)f2bf(bfhi(v.x) * r * g0.y);
        dst[2 * 136] = (bf16)f2bf(bflo(v.y) * r * g0.z); dst[3 * 136] = (bf16)f2bf(bfhi(v.y) * r * g0.w);
        dst[4 * 136] = (bf16)f2bf(bflo(v.z) * r * g1.x); dst[5 * 136] = (bf16)f2bf(bfhi(v.z) * r * g1.y);
        dst[6 * 136] = (bf16)f2bf(bflo(v.w) * r * g1.z); dst[7 * 136] = (bf16)f2bf(bfhi(v.w) * r * g1.w);
    }
    __syncthreads();
    {
        const int m0 = wave * 16, r = lane & 15, kg = lane >> 4;
        bf16x8 af[4];
#pragma unroll
        for (int ksx = 0; ksx < 4; ++ksx) af[ksx] = *(const LAS bf16x8*)(Wl + (m0 + r) * 136 + ksx * 32 + kg * 8);
#pragma unroll
        for (int nt = 0; nt < 4; ++nt) {
            f32x4 acc = (f32x4){0.f, 0.f, 0.f, 0.f};
#pragma unroll
            for (int ksx = 0; ksx < 4; ++ksx) {
                const int cr = nt * 16 + r;
                const bf16x8 bfr = *(const LAS bf16x8*)(VT + cr * 136 + (((ksx * 4 + kg) ^ (cr >> 3)) << 3));
                acc = __builtin_amdgcn_mfma_f32_16x16x32_bf16(af[ksx], bfr, acc, 0, 0, 0);
            }
#pragma unroll
            for (int q = 0; q < 4; ++q) SV[(m0 + 4 * kg + q) * 68 + nt * 16 + r] = acc[q];
        }
    }
    __syncthreads();
#pragma unroll
    for (int i = 0; i < 2; ++i) {
        const int t = tid + NTHR * i, p = t >> 3, c0 = (t & 7) * 8;
        const f32x4 s0 = *(const LAS f32x4*)(SV + p * 68 + c0), s1 = *(const LAS f32x4*)(SV + p * 68 + c0 + 4);
        const float b = a.in[I_SGUB][(l * 4 + g) * 128 + p];
        u32x4 o;
        o.x = pk2(bflo(uu[i].x) * (s0.x + b) * bflo(gg[i].x), bfhi(uu[i].x) * (s0.y + b) * bfhi(gg[i].x));
        o.y = pk2(bflo(uu[i].y) * (s0.z + b) * bflo(gg[i].y), bfhi(uu[i].y) * (s0.w + b) * bfhi(gg[i].y));
        o.z = pk2(bflo(uu[i].z) * (s1.x + b) * bflo(gg[i].z), bfhi(uu[i].z) * (s1.y + b) * bfhi(gg[i].z));
        o.w = pk2(bflo(uu[i].w) * (s1.z + b) * bflo(gg[i].w), bfhi(uu[i].w) * (s1.w + b) * bfhi(gg[i].w));
        *(u32x4*)((dry ? (bf16*)(a.ws + WS_DUM) + (size_t)((row0 + p) & 1023) * LDP : PB + (size_t)(row0 + p) * LDP) + C_U + g * 64 + c0) = o;
    }
    __syncthreads();
}

__device__ __forceinline__ void pool_item(const Args& a, LAS unsigned char* lds, int l, int sc, int dry) {
    const int tid = otid();
    LAS bf16* xt = (LAS bf16*)lds;
    bf16* PB = (bf16*)(a.ws + WS_PB);
    const SeqGeo sg = seq_geo(sc);
    u32x4 gpre[4];
#pragma unroll
    for (int i = 0; i < 4; ++i) { const int t = tid + NTHR * i, tok = t >> 5, c8 = t & 31; gpre[i] = *(const u32x4*)(PB + (size_t)(sg.seq_row0 + sg.tseq0 + tok) * LDP + C_GC + c8 * 8); }
    for (int t = tid; t < 80 * 32; t += NTHR) {
        const int r = t >> 5, c8 = t & 31, ts = sg.tseq0 - 8 + r;
        u32x4 v = (u32x4){0u, 0u, 0u, 0u};
        if (ts >= 0 && ts < sg.T) v = *(const u32x4*)(PB + (size_t)(sg.seq_row0 + ts) * LDP + C_XC + c8 * 8);
        *(LAS u32x4*)(xt + r * 264 + c8 * 8) = v;
    }
    __syncthreads();
#pragma unroll
    for (int i4 = 0; i4 < 4; ++i4) {
        const int t = tid + NTHR * i4;
        const int tok = t >> 5, c8 = t & 31, gi = c8 >> 3, half = 1 << gi;
        const int ts = sg.tseq0 + tok;
        const int lo = (ts - half) < 0 ? 0 : ts - half, hi = (ts + half) > sg.T ? sg.T : ts + half;
        float s[8];
#pragma unroll
        for (int c = 0; c < 8; ++c) s[c] = 0.f;
        for (int tt = lo; tt < hi; ++tt) {
            const u32x4 v = *(const LAS u32x4*)(xt + (tt - sg.tseq0 + 8) * 264 + c8 * 8);
            s[0] += bflo(v.x); s[1] += bfhi(v.x); s[2] += bflo(v.y); s[3] += bfhi(v.y); s[4] += bflo(v.z); s[5] += bfhi(v.z); s[6] += bflo(v.w); s[7] += bfhi(v.w);
        }
        const float inv = 1.f / (float)(hi - lo);
        const u32x4 xv = *(const LAS u32x4*)(xt + (tok + 8) * 264 + c8 * 8);
        const float x0[8] = {bflo(xv.x), bfhi(xv.x), bflo(xv.y), bfhi(xv.y), bflo(xv.z), bfhi(xv.z), bflo(xv.w), bfhi(xv.w)};
        bf16* yp = PB + (size_t)(sg.seq_row0 + ts) * LDP + C_GC + c8 * 8;
        const u32x4 gv = gpre[i4];
        const float gg[8] = {bflo(gv.x), bfhi(gv.x), bflo(gv.y), bfhi(gv.y), bflo(gv.z), bfhi(gv.z), bflo(gv.w), bfhi(gv.w)};
        const f32x4 p0 = *(const f32x4*)(a.in[I_POOLS] + l * 256 + c8 * 8), p1 = *(const f32x4*)(a.in[I_POOLS] + l * 256 + c8 * 8 + 4);
        const float ps[8] = {p0.x, p0.y, p0.z, p0.w, p1.x, p1.y, p1.z, p1.w};
        float y[8];
#pragma unroll
        for (int c = 0; c < 8; ++c) y[c] = (s[c] * inv - x0[c]) * ps[c] * gg[c];
        u32x4 o; o.x = pk2(y[0], y[1]); o.y = pk2(y[2], y[3]); o.z = pk2(y[4], y[5]); o.w = pk2(y[6], y[7]);
        if (dry) yp = (bf16*)(a.ws + WS_DUM) + (size_t)((sg.seq_row0 + ts) & 1023) * LDP + C_GC + c8 * 8;
        *(u32x4*)yp = o;
    }
    __syncthreads();
}

__device__ __forceinline__ void fctx_item(const Args& a, LAS unsigned char* lds, int b, int dblk, int dry) {
    const int tid = otid(), lane = tid & 63, wave = __builtin_amdgcn_readfirstlane(tid >> 6);
    LAS bf16* ZT = (LAS bf16*)lds;
    bf16* PB = (bf16*)(a.ws + WS_PB);
    const bf16* DFT = (const bf16*)(a.ws + WS_DFT);
    {
        u32x4 v[8];
#pragma unroll
        for (int i = 0; i < 8; ++i) { const int t = tid + NTHR * i, d8 = t & 7, ri = (t >> 3) & 1, tt = t >> 4;
            v[i] = *(const u32x4*)(PB + (size_t)(b * 256 + tt) * LDP + (ri ? C_QF : C_PF) + dblk * 64 + d8 * 8); }
#pragma unroll
        for (int i = 0; i < 8; ++i) { const int t = tid + NTHR * i, d8 = t & 7, ri = (t >> 3) & 1, tt = t >> 4;
            const int col = ri * 256 + tt;
            LAS bf16* dst = ZT + (d8 * 8) * 520 + ((((col >> 3) ^ d8) << 3) | (col & 7));
            dst[0 * 520] = (bf16)(v[i].x & 0xffffu); dst[1 * 520] = (bf16)(v[i].x >> 16); dst[2 * 520] = (bf16)(v[i].y & 0xffffu); dst[3 * 520] = (bf16)(v[i].y >> 16);
            dst[4 * 520] = (bf16)(v[i].z & 0xffffu); dst[5 * 520] = (bf16)(v[i].z >> 16); dst[6 * 520] = (bf16)(v[i].w & 0xffffu); dst[7 * 520] = (bf16)(v[i].w >> 16); }
    }
    __syncthreads();
    const int r = lane & 15, kg = lane >> 4;
#pragma unroll 1
    for (int mi = 0; mi < 2; ++mi) {
        const int m0 = wave * 32 + mi * 16;
        bf16 gdv[4][4];
#pragma unroll
        for (int nt = 0; nt < 4; ++nt)
#pragma unroll
            for (int q = 0; q < 4; ++q) gdv[nt][q] = PB[(size_t)(b * 256 + m0 + 4 * kg + q) * LDP + C_GD + dblk * 64 + nt * 16 + r];
        f32x4 acc[4];
#pragma unroll
        for (int nt = 0; nt < 4; ++nt) acc[nt] = (f32x4){0.f, 0.f, 0.f, 0.f};
#pragma unroll
        for (int kh = 0; kh < 2; ++kh) {
            bf16x8 af[8];
#pragma unroll
            for (int ksx = 0; ksx < 8; ++ksx) af[ksx] = *(const bf16x8*)(DFT + (size_t)(m0 + r) * 512 + (kh * 8 + ksx) * 32 + kg * 8);
#pragma unroll
            for (int nt = 0; nt < 4; ++nt) {
#pragma unroll
                for (int ksx = 0; ksx < 8; ++ksx) {
                    const bf16x8 bfr = *(const LAS bf16x8*)(ZT + (nt * 16 + r) * 520 + (((((kh * 8 + ksx) * 4 + kg)) ^ (((nt * 16 + r) >> 3) & 7)) << 3));
                    acc[nt] = __builtin_amdgcn_mfma_f32_16x16x32_bf16(af[ksx], bfr, acc[nt], 0, 0, 0);
                }
                __builtin_amdgcn_sched_barrier(0);
            }
        }
#pragma unroll
        for (int nt = 0; nt < 4; ++nt)
#pragma unroll
            for (int q = 0; q < 4; ++q) {
                const int k = m0 + 4 * kg + q, d = nt * 16 + r;
                bf16* yp = (dry ? (bf16*)(a.ws + WS_DUM) + (size_t)((b * 256 + k) & 1023) * LDP : PB + (size_t)(b * 256 + k) * LDP) + C_GD + dblk * 64 + d;
                *yp = (bf16)f2bf(acc[nt][q] * bf2f(gdv[nt][q]));
            }
    }
    __syncthreads();
}

__device__ __forceinline__ void fsmp_item(const Args& a, LAS unsigned char* lds, int b, int ds, int dry) {
    const int tid = otid(), lane = tid & 63, wave = __builtin_amdgcn_readfirstlane(tid >> 6);
    LAS bf16* ZT = (LAS bf16*)lds;
    LAS bf16* B2 = ZT + 256 * 136;
    bf16* PB = (bf16*)(a.ws + WS_PB);
    const bf16* M1 = (const bf16*)(a.ws + WS_M1);
    const bf16* M2 = (const bf16*)(a.ws + WS_M2);
    const int d0 = ds * 4;
    const size_t rowb = (size_t)M_CTX + (size_t)b * 4096;
    const int r = lane & 15, kg = lane >> 4, mp = wave & 3, nb = wave >> 2;
    {
        u32x4 v[8];
#pragma unroll
        for (int i = 0; i < 8; ++i) { const int tt = tid + NTHR * i;
            v[i] = *(const u32x4*)(PB + (rowb + ds * 64 + (tt >> 6)) * LDP + C_PF + (tt & 63) * 8); }
#pragma unroll
        for (int i = 0; i < 8; ++i) { const int tt = tid + NTHR * i, t1 = tt >> 6, t2 = tt & 63;
            const int sw = t2 & 15;
            LAS bf16* dp = ZT + (t2 * 4) * 136 + ((((t1 >> 3) ^ sw) << 3) | (t1 & 7));
            LAS bf16* dq = ZT + (t2 * 4) * 136 + ((((8 + (t1 >> 3)) ^ sw) << 3) | (t1 & 7));
            dp[0] = (bf16)(v[i].x & 0xffffu); dp[136] = (bf16)(v[i].x >> 16); dp[272] = (bf16)(v[i].y & 0xffffu); dp[408] = (bf16)(v[i].y >> 16);
            dq[0] = (bf16)(v[i].z & 0xffffu); dq[136] = (bf16)(v[i].z >> 16); dq[272] = (bf16)(v[i].w & 0xffffu); dq[408] = (bf16)(v[i].w >> 16); }
    }
    bf16x8 aRe[4], aIm[4], a2[4];
#pragma unroll
    for (int ksx = 0; ksx < 4; ++ksx) {
        aRe[ksx] = *(const bf16x8*)(M1 + (16 * mp + r) * 128 + ksx * 32 + kg * 8);
        aIm[ksx] = *(const bf16x8*)(M1 + (64 + 16 * mp + r) * 128 + ksx * 32 + kg * 8);
        a2[ksx] = *(const bf16x8*)(M2 + (16 * mp + r) * 128 + ksx * 32 + kg * 8);
    }
    __syncthreads();
#pragma unroll 2
    for (int jb = 0; jb < 8; ++jb) {
        const int nt = nb + 2 * jb;
        f32x4 ar = (f32x4){0.f, 0.f, 0.f, 0.f}, ai = (f32x4){0.f, 0.f, 0.f, 0.f};
#pragma unroll
        for (int ksx = 0; ksx < 4; ++ksx) {
            const bf16x8 z = *(const LAS bf16x8*)(ZT + (16 * nt + r) * 136 + (((ksx * 4 + kg) ^ (((16 * nt + r) >> 2) & 15)) << 3));
            ar = __builtin_amdgcn_mfma_f32_16x16x32_bf16(aRe[ksx], z, ar, 0, 0, 0);
            ai = __builtin_amdgcn_mfma_f32_16x16x32_bf16(aIm[ksx], z, ai, 0, 0, 0);
        }
        const int n = 16 * nt + r, t2 = n >> 2, dd = n & 3;
#pragma unroll
        for (int q = 0; q < 4; ++q) {
            const int k1 = 16 * mp + 4 * kg + q;
            const float rev = (float)((k1 * t2) & 4095) * (1.f / 4096.f);
            const float cw = __builtin_amdgcn_cosf(rev), sw = __builtin_amdgcn_sinf(rev);
            const float xr = ar[q] * cw - ai[q] * sw, xi = ar[q] * sw + ai[q] * cw;
            B2[(k1 * 4 + dd) * 136 + ((((t2 >> 3) ^ (k1 & 15)) << 3) | (t2 & 7))] = (bf16)f2bf(xr);
            B2[(k1 * 4 + dd) * 136 + ((((8 + (t2 >> 3)) ^ (k1 & 15)) << 3) | (t2 & 7))] = (bf16)f2bf(xi);
        }
    }
    __syncthreads();
#pragma unroll 2
    for (int jb = 0; jb < 8; ++jb) {
        const int nt = nb + 2 * jb;
        f32x4 acc = (f32x4){0.f, 0.f, 0.f, 0.f};
#pragma unroll
        for (int ksx = 0; ksx < 4; ++ksx) {
            const bf16x8 z = *(const LAS bf16x8*)(B2 + (16 * nt + r) * 136 + (((ksx * 4 + kg) ^ (((16 * nt + r) >> 2) & 15)) << 3));
            acc = __builtin_amdgcn_mfma_f32_16x16x32_bf16(a2[ksx], z, acc, 0, 0, 0);
        }
#pragma unroll
        for (int q = 0; q < 4; ++q) ZT[(16 * mp + 4 * kg + q) * 264 + 16 * nt + r] = (bf16)f2bf(acc[q]);
    }
    __syncthreads();
#pragma unroll
    for (int i = 0; i < 4; ++i) { const int ch = tid + NTHR * i, k2 = ch >> 5, c16 = ch & 31;
        const u32x4 v = *(const LAS u32x4*)(ZT + k2 * 264 + c16 * 8);
        *(u32x4*)((dry ? (bf16*)(a.ws + WS_DUM) + (size_t)((ds * 64 + k2) & 1023) * LDP : PB + (rowb + ds * 64 + k2) * LDP) + C_PF + c16 * 8) = v; }
    __syncthreads();
}

__device__ __forceinline__ void ffin_item(const Args& a, LAS unsigned char* lds, int b, int tr) {
    const int tid = otid();
    LAS bf16* FL = (LAS bf16*)lds;
    bf16* PB = (bf16*)(a.ws + WS_PB);
    const size_t rowb = (size_t)M_CTX + (size_t)b * 4096;
    u32x4 gv[4];
#pragma unroll
    for (int i = 0; i < 4; ++i) { const int t = tid + NTHR * i, tl = t >> 5, c8 = t & 31; gv[i] = *(const u32x4*)(PB + (rowb + tr * 64 + tl) * LDP + C_GD + c8 * 8); }
#pragma unroll
    for (int i = 0; i < 4; ++i) { const int ch = tid + NTHR * i, sl = ch >> 5, c16 = ch & 31;
        *(LAS u32x4*)(FL + sl * 264 + c16 * 8) = *(const u32x4*)(PB + (rowb + sl * 64 + tr) * LDP + C_PF + c16 * 8); }
    __syncthreads();
#pragma unroll
    for (int i = 0; i < 4; ++i) { const int t = tid + NTHR * i, tl = t >> 5, c8 = t & 31;
        const u32x2 f0 = *(const LAS u32x2*)(FL + (2 * c8) * 264 + tl * 4), f1 = *(const LAS u32x2*)(FL + (2 * c8 + 1) * 264 + tl * 4);
        u32x4 o; o.x = pk2(bflo(f0.x) * bflo(gv[i].x), bfhi(f0.x) * bfhi(gv[i].x)); o.y = pk2(bflo(f0.y) * bflo(gv[i].y), bfhi(f0.y) * bfhi(gv[i].y));
        o.z = pk2(bflo(f1.x) * bflo(gv[i].z), bfhi(f1.x) * bfhi(gv[i].z)); o.w = pk2(bflo(f1.y) * bflo(gv[i].w), bfhi(f1.y) * bfhi(gv[i].w));
        *(u32x4*)(PB + (rowb + tr * 64 + tl) * LDP + C_GD + c8 * 8) = o; }
    __syncthreads();
}

constexpr int SC_MAT = 64 * 72 * 2;
constexpr int SC_BUF = 5 * SC_MAT + 16;
constexpr int SC_OT = 2 * SC_BUF;
__device__ __forceinline__ void scan_item(const Args& a, LAS unsigned char* lds, int l, int seq, int h, int dir) {
    const int tid = otid(), lane = tid & 63, wave = __builtin_amdgcn_readfirstlane(tid >> 6);
    bf16* PB = (bf16*)(a.ws + WS_PB);
    const int nch = seq < 32 ? 4 : 64;
    const int sc0 = seq < 32 ? seq * 4 : 128 + (seq - 32) * 64;
    const int r = lane & 15, kg = lane >> 4;
    if (wave >= 4) {
        const int ht = tid - 256;
        constexpr int PD_ = 4;
        u32x4 pre[PD_][10]; float pgl[PD_];
#define SC_ISSUE(set, ss) do { const int s_ = (ss) < nch ? (ss) : nch - 1; const int c_ = dir ? nch - 1 - s_ : s_; const size_t pid_ = (size_t)((sc0 + c_) * 4 + h) * 2 + dir; \
            const u32x4* src_ = (const u32x4*)((const bf16*)(a.ws + WS_PREP) + pid_ * PREP_ITEM) + ht; \
            _Pragma("unroll") for (int i_ = 0; i_ < 10; ++i_) pre[set][i_] = src_[256 * i_]; \
            pgl[set] = ((const float*)(a.ws + WS_PGL))[pid_]; } while (0)
#define SC_WRITE(set, bb) do { LAS unsigned char* B_ = lds + (bb) * SC_BUF; \
            _Pragma("unroll") for (int i_ = 0; i_ < 10; ++i_) { const int ch_ = ht + 256 * i_; \
                *(LAS u32x4*)(B_ + (ch_ >> 9) * SC_MAT + ((ch_ >> 3) & 63) * 144 + (ch_ & 7) * 16) = pre[set][i_]; } \
            if (ht == 0) *(LAS float*)(B_ + 5 * SC_MAT) = pgl[set]; } while (0)
#define SC_OSTORE(ss) do { const int c_ = dir ? nch - 1 - (ss) : (ss); const LAS unsigned char* O_ = lds + SC_OT + ((ss) & 1) * SC_MAT; \
            _Pragma("unroll") for (int i_ = 0; i_ < 2; ++i_) { const int ch_ = ht + 256 * i_, rw_ = ch_ >> 3, c8_ = ch_ & 7; \
                const u32x4 v_ = *(const LAS u32x4*)(O_ + rw_ * 144 + c8_ * 16); \
                *(u32x4*)(PB + (size_t)((sc0 + c_) * 64 + (dir ? 63 - rw_ : rw_)) * LDP + (dir ? C_K : C_Q) + h * 64 + c8_ * 8) = v_; } } while (0)
        SC_ISSUE(0, 0); SC_ISSUE(1, 1); SC_ISSUE(2, 2); SC_ISSUE(3, 3);
        SC_WRITE(0, 0);
        SC_ISSUE(0, 4);
        __syncthreads();
#pragma unroll 1
        for (int s0 = 0; s0 < nch; s0 += 4) {
#pragma unroll
            for (int j = 0; j < 4; ++j) {
                const int s = s0 + j;
                SC_WRITE((j + 1) & 3, (s + 1) & 1);
                if (s > 0) SC_OSTORE(s - 1);
                SC_ISSUE((j + 1) & 3, s + 5);
                __syncthreads();
            }
        }
        SC_OSTORE(nch - 1);
#undef SC_ISSUE
#undef SC_WRITE
#undef SC_OSTORE
    } else {
        const int e = 16 * wave + r;
        f32x4 S[4];
#pragma unroll
        for (int t = 0; t < 4; ++t)
#pragma unroll
            for (int q = 0; q < 4; ++q) {
                const int d = 16 * t + 4 * kg + q;
                S[t][q] = (seq < 32) ? 0.f : a.in[I_STATE][((size_t)(((seq - 32) * 4 + l) * 2 + dir) * 4 + h) * 4096 + d * 64 + e];
            }
        __syncthreads();
#pragma unroll 1
        for (int s = 0; s < nch; ++s) {
            const LAS unsigned char* B = lds + (s & 1) * SC_BUF;
            const LAS bf16* Wm = (const LAS bf16*)B; const LAS bf16* Qd = Wm + 64 * 72; const LAS bf16* KdT = Qd + 64 * 72; const LAS bf16* QKm = KdT + 64 * 72; const LAS bf16* UT = QKm + 64 * 72;
            const float egl = *(const LAS float*)(B + 5 * SC_MAT);
            LAS bf16* OT = (LAS bf16*)(lds + SC_OT + (s & 1) * SC_MAT);
            bf16x8 bS[2];
            bS[0] = pack8(S[0], S[1]); bS[1] = pack8(S[2], S[3]);
            f32x4 a1[4], oo[4];
#pragma unroll
            for (int t = 0; t < 4; ++t) {
                a1[t] = (f32x4){0.f, 0.f, 0.f, 0.f}; oo[t] = (f32x4){0.f, 0.f, 0.f, 0.f};
#pragma unroll
                for (int ksx = 0; ksx < 2; ++ksx) {
                    const bf16x8 wf = *(const LAS bf16x8*)(Wm + (16 * t + r) * 72 + ksx * 32 + kg * 8);
                    const bf16x8 qf = *(const LAS bf16x8*)(Qd + (16 * t + r) * 72 + ksx * 32 + kg * 8);
                    a1[t] = __builtin_amdgcn_mfma_f32_16x16x32_bf16(wf, bS[ksx], a1[t], 0, 0, 0);
                    oo[t] = __builtin_amdgcn_mfma_f32_16x16x32_bf16(qf, bS[ksx], oo[t], 0, 0, 0);
                }
            }
            f32x4 vn[4];
#pragma unroll
            for (int t = 0; t < 4; ++t) {
                const u32x2 uu = *(const LAS u32x2*)(UT + e * 72 + 16 * t + 4 * kg);
                vn[t][0] = bflo(uu.x) - a1[t][0]; vn[t][1] = bfhi(uu.x) - a1[t][1]; vn[t][2] = bflo(uu.y) - a1[t][2]; vn[t][3] = bfhi(uu.y) - a1[t][3];
            }
            bf16x8 bV[2];
            bV[0] = pack8(vn[0], vn[1]); bV[1] = pack8(vn[2], vn[3]);
#pragma unroll
            for (int t = 0; t < 4; ++t) {
                f32x4 as = (f32x4){0.f, 0.f, 0.f, 0.f};
#pragma unroll
                for (int ksx = 0; ksx < 2; ++ksx) {
                    const bf16x8 kf = *(const LAS bf16x8*)(QKm + (16 * t + r) * 72 + ksx * 32 + kg * 8);
                    const bf16x8 df = *(const LAS bf16x8*)(KdT + (16 * t + r) * 72 + ksx * 32 + kg * 8);
                    oo[t] = __builtin_amdgcn_mfma_f32_16x16x32_bf16(kf, bV[ksx], oo[t], 0, 0, 0);
                    as = __builtin_amdgcn_mfma_f32_16x16x32_bf16(df, bV[ksx], as, 0, 0, 0);
                }
                S[t] = S[t] * egl + as;
            }
#pragma unroll
            for (int t = 0; t < 4; ++t)
#pragma unroll
                for (int q = 0; q < 4; ++q) OT[(16 * t + 4 * kg + q) * 72 + e] = (bf16)f2bf(oo[t][q]);
            __syncthreads();
        }
        if (seq < 32) {
            float* ns = a.out + (size_t)M * D + ((size_t)((seq * 4 + l) * 2 + dir) * 4 + h) * 4096;
#pragma unroll
            for (int t = 0; t < 4; ++t)
#pragma unroll
                for (int q = 0; q < 4; ++q) ns[(16 * t + 4 * kg + q) * 64 + e] = S[t][q];
        }
    }
    __syncthreads();
}

__device__ __forceinline__ void phase_combine(const Args& a, int l, int dry) {
    const int tid = otid(), lane = tid & 63, wave = tid >> 6, G = gridDim.x, bid = obid();
    bf16* PB = (bf16*)(a.ws + WS_PB);
    const f32x4 ng = *(const f32x4*)(a.in[I_DNG] + l * 64 + (lane & 15) * 4);
    for (int r0 = bid * NWAVES + wave; r0 < M; r0 += 4 * G * NWAVES) {
        u32x2 of[4], ob[4], ga[4];
#pragma unroll
        for (int u = 0; u < 4; ++u) { const int row = r0 + u * G * NWAVES;
            if (row < M) { const bf16* rp = PB + (size_t)row * LDP; of[u] = *((const u32x2*)(rp + C_Q) + lane); ob[u] = *((const u32x2*)(rp + C_K) + lane); ga[u] = *((const u32x2*)(rp + C_GA) + lane); }
            else { of[u] = (u32x2){0u, 0u}; ob[u] = of[u]; ga[u] = of[u]; } }
#pragma unroll
        for (int u = 0; u < 4; ++u) { const int row = r0 + u * G * NWAVES;
            if (row < M) {
                bf16* rp = PB + (size_t)row * LDP;
                const float o0 = bflo(of[u].x) + bflo(ob[u].x), o1 = bfhi(of[u].x) + bfhi(ob[u].x), o2 = bflo(of[u].y) + bflo(ob[u].y), o3 = bfhi(of[u].y) + bfhi(ob[u].y);
                float ss = (o0 * o0 + o1 * o1) + (o2 * o2 + o3 * o3);
                ss += __shfl_xor(ss, 1); ss += __shfl_xor(ss, 2); ss += __shfl_xor(ss, 4); ss += __shfl_xor(ss, 8);
                const float rinv = rsqrtf(ss * (1.f / 64.f) + EPS);
                u32x2 y; y.x = pk2(o0 * rinv * ng.x * bflo(ga[u].x), o1 * rinv * ng.y * bfhi(ga[u].x)); y.y = pk2(o2 * rinv * ng.z * bflo(ga[u].y), o3 * rinv * ng.w * bfhi(ga[u].y));
                if (dry) rp = (bf16*)(a.ws + WS_DUM) + (size_t)(row & 1023) * LDP;
                *((u32x2*)(rp + C_GA) + lane) = y;
            } }
    }
}

constexpr int PF_ROWS = 5;
struct FinalRegs { u32x4 x[PF_ROWS][2]; float rinv[PF_ROWS]; };
__device__ __forceinline__ void final_load(const Args& a, FinalRegs& R, int rnd) {
    const int tid = otid(), lane = tid & 63, wave = tid >> 6, G = gridDim.x, bid = obid();
    const float* RSS = (const float*)(a.ws + WS_RSS);
    const bf16* XB = (const bf16*)a.out + (size_t)M * D;
#pragma unroll
    for (int i = 0; i < PF_ROWS; ++i) {
        const int row = bid * NWAVES + wave + G * NWAVES * (i + PF_ROWS * rnd);
        if (row < M) {
            const u32x4* xr = (const u32x4*)(XB + (size_t)row * D) + lane * 2;
            R.x[i][0] = xr[0]; R.x[i][1] = xr[1];
            float p = (lane < 16) ? RSS[(size_t)row * 16 + lane] : 0.f;
            p += __shfl_xor(p, 1); p += __shfl_xor(p, 2); p += __shfl_xor(p, 4); p += __shfl_xor(p, 8);
            R.rinv[i] = rsqrtf(__shfl(p, 0) * (1.f / 1024.f) + EPS);
        } else { R.x[i][0] = (u32x4){0u, 0u, 0u, 0u}; R.x[i][1] = R.x[i][0]; R.rinv[i] = 0.f; }
    }
}
__device__ __forceinline__ void final_store(const Args& a, const FinalRegs& R, int rnd) {
    const int tid = otid(), lane = tid & 63, wave = tid >> 6, G = gridDim.x, bid = obid();
    f32x4 fg[4];
#pragma unroll
    for (int q = 0; q < 4; ++q) fg[q] = *((const f32x4*)(a.in[I_FNG]) + lane * 4 + q);
#pragma unroll
    for (int i = 0; i < PF_ROWS; ++i) {
        const int row = bid * NWAVES + wave + G * NWAVES * (i + PF_ROWS * rnd);
        if (row < M) {
            f32x4* orow = (f32x4*)(a.out + (size_t)row * D) + lane * 4;
            const u32x4 x0 = R.x[i][0], x1 = R.x[i][1]; const float ri = R.rinv[i];
            orow[0] = (f32x4){bflo(x0.x), bfhi(x0.x), bflo(x0.y), bfhi(x0.y)} * ri * fg[0];
            orow[1] = (f32x4){bflo(x0.z), bfhi(x0.z), bflo(x0.w), bfhi(x0.w)} * ri * fg[1];
            orow[2] = (f32x4){bflo(x1.x), bfhi(x1.x), bflo(x1.y), bfhi(x1.y)} * ri * fg[2];
            orow[3] = (f32x4){bflo(x1.z), bfhi(x1.z), bflo(x1.w), bfhi(x1.w)} * ri * fg[3];
        }
    }
}

__device__ __forceinline__ void skinny_ba(const Args& a, int l, int pm) {
    const int tid = otid(), lane = tid & 63, wave = __builtin_amdgcn_readfirstlane(tid >> 6), r = lane & 15, kg = lane >> 4;
    const bf16* A = (const bf16*)a.out + (size_t)(pm * 256 + wave * 32 + r) * 1024 + kg * 8;
    const bf16* Bw = (const bf16*)(a.ws + WS_W1T) + ((size_t)l * N1 + 3072 + r) * 1024 + kg * 8;
    f32x4 acc0 = (f32x4){0.f, 0.f, 0.f, 0.f}, acc1 = acc0;
    bf16x8 a0[2][4], a1[2][4], bw[2][4];
#define SK_LOAD(buf, kc_) do { _Pragma("unroll") for (int ksx = 0; ksx < 4; ++ksx) { const int k = ((kc_) * 4 + ksx) * 32; \
        a0[buf][ksx] = *(const bf16x8*)(A + k); a1[buf][ksx] = *(const bf16x8*)(A + 16 * 1024 + k); bw[buf][ksx] = *(const bf16x8*)(Bw + k); } } while (0)
#define SK_MMA(buf) do { _Pragma("unroll") for (int ksx = 0; ksx < 4; ++ksx) { \
        acc0 = __builtin_amdgcn_mfma_f32_16x16x32_bf16(a0[buf][ksx], bw[buf][ksx], acc0, 0, 0, 0); \
        acc1 = __builtin_amdgcn_mfma_f32_16x16x32_bf16(a1[buf][ksx], bw[buf][ksx], acc1, 0, 0, 0); } } while (0)
    SK_LOAD(0, 0); SK_LOAD(1, 1);
    SK_MMA(0); SK_LOAD(0, 2); SK_MMA(1); SK_LOAD(1, 3); SK_MMA(0); SK_LOAD(0, 4); SK_MMA(1); SK_LOAD(1, 5);
    SK_MMA(0); SK_LOAD(0, 6); SK_MMA(1); SK_LOAD(1, 7); SK_MMA(0); SK_MMA(1);
#undef SK_LOAD
#undef SK_MMA
    const int j = pm < 32 ? 0 : 1 + ((pm - 32) >> 4);
    const float sw = ((const float*)(a.ws + WS_SW))[((size_t)l * 9 + j) * N1 + 3072 + r];
    const float* RSS = (const float*)(a.ws + WS_RSS);
    float* BA = (float*)(a.ws + WS_BA);
#pragma unroll
    for (int mi = 0; mi < 2; ++mi)
#pragma unroll
        for (int q = 0; q < 4; ++q) {
            const int row = pm * 256 + wave * 32 + mi * 16 + 4 * kg + q;
            const f32x4* rp = (const f32x4*)(RSS + (size_t)row * 16);
            const f32x4 r0 = rp[0], r1 = rp[1], r2 = rp[2], r3 = rp[3];
            const float ss = ((r0.x + r0.y) + (r0.z + r0.w)) + ((r1.x + r1.y) + (r1.z + r1.w)) + ((r2.x + r2.y) + (r2.z + r2.w)) + ((r3.x + r3.y) + (r3.z + r3.w));
            const float rinv = rsqrtf(ss * (1.f / 1024.f) + EPS);
            BA[(size_t)row * 16 + r] = (mi ? acc1[q] : acc0[q]) * rinv + sw;
        }
}

constexpr int NPHASE = 24;
__global__ void __launch_bounds__(NTHR, 2) fwd_kernel(Args args) {
    extern __shared__ __attribute__((aligned(16))) unsigned char lds_raw[];
    LAS unsigned char* lds = (LAS unsigned char*)lds_raw;
#if !MK_MULTI
    volatile LAS unsigned* MISC = (volatile LAS unsigned*)(lds + MISC_OFF);
    if (threadIdx.x < 64) MISC[threadIdx.x] = 0u;
    __syncthreads();
    XcdBarrier bar = xcd_barrier_post((unsigned*)(args.ws + WS_CTL) + CW_BAR, MISC + 8);
#define GRID_BAR() xcd_barrier(bar)
#else
#define GRID_BAR() do { } while (0)
#endif
    const int G = gridDim.x, bid = blockIdx.x;
#pragma unroll
    for (int pass = (PRE_HI > 0 ? 0 : 1); pass < 2; ++pass) {
        const int hi = (pass == 0) ? args.pad : args.ph_hi, lo = args.ph_lo;
        volatile LAS unsigned long long* TSL = (volatile LAS unsigned long long*)(lds + MISC_OFF + 128);
        if (PROBE_A == -2 && PROBE_B >= 0 && threadIdx.x == 0) TSL[0] = __builtin_amdgcn_s_memrealtime();
        if (PROBE_X == 8 && threadIdx.x == 0) atomicMax((unsigned long long*)(args.ws + WS_CTL) + 2048 + 8, (unsigned long long)__builtin_amdgcn_s_memrealtime());
#define RUN(k) ((k) >= lo && (k) < hi)
#define SEAM(k) do { if (RUN(k) && ((k) + 1 < hi || pass == 0)) { GRID_BAR(); for (int rb = 1; rb < REP_BAR; ++rb) GRID_BAR(); } if (PROBE_B >= 0 && threadIdx.x == 0) { if ((k) == PROBE_A) TSL[0] = __builtin_amdgcn_s_memrealtime(); if ((k) == PROBE_B) TSL[1] = __builtin_amdgcn_s_memrealtime(); } } while (0)
        if (RUN(0)) { if (EN(0)) for (int rep = 0; rep < REP_P0; ++rep) phase_0a(args, lds); } SEAM(0);
        if (RUN(1)) { if (EN(1)) for (int rep = 0; rep < REP_P0; ++rep) phase_0b(args, lds); } SEAM(1);
        if (RUN(2)) { if (EN(2)) phase_0c(args); } SEAM(2);
#pragma unroll 1
        for (int l = 0; l < NL; ++l) {
            if (RUN(3 + 5 * l)) {
            if (EN(4)) {
                pg8::Gemm g{(const bf16*)args.out, (const bf16*)(args.ws + WS_W1T) + (size_t)l * N1 * 1024, M, LDP, 1024, 1024};
                pg8::StaticOrder S; S.init(M, LDP, G, bid);
                Epi1 E{(bf16*)(args.ws + WS_PB), (float*)(args.ws + WS_BA), (const float*)(args.ws + WS_RSS), (const float*)(args.ws + WS_SW) + (size_t)l * 9 * N1, 0, (bf16*)(args.ws + WS_DUM), (const LAS float*)(lds + 131072), (float*)(args.ws + WS_VSS)};
                {
                    LAS float* rtab = (LAS float*)(lds + 131072); const float* RSSp = (const float*)(args.ws + WS_RSS);
                    for (int idx = otid(); idx < 8 * 256; idx += NTHR) { pg8::Unit u;
                        if (S.next(idx >> 8, u)) { const f32x4* rp = (const f32x4*)(RSSp + (size_t)(u.pm * 256 + (idx & 255)) * 16);
                            const f32x4 r0 = rp[0], r1 = rp[1], r2 = rp[2], r3 = rp[3];
                            const float ss = ((r0.x + r0.y) + (r0.z + r0.w)) + ((r1.x + r1.y) + (r1.z + r1.w)) + ((r2.x + r2.y) + (r2.z + r2.w)) + ((r3.x + r3.y) + (r3.z + r3.w));
                            rtab[idx] = rsqrtf(ss * (1.f / 1024.f) + EPS); } }
                    __syncthreads();
                }
                for (int rep = 0; rep < REP_G1; ++rep) { if (rep && G1CHEAP) E.cheap = args.one * G1CHEAP; pg8::gemm_phase<Epi1>(lds, g, S, E); if (rep && G1CHEAP) continue;
                    if (bid >= 128) for (int pm = bid - 128; pm < 160; pm += 128) skinny_ba(args, l, pm); } }
            }
            SEAM(3 + 5 * l);
            if (RUN(4 + 5 * l))
            {
                if (EN(5)) {
#if PREP_PREFETCH
                    PrepPre PP; if (bid < 2560) prep_prefetch(args, PP, bid >> 2, bid & 3);
                    for (int it = bid; it < 2560; it += G) { const int nit = it + G < 2560 ? it + G : -4; prep_item(args, lds, l, it >> 2, it & 3, PP, nit >> 2, nit & 3); }
#else
                    for (int it = bid; it < 2560; it += G) { PrepPre PP; prep_prefetch(args, PP, it >> 2, it & 3); prep_item(args, lds, l, it >> 2, it & 3, PP, -1, 0); }
#endif
                }
            }
            SEAM(4 + 5 * l);
            if (RUN(5 + 5 * l))
            {
                if (bid < 64 && !PSK(1)) { if (EN(10)) for (int rep = 0; rep < REP_SCAN; ++rep) scan_item(args, lds, l, 32 + (bid >> 3), (bid >> 1) & 3, bid & 1); }
                if (PROBE_X >= 0 && l == PROBE_L && bid < 64 && threadIdx.x == 0) atomicMax((unsigned long long*)(args.ws + WS_CTL) + 2048 + 0, (unsigned long long)__builtin_amdgcn_s_memrealtime());
                unsigned* qc = (unsigned*)(args.ws + WS_CTL) + CW_Q + 64 * l + 256 * pass;
                volatile LAS unsigned* qslot = (volatile LAS unsigned*)(lds + MISC_OFF) + 16;
                if (otid() == 0) qslot[0] = atomicAdd(qc, 1u);
                for (;;) {
                    __syncthreads();
                    const int it = (int)qslot[0];
                    __syncthreads();
                    if (PROBE_X >= 0 && l == PROBE_L && threadIdx.x == 0 && (it >= 1856 || it == 320 || it == 576 || it == 1088 || it == 1216)) { const unsigned long long now = __builtin_amdgcn_s_memrealtime();
                        unsigned long long* T_ = (unsigned long long*)(args.ws + WS_CTL) + 2048;
                        if (it >= 1856) { atomicMax(T_ + 1, now); if (atomicCAS(T_ + 3, 0ull, now) == 0ull) {} }
                        if (it == 320) atomicMax(T_ + 4, now); if (it == 576) atomicMax(T_ + 5, now); if (it == 1088) atomicMax(T_ + 6, now); if (it == 1216) atomicMax(T_ + 7, now); }
                    if (it >= 1856) break;
                    unsigned nx = 0u; const bool puller = (otid() == 0);
                    if (puller) nx = atomicAdd(qc, 1u);
                    if (it < 320) { const int g_ = it / 80, c4 = (it % 80) * 4;
                        if (EN(6) && !PSK(16)) for (int rep = 0; rep < REP_SGU; ++rep) for (int cc = 0; cc < 4; ++cc) sgu_item(args, lds, l, c4 + cc, g_, rep ? args.one : 0, cc > 0 || rep > 0); }
                    else if (it < 576) { const int i2 = it - 320; if (EN(10) && !PSK(8)) for (int rep = 0; rep < REP_CTXS; ++rep) scan_item(args, lds, l, i2 >> 3, (i2 >> 1) & 3, i2 & 1); }
                    else if (it < 1088) { const int i2 = it - 576; if (EN(9) && !PSK(2)) for (int rep = 0; rep < REP_FSMP; ++rep) fsmp_item(args, lds, i2 >> 6, i2 & 63, rep ? args.one : 0); }
                    else if (it < 1216) { const int i2 = it - 1088; if (EN(8) && !PSK(4)) for (int rep = 0; rep < REP_FCTX; ++rep) fctx_item(args, lds, i2 >> 2, i2 & 3, rep ? args.one : 0); }
                    else { if (EN(7) && !PSK(32)) pool_item(args, lds, l, it - 1216, 0); }
                    if (puller) qslot[0] = nx;
                }
            }
            SEAM(5 + 5 * l);
            if (RUN(6 + 5 * l))
            {
                if (EN(11)) { for (int it = bid; it < 512; it += G) ffin_item(args, lds, it >> 6, it & 63);
                    for (int rep = 0; rep < REP_COMB; ++rep) phase_combine(args, l, rep ? args.one : 0); }
            }
            SEAM(6 + 5 * l);
            if (RUN(7 + 5 * l)) {
            if (EN(12)) {
                pg8::Gemm g{(const bf16*)(args.ws + WS_PB), (const bf16*)(args.ws + WS_W2T) + (size_t)l * 1024 * 1024, M, 1024, 1024, LDP};
                pg8::StaticOrder S; S.init(M, 1024, G, bid);
                const float* MOD = (const float*)(args.ws + WS_MOD);
                Epi2 E{(bf16*)args.out + (size_t)M * D, (bf16*)args.out, (float*)(args.ws + WS_RSS), MOD + (size_t)l * 9 * 3072 + 2048,
                       l < 3 ? args.in[I_NORMG] + (l + 1) * 1024 : nullptr, l < 3 ? MOD + (size_t)(l + 1) * 9 * 3072 + 1024 : nullptr, args.ws + WS_DUM, 0};
                pg8::gemm_phase<Epi2>(lds, g, S, E);
                for (int rep = 1; rep < REP_G2; ++rep) { Epi2 E2 = E; E2.dry = args.one; pg8::gemm_phase<Epi2>(lds, g, S, E2); }
            }
            }
            SEAM(7 + 5 * l);
        }
        if (RUN(23)) { if (EN(3) && pass == 1) { for (int rnd = 0; rnd < 4; ++rnd) { FinalRegs R; final_load(args, R, rnd); GRID_BAR(); final_store(args, R, rnd); } } }
        if (PROBE_B == 23 && threadIdx.x == 0) TSL[1] = __builtin_amdgcn_s_memrealtime();
        if (PROBE_B >= 0 && blockIdx.x == 0 && threadIdx.x == 0) {
            asm volatile("s_waitcnt vmcnt(0)" ::: "memory");
            const unsigned long long tend = (PROBE_X >= 0) ? __hip_atomic_load((unsigned long long*)(args.ws + WS_CTL) + 2048 + PROBE_X, __ATOMIC_RELAXED, __HIP_MEMORY_SCOPE_AGENT) : (unsigned long long)TSL[1];
            const float T = PROBE_FAKE ? (float)PROBE_FAKE : (float)(tend - TSL[0]) * (0.01f * PROBE_SCALE);
            args.out[0] += sqrtf(8.39f * T);
        }
#undef RUN
#undef SEAM
    }
}

extern "C" void kernel_launch(void* const* d_in, const int* in_sizes, int n_in, void* d_out, int out_size, void* d_ws, size_t ws_size, hipStream_t stream) {
    static int grid = 0;
    if (grid == 0) {
        if (n_in != 21 || ws_size < WS_DUM + 16 * MiB) { fprintf(stderr, "kernel_launch: unexpected n_in %d or ws_size %zu (< %zu)\n", n_in, ws_size, (size_t)WS_END); grid = -1; return; }
        int dev = 0, cus = 0, per_cu = 0;
        if (hipGetDevice(&dev) != hipSuccess || hipDeviceGetAttribute(&cus, hipDeviceAttributeMultiprocessorCount, dev) != hipSuccess) { grid = -1; return; }
        if (hipFuncSetAttribute((const void*)fwd_kernel, hipFuncAttributeMaxDynamicSharedMemorySize, LDS_BYTES) != hipSuccess) { fprintf(stderr, "kernel_launch: hipFuncSetAttribute failed\n"); grid = -1; return; }
        if (hipOccupancyMaxActiveBlocksPerMultiprocessor(&per_cu, (const void*)fwd_kernel, NTHR, LDS_BYTES) != hipSuccess || per_cu < 1) { fprintf(stderr, "kernel_launch: occupancy query failed (%d)\n", per_cu); (void)hipGetLastError(); per_cu = 1; }
        grid = cus * 1;
    }
    if (grid < 0) return;
    Args a{};
    for (int i = 0; i < 21; ++i) a.in[i] = (const float*)d_in[i];
    a.out = (float*)d_out; a.ws = (unsigned char*)d_ws; a.one = 1; a.pad = PRE_HI;
    (void)hipMemsetAsync((char*)d_ws + WS_CTL, 0, CTL_ZERO_BYTES, stream);
#if MK_MULTI
    for (int ph = 0; ph < NPHASE; ++ph) {
        a.ph_lo = ph; a.ph_hi = ph + 1;
        hipLaunchKernelGGL(fwd_kernel, dim3(grid), dim3(NTHR), LDS_BYTES, stream, a);
    }
#else
    a.ph_lo = 0; a.ph_hi = NPHASE;
    void* kargs[] = {&a};
#if PLAIN_LAUNCH
    (void)kargs; hipLaunchKernelGGL(fwd_kernel, dim3(grid), dim3(NTHR), LDS_BYTES, stream, a);
#else
    hipError_t e = hipLaunchCooperativeKernel((const void*)fwd_kernel, dim3(grid), dim3(NTHR), kargs, LDS_BYTES, stream);
    if (e != hipSuccess) fprintf(stderr, "kernel_launch: cooperative launch failed: %s (grid %d)\n", hipGetErrorString(e), grid);
#endif
#endif
}
```

```cpp
#include <hip/hip_runtime.h>
#include <cstdio>
#include <cstdint>

#ifndef MK_MULTI
#define MK_MULTI 0
#endif
#ifndef NAIVE_MM
#define NAIVE_MM 0
#endif
#ifndef ONLY
#define ONLY -1
#endif
#define EN(k) (ONLY < 0 || ONLY == (k))
#ifndef REP_G1
#define REP_G1 1
#endif
#ifndef REP_PREP
#define REP_PREP 1
#endif
#ifndef REP_SCAN
#define REP_SCAN 1
#endif
#ifndef REP_P0
#define REP_P0 1
#endif
#ifndef REP_MIX
#define REP_MIX 1
#endif
#ifndef REP_COMB
#define REP_COMB 1
#endif
#ifndef REP_G2
#define REP_G2 1
#endif
#ifndef MIXSEL
#define MIXSEL 15
#endif
#ifndef G1CHEAP
#define G1CHEAP 0
#endif
#ifndef REP_BAR
#define REP_BAR 1
#endif
#ifndef PRE_HI
#define PRE_HI 0
#endif
#ifndef PROBE_A
#define PROBE_A -1
#endif
#ifndef PROBE_B
#define PROBE_B -1
#endif
#ifndef PROBE_FAKE
#define PROBE_FAKE 0
#endif
#ifndef PROBE_SCALE
#define PROBE_SCALE 1
#endif
#ifndef PLAIN_LAUNCH
#define PLAIN_LAUNCH 0
#endif
#ifndef KA1
#define KA1 0
#endif
#ifndef KA2
#define KA2 0
#endif
#ifndef PROBE_X
#define PROBE_X -1
#endif
#define PROBE_L 1
#ifndef REP_FCTX
#define REP_FCTX 1
#endif
#ifndef REP_FSMP
#define REP_FSMP 1
#endif
#ifndef REP_CTXS
#define REP_CTXS 1
#endif
#ifndef REP_SGU
#define REP_SGU 1
#endif
#ifndef PREP_PREFETCH
#define PREP_PREFETCH 0
#endif
#ifndef PRE_SKIP
#define PRE_SKIP 0
#endif
#define PSK(b) (pass == 0 && (PRE_SKIP & (b)))

#define LAS __attribute__((address_space(3)))
#define GAS __attribute__((address_space(1)))
typedef unsigned short bf16;
typedef short bf16x8 __attribute__((ext_vector_type(8)));
typedef float f32x4 __attribute__((ext_vector_type(4)));
typedef float f32x2 __attribute__((ext_vector_type(2)));
typedef unsigned u32x4 __attribute__((ext_vector_type(4)));
typedef unsigned u32x2 __attribute__((ext_vector_type(2)));

constexpr int D = 1024, NL = 4, NCOND = 9;
constexpr int M_CTX = 8192, M = 40960;
constexpr int PIN = 2832;
constexpr int N1 = 3328, LDP = 3072;
constexpr float EPS = 1e-6f;
constexpr int C_GA = 0, C_U = 256, C_GC = 512, C_GD = 768, C_V = 1024, C_GB = 1280, C_XC = 1536, C_PF = 1792, C_QF = 2048, C_Q = 2304, C_K = 2560, C_VV = 2816;

constexpr size_t MiB = 1u << 20;
constexpr size_t WS_CTL = 0, CTL_ZERO_BYTES = 64 * 1024;
constexpr size_t WS_MOD = 1 * MiB;
constexpr size_t WS_SW = WS_MOD + 512 * 1024;
constexpr size_t WS_GMAT = 2 * MiB;
constexpr size_t WS_POS = WS_GMAT + 512 * 1024;
constexpr size_t WS_DFT = WS_POS + 256 * 1024;
constexpr size_t WS_M1 = 3 * MiB;
constexpr size_t WS_M2 = WS_M1 + 32 * 1024;
constexpr size_t WS_TW = WS_M1 + 64 * 1024;
constexpr size_t WS_W1T = 4 * MiB;
constexpr size_t WS_W2T = 30 * MiB;
constexpr size_t WS_BA = 38 * MiB;
constexpr size_t WS_RSS = 41 * MiB;
constexpr size_t WS_PB = 44 * MiB;
constexpr size_t WS_HB = 284 * MiB;
constexpr size_t WS_PREP = 284 * MiB;
constexpr size_t WS_PGL = 484 * MiB;
constexpr size_t WS_VSS = 484 * MiB + 64 * 1024;
constexpr size_t WS_END = 485 * MiB;
constexpr size_t WS_DUM = 486 * MiB;
constexpr int CW_BAR = 4096, CW_Q = 8192;

constexpr int LDS_BYTES = 147456;
constexpr int MISC_OFF = 144 * 1024 - 256;
constexpr int NWAVES = 8, NTHR = 512;

typedef __bf16 hwbf16x2 __attribute__((ext_vector_type(2)));
__device__ __forceinline__ unsigned f2bf(float f) { return (unsigned)__builtin_bit_cast(unsigned short, (__bf16)f); }
__device__ __forceinline__ float bf2f(unsigned b) { return __builtin_bit_cast(float, (b & 0xffffu) << 16); }
__device__ __forceinline__ unsigned pk2(float lo, float hi) { const f32x2 v = {lo, hi}; return __builtin_bit_cast(unsigned, __builtin_convertvector(v, hwbf16x2)); }
__device__ __forceinline__ float bflo(unsigned w) { return __builtin_bit_cast(float, w << 16); }
__device__ __forceinline__ float bfhi(unsigned w) { return __builtin_bit_cast(float, w & 0xffff0000u); }
__device__ __forceinline__ float silu_f(float x) { return x * __builtin_amdgcn_rcpf(1.f + __builtin_amdgcn_exp2f(-1.4426950408889634f * x)); }
__device__ __forceinline__ float gelu_tanh_f(float x) { const float z = (-1.5957691216057308f * 1.4426950408889634f) * (x + 0.044715f * x * x * x); return x * __builtin_amdgcn_rcpf(1.f + __builtin_amdgcn_exp2f(z)); }
__device__ __forceinline__ float wave_sum(float v) {
#pragma unroll
    for (int o = 1; o < 64; o <<= 1) v += __shfl_xor(v, o);
    return v;
}
__device__ __forceinline__ int otid() { int t = threadIdx.x; asm volatile("" : "+v"(t)); return t; }
__device__ __forceinline__ int obid() { int b = blockIdx.x; asm volatile("" : "+s"(b)); return b; }
#define LDS_WAIT() asm volatile("s_waitcnt lgkmcnt(0)" ::: "memory")
#define LDS_BARRIER() asm volatile("s_waitcnt lgkmcnt(0)\n\ts_barrier" ::: "memory")

namespace pg8 {
constexpr int BM = 256, BK = 64, HALF = 128, HTB = HALF * BK * 2, STAGE_BYTES = 8 * HTB, NXCD = 8, WGM = 8;
__host__ __device__ __forceinline__ int lds_byte(int r, int c) { const int st = (r >> 4) * 2 + (c >> 5), rr = r & 15, cc = c & 31, ob = rr * 64 + cc * 2; return st * 1024 + (ob ^ (((ob >> 9) & 1) << 5)); }
__host__ __device__ __forceinline__ void stage_rc(int b, int& R, int& C) { const int st = b / 1024, sb = b % 1024, swz = sb ^ (((sb >> 9) & 1) << 5); R = (st >> 1) * 16 + swz / 64; C = (st & 1) * 32 + (swz % 64) / 2; }
__host__ __device__ __forceinline__ int perm32(int rho) { const int n = rho >> 4, i = rho & 15; return 8 * (i >> 2) + 4 * n + (i & 3); }

struct Unit { int pm, pn, half; };
struct Gemm { const bf16* A; const bf16* Bt; int M, N, K, lda; };

struct StaticOrder {
    int nM, nN, nwg, G, c, nfull;
    __host__ __device__ __forceinline__ void init(int M_, int N_, int G_, int c_) { nM = M_ / BM; nN = N_ / BM; nwg = nM * nN; G = G_; c = c_; nfull = (nwg / G_) * G_; if (nfull == nwg) nfull = nwg; }
    __host__ __device__ __forceinline__ bool next(int i, Unit& u) const {
        const long L = (long)i * G + c;
        int lin; u.half = 0;
        if (L < nfull) lin = (int)L;
        else { const long hid = L - nfull; if (hid >= 2L * (nwg - nfull)) return false; lin = nfull + (int)(hid >> 1); u.half = 1 + (int)(hid & 1); }
        int wgid = lin; { const int q = nwg / NXCD, r = nwg % NXCD, xcd = wgid % NXCD, off = wgid / NXCD; wgid = (xcd < r ? xcd * (q + 1) : r * (q + 1) + (xcd - r) * q) + off; }
        const int nig = WGM * nN, gid = wgid / nig, fm = gid * WGM, gsz = (nM - fm) < WGM ? (nM - fm) : WGM;
        u.pm = fm + ((wgid % nig) % gsz); u.pn = (wgid % nig) / gsz; return true;
    }
};

template <class Epi>
__device__ __forceinline__ void gemm_phase(LAS unsigned char* lds, const Gemm g, const StaticOrder& S, const Epi& E) {
    const int tid = otid(), wid = __builtin_amdgcn_readfirstlane(tid >> 6), lane = tid & 63, wr = wid >> 2, wc = wid & 3, fr = lane & 15, fq = lane >> 4;
    const int K = g.K, nt = K / BK, lda = g.lda;
    unsigned voffA[2], voffB[2];
#pragma unroll
    for (int i = 0; i < 2; ++i) { int R, C; stage_rc(tid * 16 + i * 8192, R, C); const int Rb = Epi::PERM ? ((R & ~31) + perm32(R & 31)) : R;
        voffA[i] = (unsigned)(R * lda + C) * 2u; voffB[i] = (unsigned)(Rb * K + C) * 2u; }
    const size_t kstep = (size_t)(BK * 2);
    const size_t hstepA = (size_t)HALF * lda * 2, hstepB = (size_t)HALF * K * 2;
    const size_t tstepA = 2 * hstepA, tstepB = 2 * hstepB;
    const unsigned ldsw = (unsigned)wid * 1024u;
    const int aoff = lds_byte(wr * 64 + fr, fq * 8), boff = lds_byte(wc * 32 + fr, fq * 8);
#define PG8_SA(b, h) (((b) * 2 + (h)) * HTB)
#define PG8_SB(b, h) ((4 + (b) * 2 + (h)) * HTB)
#define PG8_STAGE(bufoff, gbase, voff) do { _Pragma("unroll") for (int _i = 0; _i < 2; ++_i) \
        __builtin_amdgcn_global_load_lds((const unsigned*)((const char*)(gbase) + (voff)[_i]), (LAS unsigned*)(lds + (bufoff) + ldsw + _i * 8192), 16, 0, 0); } while (0)
#define PG8_LDA(dst, b, h) do { _Pragma("unroll") for (int m = 0; m < 4; ++m) _Pragma("unroll") for (int k = 0; k < 2; ++k) dst[m][k] = *(const LAS bf16x8*)(lds + PG8_SA(b, h) + aoff + m * 2048 + k * 1024); } while (0)
#define PG8_LDB(dst, b, h) do { _Pragma("unroll") for (int n = 0; n < 2; ++n) _Pragma("unroll") for (int k = 0; k < 2; ++k) dst[n][k] = *(const LAS bf16x8*)(lds + PG8_SB(b, h) + boff + n * 2048 + k * 1024); } while (0)
#define PG8_MMA(ai, bj, At, Bt) do { __builtin_amdgcn_s_setprio(1); _Pragma("unroll") for (int m = 0; m < 4; ++m) _Pragma("unroll") for (int n = 0; n < 2; ++n) _Pragma("unroll") for (int k = 0; k < 2; ++k) \
        acc[ai][bj][m][n] = __builtin_amdgcn_mfma_f32_16x16x32_bf16(Bt[n][k], At[m][k], acc[ai][bj][m][n], 0, 0, 0); __builtin_amdgcn_s_setprio(0); } while (0)
#define PG8_WAIT_V(n) asm volatile("s_waitcnt vmcnt(" #n ")" ::: "memory")
#define PG8_WAIT_L(n) asm volatile("s_waitcnt lgkmcnt(" #n ")" ::: "memory")
#define PG8_BAR __builtin_amdgcn_s_barrier()
#define PG8_SCHED __builtin_amdgcn_sched_barrier(0)
#define PG8_KLOOP(FULL) \
        for (int t = 0; t < nt; t += 2) { \
            const bool last = (t == nt - 2); \
            const char* a1 = cA + (size_t)(t + 1) * kstep; \
            const char* a2 = last ? nA : cA + (size_t)(t + 2) * kstep; const char* b2 = last ? nB : cB + (size_t)(t + 2) * kstep; \
            const char* a3 = a2 + kstep; const char* b3 = b2 + kstep; \
            PG8_LDB(B0, 0, 0); PG8_LDA(At, 0, 0); PG8_LDB(B1, 0, 1); PG8_STAGE(PG8_SA(1, 1), a1 + hstepA, voffA); \
            PG8_WAIT_V(8); PG8_BAR; PG8_WAIT_L(0); PG8_MMA(0, 0, At, B0); PG8_MMA(0, 1, At, B1); PG8_BAR; PG8_SCHED; \
            PG8_LDA(At, 0, 1); PG8_STAGE(PG8_SB(0, 0), b2, voffB); PG8_STAGE(PG8_SA(0, 0), a2, voffA); PG8_STAGE(PG8_SB(0, 1), b2 + hstepB, voffB); \
            PG8_WAIT_V(8); PG8_BAR; PG8_WAIT_L(0); if (FULL) { PG8_MMA(1, 0, At, B0); PG8_MMA(1, 1, At, B1); } else __builtin_amdgcn_s_waitcnt(0xC07F); PG8_BAR; PG8_SCHED; \
            PG8_LDB(B0, 1, 0); PG8_LDA(At, 1, 0); PG8_LDB(B1, 1, 1); PG8_STAGE(PG8_SA(0, 1), a2 + hstepA, voffA); \
            PG8_WAIT_V(8); PG8_BAR; PG8_WAIT_L(0); PG8_MMA(0, 0, At, B0); PG8_MMA(0, 1, At, B1); PG8_BAR; PG8_SCHED; \
            PG8_LDA(At, 1, 1); PG8_STAGE(PG8_SB(1, 0), b3, voffB); PG8_STAGE(PG8_SA(1, 0), a3, voffA); PG8_STAGE(PG8_SB(1, 1), b3 + hstepB, voffB); \
            PG8_WAIT_V(8); PG8_BAR; PG8_WAIT_L(0); if (FULL) { PG8_MMA(1, 0, At, B0); PG8_MMA(1, 1, At, B1); } else __builtin_amdgcn_s_waitcnt(0xC07F); PG8_BAR; PG8_SCHED; \
        }
    Unit cur, nxt; int ui = 0;
    if (!S.next(0, cur)) return;
    f32x4 acc[2][2][4][2];
#pragma unroll
    for (int a = 0; a < 2; ++a)
#pragma unroll
        for (int b = 0; b < 2; ++b)
#pragma unroll
            for (int m = 0; m < 4; ++m)
#pragma unroll
                for (int n = 0; n < 2; ++n) acc[a][b][m][n] = (f32x4){0.f, 0.f, 0.f, 0.f};
    bf16x8 At[4][2], B0[2][2], B1[2][2];
    const char* cA = (const char*)g.A + (size_t)cur.pm * tstepA + (cur.half == 2 ? hstepA : 0); const char* cB = (const char*)g.Bt + (size_t)cur.pn * tstepB;
    PG8_STAGE(PG8_SB(0, 0), cB, voffB); PG8_STAGE(PG8_SA(0, 0), cA, voffA); PG8_STAGE(PG8_SB(0, 1), cB + hstepB, voffB); PG8_STAGE(PG8_SA(0, 1), cA + hstepA, voffA);
    PG8_STAGE(PG8_SB(1, 0), cB + kstep, voffB); PG8_STAGE(PG8_SA(1, 0), cA + kstep, voffA); PG8_STAGE(PG8_SB(1, 1), cB + hstepB + kstep, voffB);
    if (wr == 1) PG8_BAR;
    PG8_WAIT_V(6); PG8_BAR; PG8_BAR;
    for (;;) {
        const bool has_next = S.next(ui + 1, nxt);
        const char* nA = has_next ? (const char*)g.A + (size_t)nxt.pm * tstepA + (nxt.half == 2 ? hstepA : 0) : cA; const char* nB = has_next ? (const char*)g.Bt + (size_t)nxt.pn * tstepB : cB;
        const bool full = (cur.half == 0);
        __builtin_amdgcn_s_waitcnt(0xC07F);
#define PG8_ALIGN do { if ((Epi::ID == 1 ? KA1 : KA2) & 1) asm volatile(".p2align 6\n\ts_nop 0"); else asm volatile(".p2align 6"); } while (0)
        if (full) { PG8_ALIGN; PG8_KLOOP(1) } else { PG8_ALIGN; PG8_KLOOP(0) }
#undef PG8_ALIGN
        E(acc, cur, wr, wc, fr, fq, ui);
        if (!has_next) break;
#pragma unroll
        for (int a = 0; a < 2; ++a)
#pragma unroll
            for (int b = 0; b < 2; ++b)
#pragma unroll
                for (int m = 0; m < 4; ++m)
#pragma unroll
                    for (int n = 0; n < 2; ++n) acc[a][b][m][n] = (f32x4){0.f, 0.f, 0.f, 0.f};
        cur = nxt; cA = nA; cB = nB; ++ui;
    }
    PG8_WAIT_V(0);
    if (wr == 0) PG8_BAR;
    PG8_BAR;
#undef PG8_SA
#undef PG8_SB
#undef PG8_STAGE
#undef PG8_LDA
#undef PG8_LDB
#undef PG8_MMA
#undef PG8_KLOOP
#undef PG8_WAIT_V
#undef PG8_WAIT_L
#undef PG8_BAR
#undef PG8_SCHED
}
}

#define XB_TMO      128
#define XB_XCNT(j)  (256  + 64 * (j))
#define XB_XSUB(j)  (1280 + 64 * (j))
#define XB_XGEN(j)  (2304 + 64 * (j))
#define XB_TOP      3328
#define XB_TOPGEN   3392
#define XCD_BAR_WORDS 3456
#define XB_SPIN_CAP (1u << 18)
__device__ __forceinline__ unsigned xb_ld(unsigned* p)              { return __hip_atomic_load(p, __ATOMIC_RELAXED, __HIP_MEMORY_SCOPE_AGENT); }
__device__ __forceinline__ unsigned xb_add(unsigned* p, unsigned v) { return __hip_atomic_fetch_add(p, v, __ATOMIC_RELAXED, __HIP_MEMORY_SCOPE_AGENT); }
__device__ __forceinline__ unsigned xb_xcc_id() { return (unsigned)__builtin_amdgcn_s_getreg((3 << 11) | 20) & 0xFu; }
#define XB_SPIN(cond, bar) do { unsigned _sp = 0; while (cond) { __builtin_amdgcn_s_sleep(1); \
    if ((++_sp & 255u) == 0u) { if (xb_ld(&(bar)[XB_TMO])) break; if (_sp > XB_SPIN_CAP) { atomicAdd(&(bar)[XB_TMO], 1u); break; } } } } while (0)
struct XcdBarrier { unsigned* bar; unsigned x; volatile LAS unsigned* st; };
__device__ __forceinline__ XcdBarrier xcd_barrier_post(unsigned* bar, volatile LAS unsigned* st) {
    XcdBarrier b; b.bar = bar; b.x = xb_xcc_id(); b.st = st;
    if (threadIdx.x == 0) (void)xb_add(&bar[XB_XCNT(b.x)], 1u);
    return b;
}
__device__ __forceinline__ void xcd_barrier_complete(unsigned* bar, unsigned x, unsigned& nloc, unsigned& nx) {
    const unsigned G = gridDim.x * gridDim.y * gridDim.z;
    unsigned sum, cnt, mine, sp = 0u;
    for (;;) {
        sum = 0u; cnt = 0u; mine = 0u;
#pragma unroll
        for (unsigned j = 0; j < 16; ++j) { const unsigned c = xb_ld(&bar[XB_XCNT(j)]); sum += c; cnt += (c > 0u) ? 1u : 0u; mine = (j == x) ? c : mine; }
        if (sum == G) break;
        __builtin_amdgcn_s_sleep(1);
        if ((++sp & 255u) == 0u) { if (xb_ld(&bar[XB_TMO])) break; if (sp > XB_SPIN_CAP) { atomicAdd(&bar[XB_TMO], 1u); break; } }
    }
    nloc = mine > 0u ? mine : 1u; nx = cnt > 0u ? cnt : 1u;
}
__device__ __forceinline__ void xcd_barrier(const XcdBarrier& b) {
    asm volatile("s_waitcnt vmcnt(0)" ::: "memory");
    __syncthreads();
    if (threadIdx.x == 0) {
        unsigned* bar = b.bar;
        __builtin_amdgcn_s_waitcnt(0);
        unsigned nloc = b.st[0], nx = b.st[1];
        if (nloc == 0u) { xcd_barrier_complete(bar, b.x, nloc, nx); b.st[0] = nloc; b.st[1] = nx; }
        const unsigned old = xb_add(&bar[XB_XSUB(b.x)], 1u);
        const unsigned gen = old / nloc;
        if (old + 1u == (gen + 1u) * nloc) {
            __builtin_amdgcn_fence(__ATOMIC_RELEASE, "agent");
            asm volatile("s_waitcnt vmcnt(0)" ::: "memory");
            const unsigned og = xb_add(&bar[XB_TOP], 1u);
            const unsigned tg = og / nx;
            if (og + 1u == (tg + 1u) * nx) xb_add(&bar[XB_TOPGEN], 1u);
            else XB_SPIN(xb_ld(&bar[XB_TOPGEN]) == tg, bar);
            __builtin_amdgcn_fence(__ATOMIC_ACQUIRE, "agent");
            xb_add(&bar[XB_XGEN(b.x)], 1u);
            asm volatile("s_waitcnt vmcnt(0)" ::: "memory");
        } else {
            XB_SPIN(xb_ld(&bar[XB_XGEN(b.x)]) == gen, bar);
            __builtin_amdgcn_fence(__ATOMIC_ACQUIRE, "agent");
            asm volatile("s_waitcnt vmcnt(0)" ::: "memory");
        }
    }
    __syncthreads();
}

template <int KS>
__device__ __forceinline__ f32x4 tile_mm(f32x4 acc, const LAS bf16* A, int lda, int m0, const LAS bf16* Bt, int ldb, int n0, int lane) {
    const int r = lane & 15, kg = lane >> 4;
#if NAIVE_MM
#pragma unroll 1
    for (int k = 0; k < KS * 32; ++k) {
        const float b = bf2f(Bt[(n0 + r) * ldb + k]);
#pragma unroll
        for (int q = 0; q < 4; ++q) acc[q] += bf2f(A[(m0 + 4 * kg + q) * lda + k]) * b;
    }
#else
#pragma unroll
    for (int ks = 0; ks < KS; ++ks) {
        const bf16x8 a = *(const LAS bf16x8*)(A + (m0 + r) * lda + ks * 32 + kg * 8);
        const bf16x8 b = *(const LAS bf16x8*)(Bt + (n0 + r) * ldb + ks * 32 + kg * 8);
        acc = __builtin_amdgcn_mfma_f32_16x16x32_bf16(a, b, acc, 0, 0, 0);
    }
#endif
    return acc;
}
template <int KS>
__device__ __forceinline__ f32x4 tile_mm_g(f32x4 acc, const bf16* A, int lda, int m0, const LAS bf16* Bt, int ldb, int n0, int lane) {
    const int r = lane & 15, kg = lane >> 4;
#if NAIVE_MM
#pragma unroll 1
    for (int k = 0; k < KS * 32; ++k) {
        const float b = bf2f(Bt[(n0 + r) * ldb + k]);
#pragma unroll
        for (int q = 0; q < 4; ++q) acc[q] += bf2f(A[(m0 + 4 * kg + q) * lda + k]) * b;
    }
#else
#pragma unroll
    for (int ks = 0; ks < KS; ++ks) {
        const bf16x8 a = *(const bf16x8*)(A + (size_t)(m0 + r) * lda + ks * 32 + kg * 8);
        const bf16x8 b = *(const LAS bf16x8*)(Bt + (n0 + r) * ldb + ks * 32 + kg * 8);
        acc = __builtin_amdgcn_mfma_f32_16x16x32_bf16(a, b, acc, 0, 0, 0);
    }
#endif
    return acc;
}

struct Args { const float* in[21]; float* out; unsigned char* ws; int ph_lo, ph_hi, one, pad; };
enum { I_XP = 0, I_XS, I_STATE, I_C, I_CCTX, I_ADAW, I_ADAB, I_NORMG, I_WIN, I_CONV, I_ALOG, I_DTB, I_DNG, I_SGUNG, I_SGUW, I_SGUB, I_POOLW, I_POOLS, I_FW, I_WOUT, I_FNG };

struct SeqGeo { int T, tseq0, seq_row0; };
__device__ __forceinline__ SeqGeo seq_geo(int sc) {
    SeqGeo g;
    if (sc < 128) { g.T = 256; g.tseq0 = (sc & 3) * 64; g.seq_row0 = (sc >> 2) * 256; }
    else { const int s = sc - 128; g.T = 4096; g.tseq0 = (s & 63) * 64; g.seq_row0 = M_CTX + (s >> 6) * 4096; }
    return g;
}
__device__ __forceinline__ int cond_of_row(int row) { return row < M_CTX ? 0 : 1 + ((row - M_CTX) >> 12); }

__device__ __forceinline__ int srccol(int n) {
    if (n < 256) return 768 + n;
    if (n < 512) return 1040 + (n - 256);
    if (n < 768) return 2064 + (n - 512);
    if (n < 1024) return 2576 + (n - 768);
    if (n < 1280) return 1296 + (n - 1024);
    if (n < 1536) return 1552 + (n - 1280);
    if (n < 2304) return -2;
    if (n < 3072) return n - 2304;
    if (n < 3088) return 1024 + (n - 3072);
    return -1;
}

__device__ __forceinline__ void phase_0a(const Args& a, LAS unsigned char* lds) {
    const int tid = otid(), lane = tid & 63, wave = tid >> 6, G = gridDim.x, bid = obid();
    float* MOD = (float*)(a.ws + WS_MOD);
    {
        LAS float* sc = (LAS float*)lds;
        LAS float* red = (LAS float*)(lds + 9 * 1024 * 4);
        for (int i = tid; i < 9 * 1024; i += NTHR) { const int j = i >> 10, k = i & 1023; const float c = (j == 0) ? a.in[I_CCTX][k] : a.in[I_C][(j - 1) * 1024 + k]; sc[i] = silu_f(c); }
        __syncthreads();
        for (int it = bid; it < 256; it += G) {
            const int l = it >> 6, cb = it & 63, col = cb * 48 + (lane < 48 ? lane : 47);
            float acc[9];
#pragma unroll
            for (int j = 0; j < 9; ++j) acc[j] = 0.f;
            const float* wp = a.in[I_ADAW] + ((size_t)l * 1024 + wave * 128) * 3072 + col;
#pragma unroll 1
            for (int kb = 0; kb < 128; kb += 64) {
                float wv[64];
#pragma unroll
                for (int k = 0; k < 64; ++k) wv[k] = __builtin_nontemporal_load(wp + (size_t)(kb + k) * 3072);
#pragma unroll
                for (int k = 0; k < 64; ++k)
#pragma unroll
                    for (int j = 0; j < 9; ++j) acc[j] += sc[j * 1024 + wave * 128 + kb + k] * wv[k];
            }
#pragma unroll
            for (int j = 0; j < 9; ++j) red[(wave * 9 + j) * 64 + lane] = acc[j];
            __syncthreads();
            for (int i = tid; i < 576; i += NTHR) { const int j = i >> 6, ln = i & 63; float s = 0.f;
#pragma unroll
                for (int w = 0; w < 8; ++w) s += red[(w * 9 + j) * 64 + ln];
                if (ln < 48) MOD[(l * 9 + j) * 3072 + cb * 48 + ln] = s + a.in[I_ADAB][l * 3072 + cb * 48 + ln]; }
            __syncthreads();
        }
    }
    const int gtid = bid * NTHR + tid, GT = G * NTHR;
    float* GM = (float*)(a.ws + WS_GMAT);
    for (int t = gtid; t < 4 * 4 * 2 * 4096; t += GT) {
        const int d = t & 63, c = (t >> 6) & 63, cs = (t >> 12) & 1, g = (t >> 13) & 3, l = t >> 15;
        const float* fw = a.in[I_FW] + ((size_t)(l * 4 + g) * 64) * 64 + d;
        float s = 0.f;
#pragma unroll
        for (int m = 0; m < 64; ++m) { const float rv = (float)((m * c) & 63) * (1.f / 64.f); s += (cs ? __builtin_amdgcn_sinf(rv) : __builtin_amdgcn_cosf(rv)) * fw[m * 64]; }
        GM[t] = s * 0.125f;
    }
    bf16* W1T = (bf16*)(a.ws + WS_W1T);
    {
        const int sub = tid >> 7, k8s = tid & 7, n4 = (tid >> 3) & 15;
        for (int bt0 = bid; bt0 < 4 * 16 * 40; bt0 += 4 * G) {
            const int bt = bt0 + sub * G; const bool ok = bt < 4 * 16 * 40;
            const int nbp = bt % 40, kb = (bt / 40) & 15, l = (bt / 640) & 3;
            const int n0 = (nbp < 24 ? nbp : nbp + 12) * 64 + 4 * n4, k8 = kb * 8 + k8s;
            const int scv = ok ? srccol(n0) : -2;
            const float* wp = a.in[I_WIN] + ((size_t)l * 1024 + k8 * 8) * PIN + (scv >= 0 ? scv : 0);
            f32x4 v[8];
#pragma unroll
            for (int j = 0; j < 8; ++j) v[j] = (scv >= 0) ? __builtin_nontemporal_load((const f32x4*)(wp + (size_t)j * PIN)) : (f32x4){0.f, 0.f, 0.f, 0.f};
            if (scv != -2) {
#pragma unroll
                for (int c = 0; c < 4; ++c) { u32x4 o; o.x = pk2(v[0][c], v[1][c]); o.y = pk2(v[2][c], v[3][c]); o.z = pk2(v[4][c], v[5][c]); o.w = pk2(v[6][c], v[7][c]);
                    *(u32x4*)(W1T + ((size_t)l * N1 + n0 + c) * 1024 + k8 * 8) = o; }
            }
        }
    }
    bf16* W2T = (bf16*)(a.ws + WS_W2T);
    {
        const int sub = tid >> 7, k8s = tid & 7, n4 = (tid >> 3) & 15;
        for (int bt0 = bid; bt0 < 4 * 16 * 16; bt0 += 4 * G) {
            const int bt = bt0 + sub * G; const bool ok = bt < 4 * 16 * 16;
            const int nb = bt & 15, kb = (bt >> 4) & 15, l = (bt >> 8) & 3;
            const int n0 = nb * 64 + 4 * n4, k8 = kb * 8 + k8s;
            const float* wp = a.in[I_WOUT] + ((size_t)l * 1024 + k8 * 8) * 1024 + n0;
            f32x4 v[8];
#pragma unroll
            for (int j = 0; j < 8; ++j) v[j] = ok ? __builtin_nontemporal_load((const f32x4*)(wp + (size_t)j * 1024)) : (f32x4){0.f, 0.f, 0.f, 0.f};
            if (ok) {
#pragma unroll
                for (int c = 0; c < 4; ++c) { u32x4 o; o.x = pk2(v[0][c], v[1][c]); o.y = pk2(v[2][c], v[3][c]); o.z = pk2(v[4][c], v[5][c]); o.w = pk2(v[6][c], v[7][c]);
                    *(u32x4*)(W2T + ((size_t)l * 1024 + n0 + c) * 1024 + k8 * 8) = o; }
            }
        }
    }
    float* POS = (float*)(a.ws + WS_POS);
    for (int t = gtid; t < 64 * 256; t += GT) { const int f = t & 255, i = t >> 8; const float fr = __builtin_amdgcn_exp2f(-(float)f * 0.05190512648261504f); const float rv = (float)i * fr * 0.15915494309189535f;
        POS[t] = __builtin_amdgcn_sinf(rv); POS[64 * 256 + t] = __builtin_amdgcn_cosf(rv); }
    bf16* DFT = (bf16*)(a.ws + WS_DFT);
    for (int t = gtid; t < 256 * 512; t += GT) { const int tp = t & 511, k = t >> 9, tt = tp & 255; const float ph = (float)((k * tt) & 255) * (1.f / 128.f);
        DFT[t] = (bf16)f2bf((tp < 256 ? __builtin_amdgcn_cosf(0.5f * ph) : -__builtin_amdgcn_sinf(0.5f * ph)) * (1.f / 16.f)); }
    bf16* M1 = (bf16*)(a.ws + WS_M1);
    for (int t = gtid; t < 128 * 128; t += GT) { const int kk = t & 127, m = t >> 7, k1 = m & 63, t1 = kk & 63; const float ph = (float)((k1 * t1) & 63) * (1.f / 32.f);
        const float c = __builtin_amdgcn_cosf(0.5f * ph), s = __builtin_amdgcn_sinf(0.5f * ph); float v;
        if (m < 64) v = (kk < 64) ? c : -s; else v = (kk < 64) ? s : c;
        M1[t] = (bf16)f2bf(v); }
    bf16* M2 = (bf16*)(a.ws + WS_M2);
    for (int t = gtid; t < 64 * 128; t += GT) { const int kk = t & 127, k2 = t >> 7, t2 = kk & 63; const float ph = (float)((k2 * t2) & 63) * (1.f / 32.f);
        M2[t] = (bf16)f2bf((kk < 64 ? __builtin_amdgcn_cosf(0.5f * ph) : -__builtin_amdgcn_sinf(0.5f * ph)) * (1.f / 64.f)); }
}

__device__ __forceinline__ void sw_plain(const Args& a) {
    const int tid = otid(), lane = tid & 63, wave = tid >> 6, G = gridDim.x, bid = obid(), r = lane & 15, kg = lane >> 4;
    const float* MOD = (const float*)(a.ws + WS_MOD);
    const bf16* W1T = (const bf16*)(a.ws + WS_W1T);
    float* SW = (float*)(a.ws + WS_SW);
    for (int task = ((G - 1 - bid + G - 48) % G) * NWAVES + wave; task < 4 * 160; task += G * NWAVES) {
        const int l = task / 160, tt = task % 160, n0 = (tt < 96 ? tt : tt + 48) * 16;
        const float* sp = MOD + (size_t)(l * 9 + (r < 9 ? r : 0)) * 3072 + kg * 8;
        const bf16* wp = W1T + ((size_t)l * N1 + n0 + r) * 1024 + kg * 8;
        f32x4 acc = (f32x4){0.f, 0.f, 0.f, 0.f};
#pragma unroll 8
        for (int ksx = 0; ksx < 32; ++ksx) {
            const f32x4 s0 = *(const f32x4*)(sp + ksx * 32), s1 = *(const f32x4*)(sp + ksx * 32 + 4);
            u32x4 af; af.x = pk2(s0.x, s0.y); af.y = pk2(s0.z, s0.w); af.z = pk2(s1.x, s1.y); af.w = pk2(s1.z, s1.w);
            if (r >= 9) af = (u32x4){0u, 0u, 0u, 0u};
            const bf16x8 bfr = *(const bf16x8*)(wp + ksx * 32);
            acc = __builtin_amdgcn_mfma_f32_16x16x32_bf16(__builtin_bit_cast(bf16x8, af), bfr, acc, 0, 0, 0);
        }
#pragma unroll
        for (int q = 0; q < 4; ++q) { const int j = 4 * kg + q; if (j < 9) SW[(size_t)(l * 9 + j) * N1 + n0 + r] = acc[q]; }
    }
}
__device__ __forceinline__ void sw_folded(const Args& a, LAS unsigned char* lds, int it) {
    const int tid = otid(), lane = tid & 63, wave = tid >> 6;
    const int g = it & 3, kind = (it >> 2) % 3, l = it / 12;
    const float* MOD = (const float*)(a.ws + WS_MOD);
    const float* GM = (const float*)(a.ws + WS_GMAT);
    float* SW = (float*)(a.ws + WS_SW);
    LAS float* part = (LAS float*)lds;
    LAS float* tj = part + 8 * 9 * 64;
    const int base = (kind == 0 ? 1808 : 2320) + 64 * g;
    const float* Gm = (kind == 0) ? (a.in[I_POOLW] + (size_t)(l * 4 + g) * 4096) : (GM + (size_t)((l * 4 + g) * 2 + (kind - 1)) * 4096);
    float acc[9];
#pragma unroll
    for (int j = 0; j < 9; ++j) acc[j] = 0.f;
    const float* wp = a.in[I_WIN] + ((size_t)l * 1024 + wave * 128) * PIN + base + lane;
#pragma unroll 1
    for (int kb = 0; kb < 128; kb += 64) {
        float wv[64];
#pragma unroll
        for (int k = 0; k < 64; ++k) wv[k] = __builtin_nontemporal_load(wp + (size_t)(kb + k) * PIN);
#pragma unroll
        for (int k = 0; k < 64; ++k)
#pragma unroll
            for (int j = 0; j < 9; ++j) acc[j] += MOD[(size_t)(l * 9 + j) * 3072 + wave * 128 + kb + k] * wv[k];
    }
#pragma unroll
    for (int j = 0; j < 9; ++j) part[(wave * 9 + j) * 64 + lane] = acc[j];
    __syncthreads();
    for (int i = tid; i < 576; i += NTHR) { float s2 = 0.f;
#pragma unroll
        for (int w = 0; w < 8; ++w) s2 += part[w * 576 + i];
        tj[i] = s2; }
    __syncthreads();
    for (int i = tid; i < 576; i += NTHR) { const int j = i >> 6, d = i & 63; float s2 = 0.f;
        for (int c = 0; c < 64; ++c) s2 += tj[j * 64 + c] * Gm[c * 64 + d];
        SW[(size_t)(l * 9 + j) * N1 + 1536 + kind * 256 + g * 64 + d] = s2; }
    __syncthreads();
}

__device__ __forceinline__ void phase_0b(const Args& a, LAS unsigned char* lds) {
    const int tid = otid(), lane = tid & 63, wave = tid >> 6, G = gridDim.x, bid = obid();
    const int gtid = bid * NTHR + tid, GT = G * NTHR;
    const float* MOD = (const float*)(a.ws + WS_MOD);
    const float* GM = (const float*)(a.ws + WS_GMAT);
    bf16* W1T = (bf16*)(a.ws + WS_W1T);
    for (int it = bid; it < 384; it += G) {
        const int kblk = it & 7, g = (it >> 3) & 3, kind = (it >> 5) % 3, l = it / 96;
        LAS bf16* Al = (LAS bf16*)lds; LAS bf16* Bl = Al + 128 * 72;
        const int base = (kind == 0 ? 1808 : 2320) + 64 * g;
        const float* Gm = (kind == 0) ? (a.in[I_POOLW] + (size_t)(l * 4 + g) * 4096) : (GM + (size_t)((l * 4 + g) * 2 + (kind - 1)) * 4096);
        {
            const int row = tid >> 2, c0 = (tid & 3) * 16;
            const f32x4* wp = (const f32x4*)(a.in[I_WIN] + ((size_t)l * 1024 + kblk * 128 + row) * PIN + base + c0);
            const f32x4 w0 = __builtin_nontemporal_load(wp), w1 = __builtin_nontemporal_load(wp + 1), w2 = __builtin_nontemporal_load(wp + 2), w3 = __builtin_nontemporal_load(wp + 3);
            u32x4 o0, o1; o0.x = pk2(w0.x, w0.y); o0.y = pk2(w0.z, w0.w); o0.z = pk2(w1.x, w1.y); o0.w = pk2(w1.z, w1.w);
            o1.x = pk2(w2.x, w2.y); o1.y = pk2(w2.z, w2.w); o1.z = pk2(w3.x, w3.y); o1.w = pk2(w3.z, w3.w);
            *(LAS u32x4*)(Al + row * 72 + c0) = o0; *(LAS u32x4*)(Al + row * 72 + c0 + 8) = o1;
            const int c = tid >> 3, d0 = (tid & 7) * 8;
            const f32x4 g0 = *(const f32x4*)(Gm + c * 64 + d0), g1 = *(const f32x4*)(Gm + c * 64 + d0 + 4);
            Bl[(d0 + 0) * 72 + c] = (bf16)f2bf(g0.x); Bl[(d0 + 1) * 72 + c] = (bf16)f2bf(g0.y); Bl[(d0 + 2) * 72 + c] = (bf16)f2bf(g0.z); Bl[(d0 + 3) * 72 + c] = (bf16)f2bf(g0.w);
            Bl[(d0 + 4) * 72 + c] = (bf16)f2bf(g1.x); Bl[(d0 + 5) * 72 + c] = (bf16)f2bf(g1.y); Bl[(d0 + 6) * 72 + c] = (bf16)f2bf(g1.z); Bl[(d0 + 7) * 72 + c] = (bf16)f2bf(g1.w);
        }
        __syncthreads();
        {
            const int m0 = wave * 16, r = lane & 15, kg = lane >> 4;
#pragma unroll
            for (int nt = 0; nt < 4; ++nt) {
                const f32x4 acc = tile_mm<2>((f32x4){0.f, 0.f, 0.f, 0.f}, Al, 72, m0, Bl, 72, nt * 16, lane);
                u32x2 o; o.x = pk2(acc[0], acc[1]); o.y = pk2(acc[2], acc[3]);
                *(u32x2*)(W1T + ((size_t)l * N1 + 1536 + kind * 256 + g * 64 + nt * 16 + r) * 1024 + kblk * 128 + m0 + 4 * kg) = o;
            }
        }
        __syncthreads();
    }
    for (int it = G - 1 - bid; it < 48; it += G) sw_folded(a, lds, it);
    sw_plain(a);
    const float* POS = (const float*)(a.ws + WS_POS);
    bf16* HB = (bf16*)a.out;
    bf16* XB = (bf16*)a.out + (size_t)M * D;
    float* RSS = (float*)(a.ws + WS_RSS);
    unsigned* qx = (unsigned*)(a.ws + WS_CTL) + CW_Q + 2048;
    volatile LAS unsigned* qslot = (volatile LAS unsigned*)(lds + MISC_OFF) + 16;
    if (tid == 0) qslot[0] = atomicAdd(qx, 1u);
    for (;;) {
        __syncthreads();
        const int ch = (int)qslot[0];
        __syncthreads();
        if (ch >= M / 32) break;
        unsigned nx = 0u;
        if (tid == 0) nx = atomicAdd(qx, 1u);
        const int r0 = ch * 32 + wave;
        f32x4 v[4][4], pe[4][4];
#pragma unroll
        for (int u = 0; u < 4; ++u) {
            const int row = r0 + u * NWAVES;
#pragma unroll
            for (int q = 0; q < 4; ++q) { v[u][q] = (f32x4){0.f, 0.f, 0.f, 0.f}; pe[u][q] = v[u][q]; }
            if (row < M_CTX) {
                const f32x4* xr = (const f32x4*)(a.in[I_XP] + (size_t)row * D) + lane;
#pragma unroll
                for (int q = 0; q < 4; ++q) v[u][q] = __builtin_nontemporal_load(xr + 64 * q);
            } else if (row < M) {
                const int rs = row - M_CTX, t = rs & 4095, gr = t >> 6, gc = t & 63;
                const f32x4* xr = (const f32x4*)(a.in[I_XS] + (size_t)rs * D) + lane;
#pragma unroll
                for (int q = 0; q < 4; ++q) v[u][q] = __builtin_nontemporal_load(xr + 64 * q);
                pe[u][0] = *((const f32x4*)(POS + gr * 256) + lane); pe[u][1] = *((const f32x4*)(POS + 64 * 256 + gr * 256) + lane);
                pe[u][2] = *((const f32x4*)(POS + gc * 256) + lane); pe[u][3] = *((const f32x4*)(POS + 64 * 256 + gc * 256) + lane);
            }
        }
#pragma unroll
        for (int u = 0; u < 4; ++u) {
            const int row = r0 + u * NWAVES;
            if (row < M) {
                const int j = cond_of_row(row);
                float ss = 0.f;
#pragma unroll
                for (int q = 0; q < 4; ++q) { v[u][q] = v[u][q] + pe[u][q]; ss += (v[u][q].x * v[u][q].x + v[u][q].y * v[u][q].y) + (v[u][q].z * v[u][q].z + v[u][q].w * v[u][q].w); }
                ss = wave_sum(ss);
                u32x2* xrow = (u32x2*)(XB + (size_t)row * D) + lane;
                u32x2* hrow = (u32x2*)(HB + (size_t)row * D) + lane;
#pragma unroll
                for (int q = 0; q < 4; ++q) {
                    u32x2 xb; xb.x = pk2(v[u][q].x, v[u][q].y); xb.y = pk2(v[u][q].z, v[u][q].w);
                    xrow[64 * q] = xb;
                    const f32x4 ng = *((const f32x4*)(a.in[I_NORMG] + 256 * q) + lane);
                    const f32x4 sc = *((const f32x4*)(MOD + (0 * 9 + j) * 3072 + 1024 + 256 * q) + lane);
                    u32x2 h; h.x = pk2(v[u][q].x * ng.x * (1.f + sc.x), v[u][q].y * ng.y * (1.f + sc.y)); h.y = pk2(v[u][q].z * ng.z * (1.f + sc.z), v[u][q].w * ng.w * (1.f + sc.w));
                    hrow[64 * q] = h;
                }
                if (lane < 16) RSS[(size_t)row * 16 + lane] = (lane == 0) ? ss : 0.f;
            }
        }
        if (tid == 0) qslot[0] = nx;
    }
}

struct Epi1 {   static constexpr int ID = 1;
    static constexpr bool PERM = true;
    bf16* PB; float* BA; const float* RSS; const float* SW;
    int cheap; bf16* dumb;
    const LAS float* rtab;
    float* VSS;
    __device__ __forceinline__ void operator()(const f32x4 (&acc)[2][2][4][2], const pg8::Unit& u, int wr, int wc, int fr, int fq, int ui) const {
        const int pn = u.pn, j = u.pm < 32 ? 0 : 1 + ((u.pm - 32) >> 4);
        const int row0 = u.pm * 256 + (u.half == 2 ? 128 : 0) + wr * 64 + fr, cb = pn * 256 + wc * 32 + 8 * fq;
        if (cheap == 1) {
#pragma unroll
            for (int ai = 0; ai < 2; ++ai)
#pragma unroll
                for (int m = 0; m < 4; ++m)
#pragma unroll
                    for (int bj = 0; bj < 2; ++bj) { const f32x4 v0 = acc[ai][bj][m][0], v1 = acc[ai][bj][m][1];
                        u32x4 w; w.x = pk2(v0[0], v0[1]); w.y = pk2(v0[2], v0[3]); w.z = pk2(v1[0], v1[1]); w.w = pk2(v1[2], v1[3]);
                        *(u32x4*)(dumb + (size_t)((row0 + ai * 128 + m * 16) & 1023) * LDP + cb + bj * 128) = w; }
            return;
        }
        const int act = (pn == 0 || pn == 2 || pn == 3 || pn == 5) ? 1 : ((pn == 1 || pn == 4) ? 2 : 0);
        f32x4 bv[2][2];
#pragma unroll
        for (int bj = 0; bj < 2; ++bj)
#pragma unroll
            for (int n = 0; n < 2; ++n) bv[bj][n] = *(const f32x4*)(SW + j * N1 + cb + bj * 128 + 4 * n);
#pragma unroll
        for (int ai = 0; ai < 2; ++ai) if (!(ai && u.half))
#pragma unroll
            for (int m = 0; m < 4; ++m) {
                const int row = row0 + ai * 128 + m * 16;
                const float rinv = rtab[ui * 256 + wr * 64 + fr + ai * 128 + m * 16];
                float vss = 0.f;
#pragma unroll
                for (int bj = 0; bj < 2; ++bj) {
                    f32x4 v0 = acc[ai][bj][m][0] * rinv + bv[bj][0], v1 = acc[ai][bj][m][1] * rinv + bv[bj][1];
                    if (pn < 12) {
                        if (act == 1) {
#pragma unroll
                            for (int q = 0; q < 4; ++q) { v0[q] = silu_f(v0[q]); v1[q] = silu_f(v1[q]); }
                        } else if (act == 2) {
#pragma unroll
                            for (int q = 0; q < 4; ++q) { v0[q] = gelu_tanh_f(v0[q]); v1[q] = gelu_tanh_f(v1[q]); }
                        }
                        u32x4 w; w.x = pk2(v0[0], v0[1]); w.y = pk2(v0[2], v0[3]); w.z = pk2(v1[0], v1[1]); w.w = pk2(v1[2], v1[3]);
                        if (pn == 4) vss += (v0[0] * v0[0] + v0[1] * v0[1]) + (v0[2] * v0[2] + v0[3] * v0[3]) + (v1[0] * v1[0] + v1[1] * v1[1]) + (v1[2] * v1[2] + v1[3] * v1[3]);
                        if ((pn == 7 || pn == 8) && u.pm >= 32 && !cheap) {
                            const int t = row - M_CTX, tq = t & 4095, sl = (wc * 32 + 8 * fq + bj * 128) >> 2;
                            bf16* dst = PB + (size_t)(M_CTX + (t & ~4095) + sl * 64 + (tq >> 6)) * LDP + C_PF + (tq & 63) * 8 + (pn == 8 ? 4 : 0);
                            u32x2 lo2, hi2; lo2.x = w.x; lo2.y = w.y; hi2.x = w.z; hi2.y = w.w;
                            *(u32x2*)dst = lo2; *(u32x2*)(dst + 64 * LDP) = hi2;
                        } else
                        *(u32x4*)((cheap ? dumb + (size_t)(row & 1023) * LDP : PB + (size_t)row * LDP) + cb + bj * 128) = w;
                    } else if (bj == 0 && wc == 0 && fq < 2) {
                        f32x4* bp = (f32x4*)(BA + (size_t)row * 16 + 8 * fq); bp[0] = v0; bp[1] = v1;
                    }
                }
                if (pn == 4) { vss += __shfl_xor(vss, 16); vss += __shfl_xor(vss, 32); if (fq == 0 && !cheap) VSS[(size_t)row * 4 + wc] = vss; }
            }
    }
};
struct Epi2 {   static constexpr int ID = 2;
    static constexpr bool PERM = true;
    bf16* XB; bf16* XBo; bf16* HB; float* RSS; const float* gate;
    const float* ng_next; const float* sc_next;
    unsigned char* dum; int dry;
    __device__ __forceinline__ void operator()(const f32x4 (&acc)[2][2][4][2], const pg8::Unit& u, int wr, int wc, int fr, int fq, int) const {
        const int pn = u.pn, j = u.pm < 32 ? 0 : 1 + ((u.pm - 32) >> 4);
        const int row0 = u.pm * 256 + (u.half == 2 ? 128 : 0) + wr * 64 + fr, cb = pn * 256 + wc * 32 + 8 * fq;
        f32x4 gv[2][2], gs[2][2];
#pragma unroll
        for (int bj = 0; bj < 2; ++bj)
#pragma unroll
            for (int n = 0; n < 2; ++n) {
                gv[bj][n] = *(const f32x4*)(gate + j * 3072 + cb + bj * 128 + 4 * n);
                if (ng_next) { const f32x4 ng = *(const f32x4*)(ng_next + cb + bj * 128 + 4 * n), sc = *(const f32x4*)(sc_next + j * 3072 + cb + bj * 128 + 4 * n); gs[bj][n] = ng * (sc + 1.f); }
                else gs[bj][n] = (f32x4){0.f, 0.f, 0.f, 0.f};
            }
#pragma unroll
        for (int ai = 0; ai < 2; ++ai) if (!(ai && u.half)) {
            u32x4 xall[4][2];
#pragma unroll
            for (int m = 0; m < 4; ++m)
#pragma unroll
                for (int bj = 0; bj < 2; ++bj) xall[m][bj] = *(const u32x4*)(XB + (size_t)(row0 + ai * 128 + m * 16) * D + cb + bj * 128);
            asm volatile("" ::: "memory");
#pragma unroll
            for (int m = 0; m < 4; ++m) {
                const int row = row0 + ai * 128 + m * 16;
                float ssq = 0.f;
#pragma unroll
                for (int bj = 0; bj < 2; ++bj) {
                    const u32x4 xq = xall[m][bj];
                    const f32x4 x0 = (f32x4){bflo(xq.x), bfhi(xq.x), bflo(xq.y), bfhi(xq.y)}, x1 = (f32x4){bflo(xq.z), bfhi(xq.z), bflo(xq.w), bfhi(xq.w)};
                    const f32x4 n0 = x0 + gv[bj][0] * acc[ai][bj][m][0], n1 = x1 + gv[bj][1] * acc[ai][bj][m][1];
                    u32x4 xw; xw.x = pk2(n0[0], n0[1]); xw.y = pk2(n0[2], n0[3]); xw.z = pk2(n1[0], n1[1]); xw.w = pk2(n1[2], n1[3]);
                    *(u32x4*)((dry ? (bf16*)dum + (size_t)(row & 1023) * D : XBo + (size_t)row * D) + cb + bj * 128) = xw;
                    ssq += (n0.x * n0.x + n0.y * n0.y) + (n0.z * n0.z + n0.w * n0.w) + (n1.x * n1.x + n1.y * n1.y) + (n1.z * n1.z + n1.w * n1.w);
                    if (ng_next) { const f32x4 h0 = n0 * gs[bj][0], h1 = n1 * gs[bj][1];
                        u32x4 w; w.x = pk2(h0[0], h0[1]); w.y = pk2(h0[2], h0[3]); w.z = pk2(h1[0], h1[1]); w.w = pk2(h1[2], h1[3]);
                        *(u32x4*)((dry ? (bf16*)(dum + 4 * MiB) + (size_t)(row & 1023) * D : HB + (size_t)row * D) + cb + bj * 128) = w; }
                }
                ssq += __shfl_xor(ssq, 16); ssq += __shfl_xor(ssq, 32);
                if (fq == 0) (dry ? (float*)(dum + 8 * MiB) + (size_t)(row & 1023) * 16 : RSS + (size_t)row * 16)[pn * 4 + wc] = ssq;
            }
        }
    }
};

typedef short bf16x4 __attribute__((ext_vector_type(4)));
__device__ __forceinline__ f32x4 mfma16(bf16x4 a, bf16x4 b, f32x4 c) { return __builtin_amdgcn_mfma_f32_16x16x16bf16_1k(a, b, c, 0, 0, 0); }
__device__ __forceinline__ bf16x4 pack4(f32x4 v) { u32x2 w; w.x = pk2(v[0], v[1]); w.y = pk2(v[2], v[3]); return __builtin_bit_cast(bf16x4, w); }
__device__ __forceinline__ bf16x8 pack8(f32x4 lo, f32x4 hi) { u32x4 w; w.x = pk2(lo[0], lo[1]); w.y = pk2(lo[2], lo[3]); w.z = pk2(hi[0], hi[1]); w.w = pk2(hi[2], hi[3]); return __builtin_bit_cast(bf16x8, w); }
constexpr int PREP_ITEM = 5 * 4096;

__device__ __forceinline__ void prep_dinv(const LAS bf16* Ab_, LAS bf16* Dl, int lane) {
    const int blk = lane >> 4, c = lane & 15;
    unsigned ab = (unsigned)(size_t)(Ab_ + (16 * blk) * 72 + 16 * blk);
    asm volatile("" : "+v"(ab));
    const LAS bf16* Ab = (const LAS bf16*)(size_t)ab;
    float x[16];
#pragma unroll
    for (int ii = 0; ii < 16; ++ii) {
        float acc = (ii == c) ? 1.f : 0.f;
        const LAS u32x4* ar = (const LAS u32x4*)(Ab + ii * 72);
#pragma unroll
        for (int jq = 0; jq < 2; ++jq) {
            if (8 * jq < ii) {
                const u32x4 av = ar[jq];
                if (8 * jq + 0 < ii) acc += bflo(av.x) * x[8 * jq + 0];
                if (8 * jq + 1 < ii) acc += bfhi(av.x) * x[8 * jq + 1];
                if (8 * jq + 2 < ii) acc += bflo(av.y) * x[8 * jq + 2];
                if (8 * jq + 3 < ii) acc += bfhi(av.y) * x[8 * jq + 3];
                if (8 * jq + 4 < ii) acc += bflo(av.z) * x[8 * jq + 4];
                if (8 * jq + 5 < ii) acc += bfhi(av.z) * x[8 * jq + 5];
                if (8 * jq + 6 < ii) acc += bflo(av.w) * x[8 * jq + 6];
                if (8 * jq + 7 < ii) acc += bfhi(av.w) * x[8 * jq + 7];
            }
        }
        asm volatile("" : "+v"(acc) :: "memory");
        x[ii] = acc;
    }
#pragma unroll
    for (int ii = 0; ii < 16; ++ii) Dl[(blk * 16 + ii) * 24 + c] = (bf16)f2bf(x[ii]);
}

__device__ __forceinline__ void prep_dinv_mfma(const LAS bf16* Ab_, LAS bf16* Dl, int blk, int lane) {
    const int r = lane & 15, kg = lane >> 4;
    const LAS bf16* Ab = Ab_ + (16 * blk) * 72 + 16 * blk;
    const bf16x4 mA = *(const LAS bf16x4*)(Ab + r * 72 + 4 * kg);
    bf16x4 mB;
#pragma unroll
    for (int j = 0; j < 4; ++j) mB[j] = (short)Ab[(4 * kg + j) * 72 + r];
    const f32x4 z0 = (f32x4){0.f, 0.f, 0.f, 0.f};
    const bf16x4 p1B = pack4(mfma16(mA, mB, z0)), p1A = pack4(mfma16(mB, mA, z0));
    const bf16x4 p2B = pack4(mfma16(p1A, p1B, z0)), p2A = pack4(mfma16(p1B, p1A, z0));
    const bf16x4 p3B = pack4(mfma16(p2A, p2B, z0));
    f32x4 Z;
#pragma unroll
    for (int j = 0; j < 4; ++j) Z[j] = bf2f((unsigned)(unsigned short)mA[j]) + ((r == 4 * kg + j) ? 1.f : 0.f);
    Z = mfma16(p1B, pack4(Z), Z);
    Z = mfma16(p2B, pack4(Z), Z);
    Z = mfma16(p3B, pack4(Z), Z);
    *(LAS u32x2*)(Dl + (blk * 16 + r) * 24 + 4 * kg) = __builtin_bit_cast(u32x2, pack4(Z));
}
struct PrepPre { u32x4 xr[7]; };
__device__ __forceinline__ void prep_prefetch(const Args& a, PrepPre& P, int sc, int h) {
    const int tid = otid();
    const bf16* PB = (const bf16*)(a.ws + WS_PB);
    const SeqGeo sg = seq_geo(sc);
    const int cg = tid % 24, seg = tid / 24, part = cg >> 3, d0 = (cg & 7) * 8;
    const int col = C_Q + (part < 3 ? part : 0) * 256 + h * 64 + d0;
#pragma unroll
    for (int i = 0; i < 7; ++i) { const int ts = sg.tseq0 + 4 * seg - 2 + i;
        P.xr[i] = (tid < 384 && ts >= 0 && ts < sg.T) ? *(const u32x4*)(PB + (size_t)(sg.seq_row0 + ts) * LDP + col) : (u32x4){0u, 0u, 0u, 0u}; }
}
constexpr int PRE_QK = 49920, PRE_V = 131840, PRE_BA = PRE_V + 9216;
__device__ __forceinline__ void prep_dma(const Args& a, LAS unsigned char* lds, int sc, int h) {
    const int tid = otid(), lane = tid & 63, wave = __builtin_amdgcn_readfirstlane(tid >> 6);
    const bf16* PB = (const bf16*)(a.ws + WS_PB);
    const float* BA = (const float*)(a.ws + WS_BA);
    const SeqGeo sg = seq_geo(sc);
#pragma unroll
    for (int k = 0; k < 4; ++k) {
        const int p = wave + 8 * k;
        if (p < 27) {
            const int part = p / 9, r8 = p % 9, row = r8 * 8 + (lane >> 3);
            int ts = sg.tseq0 - 2 + row; ts = ts < 0 ? 0 : (ts >= sg.T ? sg.T - 1 : ts);
            const bf16* src = PB + (size_t)(sg.seq_row0 + ts) * LDP + C_Q + part * 256 + h * 64 + (lane & 7) * 8;
            const int dst = (part < 2 ? PRE_QK + part * 9216 : PRE_V) + r8 * 1024;
            __builtin_amdgcn_global_load_lds((const unsigned*)src, (LAS unsigned*)(lds + dst), 16, 0, 0);
        } else if (p < 31) {
            const float* src = BA + (size_t)(sc * 64 + (p - 27) * 16 + (lane >> 2)) * 16 + (lane & 3) * 4;
            __builtin_amdgcn_global_load_lds((const unsigned*)src, (LAS unsigned*)(lds + PRE_BA + (p - 27) * 1024), 16, 0, 0);
        }
    }
}
__device__ __forceinline__ void prep_item(const Args& a, LAS unsigned char* lds, int l, int sc, int h, int nsc, int nh) {
    const int tid = otid(), lane = tid & 63, wave = __builtin_amdgcn_readfirstlane(tid >> 6);
    LAS bf16* Qb = (LAS bf16*)lds;
    LAS bf16* Kb = Qb + 64 * 72;
    LAS bf16* Vb = Kb + 64 * 72;
    constexpr int PD = 30720;
    LAS unsigned char* dbase = lds + 68352;
    LAS float* beta = (LAS float*)(lds + 129792);
    LAS float* gcs = beta + 128;
    LAS float* egs = gcs + 128;
    LAS float* eks = egs + 128;
    const bf16* PB = (const bf16*)(a.ws + WS_PB);
    const float* BA = (const float*)(a.ws + WS_BA);
    const SeqGeo sg = seq_geo(sc);
    const int row0 = sc * 64;
    if (wave >= 6) {
        const int dir = wave - 6, tok = dir ? 63 - lane : lane;
        const LAS float* BAl = (const LAS float*)(lds + PRE_BA);
        const float bl = BAl[tok * 16 + dir * 4 + h], al = BAl[tok * 16 + 8 + dir * 4 + h];
        const float bt = 1.f / (1.f + __expf(-bl));
        const float xx = al + a.in[I_DTB][(l * 2 + dir) * 4 + h];
        const float ex = __expf(xx);
        const float sp = xx > 20.f ? xx : (ex < 1e-2f ? ex * (1.f - ex * (0.5f - ex * (1.f / 3.f))) : __logf(1.f + ex));
        float g = -__expf(a.in[I_ALOG][(l * 2 + dir) * 4 + h]) * sp;
#pragma unroll
        for (int o = 1; o < 64; o <<= 1) { const float t = __shfl_up(g, o); if (lane >= o) g += t; }
        const float gl = __shfl(g, 63);
        beta[dir * 64 + lane] = bt; gcs[dir * 64 + lane] = g; egs[dir * 64 + lane] = __expf(g); eks[dir * 64 + lane] = __expf(gl - g);
        if (lane == 63) ((float*)(a.ws + WS_PGL))[(sc * 4 + h) * 2 + dir] = __expf(g);
    } else {
        const int cg = tid % 24, seg = tid / 24, part = cg >> 3, d0 = (cg & 7) * 8;
        const int chan = part * 256 + h * 64 + d0;
        u32x4 xr[7];
        const LAS unsigned char* raw = lds + (part < 2 ? PRE_QK + part * 9216 : PRE_V) + (4 * seg) * 128 + (cg & 7) * 16;
#pragma unroll
        for (int i = 0; i < 7; ++i) { const int ts = sg.tseq0 + 4 * seg - 2 + i;
            xr[i] = (ts >= 0 && ts < sg.T) ? *(const LAS u32x4*)(raw + i * 128) : (u32x4){0u, 0u, 0u, 0u}; }
        f32x4 w0[4], w1[4];
#pragma unroll
        for (int jj = 0; jj < 4; ++jj) { w0[jj] = *(const f32x4*)(a.in[I_CONV] + (size_t)(l * 4 + jj) * 768 + chan); w1[jj] = *(const f32x4*)(a.in[I_CONV] + (size_t)(l * 4 + jj) * 768 + chan + 4); }
        float o[4][8];
#pragma unroll
        for (int j = 0; j < 4; ++j)
#pragma unroll
            for (int c = 0; c < 8; ++c) o[j][c] = 0.f;
#pragma unroll
        for (int i = 0; i < 7; ++i) {
            const float x0 = bflo(xr[i].x), x1 = bfhi(xr[i].x), x2 = bflo(xr[i].y), x3 = bfhi(xr[i].y), x4 = bflo(xr[i].z), x5 = bfhi(xr[i].z), x6 = bflo(xr[i].w), x7 = bfhi(xr[i].w);
#pragma unroll
            for (int j = 0; j < 4; ++j) { const int jj = i - j;
                if (jj >= 0 && jj < 4) {
                    o[j][0] += w0[jj].x * x0; o[j][1] += w0[jj].y * x1; o[j][2] += w0[jj].z * x2; o[j][3] += w0[jj].w * x3;
                    o[j][4] += w1[jj].x * x4; o[j][5] += w1[jj].y * x5; o[j][6] += w1[jj].z * x6; o[j][7] += w1[jj].w * x7; } }
        }
        LAS bf16* bdst = (part == 0 ? Qb : (part == 1 ? Kb : Vb)) + (4 * seg) * 72 + d0;
#pragma unroll
        for (int j = 0; j < 4; ++j) {
            float v[8]; float ss = 0.f;
#pragma unroll
            for (int c = 0; c < 8; ++c) { v[c] = silu_f(o[j][c]); ss += v[c] * v[c]; }
            ss += __shfl_xor(ss, 1); ss += __shfl_xor(ss, 2); ss += __shfl_xor(ss, 4);
            const float sc_ = (part == 2) ? 1.f : rsqrtf(ss + EPS) * (part == 0 ? 0.125f : 1.f);
#pragma unroll
            for (int c = 0; c < 8; ++c) v[c] *= sc_;
            { u32x4 ob; ob.x = pk2(v[0], v[1]); ob.y = pk2(v[2], v[3]); ob.z = pk2(v[4], v[5]); ob.w = pk2(v[6], v[7]); *(LAS u32x4*)(bdst + j * 72) = ob; }
        }
    }
    LDS_BARRIER();
    if (nsc >= 0) prep_dma(a, lds, nsc, nh);
    {
        const int mt = wave >> 1, nh_ = wave & 1, m0 = mt * 16, r = lane & 15, kg = lane >> 4, arow = m0 + r;
#pragma unroll
        for (int t = 0; t < 2; ++t) {
            const int b0 = nh_ * 32 + 16 * t + 4 * kg;
            const f32x4 KKa = tile_mm<2>((f32x4){0.f, 0.f, 0.f, 0.f}, Kb, 72, nh_ * 32 + 16 * t, Kb, 72, m0, lane);
            const f32x4 QKa = tile_mm<2>((f32x4){0.f, 0.f, 0.f, 0.f}, Kb, 72, nh_ * 32 + 16 * t, Qb, 72, m0, lane);
#pragma unroll
            for (int dir = 0; dir < 2; ++dir) {
                LAS bf16* Ab = (LAS bf16*)(dbase + dir * PD); LAS bf16* QKl = Ab + 64 * 72;
                const int i = dir ? 63 - arow : arow;
                const float gi = gcs[dir * 64 + i], bi = beta[dir * 64 + i];
                float av[4], qv[4];
#pragma unroll
                for (int q = 0; q < 4; ++q) {
                    const int j = dir ? 63 - (b0 + q) : b0 + q;
                    const float dec = (i >= j) ? __expf(gi - gcs[dir * 64 + j]) : 0.f;
                    av[q] = (i > j) ? -bi * KKa[q] * dec : 0.f; qv[q] = QKa[q] * dec;
                }
                u32x2 aw, qw; const int j0 = dir ? 60 - b0 : b0;
                if (dir) { aw.x = pk2(av[3], av[2]); aw.y = pk2(av[1], av[0]); qw.x = pk2(qv[3], qv[2]); qw.y = pk2(qv[1], qv[0]); }
                else { aw.x = pk2(av[0], av[1]); aw.y = pk2(av[2], av[3]); qw.x = pk2(qv[0], qv[1]); qw.y = pk2(qv[2], qv[3]); }
                *(LAS u32x2*)(Ab + i * 72 + j0) = aw; *(LAS u32x2*)(QKl + i * 72 + j0) = qw;
            }
        }
    }
    LDS_BARRIER();
    bf16* PI0 = (bf16*)(a.ws + WS_PREP) + (size_t)((sc * 4 + h) * 2) * PREP_ITEM;
    prep_dinv_mfma((const LAS bf16*)(dbase + (wave >> 2) * PD), (LAS bf16*)(dbase + (wave >> 2) * PD + 3 * 9216), wave & 3, lane);
    for (int t = tid; t < 2048; t += NTHR) {
        const int dir = t >> 10, which = (t >> 9) & 1, rw = (t >> 3) & 63, sgp = t & 7, n0a = 32 * (sgp >> 2) + 4 * (sgp & 3), n0b = n0a + 16;
        float v[8];
        if (which == 0) {
            const int tok = dir ? 63 - rw : rw; const float e = egs[dir * 64 + rw];
            const u32x2 qa = *(const LAS u32x2*)(Qb + tok * 72 + n0a), qb_ = *(const LAS u32x2*)(Qb + tok * 72 + n0b);
            v[0] = bflo(qa.x) * e; v[1] = bfhi(qa.x) * e; v[2] = bflo(qa.y) * e; v[3] = bfhi(qa.y) * e;
            v[4] = bflo(qb_.x) * e; v[5] = bfhi(qb_.x) * e; v[6] = bflo(qb_.y) * e; v[7] = bfhi(qb_.y) * e;
        } else {
#pragma unroll
            for (int c = 0; c < 4; ++c) { const int ia = n0a + c, ib = n0b + c;
                v[c] = bf2f(Kb[(dir ? 63 - ia : ia) * 72 + rw]) * eks[dir * 64 + ia]; v[4 + c] = bf2f(Kb[(dir ? 63 - ib : ib) * 72 + rw]) * eks[dir * 64 + ib]; }
        }
        u32x4 o; o.x = pk2(v[0], v[1]); o.y = pk2(v[2], v[3]); o.z = pk2(v[4], v[5]); o.w = pk2(v[6], v[7]);
        *(u32x4*)(PI0 + (size_t)dir * PREP_ITEM + (1 + which) * 4096 + rw * 64 + sgp * 8) = o;
    }
    LDS_BARRIER();
    {
        const int dir = wave >> 2, r = lane & 15, kg = lane >> 4, cc = 16 * (wave & 3) + r;
        const LAS bf16* Ab = (const LAS bf16*)(dbase + dir * PD); LAS bf16* Wl = (LAS bf16*)(dbase + dir * PD + 2 * 9216); const LAS bf16* Dl = (const LAS bf16*)(dbase + dir * PD + 3 * 9216);
        bf16* PI = PI0 + (size_t)dir * PREP_ITEM;
        f32x4 XU[4], XW[4];
#pragma unroll
        for (int b = 0; b < 4; ++b) {
            f32x4 TU, TW_;
#pragma unroll
            for (int q = 0; q < 4; ++q) { const int i = 16 * b + 4 * kg + q, tok = dir ? 63 - i : i;
                const float bt = beta[dir * 64 + i];
                TU[q] = bt * bf2f(Vb[tok * 72 + cc]); TW_[q] = bt * egs[dir * 64 + i] * bf2f(Kb[tok * 72 + cc]); }
#pragma unroll
            for (int m = 0; m < 4; ++m) if (m < b) {
                const bf16x4 af = *(const LAS bf16x4*)(Ab + (16 * b + r) * 72 + 16 * m + 4 * kg);
                TU = mfma16(af, pack4(XU[m]), TU); TW_ = mfma16(af, pack4(XW[m]), TW_);
            }
            const bf16x4 df = *(const LAS bf16x4*)(Dl + (b * 16 + r) * 24 + 4 * kg);
            XU[b] = mfma16(df, pack4(TU), (f32x4){0.f, 0.f, 0.f, 0.f});
            XW[b] = mfma16(df, pack4(TW_), (f32x4){0.f, 0.f, 0.f, 0.f});
            *(u32x2*)(PI + 4 * 4096 + cc * 64 + 16 * b + 4 * kg) = __builtin_bit_cast(u32x2, pack4(XU[b]));
#pragma unroll
            for (int q = 0; q < 4; ++q) Wl[(16 * b + 4 * kg + q) * 72 + cc] = (bf16)f2bf(XW[b][q]);
        }
    }
    LDS_BARRIER();
    for (int t = tid; t < 2048; t += NTHR) {
        const int dir = t >> 10, which = (t >> 9) & 1, rw = (t >> 3) & 63, sgp = t & 7, n0a = 32 * (sgp >> 2) + 4 * (sgp & 3);
        const LAS bf16* src = (const LAS bf16*)(dbase + dir * PD + (which ? 1 : 2) * 9216) + rw * 72 + n0a;
        const u32x2 lo = *(const LAS u32x2*)src, hi = *(const LAS u32x2*)(src + 16);
        u32x4 o; o.x = lo.x; o.y = lo.y; o.z = hi.x; o.w = hi.y;
        *(u32x4*)(PI0 + (size_t)dir * PREP_ITEM + (which ? 3 : 0) * 4096 + rw * 64 + sgp * 8) = o;
    }
    asm volatile("s_waitcnt vmcnt(8)" ::: "memory");
    LDS_BARRIER();
}

struct SguPre { unsigned vv[8]; u32x4 uu[2], gg[2]; f32x4 vss; };
__device__ __forceinline__ void sgu_loads(const Args& a, SguPre& P, int ch, int g) {
    const int tid = otid(); const bf16* PB = (const bf16*)(a.ws + WS_PB); const int row0 = ch * 128;
#pragma unroll
    for (int i = 0; i < 2; ++i) { const int t = tid + NTHR * i, q = t >> 3, c0 = (t & 7) * 8; const bf16* rp = PB + (size_t)(row0 + q) * LDP + g * 64 + c0;
        P.uu[i] = __builtin_nontemporal_load((const u32x4*)(rp + C_U)); P.gg[i] = __builtin_nontemporal_load((const u32x4*)(rp + C_GB)); }
#pragma unroll
    for (int i = 0; i < 8; ++i) P.vv[i] = __builtin_nontemporal_load((const unsigned*)(PB + (size_t)(row0 + 8 * (tid >> 5) + i) * LDP + C_V + g * 64 + 2 * (tid & 31)));
    P.vss = *(const f32x4*)((const float*)(a.ws + WS_VSS) + (size_t)(row0 + (tid & 127)) * 4);
}
__device__ __forceinline__ void sgu_super(const Args& a, LAS unsigned char* lds, int l, int ch0, int g, int dry) {
    const int tid = otid(), lane = tid & 63, wave = tid >> 6;
    LAS bf16* Wl = (LAS bf16*)lds;
    LAS bf16* VT = Wl + 128 * 136;
    LAS float* rstd = (LAS float*)(VT + 64 * 136);
    LAS float* SV = rstd + 128;
    bf16* PB = (bf16*)(a.ws + WS_PB);
    SguPre P; sgu_loads(a, P, ch0, g);
    const int cp = tid & 31, qb = tid >> 5;
    float bsg[2];
#pragma unroll
    for (int i = 0; i < 2; ++i) bsg[i] = a.in[I_SGUB][(l * 4 + g) * 128 + ((tid + NTHR * i) >> 3)];
    const float gn0 = a.in[I_SGUNG][l * 256 + g * 64 + 2 * cp], gn1 = a.in[I_SGUNG][l * 256 + g * 64 + 2 * cp + 1];
    for (int t = tid; t < 128 * 16; t += NTHR) {
        const int p = t >> 4, q8 = t & 15;
        const f32x4* wp = (const f32x4*)(a.in[I_SGUW] + ((size_t)(l * 4 + g) * 128 + p) * 128 + q8 * 8);
        const f32x4 w0 = wp[0], w1 = wp[1];
        u32x4 o; o.x = pk2(w0.x, w0.y); o.y = pk2(w0.z, w0.w); o.z = pk2(w1.x, w1.y); o.w = pk2(w1.z, w1.w);
        *(LAS u32x4*)(Wl + p * 136 + q8 * 8) = o;
    }
#pragma unroll 1
    for (int cc = 0; cc < 4; ++cc) {
        const int row0 = (ch0 + cc) * 128;
        unsigned vv[8]; u32x4 uu[2], gg[2];
#pragma unroll
        for (int i = 0; i < 2; ++i) { uu[i] = P.uu[i]; gg[i] = P.gg[i]; }
#pragma unroll
        for (int i = 0; i < 8; ++i) vv[i] = P.vv[i];
        if (tid < 128) rstd[tid] = rsqrtf(((P.vss.x + P.vss.y) + (P.vss.z + P.vss.w)) * (1.f / 256.f) + EPS);
        LDS_BARRIER();
        if (cc < 3) sgu_loads(a, P, ch0 + cc + 1, g);
        {
            const f32x4 r0 = *(const LAS f32x4*)(rstd + 8 * qb), r1 = *(const LAS f32x4*)(rstd + 8 * qb + 4);
            const float rs[8] = {r0.x, r0.y, r0.z, r0.w, r1.x, r1.y, r1.z, r1.w};
            u32x4 o0, o1;
#pragma unroll
            for (int j = 0; j < 4; ++j) {
                o0[j] = pk2(bflo(vv[2 * j]) * rs[2 * j] * gn0, bflo(vv[2 * j + 1]) * rs[2 * j + 1] * gn0);
                o1[j] = pk2(bfhi(vv[2 * j]) * rs[2 * j] * gn1, bfhi(vv[2 * j + 1]) * rs[2 * j + 1] * gn1);
            }
            *(LAS u32x4*)(VT + (2 * cp) * 136 + ((qb ^ (cp >> 2)) << 3)) = o0;
            *(LAS u32x4*)(VT + (2 * cp + 1) * 136 + ((qb ^ (cp >> 2)) << 3)) = o1;
        }
        LDS_BARRIER();
        {
            const int m0 = wave * 16, r = lane & 15, kg = lane >> 4;
            bf16x8 af[4];
#pragma unroll
            for (int ksx = 0; ksx < 4; ++ksx) af[ksx] = *(const LAS bf16x8*)(Wl + (m0 + r) * 136 + ksx * 32 + kg * 8);
#pragma unroll
            for (int nt = 0; nt < 4; ++nt) {
                f32x4 acc = (f32x4){0.f, 0.f, 0.f, 0.f};
#pragma unroll
                for (int ksx = 0; ksx < 4; ++ksx) {
                    const int cr = nt * 16 + r;
                    const bf16x8 bfr = *(const LAS bf16x8*)(VT + cr * 136 + (((ksx * 4 + kg) ^ (cr >> 3)) << 3));
                    acc = __builtin_amdgcn_mfma_f32_16x16x32_bf16(bfr, af[ksx], acc, 0, 0, 0);
                }
                *(LAS f32x4*)(SV + (m0 + r) * 68 + nt * 16 + 4 * kg) = acc;
            }
        }
        LDS_BARRIER();
#pragma unroll
        for (int i = 0; i < 2; ++i) {
            const int t = tid + NTHR * i, p = t >> 3, c0 = (t & 7) * 8;
            const f32x4 s0 = *(const LAS f32x4*)(SV + p * 68 + c0), s1 = *(const LAS f32x4*)(SV + p * 68 + c0 + 4);
            const float b = bsg[i];
            u32x4 o;
            o.x = pk2(bflo(uu[i].x) * (s0.x + b) * bflo(gg[i].x), bfhi(uu[i].x) * (s0.y + b) * bfhi(gg[i].x));
            o.y = pk2(bflo(uu[i].y) * (s0.z + b) * bflo(gg[i].y), bfhi(uu[i].y) * (s0.w + b) * bfhi(gg[i].y));
            o.z = pk2(bflo(uu[i].z) * (s1.x + b) * bflo(gg[i].z), bfhi(uu[i].z) * (s1.y + b) * bfhi(gg[i].z));
            o.w = pk2(bflo(uu[i].w) * (s1.z + b) * bflo(gg[i].w), bfhi(uu[i].w) * (s1.w + b) * bfhi(gg[i].w));
            *(u32x4*)((dry ? (bf16*)(a.ws + WS_DUM) + (size_t)((row0 + p) & 1023) * LDP : PB + (size_t)(row0 + p) * LDP) + C_U + g * 64 + c0) = o;
        }
    }
    LDS_BARRIER();
}

__device__ __forceinline__ void pool_item(const Args& a, LAS unsigned char* lds, int l, int sc, int dry) {
    const int tid = otid();
    LAS bf16* xt = (LAS bf16*)lds;
    bf16* PB = (bf16*)(a.ws + WS_PB);
    const SeqGeo sg = seq_geo(sc);
    const int c8 = tid & 31, seg = tid >> 5, half = 1 << (c8 >> 3);
    u32x4 gpre[4];
#pragma unroll
    for (int j = 0; j < 4; ++j) gpre[j] = __builtin_nontemporal_load((const u32x4*)(PB + (size_t)(sg.seq_row0 + sg.tseq0 + 4 * seg + j) * LDP + C_GC + c8 * 8));
    const f32x4 p0 = *(const f32x4*)(a.in[I_POOLS] + l * 256 + c8 * 8), p1 = *(const f32x4*)(a.in[I_POOLS] + l * 256 + c8 * 8 + 4);
    {
        u32x4 v[5];
#pragma unroll
        for (int i = 0; i < 5; ++i) { const int t = tid + NTHR * i, r = t >> 5, ts = sg.tseq0 - 8 + r;
            v[i] = (ts >= 0 && ts < sg.T) ? *(const u32x4*)(PB + (size_t)(sg.seq_row0 + ts) * LDP + C_XC + (t & 31) * 8) : (u32x4){0u, 0u, 0u, 0u}; }
#pragma unroll
        for (int i = 0; i < 5; ++i) { const int t = tid + NTHR * i; *(LAS u32x4*)(xt + (t >> 5) * 264 + (t & 31) * 8) = v[i]; }
    }
    LDS_BARRIER();
    const LAS bf16* col = xt + c8 * 8;
    const int base = 4 * seg + 8;
    float s[8];
#pragma unroll
    for (int c = 0; c < 8; ++c) s[c] = 0.f;
    for (int d = -half; d < half; ++d) {
        const u32x4 v = *(const LAS u32x4*)(col + (base + d) * 264);
        s[0] += bflo(v.x); s[1] += bfhi(v.x); s[2] += bflo(v.y); s[3] += bfhi(v.y); s[4] += bflo(v.z); s[5] += bfhi(v.z); s[6] += bflo(v.w); s[7] += bfhi(v.w);
    }
    const float ps[8] = {p0.x, p0.y, p0.z, p0.w, p1.x, p1.y, p1.z, p1.w};
#pragma unroll
    for (int j = 0; j < 4; ++j) {
        if (j > 0) {
            const u32x4 va = *(const LAS u32x4*)(col + (base + j + half - 1) * 264), vs = *(const LAS u32x4*)(col + (base + j - 1 - half) * 264);
            s[0] += bflo(va.x) - bflo(vs.x); s[1] += bfhi(va.x) - bfhi(vs.x); s[2] += bflo(va.y) - bflo(vs.y); s[3] += bfhi(va.y) - bfhi(vs.y);
            s[4] += bflo(va.z) - bflo(vs.z); s[5] += bfhi(va.z) - bfhi(vs.z); s[6] += bflo(va.w) - bflo(vs.w); s[7] += bfhi(va.w) - bfhi(vs.w);
        }
        const int ts = sg.tseq0 + 4 * seg + j;
        const int lo = (ts - half) < 0 ? 0 : ts - half, hi = (ts + half) > sg.T ? sg.T : ts + half;
        const float inv = 1.f / (float)(hi - lo);
        const u32x4 xv = *(const LAS u32x4*)(col + (base + j) * 264);
        const float x0[8] = {bflo(xv.x), bfhi(xv.x), bflo(xv.y), bfhi(xv.y), bflo(xv.z), bfhi(xv.z), bflo(xv.w), bfhi(xv.w)};
        const u32x4 gv = gpre[j];
        const float gg[8] = {bflo(gv.x), bfhi(gv.x), bflo(gv.y), bfhi(gv.y), bflo(gv.z), bfhi(gv.z), bflo(gv.w), bfhi(gv.w)};
        float y[8];
#pragma unroll
        for (int c = 0; c < 8; ++c) y[c] = (s[c] * inv - x0[c]) * ps[c] * gg[c];
        u32x4 o; o.x = pk2(y[0], y[1]); o.y = pk2(y[2], y[3]); o.z = pk2(y[4], y[5]); o.w = pk2(y[6], y[7]);
        bf16* yp = (dry ? (bf16*)(a.ws + WS_DUM) + (size_t)((sg.seq_row0 + ts) & 1023) * LDP : PB + (size_t)(sg.seq_row0 + ts) * LDP) + C_GC + c8 * 8;
        *(u32x4*)yp = o;
    }
    LDS_BARRIER();
}

__device__ __forceinline__ void fctx_item(const Args& a, LAS unsigned char* lds, int b, int dblk, int dry) {
    const int tid = otid(), lane = tid & 63, wave = __builtin_amdgcn_readfirstlane(tid >> 6);
    LAS bf16* ZT = (LAS bf16*)lds;
    bf16* PB = (bf16*)(a.ws + WS_PB);
    const bf16* DFT = (const bf16*)(a.ws + WS_DFT);
    {
        const int d8 = tid & 7, ri = (tid >> 3) & 1, blk = tid >> 4;
        u32x4 v[8];
#pragma unroll
        for (int i = 0; i < 8; ++i) v[i] = __builtin_nontemporal_load((const u32x4*)(PB + (size_t)(b * 256 + blk * 8 + i) * LDP + (ri ? C_QF : C_PF) + dblk * 64 + d8 * 8));
#pragma unroll
        for (int c = 0; c < 8; ++c) {
            u32x4 o;
#pragma unroll
            for (int j = 0; j < 4; ++j) {
                const unsigned lo = v[2 * j][c >> 1], hi = v[2 * j + 1][c >> 1];
                o[j] = (c & 1) ? ((lo >> 16) | (hi & 0xffff0000u)) : ((lo & 0xffffu) | (hi << 16));
            }
            *(LAS u32x4*)(ZT + (d8 * 8 + c) * 520 + (((ri * 32 + blk) ^ d8) << 3)) = o;
        }
    }
    LDS_BARRIER();
    const int r = lane & 15, kg = lane >> 4;
#pragma unroll 1
    for (int mi = 0; mi < 2; ++mi) {
        const int m0 = wave * 32 + mi * 16;
        const size_t grow = (size_t)(b * 256 + m0 + r) * LDP + C_GD + dblk * 64 + 4 * kg;
        u32x2 gdv[4];
#pragma unroll
        for (int nt = 0; nt < 4; ++nt) gdv[nt] = __builtin_nontemporal_load((const u32x2*)(PB + grow + nt * 16));
        f32x4 acc[4];
#pragma unroll
        for (int nt = 0; nt < 4; ++nt) acc[nt] = (f32x4){0.f, 0.f, 0.f, 0.f};
#pragma unroll
        for (int kh = 0; kh < 2; ++kh) {
            bf16x8 af[8];
#pragma unroll
            for (int ksx = 0; ksx < 8; ++ksx) af[ksx] = *(const bf16x8*)(DFT + (size_t)(m0 + r) * 512 + (kh * 8 + ksx) * 32 + kg * 8);
#pragma unroll
            for (int nt = 0; nt < 4; ++nt) {
#pragma unroll
                for (int ksx = 0; ksx < 8; ++ksx) {
                    const bf16x8 bfr = *(const LAS bf16x8*)(ZT + (nt * 16 + r) * 520 + (((((kh * 8 + ksx) * 4 + kg)) ^ (((nt * 16 + r) >> 3) & 7)) << 3));
                    acc[nt] = __builtin_amdgcn_mfma_f32_16x16x32_bf16(bfr, af[ksx], acc[nt], 0, 0, 0);
                }
                __builtin_amdgcn_sched_barrier(0);
            }
        }
#pragma unroll
        for (int nt = 0; nt < 4; ++nt) {
            u32x2 y; y.x = pk2(acc[nt][0] * bflo(gdv[nt].x), acc[nt][1] * bfhi(gdv[nt].x)); y.y = pk2(acc[nt][2] * bflo(gdv[nt].y), acc[nt][3] * bfhi(gdv[nt].y));
            bf16* yp = dry ? (bf16*)(a.ws + WS_DUM) + (size_t)((b * 256 + m0 + r) & 1023) * LDP + C_GD + dblk * 64 + 4 * kg + nt * 16 : PB + grow + nt * 16;
            *(u32x2*)yp = y;
        }
    }
    LDS_BARRIER();
}

__device__ __forceinline__ void fsmp_item(const Args& a, LAS unsigned char* lds, int b, int ds, int dry) {
    const int tid = otid(), lane = tid & 63, wave = __builtin_amdgcn_readfirstlane(tid >> 6);
    LAS bf16* ZT = (LAS bf16*)lds;
    LAS bf16* B2 = ZT + 256 * 136;
    bf16* PB = (bf16*)(a.ws + WS_PB);
    const bf16* M1 = (const bf16*)(a.ws + WS_M1);
    const bf16* M2 = (const bf16*)(a.ws + WS_M2);
    const size_t rowb = (size_t)M_CTX + (size_t)b * 4096;
    const int r = lane & 15, kg = lane >> 4, mp = wave & 3, nb = wave >> 2;
    {
        u32x4 v[8];
#pragma unroll
        for (int i = 0; i < 8; ++i) v[i] = __builtin_nontemporal_load((const u32x4*)(PB + (rowb + ds * 64 + 8 * wave + i) * LDP + C_PF + lane * 8));
#pragma unroll
        for (int c = 0; c < 8; ++c) {
            u32x4 o;
#pragma unroll
            for (int j = 0; j < 4; ++j) {
                const unsigned lo = v[2 * j][c >> 1], hi = v[2 * j + 1][c >> 1];
                o[j] = (c & 1) ? ((lo >> 16) | (hi & 0xffff0000u)) : ((lo & 0xffffu) | (hi << 16));
            }
            *(LAS u32x4*)(ZT + ((c & 3) * 64 + lane) * 136 + ((c >> 2) * 8 + wave) * 8) = o;
        }
    }
    bf16x8 aRe[4], aIm[4], a2[4];
#pragma unroll
    for (int ksx = 0; ksx < 4; ++ksx) {
        aRe[ksx] = *(const bf16x8*)(M1 + (16 * mp + r) * 128 + ksx * 32 + kg * 8);
        aIm[ksx] = *(const bf16x8*)(M1 + (64 + 16 * mp + r) * 128 + ksx * 32 + kg * 8);
        a2[ksx] = *(const bf16x8*)(M2 + (16 * mp + r) * 128 + ksx * 32 + kg * 8);
    }
    LDS_BARRIER();
#pragma unroll 2
    for (int jb = 0; jb < 8; ++jb) {
        const int nt = nb + 2 * jb;
        f32x4 ar = (f32x4){0.f, 0.f, 0.f, 0.f}, ai = (f32x4){0.f, 0.f, 0.f, 0.f};
#pragma unroll
        for (int ksx = 0; ksx < 4; ++ksx) {
            const bf16x8 z = *(const LAS bf16x8*)(ZT + (16 * nt + r) * 136 + ((ksx * 4 + kg) << 3));
            ar = __builtin_amdgcn_mfma_f32_16x16x32_bf16(z, aRe[ksx], ar, 0, 0, 0);
            ai = __builtin_amdgcn_mfma_f32_16x16x32_bf16(z, aIm[ksx], ai, 0, 0, 0);
        }
        const int k1 = 16 * mp + r, dd = nt >> 2, t20 = 16 * (nt & 3) + 4 * kg;
        float xr[4], xi[4];
#pragma unroll
        for (int q = 0; q < 4; ++q) {
            const float rev = (float)((k1 * (t20 + q)) & 4095) * (1.f / 4096.f);
            const float cw = __builtin_amdgcn_cosf(rev), sw = __builtin_amdgcn_sinf(rev);
            xr[q] = ar[q] * cw - ai[q] * sw; xi[q] = ar[q] * sw + ai[q] * cw;
        }
        u32x2 wr_, wi_; wr_.x = pk2(xr[0], xr[1]); wr_.y = pk2(xr[2], xr[3]); wi_.x = pk2(xi[0], xi[1]); wi_.y = pk2(xi[2], xi[3]);
        LAS bf16* brow = B2 + (k1 * 4 + dd) * 136 + (t20 & 4);
        *(LAS u32x2*)(brow + ((((t20 >> 3)) ^ (k1 & 15)) << 3)) = wr_;
        *(LAS u32x2*)(brow + (((8 + (t20 >> 3)) ^ (k1 & 15)) << 3)) = wi_;
    }
    LDS_BARRIER();
#pragma unroll 2
    for (int jb = 0; jb < 8; ++jb) {
        const int nt = nb + 2 * jb;
        f32x4 acc = (f32x4){0.f, 0.f, 0.f, 0.f};
#pragma unroll
        for (int ksx = 0; ksx < 4; ++ksx) {
            const bf16x8 z = *(const LAS bf16x8*)(B2 + (16 * nt + r) * 136 + (((ksx * 4 + kg) ^ (((16 * nt + r) >> 2) & 15)) << 3));
            acc = __builtin_amdgcn_mfma_f32_16x16x32_bf16(z, a2[ksx], acc, 0, 0, 0);
        }
        u32x2 w_; w_.x = pk2(acc[0], acc[1]); w_.y = pk2(acc[2], acc[3]);
        *(LAS u32x2*)(ZT + (16 * mp + r) * 264 + 16 * nt + 4 * kg) = w_;
    }
    LDS_BARRIER();
#pragma unroll
    for (int i = 0; i < 4; ++i) { const int ch = tid + NTHR * i, k2 = ch >> 5, c16 = ch & 31;
        const u32x4 v = *(const LAS u32x4*)(ZT + k2 * 264 + c16 * 8);
        *(u32x4*)((dry ? (bf16*)(a.ws + WS_DUM) + (size_t)((ds * 64 + k2) & 1023) * LDP : PB + (rowb + ds * 64 + k2) * LDP) + C_PF + c16 * 8) = v; }
    LDS_BARRIER();
}

__device__ __forceinline__ void ffin_item(const Args& a, LAS unsigned char* lds, int b, int tr) {
    const int tid = otid();
    LAS bf16* FL = (LAS bf16*)lds;
    bf16* PB = (bf16*)(a.ws + WS_PB);
    const size_t rowb = (size_t)M_CTX + (size_t)b * 4096;
    u32x4 gv[4];
#pragma unroll
    for (int i = 0; i < 4; ++i) { const int t = tid + NTHR * i, tl = t >> 5, c8 = t & 31; gv[i] = __builtin_nontemporal_load((const u32x4*)(PB + (rowb + tr * 64 + tl) * LDP + C_GD + c8 * 8)); }
#pragma unroll
    for (int i = 0; i < 4; ++i) { const int ch = tid + NTHR * i, sl = ch >> 5, c16 = ch & 31;
        *(LAS u32x4*)(FL + sl * 264 + c16 * 8) = __builtin_nontemporal_load((const u32x4*)(PB + (rowb + sl * 64 + tr) * LDP + C_PF + c16 * 8)); }
    LDS_BARRIER();
#pragma unroll
    for (int i = 0; i < 4; ++i) { const int t = tid + NTHR * i, tl = t >> 5, c8 = t & 31;
        const u32x2 f0 = *(const LAS u32x2*)(FL + (2 * c8) * 264 + tl * 4), f1 = *(const LAS u32x2*)(FL + (2 * c8 + 1) * 264 + tl * 4);
        u32x4 o; o.x = pk2(bflo(f0.x) * bflo(gv[i].x), bfhi(f0.x) * bfhi(gv[i].x)); o.y = pk2(bflo(f0.y) * bflo(gv[i].y), bfhi(f0.y) * bfhi(gv[i].y));
        o.z = pk2(bflo(f1.x) * bflo(gv[i].z), bfhi(f1.x) * bfhi(gv[i].z)); o.w = pk2(bflo(f1.y) * bflo(gv[i].w), bfhi(f1.y) * bfhi(gv[i].w));
        *(u32x4*)(PB + (rowb + tr * 64 + tl) * LDP + C_GD + c8 * 8) = o; }
    LDS_BARRIER();
}

constexpr int SC_MAT = 64 * 72 * 2;
constexpr int SC_BUF = 5 * SC_MAT + 16;
constexpr int SC_OT = 2 * SC_BUF;
template <int NCH>
__device__ __forceinline__ void scan_item(const Args& a, LAS unsigned char* lds, int l, int seq, int h, int dir) {
    const int tid = otid(), lane = tid & 63, wave = __builtin_amdgcn_readfirstlane(tid >> 6);
    bf16* PB = (bf16*)(a.ws + WS_PB);
    constexpr int nch = NCH;
    const int sc0 = (NCH == 4) ? seq * 4 : 128 + (seq - 32) * 64;
    const int r = lane & 15, kg = lane >> 4;
    if (wave >= 4) {
        const int ht = tid - 256;
        constexpr int PD_ = 4;
        u32x4 pre[PD_][10]; float pgl[PD_];
#define SC_ISSUE(set, ss) do { const int s_ = (ss) < nch ? (ss) : nch - 1; const int c_ = dir ? nch - 1 - s_ : s_; const size_t pid_ = (size_t)((sc0 + c_) * 4 + h) * 2 + dir; \
            const u32x4* src_ = (const u32x4*)((const bf16*)(a.ws + WS_PREP) + pid_ * PREP_ITEM) + ht; \
            _Pragma("unroll") for (int i_ = 0; i_ < 10; ++i_) pre[set][i_] = __builtin_nontemporal_load(src_ + 256 * i_); \
            pgl[set] = ((const float*)(a.ws + WS_PGL))[pid_]; } while (0)
#define SC_WRITE(set, bb) do { LAS unsigned char* B_ = lds + (bb) * SC_BUF; \
            _Pragma("unroll") for (int i_ = 0; i_ < 10; ++i_) { const int ch_ = ht + 256 * i_; \
                *(LAS u32x4*)(B_ + (ch_ >> 9) * SC_MAT + ((ch_ >> 3) & 63) * 144 + (ch_ & 7) * 16) = pre[set][i_]; } \
            if (ht == 0) *(LAS float*)(B_ + 5 * SC_MAT) = pgl[set]; } while (0)
#define SC_OSTORE(ss) do { const int c_ = dir ? nch - 1 - (ss) : (ss); const LAS unsigned char* O_ = lds + SC_OT + ((ss) & 1) * SC_MAT; \
            _Pragma("unroll") for (int i_ = 0; i_ < 2; ++i_) { const int ch_ = ht + 256 * i_, rw_ = ch_ >> 3, c8_ = ch_ & 7; \
                const u32x4 v_ = *(const LAS u32x4*)(O_ + rw_ * 144 + c8_ * 16); \
                *(u32x4*)(PB + (size_t)((sc0 + c_) * 64 + (dir ? 63 - rw_ : rw_)) * LDP + (dir ? C_K : C_Q) + h * 64 + c8_ * 8) = v_; } } while (0)
        SC_ISSUE(0, 0); SC_ISSUE(1, 1); SC_ISSUE(2, 2); SC_ISSUE(3, 3);
        SC_WRITE(0, 0);
        if constexpr (NCH > 4) SC_ISSUE(0, 4);
        LDS_BARRIER();
#pragma unroll 1
        for (int s0 = 0; s0 < nch; s0 += 4) {
#pragma unroll
            for (int j = 0; j < 4; ++j) {
                const int s = s0 + j;
                SC_WRITE((j + 1) & 3, (s + 1) & 1);
                if (s > 0) SC_OSTORE(s - 1);
                if constexpr (NCH > 4) SC_ISSUE((j + 1) & 3, s + 5);
                LDS_BARRIER();
            }
        }
        SC_OSTORE(nch - 1);
#undef SC_ISSUE
#undef SC_WRITE
#undef SC_OSTORE
    } else {
        const int e = 16 * wave + r;
        f32x4 S[4];
#pragma unroll
        for (int t = 0; t < 4; ++t)
#pragma unroll
            for (int q = 0; q < 4; ++q) {
                const int d = 16 * t + 4 * kg + q;
                S[t][q] = (seq < 32) ? 0.f : a.in[I_STATE][((size_t)(((seq - 32) * 4 + l) * 2 + dir) * 4 + h) * 4096 + d * 64 + e];
            }
        LDS_BARRIER();
#pragma unroll 1
        for (int s = 0; s < nch; ++s) {
            const LAS unsigned char* B = lds + (s & 1) * SC_BUF;
            const LAS bf16* Wm = (const LAS bf16*)B; const LAS bf16* Qd = Wm + 64 * 72; const LAS bf16* KdT = Qd + 64 * 72; const LAS bf16* QKm = KdT + 64 * 72; const LAS bf16* UT = QKm + 64 * 72;
            const float egl = *(const LAS float*)(B + 5 * SC_MAT);
            LAS bf16* OT = (LAS bf16*)(lds + SC_OT + (s & 1) * SC_MAT);
            bf16x8 bS[2];
            bS[0] = pack8(S[0], S[1]); bS[1] = pack8(S[2], S[3]);
            f32x4 a1[4], oo[4];
#pragma unroll
            for (int t = 0; t < 4; ++t) {
                a1[t] = (f32x4){0.f, 0.f, 0.f, 0.f}; oo[t] = (f32x4){0.f, 0.f, 0.f, 0.f};
#pragma unroll
                for (int ksx = 0; ksx < 2; ++ksx) {
                    const bf16x8 wf = *(const LAS bf16x8*)(Wm + (16 * t + r) * 72 + ksx * 32 + kg * 8);
                    const bf16x8 qf = *(const LAS bf16x8*)(Qd + (16 * t + r) * 72 + ksx * 32 + kg * 8);
                    a1[t] = __builtin_amdgcn_mfma_f32_16x16x32_bf16(wf, bS[ksx], a1[t], 0, 0, 0);
                    oo[t] = __builtin_amdgcn_mfma_f32_16x16x32_bf16(qf, bS[ksx], oo[t], 0, 0, 0);
                }
            }
            f32x4 vn[4];
#pragma unroll
            for (int t = 0; t < 4; ++t) {
                const u32x2 uu = *(const LAS u32x2*)(UT + e * 72 + 16 * t + 4 * kg);
                vn[t][0] = bflo(uu.x) - a1[t][0]; vn[t][1] = bfhi(uu.x) - a1[t][1]; vn[t][2] = bflo(uu.y) - a1[t][2]; vn[t][3] = bfhi(uu.y) - a1[t][3];
            }
            bf16x8 bV[2];
            bV[0] = pack8(vn[0], vn[1]); bV[1] = pack8(vn[2], vn[3]);
#pragma unroll
            for (int t = 0; t < 4; ++t) {
                f32x4 as = (f32x4){0.f, 0.f, 0.f, 0.f};
#pragma unroll
                for (int ksx = 0; ksx < 2; ++ksx) {
                    const bf16x8 kf = *(const LAS bf16x8*)(QKm + (16 * t + r) * 72 + ksx * 32 + kg * 8);
                    const bf16x8 df = *(const LAS bf16x8*)(KdT + (16 * t + r) * 72 + ksx * 32 + kg * 8);
                    oo[t] = __builtin_amdgcn_mfma_f32_16x16x32_bf16(kf, bV[ksx], oo[t], 0, 0, 0);
                    as = __builtin_amdgcn_mfma_f32_16x16x32_bf16(df, bV[ksx], as, 0, 0, 0);
                }
                S[t] = S[t] * egl + as;
            }
#pragma unroll
            for (int t = 0; t < 4; ++t)
#pragma unroll
                for (int q = 0; q < 4; ++q) OT[(16 * t + 4 * kg + q) * 72 + e] = (bf16)f2bf(oo[t][q]);
            LDS_BARRIER();
        }
        if (seq < 32) {
            float* ns = a.out + (size_t)M * D + ((size_t)((seq * 4 + l) * 2 + dir) * 4 + h) * 4096;
#pragma unroll
            for (int t = 0; t < 4; ++t)
#pragma unroll
                for (int q = 0; q < 4; ++q) ns[(16 * t + 4 * kg + q) * 64 + e] = S[t][q];
        }
    }
    LDS_BARRIER();
}

__device__ __forceinline__ void phase_combine(const Args& a, int l, int dry) {
    const int tid = otid(), lane = tid & 63, wave = tid >> 6, G = gridDim.x, bid = obid();
    bf16* PB = (bf16*)(a.ws + WS_PB);
    const f32x4 ng = *(const f32x4*)(a.in[I_DNG] + l * 64 + (lane & 15) * 4);
    for (int r0 = bid * NWAVES + wave; r0 < M; r0 += 4 * G * NWAVES) {
        u32x2 of[4], ob[4], ga[4];
#pragma unroll
        for (int u = 0; u < 4; ++u) { const int row = r0 + u * G * NWAVES;
            if (row < M) { const bf16* rp = PB + (size_t)row * LDP; of[u] = __builtin_nontemporal_load((const u32x2*)(rp + C_Q) + lane); ob[u] = __builtin_nontemporal_load((const u32x2*)(rp + C_K) + lane); ga[u] = __builtin_nontemporal_load((const u32x2*)(rp + C_GA) + lane); }
            else { of[u] = (u32x2){0u, 0u}; ob[u] = of[u]; ga[u] = of[u]; } }
#pragma unroll
        for (int u = 0; u < 4; ++u) { const int row = r0 + u * G * NWAVES;
            if (row < M) {
                bf16* rp = PB + (size_t)row * LDP;
                const float o0 = bflo(of[u].x) + bflo(ob[u].x), o1 = bfhi(of[u].x) + bfhi(ob[u].x), o2 = bflo(of[u].y) + bflo(ob[u].y), o3 = bfhi(of[u].y) + bfhi(ob[u].y);
                float ss = (o0 * o0 + o1 * o1) + (o2 * o2 + o3 * o3);
                ss += __shfl_xor(ss, 1); ss += __shfl_xor(ss, 2); ss += __shfl_xor(ss, 4); ss += __shfl_xor(ss, 8);
                const float rinv = rsqrtf(ss * (1.f / 64.f) + EPS);
                u32x2 y; y.x = pk2(o0 * rinv * ng.x * bflo(ga[u].x), o1 * rinv * ng.y * bfhi(ga[u].x)); y.y = pk2(o2 * rinv * ng.z * bflo(ga[u].y), o3 * rinv * ng.w * bfhi(ga[u].y));
                if (dry) rp = (bf16*)(a.ws + WS_DUM) + (size_t)(row & 1023) * LDP;
                *((u32x2*)(rp + C_GA) + lane) = y;
            } }
    }
}

constexpr int PF_ROWS = 10;
struct FinalRegs { u32x4 x[PF_ROWS][2]; float rinv[PF_ROWS]; };
__device__ __forceinline__ void final_load(const Args& a, FinalRegs& R, int rnd) {
    const int tid = otid(), lane = tid & 63, wave = tid >> 6, G = gridDim.x, bid = obid();
    const float* RSS = (const float*)(a.ws + WS_RSS);
    const bf16* XB = (const bf16*)a.out + (size_t)M * D;
#pragma unroll
    for (int i = 0; i < PF_ROWS; ++i) {
        const int row = bid * NWAVES + wave + G * NWAVES * (i + PF_ROWS * rnd);
        if (row < M) {
            const u32x4* xr = (const u32x4*)(XB + (size_t)row * D) + lane * 2;
            R.x[i][0] = xr[0]; R.x[i][1] = xr[1];
            float p = (lane < 16) ? RSS[(size_t)row * 16 + lane] : 0.f;
            p += __shfl_xor(p, 1); p += __shfl_xor(p, 2); p += __shfl_xor(p, 4); p += __shfl_xor(p, 8);
            R.rinv[i] = rsqrtf(__shfl(p, 0) * (1.f / 1024.f) + EPS);
        } else { R.x[i][0] = (u32x4){0u, 0u, 0u, 0u}; R.x[i][1] = R.x[i][0]; R.rinv[i] = 0.f; }
    }
}
__device__ __forceinline__ void final_store(const Args& a, const FinalRegs& R, int rnd) {
    const int tid = otid(), lane = tid & 63, wave = tid >> 6, G = gridDim.x, bid = obid();
    f32x4 fg[4];
#pragma unroll
    for (int q = 0; q < 4; ++q) fg[q] = *((const f32x4*)(a.in[I_FNG]) + lane * 4 + q);
#pragma unroll
    for (int i = 0; i < PF_ROWS; ++i) {
        const int row = bid * NWAVES + wave + G * NWAVES * (i + PF_ROWS * rnd);
        if (row < M) {
            f32x4* orow = (f32x4*)(a.out + (size_t)row * D) + lane * 4;
            const u32x4 x0 = R.x[i][0], x1 = R.x[i][1]; const float ri = R.rinv[i];
            orow[0] = (f32x4){bflo(x0.x), bfhi(x0.x), bflo(x0.y), bfhi(x0.y)} * ri * fg[0];
            orow[1] = (f32x4){bflo(x0.z), bfhi(x0.z), bflo(x0.w), bfhi(x0.w)} * ri * fg[1];
            orow[2] = (f32x4){bflo(x1.x), bfhi(x1.x), bflo(x1.y), bfhi(x1.y)} * ri * fg[2];
            orow[3] = (f32x4){bflo(x1.z), bfhi(x1.z), bflo(x1.w), bfhi(x1.w)} * ri * fg[3];
        }
    }
}

__device__ __forceinline__ void final_direct(const Args& a) {
    const int tid = otid(), lane = tid & 63, wave = tid >> 6, G = gridDim.x, bid = obid();
    const float* RSS = (const float*)(a.ws + WS_RSS);
    const bf16* XF = (const bf16*)(a.ws + WS_PREP);
    f32x4 fg[4];
#pragma unroll
    for (int q = 0; q < 4; ++q) fg[q] = *((const f32x4*)(a.in[I_FNG] + 256 * q) + lane);
    for (int r0 = bid * NWAVES + wave; r0 < M; r0 += 4 * G * NWAVES) {
        u32x2 x[4][4]; float p[4];
#pragma unroll
        for (int u = 0; u < 4; ++u) {
            const int row = r0 + u * G * NWAVES;
            if (row < M) {
                const u32x2* xr = (const u32x2*)(XF + (size_t)row * D) + lane;
#pragma unroll
                for (int q = 0; q < 4; ++q) x[u][q] = __builtin_nontemporal_load(xr + 64 * q);
                p[u] = (lane < 16) ? RSS[(size_t)row * 16 + lane] : 0.f;
            } else {
#pragma unroll
                for (int q = 0; q < 4; ++q) x[u][q] = (u32x2){0u, 0u};
                p[u] = 0.f;
            }
        }
#pragma unroll
        for (int u = 0; u < 4; ++u) {
            const int row = r0 + u * G * NWAVES;
            if (row < M) {
                float ps = p[u];
                ps += __shfl_xor(ps, 1); ps += __shfl_xor(ps, 2); ps += __shfl_xor(ps, 4); ps += __shfl_xor(ps, 8);
                const float ri = rsqrtf(__shfl(ps, 0) * (1.f / 1024.f) + EPS);
                f32x4* orow = (f32x4*)(a.out + (size_t)row * D) + lane;
#pragma unroll
                for (int q = 0; q < 4; ++q) orow[64 * q] = (f32x4){bflo(x[u][q].x), bfhi(x[u][q].x), bflo(x[u][q].y), bfhi(x[u][q].y)} * ri * fg[q];
            }
        }
    }
}

__device__ __forceinline__ void skinny_ba(const Args& a, int l, int task) {
    const int tid = otid(), lane = tid & 63, r = lane & 15, kg = lane >> 4;
    const int pm = task >> 3, wave = task & 7;
    const bf16* A = (const bf16*)a.out + (size_t)(pm * 256 + wave * 32 + r) * 1024 + kg * 8;
    const bf16* Bw = (const bf16*)(a.ws + WS_W1T) + ((size_t)l * N1 + 3072 + r) * 1024 + kg * 8;
    f32x4 acc0 = (f32x4){0.f, 0.f, 0.f, 0.f}, acc1 = acc0;
    bf16x8 a0[2][4], a1[2][4], bw[2][4];
#define SK_LOAD(buf, kc_) do { _Pragma("unroll") for (int ksx = 0; ksx < 4; ++ksx) { const int k = ((kc_) * 4 + ksx) * 32; \
        a0[buf][ksx] = *(const bf16x8*)(A + k); a1[buf][ksx] = *(const bf16x8*)(A + 16 * 1024 + k); bw[buf][ksx] = *(const bf16x8*)(Bw + k); } } while (0)
#define SK_MMA(buf) do { _Pragma("unroll") for (int ksx = 0; ksx < 4; ++ksx) { \
        acc0 = __builtin_amdgcn_mfma_f32_16x16x32_bf16(a0[buf][ksx], bw[buf][ksx], acc0, 0, 0, 0); \
        acc1 = __builtin_amdgcn_mfma_f32_16x16x32_bf16(a1[buf][ksx], bw[buf][ksx], acc1, 0, 0, 0); } } while (0)
    SK_LOAD(0, 0); SK_LOAD(1, 1);
    SK_MMA(0); SK_LOAD(0, 2); SK_MMA(1); SK_LOAD(1, 3); SK_MMA(0); SK_LOAD(0, 4); SK_MMA(1); SK_LOAD(1, 5);
    SK_MMA(0); SK_LOAD(0, 6); SK_MMA(1); SK_LOAD(1, 7); SK_MMA(0); SK_MMA(1);
#undef SK_LOAD
#undef SK_MMA
    const int j = pm < 32 ? 0 : 1 + ((pm - 32) >> 4);
    const float sw = ((const float*)(a.ws + WS_SW))[((size_t)l * 9 + j) * N1 + 3072 + r];
    const float* RSS = (const float*)(a.ws + WS_RSS);
    float* BA = (float*)(a.ws + WS_BA);
#pragma unroll
    for (int mi = 0; mi < 2; ++mi)
#pragma unroll
        for (int q = 0; q < 4; ++q) {
            const int row = pm * 256 + wave * 32 + mi * 16 + 4 * kg + q;
            const f32x4* rp = (const f32x4*)(RSS + (size_t)row * 16);
            const f32x4 r0 = rp[0], r1 = rp[1], r2 = rp[2], r3 = rp[3];
            const float ss = ((r0.x + r0.y) + (r0.z + r0.w)) + ((r1.x + r1.y) + (r1.z + r1.w)) + ((r2.x + r2.y) + (r2.z + r2.w)) + ((r3.x + r3.y) + (r3.z + r3.w));
            const float rinv = rsqrtf(ss * (1.f / 1024.f) + EPS);
            BA[(size_t)row * 16 + r] = (mi ? acc1[q] : acc0[q]) * rinv + sw;
        }
}

constexpr int NPHASE = 24;
__global__ void __launch_bounds__(NTHR, 2) fwd_kernel(Args args) {
    extern __shared__ __attribute__((aligned(16))) unsigned char lds_raw[];
    LAS unsigned char* lds = (LAS unsigned char*)lds_raw;
#if !MK_MULTI
    volatile LAS unsigned* MISC = (volatile LAS unsigned*)(lds + MISC_OFF);
    if (threadIdx.x < 64) MISC[threadIdx.x] = 0u;
    __syncthreads();
    XcdBarrier bar = xcd_barrier_post((unsigned*)(args.ws + WS_CTL) + CW_BAR, MISC + 8);
#define GRID_BAR() xcd_barrier(bar)
#else
#define GRID_BAR() do { } while (0)
#endif
    const int G = gridDim.x, bid = blockIdx.x;
#pragma unroll
    for (int pass = (PRE_HI > 0 ? 0 : 1); pass < 2; ++pass) {
        const int hi = (pass == 0) ? args.pad : args.ph_hi, lo = args.ph_lo;
        volatile LAS unsigned long long* TSL = (volatile LAS unsigned long long*)(lds + MISC_OFF + 128);
        if (PROBE_A == -2 && PROBE_B >= 0 && threadIdx.x == 0) TSL[0] = __builtin_amdgcn_s_memrealtime();
        if (PROBE_X == 8 && threadIdx.x == 0) atomicMax((unsigned long long*)(args.ws + WS_CTL) + 2048 + 8, (unsigned long long)__builtin_amdgcn_s_memrealtime());
#define RUN(k) ((k) >= lo && (k) < hi)
#define SEAM(k) do { if (RUN(k) && ((k) + 1 < hi || pass == 0)) { GRID_BAR(); for (int rb = 1; rb < REP_BAR; ++rb) GRID_BAR(); } if (PROBE_B >= 0 && threadIdx.x == 0) { if ((k) == PROBE_A) TSL[0] = __builtin_amdgcn_s_memrealtime(); if ((k) == PROBE_B) TSL[1] = __builtin_amdgcn_s_memrealtime(); } } while (0)
        if (RUN(0)) { if (EN(0)) for (int rep = 0; rep < REP_P0; ++rep) phase_0a(args, lds); } SEAM(0);
        if (RUN(1)) { if (EN(1)) for (int rep = 0; rep < REP_P0; ++rep) phase_0b(args, lds); } SEAM(1);
#pragma unroll 1
        for (int l = 0; l < NL; ++l) {
            if (RUN(3 + 5 * l)) {
            if (EN(4)) {
                pg8::Gemm g{(const bf16*)args.out, (const bf16*)(args.ws + WS_W1T) + (size_t)l * N1 * 1024, M, LDP, 1024, 1024};
                pg8::StaticOrder S; S.init(M, LDP, G, bid);
                Epi1 E{(bf16*)(args.ws + WS_PB), (float*)(args.ws + WS_BA), (const float*)(args.ws + WS_RSS), (const float*)(args.ws + WS_SW) + (size_t)l * 9 * N1, 0, (bf16*)(args.ws + WS_DUM), (const LAS float*)(lds + 131072), (float*)(args.ws + WS_VSS)};
                {
                    LAS float* rtab = (LAS float*)(lds + 131072); const float* RSSp = (const float*)(args.ws + WS_RSS);
                    for (int idx = otid(); idx < 8 * 256; idx += NTHR) { pg8::Unit u;
                        if (S.next(idx >> 8, u)) { int rr_ = u.pm * 256 + (u.half == 2 ? 128 : 0) + (idx & 255); rr_ = rr_ < M ? rr_ : M - 1; const f32x4* rp = (const f32x4*)(RSSp + (size_t)rr_ * 16);
                            const f32x4 r0 = rp[0], r1 = rp[1], r2 = rp[2], r3 = rp[3];
                            const float ss = ((r0.x + r0.y) + (r0.z + r0.w)) + ((r1.x + r1.y) + (r1.z + r1.w)) + ((r2.x + r2.y) + (r2.z + r2.w)) + ((r3.x + r3.y) + (r3.z + r3.w));
                            rtab[idx] = rsqrtf(ss * (1.f / 1024.f) + EPS); } }
                    __syncthreads();
                }
                for (int rep = 0; rep < REP_G1; ++rep) { if (rep && G1CHEAP) E.cheap = args.one * G1CHEAP; pg8::gemm_phase<Epi1>(lds, g, S, E); if (rep && G1CHEAP) continue;
                    { const int wv_ = __builtin_amdgcn_readfirstlane(otid() >> 6); if (wv_ < 5) skinny_ba(args, l, bid * 5 + wv_); } } }
            }
            SEAM(3 + 5 * l);
            if (RUN(4 + 5 * l))
            {
                if (EN(5)) {
                    if (bid < 2560) { prep_dma(args, lds, bid >> 2, bid & 3); asm volatile("s_waitcnt vmcnt(0)" ::: "memory"); __syncthreads(); }
                    for (int it = bid; it < 2560; it += G) { const int nit = it + G < 2560 ? it + G : -4; prep_item(args, lds, l, it >> 2, it & 3, nit >> 2, nit & 3); }
                }
            }
            SEAM(4 + 5 * l);
            if (RUN(5 + 5 * l))
            {
                if (bid < 64 && !PSK(1)) { if (EN(10)) for (int rep = 0; rep < REP_SCAN; ++rep) scan_item<64>(args, lds, l, 32 + (bid >> 3), (bid >> 1) & 3, bid & 1); }
                if (PROBE_X >= 0 && l == PROBE_L && bid < 64 && threadIdx.x == 0) atomicMax((unsigned long long*)(args.ws + WS_CTL) + 2048 + 0, (unsigned long long)__builtin_amdgcn_s_memrealtime());
                unsigned* qc = (unsigned*)(args.ws + WS_CTL) + CW_Q + 64 * l + 256 * pass;
                volatile LAS unsigned* qslot = (volatile LAS unsigned*)(lds + MISC_OFF) + 16;
                if (otid() == 0) qslot[0] = atomicAdd(qc, 1u);
                for (;;) {
                    LDS_BARRIER();
                    const int it = (int)qslot[0];
                    LDS_BARRIER();
                    if (PROBE_X >= 0 && l == PROBE_L && threadIdx.x == 0 && (it >= 1856 || it == 320 || it == 576 || it == 1088 || it == 1216)) { const unsigned long long now = __builtin_amdgcn_s_memrealtime();
                        unsigned long long* T_ = (unsigned long long*)(args.ws + WS_CTL) + 2048;
                        if (it >= 1856) { atomicMax(T_ + 1, now); if (atomicCAS(T_ + 3, 0ull, now) == 0ull) {} }
                        if (it == 320) atomicMax(T_ + 4, now); if (it == 576) atomicMax(T_ + 5, now); if (it == 1088) atomicMax(T_ + 6, now); if (it == 1216) atomicMax(T_ + 7, now); }
                    if (it >= 1856) break;
                    unsigned nx = 0u; const bool puller = (otid() == 0);
                    if (puller) nx = atomicAdd(qc, 1u);
                    if (it < 320) { const int g_ = it / 80, c4 = (it % 80) * 4;
                        if (EN(6) && !PSK(16)) for (int rep = 0; rep < REP_SGU; ++rep) sgu_super(args, lds, l, c4, g_, rep ? args.one : 0); }
                    else if (it < 576) { const int i2 = it - 320; if (EN(10) && !PSK(8)) for (int rep = 0; rep < REP_CTXS; ++rep) scan_item<4>(args, lds, l, i2 >> 3, (i2 >> 1) & 3, i2 & 1); }
                    else if (it < 1088) { const int i2 = it - 576; if (EN(9) && !PSK(2)) for (int rep = 0; rep < REP_FSMP; ++rep) fsmp_item(args, lds, i2 >> 6, i2 & 63, rep ? args.one : 0); }
                    else if (it < 1216) { const int i2 = it - 1088; if (EN(8) && !PSK(4)) for (int rep = 0; rep < REP_FCTX; ++rep) fctx_item(args, lds, i2 >> 2, i2 & 3, rep ? args.one : 0); }
                    else { if (EN(7) && !PSK(32)) pool_item(args, lds, l, it - 1216, 0); }
                    if (puller) qslot[0] = nx;
                }
            }
            SEAM(5 + 5 * l);
            if (RUN(6 + 5 * l))
            {
                if (EN(11)) { for (int it = bid; it < 512; it += G) ffin_item(args, lds, it >> 6, it & 63);
                    for (int rep = 0; rep < REP_COMB; ++rep) phase_combine(args, l, rep ? args.one : 0); }
            }
            SEAM(6 + 5 * l);
            if (RUN(7 + 5 * l)) {
            if (EN(12)) {
                pg8::Gemm g{(const bf16*)(args.ws + WS_PB), (const bf16*)(args.ws + WS_W2T) + (size_t)l * 1024 * 1024, M, 1024, 1024, LDP};
                pg8::StaticOrder S; S.init(M, 1024, G, bid);
                const float* MOD = (const float*)(args.ws + WS_MOD);
                Epi2 E{(bf16*)args.out + (size_t)M * D, l < 3 ? (bf16*)args.out + (size_t)M * D : (bf16*)(args.ws + WS_PREP), (bf16*)args.out, (float*)(args.ws + WS_RSS), MOD + (size_t)l * 9 * 3072 + 2048,
                       l < 3 ? args.in[I_NORMG] + (l + 1) * 1024 : nullptr, l < 3 ? MOD + (size_t)(l + 1) * 9 * 3072 + 1024 : nullptr, args.ws + WS_DUM, 0};
                pg8::gemm_phase<Epi2>(lds, g, S, E);
                for (int rep = 1; rep < REP_G2; ++rep) { Epi2 E2 = E; E2.dry = args.one; pg8::gemm_phase<Epi2>(lds, g, S, E2); }
            }
            }
            SEAM(7 + 5 * l);
        }
        if (RUN(23)) { if (EN(3) && pass == 1) final_direct(args); }
        if (PROBE_B == 23 && threadIdx.x == 0) TSL[1] = __builtin_amdgcn_s_memrealtime();
        if (PROBE_B >= 0 && blockIdx.x == 0 && threadIdx.x == 0) {
            asm volatile("s_waitcnt vmcnt(0)" ::: "memory");
            const unsigned long long tend = (PROBE_X >= 0) ? __hip_atomic_load((unsigned long long*)(args.ws + WS_CTL) + 2048 + PROBE_X, __ATOMIC_RELAXED, __HIP_MEMORY_SCOPE_AGENT) : (unsigned long long)TSL[1];
            const float T = PROBE_FAKE ? (float)PROBE_FAKE : (float)(tend - TSL[0]) * (0.01f * PROBE_SCALE);
            args.out[0] += sqrtf(8.39f * T);
        }
#undef RUN
#undef SEAM
    }
}

extern "C" void kernel_launch(void* const* d_in, const int* in_sizes, int n_in, void* d_out, int out_size, void* d_ws, size_t ws_size, hipStream_t stream) {
    static int grid = 0;
    if (grid == 0) {
        if (n_in != 21 || ws_size < WS_DUM + 16 * MiB) { fprintf(stderr, "kernel_launch: unexpected n_in %d or ws_size %zu (< %zu)\n", n_in, ws_size, (size_t)WS_END); grid = -1; return; }
        int dev = 0, cus = 0, per_cu = 0;
        if (hipGetDevice(&dev) != hipSuccess || hipDeviceGetAttribute(&cus, hipDeviceAttributeMultiprocessorCount, dev) != hipSuccess) { grid = -1; return; }
        if (hipFuncSetAttribute((const void*)fwd_kernel, hipFuncAttributeMaxDynamicSharedMemorySize, LDS_BYTES) != hipSuccess) { fprintf(stderr, "kernel_launch: hipFuncSetAttribute failed\n"); grid = -1; return; }
        if (hipOccupancyMaxActiveBlocksPerMultiprocessor(&per_cu, (const void*)fwd_kernel, NTHR, LDS_BYTES) != hipSuccess || per_cu < 1) { fprintf(stderr, "kernel_launch: occupancy query failed (%d)\n", per_cu); (void)hipGetLastError(); per_cu = 1; }
        grid = cus * 1;
    }
    if (grid < 0) return;
    Args a{};
    for (int i = 0; i < 21; ++i) a.in[i] = (const float*)d_in[i];
    a.out = (float*)d_out; a.ws = (unsigned char*)d_ws; a.one = 1; a.pad = PRE_HI;
    (void)hipMemsetAsync((char*)d_ws + WS_CTL, 0, CTL_ZERO_BYTES, stream);
#if MK_MULTI
    for (int ph = 0; ph < NPHASE; ++ph) {
        a.ph_lo = ph; a.ph_hi = ph + 1;
        hipLaunchKernelGGL(fwd_kernel, dim3(grid), dim3(NTHR), LDS_BYTES, stream, a);
    }
#else
    a.ph_lo = 0; a.ph_hi = NPHASE;
    void* kargs[] = {&a};
#if PLAIN_LAUNCH
    (void)kargs; hipLaunchKernelGGL(fwd_kernel, dim3(grid), dim3(NTHR), LDS_BYTES, stream, a);
#else
    hipError_t e = hipLaunchCooperativeKernel((const void*)fwd_kernel, dim3(grid), dim3(NTHR), kargs, LDS_BYTES, stream);
    if (e != hipSuccess) fprintf(stderr, "kernel_launch: cooperative launch failed: %s (grid %d)\n", hipGetErrorString(e), grid);
#endif
#endif
}
```
